# Optimizing an MI355X kernel written in HIP

```python
import math
import jax, jax.numpy as jnp
from jax import lax
import numpy as np

D_MODEL = 1024
BATCH = 2
SEQ = 8192
DEPTH = 4

N_META = 16
BLK = 128
PAD_LEAD = BLK - N_META
D_MIX = 2 * D_MODEL
N_MIXERS = 4
D_GROUP = D_MIX // N_MIXERS
HEAD_DIM = 64
N_HG = D_GROUP // HEAD_DIM

FOX_HEADS = N_HG
MLA_HEADS = N_HG
MLA_NOPE = HEAD_DIM
MLA_ROPE = 32
MLA_V = HEAD_DIM
MLA_Q_RANK = D_MODEL // 4
MLA_KV_RANK = D_MODEL // 8
DSA_HEADS = N_HG
DSA_KV = 2
IDX_HEADS = 8
IDX_DIM = 64
TOPK_MAX = 256
SWA_HEADS = N_HG
SWA_KV = 2
WINDOW = 128
REL_BUCKETS = 32
REL_MAX_DIST = 128
ROPE_BASE = 10000.0
LN_EPS = 1e-5
RMS_EPS = 1e-6
NEG = -1e30
ALPHA = (2 * DEPTH) ** 0.25
BETA = (8 * DEPTH) ** -0.25

IN_COLS = (
    ('a_q', FOX_HEADS * HEAD_DIM), ('a_k', FOX_HEADS * HEAD_DIM), ('a_v', FOX_HEADS * HEAD_DIM),
    ('a_f', FOX_HEADS), ('a_g', D_GROUP),
    ('b_cq', MLA_Q_RANK), ('b_ckv', MLA_KV_RANK), ('b_kr', MLA_ROPE), ('b_g', D_GROUP),
    ('c_q', DSA_HEADS * HEAD_DIM), ('c_k', DSA_KV * HEAD_DIM), ('c_v', DSA_KV * HEAD_DIM),
    ('c_iq', IDX_HEADS * IDX_DIM), ('c_ik', IDX_DIM), ('c_iw', IDX_HEADS), ('c_g', D_GROUP),
    ('d_q', SWA_HEADS * HEAD_DIM), ('d_k', SWA_KV * HEAD_DIM), ('d_v', SWA_KV * HEAD_DIM), ('d_g', D_GROUP),
)
VALUE_COLS = ('a_v', 'c_v', 'd_v')
D_IN = sum(s for _, s in IN_COLS)

kernel_name = 'hymba_fox_mla_dsa_swa_deepnorm'


def split_cols(h):
    out = {}
    off = 0
    for name, size in IN_COLS:
        out[name] = h[..., off:off + size]
        off += size
    return out


def layer_norm(x, g, b):
    xf = x.astype(jnp.float32)
    mu = jnp.mean(xf, axis=-1, keepdims=True)
    var = jnp.mean(jnp.square(xf - mu), axis=-1, keepdims=True)
    y = (xf - mu) * lax.rsqrt(var + LN_EPS) * g.astype(jnp.float32) + b.astype(jnp.float32)
    return y.astype(x.dtype)


def rms_norm(x, g):
    xf = x.astype(jnp.float32)
    y = xf * lax.rsqrt(jnp.mean(jnp.square(xf), axis=-1, keepdims=True) + RMS_EPS) * g.astype(jnp.float32)
    return y.astype(x.dtype)


def rope(x, pos):
    half = x.shape[-1] // 2
    freqs = ROPE_BASE ** (-jnp.arange(half, dtype=jnp.float32) / half)
    ang = pos.astype(jnp.float32)[:, None] * freqs[None, :]
    cos = jnp.cos(ang)[:, None, :]
    sin = jnp.sin(ang)[:, None, :]
    x1 = x[..., :half].astype(jnp.float32)
    x2 = x[..., half:].astype(jnp.float32)
    return jnp.concatenate([x1 * cos - x2 * sin, x1 * sin + x2 * cos], axis=-1).astype(x.dtype)


def t5_bucket(dist):
    n = jnp.maximum(dist, 0)
    max_exact = REL_BUCKETS // 2
    nf = jnp.maximum(n, 1).astype(jnp.float32)
    large = max_exact + (jnp.log(nf / max_exact) / math.log(REL_MAX_DIST / max_exact)
                         * (REL_BUCKETS - max_exact)).astype(jnp.int32)
    large = jnp.minimum(large, REL_BUCKETS - 1)
    return jnp.where(n < max_exact, n, large)


def causal_dense_attention(q, k, v, key_valid, scale, decay=None):
    B, P, H, _ = q.shape
    dv = v.shape[-1]
    nb = P // BLK
    kpos = jnp.arange(P)

    def one_block(i):
        start = i * BLK
        qb = lax.dynamic_slice_in_dim(q, start, BLK, axis=1)
        tpos = start + jnp.arange(BLK)
        logits = jnp.einsum('bqhd,bkhd->bhqk', qb, k, preferred_element_type=jnp.float32) * scale
        if decay is not None:
            cq = lax.dynamic_slice_in_dim(decay, start, BLK, axis=2)
            logits = logits + cq[..., None] - decay[:, :, None, :]
        mask = (kpos[None, :] <= tpos[:, None]) & key_valid[None, :]
        probs = jax.nn.softmax(jnp.where(mask, logits, NEG), axis=-1)
        return jnp.einsum('bhqk,bkhd->bqhd', probs.astype(v.dtype), v)

    out = lax.map(one_block, jnp.arange(nb))
    return jnp.transpose(out, (1, 0, 2, 3, 4)).reshape(B, P, H * dv)


def mla_attention(c_q, c_kv, k_rope, g_q, g_kv, w_uq, w_ukv, pos, key_valid):
    B, P, _ = c_q.shape
    q = (rms_norm(c_q, g_q) @ w_uq).reshape(B, P, MLA_HEADS, MLA_NOPE + MLA_ROPE)
    q = jnp.concatenate([q[..., :MLA_NOPE], rope(q[..., MLA_NOPE:], pos)], axis=-1)
    kv = (rms_norm(c_kv, g_kv) @ w_ukv).reshape(B, P, MLA_HEADS, MLA_NOPE + MLA_V)
    k_pe = jnp.broadcast_to(rope(k_rope[:, :, None, :], pos), (B, P, MLA_HEADS, MLA_ROPE))
    k = jnp.concatenate([kv[..., :MLA_NOPE], k_pe], axis=-1)
    v = kv[..., MLA_NOPE:]
    return causal_dense_attention(q, k, v, key_valid, (MLA_NOPE + MLA_ROPE) ** -0.5)


def dsa_sparse_attention(q, k, v, iq, ik, iw, key_valid, rel_bias_c, top_k):
    B, P, G, R, d = q.shape
    nb = P // BLK
    kpos = jnp.arange(P)
    gather = jax.vmap(lambda arr, idx: arr[idx])

    def one_block(i):
        start = i * BLK
        tpos = start + jnp.arange(BLK)
        qb = lax.dynamic_slice_in_dim(q, start, BLK, axis=1)
        iqb = lax.dynamic_slice_in_dim(iq, start, BLK, axis=1)
        iwb = lax.dynamic_slice_in_dim(iw, start, BLK, axis=1)
        s = jnp.einsum('bqhd,bkd->bqhk', iqb, ik, preferred_element_type=jnp.float32) * IDX_DIM ** -0.5
        score = jnp.einsum('bqhk,bqh->bqk', jax.nn.relu(s), iwb.astype(jnp.float32)) * IDX_HEADS ** -0.5
        adm = (kpos[None, :] <= tpos[:, None]) & key_valid[None, :]
        score = jnp.where(adm[None], score, NEG)
        _, idx = lax.top_k(score, top_k)
        k_sel = gather(k, idx)
        v_sel = gather(v, idx)
        logits = jnp.einsum('bqgrd,bqkgd->bgrqk', qb, k_sel, preferred_element_type=jnp.float32) * d ** -0.5
        bias = rel_bias_c[t5_bucket(tpos[None, :, None] - idx)].astype(jnp.float32)
        bias = bias.reshape(B, BLK, top_k, G, R).transpose(0, 3, 4, 1, 2)
        sel_ok = (idx <= tpos[None, :, None]) & key_valid[idx]
        logits = jnp.where(sel_ok[:, None, None], logits + bias, NEG)
        probs = jax.nn.softmax(logits, axis=-1)
        return jnp.einsum('bgrqk,bqkgd->bqgrd', probs.astype(v.dtype), v_sel)

    out = lax.map(one_block, jnp.arange(nb))
    return jnp.transpose(out, (1, 0, 2, 3, 4, 5)).reshape(B, P, G * R * d)


def sliding_window_sink_attention(q, k, v, key_valid, rel_bias_d, sinks):
    B, P, G, R, d = q.shape
    nb = P // BLK
    qb = q.reshape(B, nb, BLK, G, R, d)
    kb = k.reshape(B, nb, BLK, G, d)
    vb = v.reshape(B, nb, BLK, G, d)
    zero = jnp.zeros_like(kb[:, :1])
    kk = jnp.concatenate([jnp.concatenate([zero, kb[:, :-1]], axis=1), kb], axis=2)
    vv = jnp.concatenate([jnp.concatenate([zero, vb[:, :-1]], axis=1), vb], axis=2)
    qi = jnp.arange(BLK)
    kj = jnp.arange(2 * BLK)
    dist = BLK + qi[:, None] - kj[None, :]
    kabs = (jnp.arange(nb)[:, None] - 1) * BLK + kj[None, :]
    kval = (kabs >= 0) & key_valid[jnp.clip(kabs, 0, P - 1)]
    mask = ((dist >= 0) & (dist < WINDOW))[None] & kval[:, None, :]
    bias = rel_bias_d[t5_bucket(dist)].astype(jnp.float32)
    bias = bias.reshape(BLK, 2 * BLK, G, R).transpose(2, 3, 0, 1)
    logits = jnp.einsum('bnqgrd,bnkgd->bngrqk', qb, kk, preferred_element_type=jnp.float32) * d ** -0.5 + bias
    logits = jnp.where(mask[None, :, None, None], logits, NEG)
    sink = sinks.astype(jnp.float32).reshape(G, R)[None, None, :, :, None, None]
    m = jnp.maximum(jnp.max(logits, axis=-1, keepdims=True), sink)
    e = jnp.exp(logits - m)
    probs = e / (jnp.sum(e, axis=-1, keepdims=True) + jnp.exp(sink - m))
    out = jnp.einsum('bngrqk,bnkgd->bnqgrd', probs.astype(v.dtype), vv)
    return out.reshape(B, P, G * R * d)


def hybrid_layer(x, pos, key_valid, rel_bias, top_k, w_in, b_f, g_q, g_kv, w_uq, w_ukv, sinks, w_out, ln_g, ln_b):
    B, P, _ = x.shape
    h = split_cols(x @ w_in)
    qa = h['a_q'].reshape(B, P, FOX_HEADS, HEAD_DIM)
    ka = h['a_k'].reshape(B, P, FOX_HEADS, HEAD_DIM)
    va = h['a_v'].reshape(B, P, FOX_HEADS, HEAD_DIM)
    logf = jax.nn.log_sigmoid(h['a_f'].astype(jnp.float32) + b_f.astype(jnp.float32))
    decay = jnp.transpose(jnp.cumsum(logf, axis=1), (0, 2, 1))
    out_a = causal_dense_attention(qa, ka, va, key_valid, HEAD_DIM ** -0.5, decay)
    out_b = mla_attention(h['b_cq'], h['b_ckv'], h['b_kr'], g_q, g_kv, w_uq, w_ukv, pos, key_valid)
    rc = DSA_HEADS // DSA_KV
    out_c = dsa_sparse_attention(
        h['c_q'].reshape(B, P, DSA_KV, rc, HEAD_DIM),
        h['c_k'].reshape(B, P, DSA_KV, HEAD_DIM),
        h['c_v'].reshape(B, P, DSA_KV, HEAD_DIM),
        h['c_iq'].reshape(B, P, IDX_HEADS, IDX_DIM), h['c_ik'], h['c_iw'],
        key_valid, rel_bias[:, :DSA_HEADS], top_k)
    rd = SWA_HEADS // SWA_KV
    out_d = sliding_window_sink_attention(
        h['d_q'].reshape(B, P, SWA_KV, rd, HEAD_DIM),
        h['d_k'].reshape(B, P, SWA_KV, HEAD_DIM),
        h['d_v'].reshape(B, P, SWA_KV, HEAD_DIM),
        key_valid, rel_bias[:, DSA_HEADS:], sinks)
    mixed = jnp.concatenate([
        out_a * jax.nn.silu(h['a_g']), out_b * jax.nn.silu(h['b_g']),
        out_c * jax.nn.silu(h['c_g']), out_d * jax.nn.silu(h['d_g'])], axis=-1)
    y = mixed @ w_out
    return layer_norm(ALPHA * x + y, ln_g, ln_b)


def setup_inputs(seed: int = 0) -> dict:
    key = jax.random.key(seed)
    ks = jax.random.split(key, 16)
    f32 = jnp.float32
    col_scale = jnp.asarray(np.concatenate(
        [np.full((s,), BETA if name in VALUE_COLS else 1.0, dtype=np.float32) for name, s in IN_COLS]))
    ukv_scale = jnp.concatenate([jnp.ones((MLA_HEADS, MLA_NOPE), f32),
                                 jnp.full((MLA_HEADS, MLA_V), BETA, f32)], axis=-1).reshape(-1)
    return {
        'x': jax.random.normal(ks[0], (BATCH, SEQ, D_MODEL), f32),
        'meta_tokens': jax.random.normal(ks[1], (N_META, D_MODEL), f32),
        'ln0_g': 1.0 + 0.02 * jax.random.normal(ks[2], (D_MODEL,), f32),
        'ln0_b': 0.02 * jax.random.normal(ks[3], (D_MODEL,), f32),
        'rel_bias': 0.5 * jax.random.normal(ks[4], (REL_BUCKETS, DSA_HEADS + SWA_HEADS), f32),
        'w_in': jax.random.normal(ks[5], (DEPTH, D_MODEL, D_IN), f32) * D_MODEL ** -0.5 * col_scale,
        'b_f': 1.0 + 0.1 * jax.random.normal(ks[6], (DEPTH, FOX_HEADS), f32),
        'mla_gq': 1.0 + 0.02 * jax.random.normal(ks[7], (DEPTH, MLA_Q_RANK), f32),
        'mla_gkv': 1.0 + 0.02 * jax.random.normal(ks[8], (DEPTH, MLA_KV_RANK), f32),
        'w_uq': jax.random.normal(ks[9], (DEPTH, MLA_Q_RANK, MLA_HEADS * (MLA_NOPE + MLA_ROPE)), f32) * MLA_Q_RANK ** -0.5,
        'w_ukv': jax.random.normal(ks[10], (DEPTH, MLA_KV_RANK, MLA_HEADS * (MLA_NOPE + MLA_V)), f32) * MLA_KV_RANK ** -0.5 * ukv_scale,
        'sinks': 0.5 * jax.random.normal(ks[11], (DEPTH, SWA_HEADS), f32),
        'w_out': jax.random.normal(ks[12], (DEPTH, D_MIX, D_MODEL), f32) * D_MIX ** -0.5 * BETA,
        'ln_g': 1.0 + 0.02 * jax.random.normal(ks[13], (DEPTH, D_MODEL), f32),
        'ln_b': 0.02 * jax.random.normal(ks[14], (DEPTH, D_MODEL), f32),
    }


def reference(x, meta_tokens, ln0_g, ln0_b, rel_bias, w_in, b_f, mla_gq, mla_gkv, w_uq, w_ukv, sinks, w_out, ln_g, ln_b):
    B, S, D = x.shape
    lead = jnp.concatenate([jnp.zeros((B, PAD_LEAD, D), x.dtype),
                            jnp.broadcast_to(meta_tokens[None].astype(x.dtype), (B, N_META, D))], axis=1)
    h = jnp.concatenate([lead, x], axis=1)
    P = h.shape[1]
    pos = jnp.arange(P) - PAD_LEAD
    key_valid = pos >= 0
    top_k = min(TOPK_MAX, S // 4)
    h = layer_norm(h, ln0_g, ln0_b)
    for l in range(DEPTH):
        h = hybrid_layer(h, pos, key_valid, rel_bias, top_k, w_in[l], b_f[l], mla_gq[l], mla_gkv[l],
                         w_uq[l], w_ukv[l], sinks[l], w_out[l], ln_g[l], ln_b[l])
    return h[:, BLK:]
```

```cpp
#include <hip/hip_runtime.h>
#include <hip/hip_cooperative_groups.h>
#include <cstdio>
namespace cg = cooperative_groups;

#define DI __device__ __forceinline__
typedef __attribute__((ext_vector_type(8))) short bf16x8;
typedef __attribute__((ext_vector_type(16))) float f32x16;
typedef __attribute__((ext_vector_type(4))) float f32x4;
typedef __attribute__((ext_vector_type(2))) float f32x2;
typedef __attribute__((ext_vector_type(2))) __bf16 bf2_t;
typedef __attribute__((ext_vector_type(4))) unsigned u32x4;
typedef __attribute__((ext_vector_type(2))) unsigned u32x2;
typedef unsigned short u16;
#define MFMA32(a, b, c) __builtin_amdgcn_mfma_f32_32x32x16_bf16((a), (b), (c), 0, 0, 0)

constexpr int NB = 2, PP = 8448, PV = 8320, LEAD = 112, DM = 1024, MT = NB * PP, SEQ = 8192;
constexpr int LDH = 5376, NIN = 6144;
constexpr int HQ_A = 0, HK_A = 512, HG_A = 1024, HCQ_B = 1536, HCKV_B = 1792, HG_B = 1920, HQ_C = 2432, HK_C = 2944, HV_C = 3072,
              HIQ_C = 3200, HG_C = 3712, HQ_D = 4224, HK_D = 4736, HG_D = 4864;
constexpr int D_IN = 6128;
constexpr float LOG2E = 1.4426950408889634f;
constexpr float NEGL = -1e30f;
constexpr float ALPHA = 1.681792830507429f;
constexpr int LDS_JOB = 135168;
constexpr int LDS_BYTES = LDS_JOB + 64;
constexpr int GEMM_STAGE = 55296;
constexpr int NTHREADS = 512;
#define REP_P1 1
#define REP_P2 1
#define REP_P3 1
#define SC_FOX 1.0f
#define SC_MLA 1.0f
#define SC_SWA 1.0f
#define SC_DSA 1.0f

struct Params {
  const float *x, *meta, *ln0_g, *ln0_b, *rel_bias, *w_in, *b_f, *gq, *gkv, *w_uq, *w_ukv, *sinks, *w_out, *ln_g, *ln_b;
  float* out;
  u16 *Wt_in, *Wt_out, *Wt_uq, *Wt_ukv;
  u16 *H, *Xb, *Mix, *VtA, *VtD, *VtB, *Qm, *Km, *Kpe, *IK, *IDX;
  float *R, *LOGF, *CUM, *IW, *ROPE;
  unsigned* ctr;
  unsigned* bar;
};

DI unsigned pk2(float a, float b) { f32x2 v = {a, b}; return __builtin_bit_cast(unsigned, __builtin_convertvector(v, bf2_t)); }
DI float bf_lo(unsigned u) { return __uint_as_float(u << 16); }
DI float bf_hi(unsigned u) { return __uint_as_float(u & 0xffff0000u); }
DI int opaque_tid() { int t = threadIdx.x; asm volatile("" : "+v"(t)); return t; }
DI int crow(int i, int h) { return (i & 3) + 8 * (i >> 2) + 4 * h; }
DI float wsum(float v) { for (int o = 32; o > 0; o >>= 1) v += __shfl_xor(v, o); return v; }
DI float wmax(float v) { for (int o = 32; o > 0; o >>= 1) v = fmaxf(v, __shfl_xor(v, o)); return v; }
DI int wsumi(int v) { for (int o = 32; o > 0; o >>= 1) v += __shfl_xor(v, o); return v; }
DI float silu(float g) { return g / (1.f + __expf(-g)); }
DI float dot2(unsigned a, unsigned b, float c) { return __builtin_amdgcn_fdot2_f32_bf16(__builtin_bit_cast(bf2_t, a), __builtin_bit_cast(bf2_t, b), c, false); }
template <int CTRL> DI float dpp_add(float v) { return v + __int_as_float(__builtin_amdgcn_mov_dpp(__float_as_int(v), CTRL, 0xF, 0xF, true)); }
DI int t5_bucket(int n) {
  if (n < 16) return n;
  int lg = 16 + (int)(logf((float)n / 16.f) / logf(8.f) * 16.f);
  return lg < 31 ? lg : 31;
}

DI int next_job(unsigned* ctr, char* lds, int& pending, int njobs) {
  int* sj = (int*)(lds + LDS_JOB);
  __syncthreads();
  if (threadIdx.x == 0) *sj = pending;
  __syncthreads();
  const int j = *sj;
  if (threadIdx.x == 0 && j < njobs) pending = (int)atomicAdd(ctr, 1u);
  return j;
}

template <bool SWAP, class Epi>
DI void gemm_tile(const u16* __restrict__ A, int lda, const u16* __restrict__ Bw, int ldb, int K, char* lds, Epi epi) {
  const int tid = opaque_tid(), lane = tid & 63, w = tid >> 6, r = lane & 31, h = lane >> 5;
  const int wm = w & 3, wn = w >> 2;
  f32x16 acc[2][2];
#pragma unroll
  for (int a = 0; a < 2; ++a)
#pragma unroll
    for (int b = 0; b < 2; ++b)
#pragma unroll
      for (int i = 0; i < 16; ++i) acc[a][b][i] = 0.f;
  const int lrow = tid >> 3, lkc = tid & 7;
  u32x4 ra0[4], rb0[2], ra1[4], rb1[2];
  const u16* ap = A + (size_t)lrow * lda + lkc * 8;
  const u16* bp = Bw + (size_t)lrow * ldb + lkc * 8;
  const int nk = K >> 6;
  auto gload = [&](int kt, u32x4* ra, u32x4* rb) {
#pragma unroll
    for (int j = 0; j < 4; ++j) ra[j] = *(const u32x4*)(ap + (size_t)(64 * j) * lda + kt * 64);
#pragma unroll
    for (int j = 0; j < 2; ++j) rb[j] = *(const u32x4*)(bp + (size_t)(64 * j) * ldb + kt * 64);
  };
  auto lstore = [&](int st, const u32x4* ra, const u32x4* rb) {
    char* base = lds + st * GEMM_STAGE;
#pragma unroll
    for (int j = 0; j < 4; ++j) *(u32x4*)(base + ((lrow + 64 * j) * 72 + lkc * 8) * 2) = ra[j];
#pragma unroll
    for (int j = 0; j < 2; ++j) *(u32x4*)(base + 36864 + ((lrow + 64 * j) * 72 + lkc * 8) * 2) = rb[j];
  };
  auto compute = [&](int st) {
    const char* as = lds + st * GEMM_STAGE;
    const char* bs = as + 36864;
#pragma unroll
    for (int ks = 0; ks < 4; ++ks) {
      bf16x8 af[2], bfr[2];
#pragma unroll
      for (int mi = 0; mi < 2; ++mi) af[mi] = *(const bf16x8*)(as + ((wm * 64 + mi * 32 + r) * 72 + ks * 16 + 8 * h) * 2);
#pragma unroll
      for (int ni = 0; ni < 2; ++ni) bfr[ni] = *(const bf16x8*)(bs + ((wn * 64 + ni * 32 + r) * 72 + ks * 16 + 8 * h) * 2);
#pragma unroll
      for (int mi = 0; mi < 2; ++mi)
#pragma unroll
        for (int ni = 0; ni < 2; ++ni) {
          if (SWAP) acc[mi][ni] = MFMA32(bfr[ni], af[mi], acc[mi][ni]);
          else acc[mi][ni] = MFMA32(af[mi], bfr[ni], acc[mi][ni]);
        }
    }
  };
  gload(0, ra0, rb0);
  lstore(0, ra0, rb0);
  gload(1, ra1, rb1);
  __syncthreads();
  for (int kt = 0; kt < nk; kt += 2) {
    if (kt + 2 < nk) gload(kt + 2, ra0, rb0);
    compute(0);
    lstore(1, ra1, rb1);
    __syncthreads();
    if (kt + 3 < nk) gload(kt + 3, ra1, rb1);
    compute(1);
    if (kt + 2 < nk) lstore(0, ra0, rb0);
    __syncthreads();
  }
#pragma unroll
  for (int mi = 0; mi < 2; ++mi)
#pragma unroll
    for (int ni = 0; ni < 2; ++ni) epi(mi, ni, acc[mi][ni]);
}

DI void store_rowmajor(u16* dst, const f32x16& a, int h, float sc) {
#pragma unroll
  for (int kp = 0; kp < 2; ++kp) {
    const int g = 2 * kp;
    unsigned ax = pk2(a[4 * g] * sc, a[4 * g + 1] * sc), ay = pk2(a[4 * g + 2] * sc, a[4 * g + 3] * sc);
    unsigned bx = pk2(a[4 * g + 4] * sc, a[4 * g + 5] * sc), by = pk2(a[4 * g + 6] * sc, a[4 * g + 7] * sc);
    const u32x2 rx = __builtin_amdgcn_permlane32_swap(ax, bx, false, false);
    const u32x2 ry = __builtin_amdgcn_permlane32_swap(ay, by, false, false);
    const u32x4 v = {rx[0], ry[0], rx[1], ry[1]};
    *(u32x4*)(dst + 8 * (g + h)) = v;
  }
}
DI void store_rope(u16* dst, const f32x16& a, int h, float sc, const float* rp) {
#pragma unroll
  for (int g = 0; g < 2; ++g) {
    f32x4 cs = *(const f32x4*)(rp + 8 * g + 4 * h);
    f32x4 sn = *(const f32x4*)(rp + 16 + 8 * g + 4 * h);
    float o1[4], o2[4];
#pragma unroll
    for (int e = 0; e < 4; ++e) {
      float x1 = a[4 * g + e] * sc, x2 = a[8 + 4 * g + e] * sc;
      o1[e] = x1 * cs[e] - x2 * sn[e];
      o2[e] = x1 * sn[e] + x2 * cs[e];
    }
    u32x2 v1 = {pk2(o1[0], o1[1]), pk2(o1[2], o1[3])};
    u32x2 v2 = {pk2(o2[0], o2[1]), pk2(o2[2], o2[3])};
    *(u32x2*)(dst + 8 * g + 4 * h) = v1;
    *(u32x2*)(dst + 16 + 8 * g + 4 * h) = v2;
  }
}
DI void store_transposed(u16* dst, const f32x16& a, int h, const float* rs  ) {
#pragma unroll
  for (int g = 0; g < 4; ++g) {
    float s0 = 1.f, s1 = 1.f, s2 = 1.f, s3 = 1.f;
    if (rs) { f32x4 sv = *(const f32x4*)(rs + 8 * g + 4 * h); s0 = sv[0]; s1 = sv[1]; s2 = sv[2]; s3 = sv[3]; }
    u32x2 v = {pk2(a[4 * g] * s0, a[4 * g + 1] * s1), pk2(a[4 * g + 2] * s2, a[4 * g + 3] * s3)};
    *(u32x2*)(dst + 8 * g + 4 * h) = v;
  }
}

DI void inproj_tile(const Params& p, int l, int mt, int nt, char* lds) {
  const int tid = opaque_tid(), lane = tid & 63, w = tid >> 6, r = lane & 31, h = lane >> 5;
  const int wm = w & 3, wn = w >> 2;
  const int m0 = mt * 256;
  const u16* A = p.Xb + (size_t)m0 * DM;
  const u16* Bw = p.Wt_in + (size_t)nt * 128 * DM;
  if (nt < 42) {
    float ssq = 0.f;
    gemm_tile<true>(A, DM, Bw, DM, DM, lds, [&](int mi, int ni, const f32x16& a) {
      const int tok = m0 + wm * 64 + mi * 32 + r;
      store_rowmajor(p.H + (size_t)tok * LDH + nt * 128 + wn * 64 + ni * 32, a, h, 1.f);
      if (nt >= 4 && nt < 8) {
        if (ni == 0) ssq = 0.f;
#pragma unroll
        for (int i = 0; i < 16; ++i) ssq += a[i] * a[i];
        if (ni == 1) {
          float tot = ssq + __shfl_xor(ssq, 32);
          tot = wmax(tot);
          if (lane == 0) atomicMax(p.ctr + 64 + l * 16 + (m0 / PP) * 8 + (nt - 4) * 2 + wn, __float_as_uint(sqrtf(tot) * 1.01f));
        }
      }
    });
  } else if (nt == 42) {
    gemm_tile<true>(A, DM, Bw, DM, DM, lds, [&](int mi, int ni, const f32x16& a) {
      const int tok = m0 + wm * 64 + mi * 32 + r;
      const int b = tok / PP, t = tok - b * PP;
      const int sub = wn * 2 + ni;
      if (sub == 0) {
        store_rope(p.Kpe + (size_t)tok * 32, a, h, 1.f, p.ROPE + (size_t)t * 32);
      } else if (sub == 1) {
        store_rowmajor(p.IK + (size_t)tok * 64, a, h, 1.f);
      } else if (sub == 2) {
        store_rowmajor(p.IK + (size_t)tok * 64 + 32, a, h, 1.f);
      } else {
#pragma unroll
        for (int e = 0; e < 4; ++e) {
          const int hd = e + 4 * h;
          float xv = a[e] + p.b_f[l * 8 + hd];
          float lf = fminf(xv, 0.f) - log1pf(expf(-fabsf(xv)));
          p.LOGF[(size_t)(b * 8 + hd) * PP + t] = lf;
          p.IW[(size_t)tok * 8 + hd] = a[4 + e];
        }
      }
    });
  } else {
    u16* vt; int nv, c0;
    if (nt < 47) { vt = p.VtA; nv = 512; c0 = (nt - 43) * 128; } else { vt = p.VtD; nv = 128; c0 = 0; }
    gemm_tile<false>(A, DM, Bw, DM, DM, lds, [&](int mi, int ni, const f32x16& a) {
      const int b = m0 / PP, t0 = m0 - b * PP + wm * 64 + mi * 32;
      const int col = c0 + wn * 64 + ni * 32 + r;
      store_transposed(vt + ((size_t)b * nv + col) * PP + t0, a, h, nullptr);
    });
  }
}

DI void upproj_tile(const Params& p, int mt, int nt14, char* lds) {
  const int tid = opaque_tid(), lane = tid & 63, w = tid >> 6, r = lane & 31, h = lane >> 5;
  const int wm = w & 3, wn = w >> 2;
  const int m0 = mt * 256;
  float* rs = (float*)(lds + 2 * GEMM_STAGE);
  const bool isq = nt14 < 6;
  {
    const int row = tid >> 1, half = tid & 1;
    const int kw = isq ? 128 : 64;
    const u16* src = p.H + (size_t)(m0 + row) * LDH + (isq ? HCQ_B : HCKV_B) + half * kw;
    float ss = 0.f;
    u32x4 rv[16];
#pragma unroll
    for (int c = 0; c < 8; ++c) rv[c] = *(const u32x4*)(src + c * 8);
    if (isq) {
#pragma unroll
      for (int c = 8; c < 16; ++c) rv[c] = *(const u32x4*)(src + c * 8);
    } else {
#pragma unroll
      for (int c = 8; c < 16; ++c) { rv[c][0] = 0u; rv[c][1] = 0u; rv[c][2] = 0u; rv[c][3] = 0u; }
    }
#pragma unroll
    for (int c = 0; c < 16; ++c)
#pragma unroll
      for (int e = 0; e < 4; ++e) { float a = bf_lo(rv[c][e]), b2 = bf_hi(rv[c][e]); ss += a * a + b2 * b2; }
    ss += __shfl_xor(ss, 1);
    if (half == 0) rs[row] = rsqrtf(ss / (isq ? 256.f : 128.f) + 1e-6f);
  }
  __syncthreads();
  if (isq) {
    const int nt = nt14;
    gemm_tile<true>(p.H + (size_t)m0 * LDH + HCQ_B, LDH, p.Wt_uq + (size_t)nt * 128 * 256, 256, 256, lds, [&](int mi, int ni, const f32x16& a) {
      const int lr = wm * 64 + mi * 32 + r;
      const int tok = m0 + lr;
      const int t = tok % PP;
      const int j32 = nt * 4 + wn * 2 + ni;
      const float sc = rs[lr];
      u16* dst = p.Qm + (size_t)tok * 768 + j32 * 32;
      if (j32 % 3 == 2) store_rope(dst, a, h, sc, p.ROPE + (size_t)t * 32);
      else store_rowmajor(dst, a, h, sc);
    });
  } else {
    const int nt = nt14 - 6;
    const u16* A = p.H + (size_t)m0 * LDH + HCKV_B;
    const u16* Bw = p.Wt_ukv + (size_t)nt * 128 * 128;
    if (nt < 4) {
      gemm_tile<true>(A, LDH, Bw, 128, 128, lds, [&](int mi, int ni, const f32x16& a) {
        const int lr = wm * 64 + mi * 32 + r;
        store_rowmajor(p.Km + (size_t)(m0 + lr) * 512 + nt * 128 + wn * 64 + ni * 32, a, h, rs[lr]);
      });
    } else {
      gemm_tile<false>(A, LDH, Bw, 128, 128, lds, [&](int mi, int ni, const f32x16& a) {
        const int b = m0 / PP, t0 = m0 - b * PP + wm * 64 + mi * 32;
        const int col = (nt - 4) * 128 + wn * 64 + ni * 32 + r;
        store_transposed(p.VtB + ((size_t)b * 512 + col) * PP + t0, a, h, rs + wm * 64 + mi * 32);
      });
    }
  }
}

DI void cumsum_job(const Params& p, int j, char* lds) {
  const int tid = opaque_tid(), lane = tid & 63, w = tid >> 6;
  const float* src = p.LOGF + (size_t)j * PP;
  float* dst = p.CUM + (size_t)j * PP;
  float* wt = (float*)lds;
  float v[17];
#pragma unroll
  for (int rr = 0; rr < 17; ++rr) {
    const int o = rr * 64 + lane, i = w * 1056 + o;
    v[rr] = (o < 1056 && i >= LEAD) ? src[i] : 0.f;
  }
  float carry = 0.f;
#pragma unroll
  for (int rr = 0; rr < 17; ++rr) {
    float inc = v[rr];
    for (int o = 1; o < 64; o <<= 1) { float x = __shfl_up(inc, o); if (lane >= o) inc += x; }
    v[rr] = inc + carry;
    carry += __shfl(inc, 63);
  }
  if (lane == 0) wt[w] = carry;
  __syncthreads();
  float base = 0.f;
  for (int k = 0; k < w; ++k) base += wt[k];
#pragma unroll
  for (int rr = 0; rr < 17; ++rr) {
    const int o = rr * 64 + lane;
    if (o < 1056) dst[w * 1056 + o] = v[rr] + base;
  }
}

DI void topk_job(const Params& p, int b, int t0, char* lds) {
  const int tid = opaque_tid(), lane = tid & 63, w = tid >> 6, r = lane & 31, h = lane >> 5;
  const int cmax = (t0 + 3) >> 6;
  unsigned sc[17][4];
  {
    const u16* iqp = p.H + (size_t)(b * PP + t0 + (r >> 3)) * LDH + HIQ_C + (r & 7) * 64 + 8 * h;
    bf16x8 af[4];
#pragma unroll
    for (int ks = 0; ks < 4; ++ks) af[ks] = *(const bf16x8*)(iqp + ks * 16);
    f32x4 iw[4];
#pragma unroll
    for (int qi = 0; qi < 4; ++qi) iw[qi] = *(const f32x4*)(p.IW + (size_t)(b * PP + t0 + qi) * 8 + 4 * h);
    char* wb = lds + 16384 + w * 9216;
    const int lrow = lane >> 3, lpc = lane & 7;
    const u16* ikb = p.IK + ((size_t)(b * PP) + lrow) * 64 + lpc * 8;
    u32x4 st[8];
    if (1 + w <= cmax) {
      const u16* kp = ikb + (size_t)(1 + w) * 64 * 64;
#pragma unroll
      for (int j = 0; j < 8; ++j) st[j] = *(const u32x4*)(kp + (size_t)j * 8 * 64);
#pragma unroll
      for (int j = 0; j < 8; ++j) *(u32x4*)(wb + (lrow + 8 * j) * 144 + lpc * 16) = st[j];
    }
#pragma unroll
    for (int i = 0; i < 17; ++i) {
      const int c = 1 + w + 8 * i;
      if (c <= cmax) {
        const bool more = c + 8 <= cmax;
        if (more) {
          const u16* kp = ikb + (size_t)(c + 8) * 64 * 64;
#pragma unroll
          for (int j = 0; j < 8; ++j) st[j] = *(const u32x4*)(kp + (size_t)j * 8 * 64);
        }
        bf16x8 b0[4], b1[4];
#pragma unroll
        for (int ks = 0; ks < 4; ++ks) {
          b0[ks] = *(const bf16x8*)(wb + r * 144 + ks * 32 + h * 16);
          b1[ks] = *(const bf16x8*)(wb + (32 + r) * 144 + ks * 32 + h * 16);
        }
        __builtin_amdgcn_sched_barrier(0);
        f32x16 a0, a1;
#pragma unroll
        for (int e = 0; e < 16; ++e) { a0[e] = 0.f; a1[e] = 0.f; }
#pragma unroll
        for (int ks = 0; ks < 4; ++ks) { a0 = MFMA32(af[ks], b0[ks], a0); a1 = MFMA32(af[ks], b1[ks], a1); }
        const int key = c * 64 + lane;
#pragma unroll
        for (int qi = 0; qi < 4; ++qi) {
          float p0 = 0.f, p1 = 0.f;
#pragma unroll
          for (int e = 0; e < 4; ++e) {
            p0 += fmaxf(a0[4 * qi + e], 0.f) * iw[qi][e];
            p1 += fmaxf(a1[4 * qi + e], 0.f) * iw[qi][e];
          }
          const u32x2 sw = __builtin_amdgcn_permlane32_swap(__float_as_uint(p0), __float_as_uint(p1), false, false);
          float mine = __uint_as_float(sw[0]) + __uint_as_float(sw[1]);
          mine += 0.0f;
          unsigned u = __float_as_uint(mine);
          u = (u & 0x80000000u) ? ~u : (u | 0x80000000u);
          if (key > t0 + qi || key < LEAD) u = 0u;
          sc[i][qi] = u;
        }
        if (more) {
#pragma unroll
          for (int j = 0; j < 8; ++j) *(u32x4*)(wb + (lrow + 8 * j) * 144 + lpc * 16) = st[j];
        }
      } else {
#pragma unroll
        for (int qi = 0; qi < 4; ++qi) sc[i][qi] = 0u;
      }
    }
  }
  int* ng = (int*)(lds + 256);
  unsigned long long* mg = (unsigned long long*)(lds + 1024);
  unsigned long long* me = mg + 4 * 132;
  int* bg = (int*)(me + 4 * 132);
  int* be = bg + 4 * 132;
  unsigned T[4];
  {
    unsigned* hist = (unsigned*)(lds + 16384);
    int* sel = (int*)(lds + 512);
    unsigned pref[4] = {0u, 0u, 0u, 0u};
    int chi[4] = {0, 0, 0, 0};
    bool few[4] = {false, false, false, false};
    __syncthreads();
#pragma unroll
    for (int pass = 0; pass < 3; ++pass) {
      {
        const u32x4 z = {0u, 0u, 0u, 0u};
#pragma unroll
        for (int j = 0; j < 8; ++j) ((u32x4*)hist)[tid + 512 * j] = z;
      }
      __syncthreads();
#pragma unroll
      for (int i = 0; i < 17; ++i) {
#pragma unroll
        for (int q = 0; q < 4; ++q) {
          const unsigned u = sc[i][q];
          bool part; unsigned bin;
          if (pass == 0) { part = (u != 0u); bin = (u >> 22) + (lane & 3) * 1024; }
          else if (pass == 1) { part = (u != 0u) && ((u >> 22) == pref[q]) && !few[q]; bin = ((u >> 12) & 1023u) + (lane & 3) * 1024; }
          else { part = (u != 0u) && ((u >> 12) == pref[q]) && !few[q]; bin = u & 4095u; }
          if (part) atomicAdd(hist + q * 4096 + bin, 1u);
        }
      }
      __syncthreads();
      if (w < 4) {
        const int q = w;
        const unsigned* hq = hist + q * 4096;
        const int need = 256 - chi[q];
        int G = 0;
        if (pass < 2) {
#pragma unroll
          for (int rep = 0; rep < 4; ++rep)
#pragma unroll
            for (int j = 0; j < 16; ++j) G += (int)hq[rep * 1024 + 16 * lane + ((j + lane) & 15)];
        } else {
#pragma unroll 8
          for (int j = 0; j < 64; ++j) G += (int)hq[64 * lane + ((j + lane) & 63)];
        }
        int S = G;
        for (int o = 1; o < 64; o <<= 1) { int x = __shfl_down(S, o); if (lane + o < 64) S += x; }
        const unsigned long long mk = __ballot(S >= need);
        int B = 0, cg2 = 0, fw = 0;
        if (mk == 0ull) {
          fw = 1;
        } else {
          const int ks = 63 - __clzll(mk);
          const int above = (ks < 63) ? __shfl(S, ks + 1) : 0;
          int hh;
          if (pass < 2) {
            hh = 0;
            if (lane < 16) hh = (int)(hq[16 * ks + lane] + hq[1024 + 16 * ks + lane] + hq[2048 + 16 * ks + lane] + hq[3072 + 16 * ks + lane]);
          } else {
            hh = (int)hq[64 * ks + lane];
          }
          int s2 = hh;
          for (int o = 1; o < 64; o <<= 1) { int x = __shfl_down(s2, o); if (lane + o < 64) s2 += x; }
          const unsigned long long m2 = __ballot(above + s2 >= need);
          const int Ls = 63 - __clzll(m2);
          B = (pass < 2 ? 16 : 64) * ks + Ls;
          cg2 = above + __shfl(s2, Ls) - __shfl(hh, Ls);
        }
        if (lane == 0) { sel[q * 4 + 0] = B; sel[q * 4 + 1] = chi[q] + cg2; sel[q * 4 + 2] = fw; }
      }
      __syncthreads();
#pragma unroll
      for (int q = 0; q < 4; ++q) {
        if (!few[q]) {
          pref[q] = (pref[q] << (pass < 2 ? 10 : 12)) | (unsigned)sel[q * 4 + 0];
          chi[q] = sel[q * 4 + 1];
          if (pass == 0) few[q] = sel[q * 4 + 2] != 0;
        }
      }
    }
#pragma unroll
    for (int q = 0; q < 4; ++q) T[q] = few[q] ? 0u : pref[q];
  }
  unsigned* cntb = (unsigned*)mg;
  unsigned* baseb = (unsigned*)bg;
#pragma unroll
  for (int i = 0; i < 17; ++i) {
    const int c = 1 + w + 8 * i;
    if (c <= cmax) {
      unsigned mine = 0u;
#pragma unroll
      for (int q = 0; q < 4; ++q) {
        const unsigned pk = (unsigned)__popcll(__ballot(sc[i][q] > T[q])) | ((unsigned)__popcll(__ballot(sc[i][q] == T[q])) << 16);
        mine = (lane == q) ? pk : mine;
      }
      if (lane < 4) cntb[lane * 132 + c] = mine;
    }
  }
  __syncthreads();
  if (w < 4) {
    const int q = w;
    int cg_ = 0, ce_ = 0;
    for (int base = 0; base <= cmax; base += 64) {
      const int c = base + lane;
      const bool in = (c >= 1) && (c <= cmax);
      const unsigned cv = in ? cntb[q * 132 + c] : 0u;
      const int v1 = (int)(cv & 0xffffu), v2 = (int)(cv >> 16);
      int i1 = v1, i2 = v2;
      for (int o = 1; o < 64; o <<= 1) {
        int x1 = __shfl_up(i1, o), x2 = __shfl_up(i2, o);
        if (lane >= o) { i1 += x1; i2 += x2; }
      }
      if (in) baseb[q * 132 + c] = (unsigned)(cg_ + i1 - v1) | ((unsigned)(ce_ + i2 - v2) << 16);
      cg_ += __shfl(i1, 63);
      ce_ += __shfl(i2, 63);
    }
    if (lane == 0) ng[q] = cg_;
  }
  __syncthreads();
  const unsigned long long lt = (1ull << lane) - 1ull;
#pragma unroll
  for (int i = 0; i < 17; ++i) {
    const int c = 1 + w + 8 * i;
    if (c <= cmax) {
      const int key = c * 64 + lane;
#pragma unroll
      for (int q = 0; q < 4; ++q) {
        u16* out = p.IDX + (size_t)(b * PP + t0 + q) * 256;
        const bool gt = sc[i][q] > T[q];
        const bool eq = (sc[i][q] == T[q]) && (T[q] != 0u);
        const unsigned long long m1 = __ballot(gt), m2 = __ballot(eq);
        if ((m1 | m2) != 0ull) {
          const unsigned bb = baseb[q * 132 + c];
          if (gt) out[(int)(bb & 0xffffu) + __popcll(m1 & lt)] = (u16)key;
          if (eq) { const int pos = ng[q] + (int)(bb >> 16) + __popcll(m2 & lt); if (pos < 256) out[pos] = (u16)key; }
        }
      }
    }
  }
#pragma unroll
  for (int q = 0; q < 4; ++q) {
    if (T[q] == 0u) {
      u16* out = p.IDX + (size_t)(b * PP + t0 + q) * 256;
      if (tid < 256 && tid >= ng[q]) out[tid] = (u16)0xFFFF;
    }
  }
}

constexpr int AT_STAGE = 23040;
template <int DK, int MODE>
DI void attn_unit(const Params& p, int l, int b, int head, int qu, char* lds) {
  const int tid = opaque_tid(), lane = tid & 63, w = tid >> 6, r = lane & 31, h = lane >> 5;
  constexpr int KS = DK / 16, KST = DK + 8;
  const int q0 = qu * 256, qw0 = q0 + w * 32, qw = qw0 + r;
  const size_t tokq = (size_t)b * PP + qw;
  const u16 *qptr, *kptr, *vtptr, *gptr;
  int ldk;
  if (MODE == 0) {
    qptr = p.H + tokq * LDH + HQ_A + head * 64; kptr = p.H + (size_t)b * PP * LDH + HK_A + head * 64; ldk = LDH;
    vtptr = p.VtA + ((size_t)b * 512 + head * 64) * PP; gptr = p.H + tokq * LDH + HG_A + head * 64;
  } else if (MODE == 1) {
    qptr = p.Qm + tokq * 768 + head * 96; kptr = p.Km + (size_t)b * PP * 512 + head * 64; ldk = 512;
    vtptr = p.VtB + ((size_t)b * 512 + head * 64) * PP; gptr = p.H + tokq * LDH + HG_B + head * 64;
  } else {
    qptr = p.H + tokq * LDH + HQ_D + head * 64; kptr = p.H + (size_t)b * PP * LDH + HK_D + (head >> 2) * 64; ldk = LDH;
    vtptr = p.VtD + ((size_t)b * 128 + (head >> 2) * 64) * PP; gptr = p.H + tokq * LDH + HG_D + head * 64;
  }
  const float* cum = p.CUM + (size_t)(b * 8 + head) * PP;
  float* btab = (float*)(lds + 2 * AT_STAGE);
  bf16x8 qf[KS];
#pragma unroll
  for (int ks = 0; ks < KS; ++ks) qf[ks] = *(const bf16x8*)(qptr + ks * 16 + 8 * h);
  float cref = 0.f;
  if (MODE == 0) cref = cum[q0];
  if (MODE == 2) { if (tid < 128) btab[tid] = p.rel_bias[t5_bucket(tid) * 16 + 8 + head] * LOG2E; }
  const float sc2 = (MODE == 1 ? 0.10206207261596577f : 0.125f) * LOG2E;
  const int kt_hi = qu * 4 + 3;
  int kt_lo = 1;
  if (MODE == 2) { kt_lo = qu * 4 - 2; if (kt_lo < 1) kt_lo = 1; }
  u32x4 rk, rk2, rv;
  float re = 0.f;
  const int srow = tid >> 3, sc8 = tid & 7;
  auto gload = [&](int kt) {
    const int k0 = kt * 64;
    rk = *(const u32x4*)(kptr + (size_t)(k0 + srow) * ldk + sc8 * 8);
    if (MODE == 1) { if (tid < 256) rk2 = *(const u32x4*)(p.Kpe + ((size_t)b * PP + k0 + (tid >> 2)) * 32 + (tid & 3) * 8); }
    rv = *(const u32x4*)(vtptr + (size_t)srow * PP + k0 + sc8 * 8);
    if (MODE == 0) { if (tid < 64) re = (cum[k0 + tid] - cref) * LOG2E; }
  };
  auto lstore = [&](int st) {
    char* base = lds + st * AT_STAGE;
    *(u32x4*)(base + (srow * KST + sc8 * 8) * 2) = rk;
    if (MODE == 1) { if (tid < 256) *(u32x4*)(base + ((tid >> 2) * KST + 64 + (tid & 3) * 8) * 2) = rk2; }
    char* vb = base + 64 * KST * 2;
    u32x2 lo = {rv[0], rv[1]}, hi = {rv[2], rv[3]};
    *(u32x2*)(vb + (srow * 68 + sc8 * 8) * 2) = lo;
    *(u32x2*)(vb + (srow * 68 + sc8 * 8 + 4) * 2) = hi;
    if (MODE == 0) { if (tid < 64) *(float*)(vb + 64 * 68 * 2 + tid * 4) = re; }
  };
  f32x16 o[2];
#pragma unroll
  for (int d = 0; d < 2; ++d)
#pragma unroll
    for (int i = 0; i < 16; ++i) o[d][i] = 0.f;
  float m = NEGL, lsum = 0.f;
  float qn = 0.f, kmx = 0.f;
  int* stopf = (int*)(lds + 2 * AT_STAGE + 1024);
  if (MODE == 0) {
#pragma unroll
    for (int ks = 0; ks < KS; ++ks) {
      const u32x4 qq = __builtin_bit_cast(u32x4, qf[ks]);
#pragma unroll
      for (int e = 0; e < 4; ++e) { const float a = bf_lo(qq[e]), b2 = bf_hi(qq[e]); qn += a * a + b2 * b2; }
    }
    qn += __shfl_xor(qn, 32);
    qn = sqrtf(qn) * 1.01f;
    kmx = __uint_as_float(p.ctr[64 + l * 16 + b * 8 + head]);
  }
  gload(kt_hi); lstore(0);
  __syncthreads();
  for (int kt = kt_hi; kt >= kt_lo; --kt) {
    const bool more = kt > kt_lo;
    if (more) gload(kt - 1);
    float cnext = 0.f;
    if (MODE == 0) { if (more) cnext = cum[(kt - 1) * 64 + 63]; }
    const int st = (kt_hi - kt) & 1;
    const int k0 = kt * 64;
    bool active = k0 <= qw0 + 31;
    if (MODE == 2) active = active && (k0 + 63 >= qw0 - 127);
    if (active) {
      const char* kb = lds + st * AT_STAGE;
      const char* vb = kb + 64 * KST * 2;
      f32x16 s[2];
      bf16x8 kf[2][KS];
#pragma unroll
      for (int kr = 0; kr < 2; ++kr)
#pragma unroll
        for (int ks = 0; ks < KS; ++ks) kf[kr][ks] = *(const bf16x8*)(kb + ((kr * 32 + r) * KST + ks * 16 + 8 * h) * 2);
      __builtin_amdgcn_sched_barrier(0);
#pragma unroll
      for (int kr = 0; kr < 2; ++kr) {
#pragma unroll
        for (int i = 0; i < 16; ++i) s[kr][i] = 0.f;
#pragma unroll
        for (int ks = 0; ks < KS; ++ks) s[kr] = MFMA32(kf[kr][ks], qf[ks], s[kr]);
      }
      u32x4 vfr[2][2][2];
#pragma unroll
      for (int kr = 0; kr < 2; ++kr)
#pragma unroll
        for (int s2 = 0; s2 < 2; ++s2)
#pragma unroll
          for (int d = 0; d < 2; ++d) {
            const char* va = vb + ((d * 32 + r) * 68 + kr * 32 + s2 * 16 + 4 * h) * 2;
            const u32x2 lo = *(const u32x2*)va;
            const u32x2 hi = *(const u32x2*)(va + 16);
            vfr[kr][s2][d] = (u32x4){lo[0], lo[1], hi[0], hi[1]};
          }
      __builtin_amdgcn_sched_barrier(0);
      const bool need_mask = (MODE == 2) || (k0 + 63 > qw0) || (k0 < LEAD);
      const bool rawpath = (MODE == 1) && !need_mask;
      float tmax = NEGL;
      const f32x2 sc2v = {sc2, sc2};
      if (rawpath) {
#pragma unroll
        for (int kr = 0; kr < 2; ++kr)
#pragma unroll
          for (int i = 0; i < 16; ++i) tmax = fmaxf(tmax, s[kr][i]);
        tmax *= sc2;
      } else {
#pragma unroll
        for (int kr = 0; kr < 2; ++kr) {
#pragma unroll
          for (int g = 0; g < 4; ++g) {
            f32x4 ev = {0.f, 0.f, 0.f, 0.f};
            if (MODE == 0) ev = *(const f32x4*)(vb + 64 * 68 * 2 + (kr * 32 + 8 * g + 4 * h) * 4);
#pragma unroll
            for (int e2 = 0; e2 < 2; ++e2) {
              const int i = 4 * g + 2 * e2;
              f32x2 v2 = {s[kr][i], s[kr][i + 1]};
              if (MODE == 0) { const f32x2 e2v = {ev[2 * e2], ev[2 * e2 + 1]}; v2 = v2 * sc2v - e2v; }
              else v2 = v2 * sc2v;
#pragma unroll
              for (int e1 = 0; e1 < 2; ++e1) {
                const int key = k0 + kr * 32 + 8 * g + 4 * h + 2 * e2 + e1;
                float v = v2[e1];
                if (MODE == 2) v += btab[(qw - key) & 127];
                if (need_mask) {
                  bool ok = (key <= qw) && (key >= LEAD);
                  if (MODE == 2) ok = ok && (qw - key < 128);
                  v = ok ? v : NEGL;
                }
                s[kr][i + e1] = v;
                tmax = fmaxf(tmax, v);
              }
            }
          }
        }
      }
      tmax = fmaxf(tmax, __shfl_xor(tmax, 32));
      const float mn = fmaxf(m, tmax);
      const float alpha = __builtin_amdgcn_exp2f(m - mn);
      const bool resc = __any(m != mn);
      m = mn;
      f32x2 ps2 = {0.f, 0.f};
      const f32x2 mnv = {mn, mn};
      const f32x2 scx = rawpath ? sc2v : (f32x2){1.f, 1.f};
#pragma unroll
      for (int kr = 0; kr < 2; ++kr)
#pragma unroll
        for (int i = 0; i < 16; i += 2) {
          f32x2 v2 = {s[kr][i], s[kr][i + 1]};
          v2 = v2 * scx - mnv;
          f32x2 p2 = {__builtin_amdgcn_exp2f(v2[0]), __builtin_amdgcn_exp2f(v2[1])};
          s[kr][i] = p2[0]; s[kr][i + 1] = p2[1];
          ps2 += p2;
        }
      const float ps = ps2[0] + ps2[1];
      lsum = lsum * alpha + ps;
      if (resc)
#pragma unroll
      for (int d = 0; d < 2; ++d)
#pragma unroll
        for (int i = 0; i < 16; ++i) o[d][i] *= alpha;
#pragma unroll
      for (int kr = 0; kr < 2; ++kr) {
#pragma unroll
        for (int s2 = 0; s2 < 2; ++s2) {
          u32x4 pp = {pk2(s[kr][8 * s2], s[kr][8 * s2 + 1]), pk2(s[kr][8 * s2 + 2], s[kr][8 * s2 + 3]),
                      pk2(s[kr][8 * s2 + 4], s[kr][8 * s2 + 5]), pk2(s[kr][8 * s2 + 6], s[kr][8 * s2 + 7])};
          bf16x8 pf = __builtin_bit_cast(bf16x8, pp);
#pragma unroll
          for (int d = 0; d < 2; ++d) o[d] = MFMA32(__builtin_bit_cast(bf16x8, vfr[kr][s2][d]), pf, o[d]);
        }
      }
    }
    if (more) lstore(st ^ 1);
    if (MODE == 0) {
      if (more) {
        const float enext = (cnext - cref) * LOG2E;
        const bool okl = (qn * kmx * sc2 - enext) <= (m - 40.f);
        const bool okw = __all(okl);
        if (lane == 0) stopf[(kt & 1) * 8 + w] = okw ? 1 : 0;
      }
    }
    __syncthreads();
    if (MODE == 0) {
      if (more) {
        const int* sf = stopf + (kt & 1) * 8;
        if (sf[0] & sf[1] & sf[2] & sf[3] & sf[4] & sf[5] & sf[6] & sf[7]) break;
      }
    }
  }
  lsum += __shfl_xor(lsum, 32);
  float f;
  if (MODE == 2) {
    const float s2 = p.sinks[l * 8 + head] * LOG2E;
    const float mf = fmaxf(m, s2);
    const float em = __builtin_amdgcn_exp2f(m - mf);
    f = em / (lsum * em + __builtin_amdgcn_exp2f(s2 - mf));
  } else {
    f = lsum > 0.f ? 1.f / lsum : 0.f;
  }
  f *= (MODE == 0 ? SC_FOX : (MODE == 1 ? SC_MLA : SC_SWA));
  u16* mp = p.Mix + tokq * 2048 + (MODE == 0 ? 0 : (MODE == 1 ? 512 : 1536)) + head * 64;
#pragma unroll
  for (int d = 0; d < 2; ++d)
#pragma unroll
    for (int g = 0; g < 4; ++g) {
      const int dd = d * 32 + 8 * g + 4 * h;
      u32x2 gv = *(const u32x2*)(gptr + dd);
      float g0 = silu(bf_lo(gv[0])), g1 = silu(bf_hi(gv[0])), g2 = silu(bf_lo(gv[1])), g3 = silu(bf_hi(gv[1]));
      u32x2 ov = {pk2(o[d][4 * g] * f * g0, o[d][4 * g + 1] * f * g1), pk2(o[d][4 * g + 2] * f * g2, o[d][4 * g + 3] * f * g3)};
      *(u32x2*)(mp + dd) = ov;
    }
}

DI void dsa_job(const Params& p, int b, int tq0, char* lds) {
  const int tid = opaque_tid(), lane = tid & 63, w = tid >> 6;
  float* biasC = (float*)(lds + 81920);
  int* btab = (int*)(lds + 81920 + 1024);
  if (tid < 256) biasC[tid] = p.rel_bias[(tid >> 3) * 16 + (tid & 7)];
  if (tid < 128) btab[tid] = t5_bucket(tid);
  __syncthreads();
  char* wl = lds + w * 10240;
  float* Pl = (float*)wl;
  int* kid = (int*)(wl + 8192);
  const int tq = tq0 + w;
  const size_t tok = (size_t)b * PP + tq;
  const u16* Hb = p.H + (size_t)b * PP * LDH;
  int kk[4], ku[4];
  {
    u32x2 iv = *(const u32x2*)(p.IDX + tok * 256 + 4 * lane);
    kk[0] = iv[0] & 0xffff; kk[1] = iv[0] >> 16; kk[2] = iv[1] & 0xffff; kk[3] = iv[1] >> 16;
#pragma unroll
    for (int j = 0; j < 4; ++j) ku[j] = (kk[j] == 0xFFFF) ? LEAD : kk[j];
    u32x4 kv4 = {(unsigned)ku[0], (unsigned)ku[1], (unsigned)ku[2], (unsigned)ku[3]};
    ((u32x4*)kid)[lane] = kv4;
  }
  __builtin_amdgcn_wave_barrier();
  const int ksub = lane >> 4, g = (lane >> 3) & 1, dc = lane & 7;
  {
    u32x4 qr[4];
#pragma unroll
    for (int hh = 0; hh < 4; ++hh) qr[hh] = *(const u32x4*)(p.H + tok * LDH + HQ_C + (g * 4 + hh) * 64 + dc * 8);
    const u16* kb = Hb + HK_C + g * 64 + dc * 8;
    u32x4 kA[8], kB[8];
#pragma unroll
    for (int s = 0; s < 8; ++s) kA[s] = *(const u32x4*)(kb + (size_t)kid[4 * s + ksub] * LDH);
#pragma unroll 1
    for (int gp = 0; gp < 4; ++gp) {
#pragma unroll
      for (int s = 0; s < 8; ++s) kB[s] = *(const u32x4*)(kb + (size_t)kid[4 * ((2 * gp + 1) * 8 + s) + ksub] * LDH);
#pragma unroll
      for (int s = 0; s < 8; ++s) {
        const int slot = 4 * (2 * gp * 8 + s) + ksub;
        const u32x4 kv = kA[s];
        f32x4 a;
#pragma unroll
        for (int hh = 0; hh < 4; ++hh) {
          float t = dot2(kv[0], qr[hh][0], 0.f); t = dot2(kv[1], qr[hh][1], t); t = dot2(kv[2], qr[hh][2], t); t = dot2(kv[3], qr[hh][3], t);
          t = dpp_add<0xB1>(t); t = dpp_add<0x4E>(t); t = dpp_add<0x141>(t);
          a[hh] = t;
        }
        if (dc == 0) *(f32x4*)(Pl + slot * 8 + g * 4) = a;
      }
      if (gp < 3) {
#pragma unroll
        for (int s = 0; s < 8; ++s) kA[s] = *(const u32x4*)(kb + (size_t)kid[4 * ((2 * gp + 2) * 8 + s) + ksub] * LDH);
      }
#pragma unroll
      for (int s = 0; s < 8; ++s) {
        const int slot = 4 * ((2 * gp + 1) * 8 + s) + ksub;
        const u32x4 kv = kB[s];
        f32x4 a;
#pragma unroll
        for (int hh = 0; hh < 4; ++hh) {
          float t = dot2(kv[0], qr[hh][0], 0.f); t = dot2(kv[1], qr[hh][1], t); t = dot2(kv[2], qr[hh][2], t); t = dot2(kv[3], qr[hh][3], t);
          t = dpp_add<0xB1>(t); t = dpp_add<0x4E>(t); t = dpp_add<0x141>(t);
          a[hh] = t;
        }
        if (dc == 0) *(f32x4*)(Pl + slot * 8 + g * 4) = a;
      }
    }
  }
  __builtin_amdgcn_wave_barrier();
  float lg[4][8];
#pragma unroll
  for (int j = 0; j < 4; ++j) {
    const f32x4 v0 = *(const f32x4*)(Pl + (4 * lane + j) * 8), v1 = *(const f32x4*)(Pl + (4 * lane + j) * 8 + 4);
#pragma unroll
    for (int e = 0; e < 4; ++e) { lg[j][e] = v0[e]; lg[j][4 + e] = v1[e]; }
  }
  int bk[4];
#pragma unroll
  for (int j = 0; j < 4; ++j) { int dist = tq - ku[j]; bk[j] = (dist < 128) ? btab[dist & 127] : 31; }
#pragma unroll
  for (int hd = 0; hd < 8; ++hd) {
    float mx = NEGL;
#pragma unroll
    for (int j = 0; j < 4; ++j) {
      float v = lg[j][hd] * 0.125f + biasC[bk[j] * 8 + hd];
      v = (kk[j] == 0xFFFF) ? NEGL : v;
      lg[j][hd] = v;
      mx = fmaxf(mx, v);
    }
    mx = wmax(mx);
    float sm = 0.f;
#pragma unroll
    for (int j = 0; j < 4; ++j) { float e = __expf(lg[j][hd] - mx); lg[j][hd] = e; sm += e; }
    sm = wsum(sm);
    const float inv = 1.f / sm;
#pragma unroll
    for (int j = 0; j < 4; ++j) lg[j][hd] *= inv;
  }
#pragma unroll
  for (int j = 0; j < 4; ++j) {
    f32x4 v0 = {lg[j][0], lg[j][1], lg[j][2], lg[j][3]}, v1 = {lg[j][4], lg[j][5], lg[j][6], lg[j][7]};
    *(f32x4*)(Pl + (4 * lane + j) * 8) = v0;
    *(f32x4*)(Pl + (4 * lane + j) * 8 + 4) = v1;
  }
  __builtin_amdgcn_wave_barrier();
  const u16* vb = Hb + HV_C + g * 64 + dc * 8;
  f32x2 acc2[4][4];
#pragma unroll
  for (int hh = 0; hh < 4; ++hh)
#pragma unroll
    for (int e = 0; e < 4; ++e) { acc2[hh][e][0] = 0.f; acc2[hh][e][1] = 0.f; }
  u32x4 vA[8], vB[8];
#pragma unroll
  for (int s = 0; s < 8; ++s) vA[s] = *(const u32x4*)(vb + (size_t)kid[4 * s + ksub] * LDH);
#pragma unroll 1
  for (int gp = 0; gp < 4; ++gp) {
#pragma unroll
    for (int s = 0; s < 8; ++s) vB[s] = *(const u32x4*)(vb + (size_t)kid[4 * ((2 * gp + 1) * 8 + s) + ksub] * LDH);
#pragma unroll
    for (int s = 0; s < 8; ++s) {
      const int slot = 4 * (2 * gp * 8 + s) + ksub;
      const f32x4 pp = *(const f32x4*)(Pl + slot * 8 + g * 4);
      const u32x4 vv = vA[s];
#pragma unroll
      for (int hh = 0; hh < 4; ++hh) {
        const f32x2 ph = {pp[hh], pp[hh]};
#pragma unroll
        for (int e = 0; e < 4; ++e) {
          const f32x2 vf2 = {bf_lo(vv[e]), bf_hi(vv[e])};
          acc2[hh][e] += ph * vf2;
        }
      }
    }
    if (gp < 3) {
#pragma unroll
      for (int s = 0; s < 8; ++s) vA[s] = *(const u32x4*)(vb + (size_t)kid[4 * ((2 * gp + 2) * 8 + s) + ksub] * LDH);
    }
#pragma unroll
    for (int s = 0; s < 8; ++s) {
      const int slot = 4 * ((2 * gp + 1) * 8 + s) + ksub;
      const f32x4 pp = *(const f32x4*)(Pl + slot * 8 + g * 4);
      const u32x4 vv = vB[s];
#pragma unroll
      for (int hh = 0; hh < 4; ++hh) {
        const f32x2 ph = {pp[hh], pp[hh]};
#pragma unroll
        for (int e = 0; e < 4; ++e) {
          const f32x2 vf2 = {bf_lo(vv[e]), bf_hi(vv[e])};
          acc2[hh][e] += ph * vf2;
        }
      }
    }
  }
  float acc[4][8];
#pragma unroll
  for (int hh = 0; hh < 4; ++hh)
#pragma unroll
    for (int e = 0; e < 8; ++e) { float v = acc2[hh][e >> 1][e & 1]; v += __shfl_xor(v, 16); v += __shfl_xor(v, 32); acc[hh][e] = v; }
  if (ksub == 0) {
#pragma unroll
    for (int hh = 0; hh < 4; ++hh) {
      const int hd = g * 4 + hh;
      u32x4 gv = *(const u32x4*)(p.H + tok * LDH + HG_C + hd * 64 + dc * 8);
      u32x4 ov;
#pragma unroll
      for (int e = 0; e < 4; ++e) ov[e] = pk2(acc[hh][2 * e] * SC_DSA * silu(bf_lo(gv[e])), acc[hh][2 * e + 1] * SC_DSA * silu(bf_hi(gv[e])));
      *(u32x4*)(p.Mix + tok * 2048 + 1024 + hd * 64 + dc * 8) = ov;
    }
  }
}

DI void outproj_tile(const Params& p, int mt, int nt, char* lds) {
  const int tid = opaque_tid(), lane = tid & 63, w = tid >> 6, r = lane & 31, h = lane >> 5;
  const int wm = w & 3, wn = w >> 2;
  const int m0 = mt * 256;
  gemm_tile<true>(p.Mix + (size_t)m0 * 2048, 2048, p.Wt_out + (size_t)nt * 128 * 2048, 2048, 2048, lds, [&](int mi, int ni, const f32x16& a) {
    const int tok = m0 + wm * 64 + mi * 32 + r;
    float* rp = p.R + (size_t)tok * DM + nt * 128 + wn * 64 + ni * 32;
#pragma unroll
    for (int g = 0; g < 4; ++g) {
      f32x4 v = *(const f32x4*)(rp + 8 * g + 4 * h);
#pragma unroll
      for (int e = 0; e < 4; ++e) v[e] = ALPHA * v[e] + a[4 * g + e];
      *(f32x4*)(rp + 8 * g + 4 * h) = v;
    }
  });
}

DI void ln_rows(const Params& p, int l) {
  const int tid = opaque_tid(), lane = tid & 63, w = tid >> 6;
  const float* gg = l < 0 ? p.ln0_g : p.ln_g + l * DM;
  const float* bb = l < 0 ? p.ln0_b : p.ln_b + l * DM;
  for (int row = blockIdx.x * 8 + w; row < MT; row += gridDim.x * 8) {
    const int b = row / PP, t = row - b * PP;
    f32x4 v[4];
    if (l < 0) {
      const float* src = nullptr;
      if (t >= 128 && t < PV) src = p.x + ((size_t)b * SEQ + (t - 128)) * DM;
      else if (t >= LEAD && t < 128) src = p.meta + (size_t)(t - LEAD) * DM;
#pragma unroll
      for (int j = 0; j < 4; ++j) {
        if (src) v[j] = *(const f32x4*)(src + lane * 4 + 256 * j);
        else { v[j][0] = 0.f; v[j][1] = 0.f; v[j][2] = 0.f; v[j][3] = 0.f; }
      }
    } else {
#pragma unroll
      for (int j = 0; j < 4; ++j) v[j] = *(const f32x4*)(p.R + (size_t)row * DM + lane * 4 + 256 * j);
    }
    float s = 0.f;
#pragma unroll
    for (int j = 0; j < 4; ++j) s += v[j][0] + v[j][1] + v[j][2] + v[j][3];
    const float mu = wsum(s) * (1.f / DM);
    float q = 0.f;
#pragma unroll
    for (int j = 0; j < 4; ++j)
#pragma unroll
      for (int e = 0; e < 4; ++e) { float d = v[j][e] - mu; q += d * d; }
    const float rstd = rsqrtf(wsum(q) * (1.f / DM) + 1e-5f);
#pragma unroll
    for (int j = 0; j < 4; ++j) {
      const int c = lane * 4 + 256 * j;
      f32x4 g4 = *(const f32x4*)(gg + c), b4 = *(const f32x4*)(bb + c);
      f32x4 y;
#pragma unroll
      for (int e = 0; e < 4; ++e) y[e] = (v[j][e] - mu) * rstd * g4[e] + b4[e];
      if (l == 3) {
        if (t >= 128 && t < PV) *(f32x4*)(p.out + ((size_t)b * SEQ + (t - 128)) * DM + c) = y;
      } else {
        *(f32x4*)(p.R + (size_t)row * DM + c) = y;
        u32x2 yb = {pk2(y[0], y[1]), pk2(y[2], y[3])};
        *(u32x2*)(p.Xb + (size_t)row * DM + c) = yb;
      }
    }
  }
}

DI int map_in(int n) {
  if (n < 512) return n;
  if (n < 1024) return n;
  if (n < 1536) return 1544 + (n - 1024);
  if (n < 1792) return 2056 + (n - 1536);
  if (n < 1920) return 2312 + (n - 1792);
  if (n < 2432) return 2472 + (n - 1920);
  if (n < 2944) return 2984 + (n - 2432);
  if (n < 3072) return 3496 + (n - 2944);
  if (n < 3200) return 3624 + (n - 3072);
  if (n < 3712) return 3752 + (n - 3200);
  if (n < 4224) return 4336 + (n - 3712);
  if (n < 4736) return 4848 + (n - 4224);
  if (n < 4864) return 5360 + (n - 4736);
  if (n < 5376) return 5616 + (n - 4864);
  if (n < 5408) return 2440 + (n - 5376);
  if (n < 5472) return 4264 + (n - 5408);
  if (n < 5480) return 1536 + (n - 5472);
  if (n < 5488) return 4328 + (n - 5480);
  if (n < 5504) return -1;
  if (n < 6016) return 1024 + (n - 5504);
  return 5488 + (n - 6016);
}
DI void conv_tile(const Params& p, int l, int tI, char* lds) {
  const int tid = opaque_tid();
  float* tile = (float*)lds;
  {
    const float* src; const float* ksc = nullptr; u16* dst; int ldsrc, K, kind, kt, ntile;
    if (tI < 1536) { kind = 0; kt = tI / 96; ntile = tI % 96; src = p.w_in + (size_t)l * DM * D_IN; ldsrc = D_IN; K = DM; dst = p.Wt_in; }
    else if (tI < 2048) { int u = tI - 1536; kind = 1; kt = u / 16; ntile = u % 16; src = p.w_out + (size_t)l * 2048 * DM; ldsrc = DM; K = 2048; dst = p.Wt_out; }
    else if (tI < 2096) { int u = tI - 2048; kind = 2; kt = u / 12; ntile = u % 12; src = p.w_uq + (size_t)l * 256 * 768; ldsrc = 768; K = 256; dst = p.Wt_uq; ksc = p.gq + l * 256; }
    else { int u = tI - 2096; kind = 3; kt = u / 16; ntile = u % 16; src = p.w_ukv + (size_t)l * 128 * 1024; ldsrc = 1024; K = 128; dst = p.Wt_ukv; ksc = p.gkv + l * 128; }
    const int k0 = kt * 64, n0 = ntile * 64;
    {
      const int nn = tid & 63;
      const int n = n0 + nn;
      int sc;
      if (kind == 0) sc = map_in(n);
      else if (kind == 3) sc = (n < 512) ? ((n >> 6) * 128 + (n & 63)) : (((n - 512) >> 6) * 128 + 64 + (n & 63));
      else sc = n;
#pragma unroll
      for (int j = 0; j < 8; ++j) {
        const int kk = (tid >> 6) + 8 * j;
        float v = 0.f;
        if (sc >= 0) v = src[(size_t)(k0 + kk) * ldsrc + sc];
        if (ksc) v *= ksc[k0 + kk];
        tile[nn * 65 + kk] = v;
      }
    }
    __syncthreads();
    {
      const int nn = tid >> 3, kc = (tid & 7) * 8;
      const float* tp = tile + nn * 65 + kc;
      u32x4 ov = {pk2(tp[0], tp[1]), pk2(tp[2], tp[3]), pk2(tp[4], tp[5]), pk2(tp[6], tp[7])};
      *(u32x4*)(dst + (size_t)(n0 + nn) * K + k0 + kc) = ov;
    }
    __syncthreads();
  }
}
DI void conv_weights(const Params& p, int l, char* lds, int lo, int hi) {
  for (int tI = lo + blockIdx.x; tI < hi; tI += gridDim.x) conv_tile(p, l, tI, lds);
}
DI void rope_table(const Params& p) {
  const int gt = blockIdx.x * NTHREADS + threadIdx.x;
  for (int i = gt; i < PP * 16; i += gridDim.x * NTHREADS) {
    const int t = i >> 4, c = i & 15;
    const float freq = powf(10000.f, -(float)c / 16.f);
    const float ang = (float)(t - LEAD) * freq;
    float sn, cs;
    sincosf(ang, &sn, &cs);
    p.ROPE[(size_t)t * 32 + c] = cs;
    p.ROPE[(size_t)t * 32 + 16 + c] = sn;
  }
}


#define XB_TMO      128
#define XB_XCNT(j)  (256  + 64 * (j))
#define XB_XSUB(j)  (1280 + 64 * (j))
#define XB_XGEN(j)  (2304 + 64 * (j))
#define XB_TOP      3328
#define XB_TOPGEN   3392
#define XCD_BAR_WORDS 3456
#define XB_SPIN_CAP (1u << 18)
DI unsigned xb_ld(unsigned* p) { return __hip_atomic_load(p, __ATOMIC_RELAXED, __HIP_MEMORY_SCOPE_AGENT); }
DI unsigned xb_add(unsigned* p, unsigned v) { return __hip_atomic_fetch_add(p, v, __ATOMIC_RELAXED, __HIP_MEMORY_SCOPE_AGENT); }
DI unsigned xb_xcc_id() { return (unsigned)__builtin_amdgcn_s_getreg((3 << 11) | 20) & 0xFu; }
#define XB_SPIN(cond, bar) do { unsigned _sp = 0; while (cond) { __builtin_amdgcn_s_sleep(1); \
    if ((++_sp & 255u) == 0u) { if (xb_ld(&(bar)[XB_TMO])) break; if (_sp > XB_SPIN_CAP) { atomicAdd(&(bar)[XB_TMO], 1u); break; } } } } while (0)
struct XcdBarrier { unsigned* bar; unsigned x; volatile unsigned* st; };
DI XcdBarrier xcd_barrier_post(unsigned* bar, volatile unsigned* st) {
  XcdBarrier b; b.bar = bar; b.x = xb_xcc_id(); b.st = st;
  if (threadIdx.x == 0) (void)xb_add(&bar[XB_XCNT(b.x)], 1u);
  return b;
}
DI void xcd_barrier_complete(unsigned* bar, unsigned x, unsigned& nloc, unsigned& nx) {
  const unsigned G = gridDim.x * gridDim.y * gridDim.z;
  unsigned sum, cnt, mine, sp = 0u;
  for (;;) {
    sum = 0u; cnt = 0u; mine = 0u;
#pragma unroll
    for (unsigned j = 0; j < 16; ++j) { const unsigned c = xb_ld(&bar[XB_XCNT(j)]); sum += c; cnt += (c > 0u) ? 1u : 0u; mine = (j == x) ? c : mine; }
    if (sum == G) break;
    __builtin_amdgcn_s_sleep(1);
    if ((++sp & 255u) == 0u) { if (xb_ld(&bar[XB_TMO])) break; if (sp > XB_SPIN_CAP) { atomicAdd(&bar[XB_TMO], 1u); break; } }
  }
  nloc = mine > 0u ? mine : 1u; nx = cnt > 0u ? cnt : 1u;
}
DI void xcd_barrier(const XcdBarrier& b) {
  asm volatile("s_waitcnt vmcnt(0)" ::: "memory");
  __syncthreads();
  if (threadIdx.x == 0) {
    unsigned* bar = b.bar;
    __builtin_amdgcn_s_waitcnt(0);
    unsigned nloc = b.st[0], nx = b.st[1];
    if (nloc == 0u) { xcd_barrier_complete(bar, b.x, nloc, nx); b.st[0] = nloc; b.st[1] = nx; }
    const unsigned old = xb_add(&bar[XB_XSUB(b.x)], 1u);
    const unsigned gen = old / nloc;
    if (old + 1u == (gen + 1u) * nloc) {
      __builtin_amdgcn_fence(__ATOMIC_RELEASE, "agent");
      asm volatile("s_waitcnt vmcnt(0)" ::: "memory");
      const unsigned og = xb_add(&bar[XB_TOP], 1u);
      const unsigned tg = og / nx;
      if (og + 1u == (tg + 1u) * nx) xb_add(&bar[XB_TOPGEN], 1u);
      else XB_SPIN(xb_ld(&bar[XB_TOPGEN]) == tg, bar);
      __builtin_amdgcn_fence(__ATOMIC_ACQUIRE, "agent");
      xb_add(&bar[XB_XGEN(b.x)], 1u);
      asm volatile("s_waitcnt vmcnt(0)" ::: "memory");
    } else {
      XB_SPIN(xb_ld(&bar[XB_XGEN(b.x)]) == gen, bar);
      __builtin_amdgcn_fence(__ATOMIC_ACQUIRE, "agent");
      asm volatile("s_waitcnt vmcnt(0)" ::: "memory");
    }
  }
  __syncthreads();
}

__global__ void __launch_bounds__(NTHREADS) mega(Params p) {
  extern __shared__ __attribute__((aligned(16))) char lds[];
  cg::grid_group grid = cg::this_grid();
  ln_rows(p, -1);
  conv_weights(p, 0, lds, 0, 2128);
  rope_table(p);
  if (blockIdx.x == 0) {
    if (threadIdx.x < 256) p.ctr[threadIdx.x] = 0u;
    for (int i = threadIdx.x; i < XCD_BAR_WORDS; i += NTHREADS) p.bar[i] = 0u;
  }
  volatile unsigned* xst = (volatile unsigned*)(lds + LDS_JOB + 16);
  if (threadIdx.x == 0) { xst[0] = 0u; xst[1] = 0u; }
  grid.sync();
  const XcdBarrier xb = xcd_barrier_post(p.bar, xst);
  for (int l = 0; l < 4; ++l) {
    for (int rep = 0; rep < REP_P1; ++rep) {
      for (int j = blockIdx.x; j < 66 * 48; j += gridDim.x) inproj_tile(p, l, j / 48, j % 48, lds);
      xcd_barrier(xb);
    }
    for (int rep = 0; rep < REP_P2; ++rep) {
      constexpr int NTK = 2 * 2052, NUP = 66 * 14, NJ = NTK + NUP + 16;
      int pending = 0;
      if (threadIdx.x == 0) pending = (int)atomicAdd(p.ctr + l * 2 + 8 * rep, 1u);
      for (;;) {
        const int j = next_job(p.ctr + l * 2 + 8 * rep, lds, pending, NJ);
        if (j >= NJ) break;
        if (j < 16) {
          cumsum_job(p, j, lds);
        } else if (j < 16 + NTK) {
          const int jj = j - 16;
          const int b = jj & 1, q = 2051 - (jj >> 1);
          topk_job(p, b, LEAD + 4 * q, lds);
        } else {
          const int u = j - 16 - NTK;
          upproj_tile(p, u / 14, u % 14, lds);
        }
      }
      xcd_barrier(xb);
    }
    for (int rep = 0; rep < REP_P3; ++rep) {
      constexpr int ND = 1056, NS = 528, NC = 2 * 1026, NJ = ND + NS + NC;
      int pending = 0;
      if (threadIdx.x == 0) pending = (int)atomicAdd(p.ctr + l * 2 + 1 + 8 * rep, 1u);
      for (;;) {
        const int j = next_job(p.ctr + l * 2 + 1 + 8 * rep, lds, pending, NJ);
        if (j >= NJ) break;
        if (j < ND) {
          const int qu = 32 - (j >> 5), rem = j & 31, kind = rem >> 4, b = (rem >> 3) & 1, head = rem & 7;
          if (kind == 0) attn_unit<64, 0>(p, l, b, head, qu, lds);
          else attn_unit<96, 1>(p, l, b, head, qu, lds);
        } else if (j < ND + NS) {
          const int u = j - ND;
          attn_unit<64, 2>(p, l, (u >> 3) & 1, u & 7, u >> 4, lds);
        } else {
          const int u = j - ND - NS;
          dsa_job(p, u & 1, LEAD + 8 * (u >> 1), lds);
        }
      }
      xcd_barrier(xb);
    }
    {
      const int NJ = 528 + (l < 3 ? 1616 : 0);
      int pending = 0;
      if (threadIdx.x == 0) pending = (int)atomicAdd(p.ctr + 16 + l, 1u);
      for (;;) {
        const int j = next_job(p.ctr + 16 + l, lds, pending, NJ);
        if (j >= NJ) break;
        if (j < 528) {
          outproj_tile(p, j >> 3, j & 7, lds);
        } else {
          const int f = j - 528;
          conv_tile(p, l + 1, f < 1536 ? f : f + 512, lds);
        }
      }
    }
    xcd_barrier(xb);
    ln_rows(p, l);
    if (l < 3) { conv_weights(p, l + 1, lds, 1536, 2048); xcd_barrier(xb); }
  }
}

extern "C" void kernel_launch(void* const* d_in, const int* in_sizes, int n_in, void* d_out, int out_size, void* d_ws, size_t ws_size,
                              hipStream_t stream) {
  static int grid = 0;
  if (grid == 0) {
    int dev = 0, cus = 0, per_cu = 0;
    hipGetDevice(&dev);
    hipDeviceGetAttribute(&cus, hipDeviceAttributeMultiprocessorCount, dev);
    if (hipFuncSetAttribute((const void*)mega, hipFuncAttributeMaxDynamicSharedMemorySize, LDS_BYTES) != hipSuccess) { fprintf(stderr, "hipFuncSetAttribute failed\n"); grid = -1; return; }
    hipOccupancyMaxActiveBlocksPerMultiprocessor(&per_cu, (const void*)mega, NTHREADS, LDS_BYTES);
    if (per_cu < 1) { fprintf(stderr, "occupancy query: %d\n", per_cu); grid = -1; return; }
    grid = cus * per_cu;
  }
  if (grid < 0) return;
  size_t off = 0;
  auto take = [&](size_t bytes) { size_t o = off; off += (bytes + 255) & ~(size_t)255; return (char*)d_ws + o; };
  Params p{};
  p.x = (const float*)d_in[0]; p.meta = (const float*)d_in[1]; p.ln0_g = (const float*)d_in[2]; p.ln0_b = (const float*)d_in[3];
  p.rel_bias = (const float*)d_in[4]; p.w_in = (const float*)d_in[5]; p.b_f = (const float*)d_in[6]; p.gq = (const float*)d_in[7];
  p.gkv = (const float*)d_in[8]; p.w_uq = (const float*)d_in[9]; p.w_ukv = (const float*)d_in[10]; p.sinks = (const float*)d_in[11];
  p.w_out = (const float*)d_in[12]; p.ln_g = (const float*)d_in[13]; p.ln_b = (const float*)d_in[14];
  p.out = (float*)d_out;
  p.ctr = (unsigned*)take(1024);
  p.bar = (unsigned*)take(XCD_BAR_WORDS * 4);
  p.Wt_in = (u16*)take((size_t)NIN * DM * 2);
  p.Wt_out = (u16*)take((size_t)DM * 2048 * 2);
  p.Wt_uq = (u16*)take((size_t)768 * 256 * 2);
  p.Wt_ukv = (u16*)take((size_t)1024 * 128 * 2);
  p.H = (u16*)take((size_t)MT * LDH * 2);
  p.Mix = (u16*)take((size_t)MT * 2048 * 2);
  p.Xb = p.Mix;
  p.VtA = (u16*)take((size_t)NB * 512 * PP * 2);
  p.VtD = (u16*)take((size_t)NB * 128 * PP * 2);
  p.R = (float*)take((size_t)MT * DM * 4);
  p.IDX = (u16*)take((size_t)MT * 256 * 2);
  p.IK = (u16*)take((size_t)MT * 64 * 2);
  p.Kpe = (u16*)take((size_t)MT * 32 * 2);
  p.IW = (float*)take((size_t)MT * 8 * 4);
  p.LOGF = (float*)take((size_t)NB * 8 * PP * 4);
  p.CUM = (float*)take((size_t)NB * 8 * PP * 4);
  p.ROPE = (float*)take((size_t)PP * 32 * 4);
  if (off > ws_size) { fprintf(stderr, "workspace too small: need %zu have %zu\n", off, ws_size); return; }
  {
    char* ob = (char*)d_out;
    p.Qm = (u16*)ob; ob += (size_t)MT * 768 * 2;
    p.Km = (u16*)ob; ob += (size_t)MT * 512 * 2;
    p.VtB = (u16*)ob; ob += (size_t)NB * 512 * PP * 2;
    if ((size_t)(ob - (char*)d_out) > (size_t)out_size * 4) { fprintf(stderr, "d_out too small for scratch\n"); return; }
  }
  hipMemsetAsync(p.ctr, 0, 1024 + XCD_BAR_WORDS * 4, stream);
  void* args[] = {&p};
  hipError_t e = hipLaunchCooperativeKernel((const void*)mega, dim3(grid), dim3(NTHREADS), args, LDS_BYTES, stream);
  if (e != hipSuccess) fprintf(stderr, "cooperative launch failed: %s (grid %d)\n", hipGetErrorString(e), grid);
}
```

```cpp
#include <hip/hip_runtime.h>
#include <hip/hip_cooperative_groups.h>
#include <cstdio>
namespace cg = cooperative_groups;

#define DI __device__ __forceinline__
typedef __attribute__((ext_vector_type(8))) short bf16x8;
typedef __attribute__((ext_vector_type(16))) float f32x16;
typedef __attribute__((ext_vector_type(4))) float f32x4;
typedef __attribute__((ext_vector_type(2))) float f32x2;
typedef __attribute__((ext_vector_type(2))) __bf16 bf2_t;
typedef __attribute__((ext_vector_type(4))) unsigned u32x4;
typedef __attribute__((ext_vector_type(2))) unsigned u32x2;
typedef unsigned short u16;
#define MFMA32(a, b, c) __builtin_amdgcn_mfma_f32_32x32x16_bf16((a), (b), (c), 0, 0, 0)

constexpr int NB = 2, PP = 8448, PV = 8320, LEAD = 112, DM = 1024, MT = NB * PP, SEQ = 8192;
constexpr int LDH = 5376, NIN = 6144;
constexpr int HQ_A = 0, HK_A = 512, HG_A = 1024, HCQ_B = 1536, HCKV_B = 1792, HG_B = 1920, HQ_C = 2432, HK_C = 2944, HV_C = 3072,
              HIQ_C = 3200, HG_C = 3712, HQ_D = 4224, HK_D = 4736, HG_D = 4864;
constexpr int D_IN = 6128;
constexpr float LOG2E = 1.4426950408889634f;
constexpr float NEGL = -1e30f;
constexpr float ALPHA = 1.681792830507429f;
constexpr int LDS_JOB = 147456;
constexpr int LDS_BYTES = LDS_JOB + 64;
constexpr int GEMM_STAGE = 55296;
constexpr int NTHREADS = 512;
#define REP_P1 1
#define REP_P2 1
#define REP_P3 1
#define SC_FOX 1.0f
#define SC_MLA 1.0f
#define SC_SWA 1.0f
#define SC_DSA 1.0f

struct Params {
  const float *x, *meta, *ln0_g, *ln0_b, *rel_bias, *w_in, *b_f, *gq, *gkv, *w_uq, *w_ukv, *sinks, *w_out, *ln_g, *ln_b;
  float* out;
  u16 *Wt_in, *Wt_out, *Wt_uq, *Wt_ukv;
  u16 *H, *Xb, *Mix, *VtA, *VtD, *VtB, *Qm, *Km, *Kpe, *IK, *IDX;
  float *R, *LOGF, *CUM, *IW, *ROPE;
  unsigned* ctr;
  unsigned* bar;
};

DI unsigned pk2(float a, float b) { f32x2 v = {a, b}; return __builtin_bit_cast(unsigned, __builtin_convertvector(v, bf2_t)); }
DI float bf_lo(unsigned u) { return __uint_as_float(u << 16); }
DI float bf_hi(unsigned u) { return __uint_as_float(u & 0xffff0000u); }
DI int opaque_tid() { int t = threadIdx.x; asm volatile("" : "+v"(t)); return t; }
DI int crow(int i, int h) { return (i & 3) + 8 * (i >> 2) + 4 * h; }
template <int CTRL> DI float dpp_mov(float v) { return __int_as_float(__builtin_amdgcn_mov_dpp(__float_as_int(v), CTRL, 0xF, 0xF, true)); }
DI float wsum(float v) {
  v += dpp_mov<0xB1>(v); v += dpp_mov<0x4E>(v); v += dpp_mov<0x141>(v); v += dpp_mov<0x140>(v);
  u32x2 r = __builtin_amdgcn_permlane16_swap(__float_as_uint(v), __float_as_uint(v), false, false);
  v = __uint_as_float(r[0]) + __uint_as_float(r[1]);
  r = __builtin_amdgcn_permlane32_swap(__float_as_uint(v), __float_as_uint(v), false, false);
  return __uint_as_float(r[0]) + __uint_as_float(r[1]);
}
DI float wmax(float v) {
  v = fmaxf(v, dpp_mov<0xB1>(v)); v = fmaxf(v, dpp_mov<0x4E>(v)); v = fmaxf(v, dpp_mov<0x141>(v)); v = fmaxf(v, dpp_mov<0x140>(v));
  u32x2 r = __builtin_amdgcn_permlane16_swap(__float_as_uint(v), __float_as_uint(v), false, false);
  v = fmaxf(__uint_as_float(r[0]), __uint_as_float(r[1]));
  r = __builtin_amdgcn_permlane32_swap(__float_as_uint(v), __float_as_uint(v), false, false);
  return fmaxf(__uint_as_float(r[0]), __uint_as_float(r[1]));
}
DI int wsumi(int v) { for (int o = 32; o > 0; o >>= 1) v += __shfl_xor(v, o); return v; }
DI float silu(float g) { return g / (1.f + __expf(-g)); }
DI float dot2(unsigned a, unsigned b, float c) { return __builtin_amdgcn_fdot2_f32_bf16(__builtin_bit_cast(bf2_t, a), __builtin_bit_cast(bf2_t, b), c, false); }
template <int CTRL> DI float dpp_add(float v) { return v + __int_as_float(__builtin_amdgcn_mov_dpp(__float_as_int(v), CTRL, 0xF, 0xF, true)); }
DI int t5_bucket(int n) {
  if (n < 16) return n;
  int lg = 16 + (int)(logf((float)n / 16.f) / logf(8.f) * 16.f);
  return lg < 31 ? lg : 31;
}

DI int next_job(unsigned* ctr, char* lds, int& pending, int njobs) {
  int* sj = (int*)(lds + LDS_JOB);
  __syncthreads();
  if (threadIdx.x == 0) *sj = pending;
  __syncthreads();
  const int j = *sj;
  if (threadIdx.x == 0 && j < njobs) pending = (int)atomicAdd(ctr, 1u);
  return j;
}

template <bool SWAP, class Epi>
DI void gemm_tile(const u16* __restrict__ A, int lda, const u16* __restrict__ Bw, int ldb, int K, char* lds, Epi epi) {
  const int tid = opaque_tid(), lane = tid & 63, w = tid >> 6, r = lane & 31, h = lane >> 5;
  const int wm = w & 3, wn = w >> 2;
  f32x16 acc[2][2];
#pragma unroll
  for (int a = 0; a < 2; ++a)
#pragma unroll
    for (int b = 0; b < 2; ++b)
#pragma unroll
      for (int i = 0; i < 16; ++i) acc[a][b][i] = 0.f;
  const int lrow = tid >> 3, lkc = tid & 7;
  u32x4 ra0[4], rb0[2], ra1[4], rb1[2];
  const u16* ap = A + (size_t)lrow * lda + lkc * 8;
  const u16* bp = Bw + (size_t)lrow * ldb + lkc * 8;
  const int nk = K >> 6;
  auto gload = [&](int kt, u32x4* ra, u32x4* rb) {
#pragma unroll
    for (int j = 0; j < 4; ++j) ra[j] = *(const u32x4*)(ap + (size_t)(64 * j) * lda + kt * 64);
#pragma unroll
    for (int j = 0; j < 2; ++j) rb[j] = *(const u32x4*)(bp + (size_t)(64 * j) * ldb + kt * 64);
  };
  auto lstore = [&](int st, const u32x4* ra, const u32x4* rb) {
    char* base = lds + st * GEMM_STAGE;
#pragma unroll
    for (int j = 0; j < 4; ++j) *(u32x4*)(base + ((lrow + 64 * j) * 72 + lkc * 8) * 2) = ra[j];
#pragma unroll
    for (int j = 0; j < 2; ++j) *(u32x4*)(base + 36864 + ((lrow + 64 * j) * 72 + lkc * 8) * 2) = rb[j];
  };
  auto compute = [&](int st) {
    const char* as = lds + st * GEMM_STAGE;
    const char* bs = as + 36864;
#pragma unroll
    for (int ks = 0; ks < 4; ++ks) {
      bf16x8 af[2], bfr[2];
#pragma unroll
      for (int mi = 0; mi < 2; ++mi) af[mi] = *(const bf16x8*)(as + ((wm * 64 + mi * 32 + r) * 72 + ks * 16 + 8 * h) * 2);
#pragma unroll
      for (int ni = 0; ni < 2; ++ni) bfr[ni] = *(const bf16x8*)(bs + ((wn * 64 + ni * 32 + r) * 72 + ks * 16 + 8 * h) * 2);
#pragma unroll
      for (int mi = 0; mi < 2; ++mi)
#pragma unroll
        for (int ni = 0; ni < 2; ++ni) {
          if (SWAP) acc[mi][ni] = MFMA32(bfr[ni], af[mi], acc[mi][ni]);
          else acc[mi][ni] = MFMA32(af[mi], bfr[ni], acc[mi][ni]);
        }
    }
  };
  gload(0, ra0, rb0);
  lstore(0, ra0, rb0);
  gload(1, ra1, rb1);
  __syncthreads();
  for (int kt = 0; kt < nk; kt += 2) {
    if (kt + 2 < nk) gload(kt + 2, ra0, rb0);
    compute(0);
    lstore(1, ra1, rb1);
    __syncthreads();
    if (kt + 3 < nk) gload(kt + 3, ra1, rb1);
    compute(1);
    if (kt + 2 < nk) lstore(0, ra0, rb0);
    __syncthreads();
  }
#pragma unroll
  for (int mi = 0; mi < 2; ++mi)
#pragma unroll
    for (int ni = 0; ni < 2; ++ni) epi(mi, ni, acc[mi][ni]);
}

DI void store_rowmajor(u16* dst, const f32x16& a, int h, float sc) {
#pragma unroll
  for (int kp = 0; kp < 2; ++kp) {
    const int g = 2 * kp;
    unsigned ax = pk2(a[4 * g] * sc, a[4 * g + 1] * sc), ay = pk2(a[4 * g + 2] * sc, a[4 * g + 3] * sc);
    unsigned bx = pk2(a[4 * g + 4] * sc, a[4 * g + 5] * sc), by = pk2(a[4 * g + 6] * sc, a[4 * g + 7] * sc);
    const u32x2 rx = __builtin_amdgcn_permlane32_swap(ax, bx, false, false);
    const u32x2 ry = __builtin_amdgcn_permlane32_swap(ay, by, false, false);
    const u32x4 v = {rx[0], ry[0], rx[1], ry[1]};
    *(u32x4*)(dst + 8 * (g + h)) = v;
  }
}
DI void store_rope(u16* dst, const f32x16& a, int h, float sc, const float* rp) {
#pragma unroll
  for (int g = 0; g < 2; ++g) {
    f32x4 cs = *(const f32x4*)(rp + 8 * g + 4 * h);
    f32x4 sn = *(const f32x4*)(rp + 16 + 8 * g + 4 * h);
    float o1[4], o2[4];
#pragma unroll
    for (int e = 0; e < 4; ++e) {
      float x1 = a[4 * g + e] * sc, x2 = a[8 + 4 * g + e] * sc;
      o1[e] = x1 * cs[e] - x2 * sn[e];
      o2[e] = x1 * sn[e] + x2 * cs[e];
    }
    u32x2 v1 = {pk2(o1[0], o1[1]), pk2(o1[2], o1[3])};
    u32x2 v2 = {pk2(o2[0], o2[1]), pk2(o2[2], o2[3])};
    *(u32x2*)(dst + 8 * g + 4 * h) = v1;
    *(u32x2*)(dst + 16 + 8 * g + 4 * h) = v2;
  }
}
DI void store_transposed(u16* dst, const f32x16& a, int h, const float* rs  ) {
#pragma unroll
  for (int g = 0; g < 4; ++g) {
    float s0 = 1.f, s1 = 1.f, s2 = 1.f, s3 = 1.f;
    if (rs) { f32x4 sv = *(const f32x4*)(rs + 8 * g + 4 * h); s0 = sv[0]; s1 = sv[1]; s2 = sv[2]; s3 = sv[3]; }
    u32x2 v = {pk2(a[4 * g] * s0, a[4 * g + 1] * s1), pk2(a[4 * g + 2] * s2, a[4 * g + 3] * s3)};
    *(u32x2*)(dst + 8 * g + 4 * h) = v;
  }
}

DI void inproj_tile(const Params& p, int l, int mt, int nt, char* lds) {
  const int tid = opaque_tid(), lane = tid & 63, w = tid >> 6, r = lane & 31, h = lane >> 5;
  const int wm = w & 3, wn = w >> 2;
  const int m0 = mt * 256;
  const u16* A = p.Xb + (size_t)m0 * DM;
  const u16* Bw = p.Wt_in + (size_t)nt * 128 * DM;
  if (nt < 42) {
    float ssq = 0.f;
    gemm_tile<true>(A, DM, Bw, DM, DM, lds, [&](int mi, int ni, const f32x16& a) {
      const int tok = m0 + wm * 64 + mi * 32 + r;
      store_rowmajor(p.H + (size_t)tok * LDH + nt * 128 + wn * 64 + ni * 32, a, h, 1.f);
      if (nt >= 4 && nt < 8) {
        if (ni == 0) ssq = 0.f;
#pragma unroll
        for (int i = 0; i < 16; ++i) ssq += a[i] * a[i];
        if (ni == 1) {
          float tot = ssq + __shfl_xor(ssq, 32);
          tot = wmax(tot);
          if (lane == 0) atomicMax(p.ctr + 64 + l * 16 + (m0 / PP) * 8 + (nt - 4) * 2 + wn, __float_as_uint(sqrtf(tot) * 1.01f));
        }
      }
    });
  } else if (nt == 42) {
    gemm_tile<true>(A, DM, Bw, DM, DM, lds, [&](int mi, int ni, const f32x16& a) {
      const int tok = m0 + wm * 64 + mi * 32 + r;
      const int b = tok / PP, t = tok - b * PP;
      const int sub = wn * 2 + ni;
      if (sub == 0) {
        store_rope(p.Kpe + (size_t)tok * 32, a, h, 1.f, p.ROPE + (size_t)t * 32);
      } else if (sub == 1) {
        store_rowmajor(p.IK + (size_t)tok * 64, a, h, 1.f);
      } else if (sub == 2) {
        store_rowmajor(p.IK + (size_t)tok * 64 + 32, a, h, 1.f);
      } else {
#pragma unroll
        for (int e = 0; e < 4; ++e) {
          const int hd = e + 4 * h;
          float xv = a[e] + p.b_f[l * 8 + hd];
          float lf = fminf(xv, 0.f) - log1pf(expf(-fabsf(xv)));
          p.LOGF[(size_t)(b * 8 + hd) * PP + t] = lf;
          p.IW[(size_t)tok * 8 + hd] = a[4 + e];
        }
      }
    });
  } else {
    u16* vt; int nv, c0;
    if (nt < 47) { vt = p.VtA; nv = 512; c0 = (nt - 43) * 128; } else { vt = p.VtD; nv = 128; c0 = 0; }
    gemm_tile<false>(A, DM, Bw, DM, DM, lds, [&](int mi, int ni, const f32x16& a) {
      const int b = m0 / PP, t0 = m0 - b * PP + wm * 64 + mi * 32;
      const int col = c0 + wn * 64 + ni * 32 + r;
      store_transposed(vt + ((size_t)b * nv + col) * PP + t0, a, h, nullptr);
    });
  }
}

DI void upproj_tile(const Params& p, int mt, int nt14, char* lds) {
  const int tid = opaque_tid(), lane = tid & 63, w = tid >> 6, r = lane & 31, h = lane >> 5;
  const int wm = w & 3, wn = w >> 2;
  const int m0 = mt * 256;
  float* rs = (float*)(lds + 2 * GEMM_STAGE);
  const bool isq = nt14 < 6;
  {
    const int row = tid >> 1, half = tid & 1;
    const int kw = isq ? 128 : 64;
    const u16* src = p.H + (size_t)(m0 + row) * LDH + (isq ? HCQ_B : HCKV_B) + half * kw;
    float ss = 0.f;
    u32x4 rv[16];
#pragma unroll
    for (int c = 0; c < 8; ++c) rv[c] = *(const u32x4*)(src + c * 8);
    if (isq) {
#pragma unroll
      for (int c = 8; c < 16; ++c) rv[c] = *(const u32x4*)(src + c * 8);
    } else {
#pragma unroll
      for (int c = 8; c < 16; ++c) { rv[c][0] = 0u; rv[c][1] = 0u; rv[c][2] = 0u; rv[c][3] = 0u; }
    }
#pragma unroll
    for (int c = 0; c < 16; ++c)
#pragma unroll
      for (int e = 0; e < 4; ++e) { float a = bf_lo(rv[c][e]), b2 = bf_hi(rv[c][e]); ss += a * a + b2 * b2; }
    ss += __shfl_xor(ss, 1);
    if (half == 0) rs[row] = rsqrtf(ss / (isq ? 256.f : 128.f) + 1e-6f);
  }
  __syncthreads();
  if (isq) {
    const int nt = nt14;
    gemm_tile<true>(p.H + (size_t)m0 * LDH + HCQ_B, LDH, p.Wt_uq + (size_t)nt * 128 * 256, 256, 256, lds, [&](int mi, int ni, const f32x16& a) {
      const int lr = wm * 64 + mi * 32 + r;
      const int tok = m0 + lr;
      const int t = tok % PP;
      const int j32 = nt * 4 + wn * 2 + ni;
      const float sc = rs[lr];
      u16* dst = p.Qm + (size_t)tok * 768 + j32 * 32;
      if (j32 % 3 == 2) store_rope(dst, a, h, sc, p.ROPE + (size_t)t * 32);
      else store_rowmajor(dst, a, h, sc);
    });
  } else {
    const int nt = nt14 - 6;
    const u16* A = p.H + (size_t)m0 * LDH + HCKV_B;
    const u16* Bw = p.Wt_ukv + (size_t)nt * 128 * 128;
    if (nt < 4) {
      gemm_tile<true>(A, LDH, Bw, 128, 128, lds, [&](int mi, int ni, const f32x16& a) {
        const int lr = wm * 64 + mi * 32 + r;
        store_rowmajor(p.Km + (size_t)(m0 + lr) * 512 + nt * 128 + wn * 64 + ni * 32, a, h, rs[lr]);
      });
    } else {
      gemm_tile<false>(A, LDH, Bw, 128, 128, lds, [&](int mi, int ni, const f32x16& a) {
        const int b = m0 / PP, t0 = m0 - b * PP + wm * 64 + mi * 32;
        const int col = (nt - 4) * 128 + wn * 64 + ni * 32 + r;
        store_transposed(p.VtB + ((size_t)b * 512 + col) * PP + t0, a, h, rs + wm * 64 + mi * 32);
      });
    }
  }
}

DI void cumsum_job(const Params& p, int j, char* lds) {
  const int tid = opaque_tid(), lane = tid & 63, w = tid >> 6;
  const float* src = p.LOGF + (size_t)j * PP;
  float* dst = p.CUM + (size_t)j * PP;
  float* wt = (float*)lds;
  float v[17];
#pragma unroll
  for (int rr = 0; rr < 17; ++rr) {
    const int o = rr * 64 + lane, i = w * 1056 + o;
    v[rr] = (o < 1056 && i >= LEAD) ? src[i] : 0.f;
  }
  float carry = 0.f;
#pragma unroll
  for (int rr = 0; rr < 17; ++rr) {
    float inc = v[rr];
    for (int o = 1; o < 64; o <<= 1) { float x = __shfl_up(inc, o); if (lane >= o) inc += x; }
    v[rr] = inc + carry;
    carry += __shfl(inc, 63);
  }
  if (lane == 0) wt[w] = carry;
  __syncthreads();
  float base = 0.f;
  for (int k = 0; k < w; ++k) base += wt[k];
#pragma unroll
  for (int rr = 0; rr < 17; ++rr) {
    const int o = rr * 64 + lane;
    if (o < 1056) dst[w * 1056 + o] = v[rr] + base;
  }
}

DI void topk_job(const Params& p, int b, int t0, char* lds) {
  const int tid = opaque_tid(), lane = tid & 63, w = tid >> 6, r = lane & 31, h = lane >> 5;
  const int cmax = (t0 + 3) >> 6;
  unsigned sc[17][4];
  {
    const u16* iqp = p.H + (size_t)(b * PP + t0 + (r >> 3)) * LDH + HIQ_C + (r & 7) * 64 + 8 * h;
    bf16x8 af[4];
#pragma unroll
    for (int ks = 0; ks < 4; ++ks) af[ks] = *(const bf16x8*)(iqp + ks * 16);
    f32x4 iw[4];
#pragma unroll
    for (int qi = 0; qi < 4; ++qi) iw[qi] = *(const f32x4*)(p.IW + (size_t)(b * PP + t0 + qi) * 8 + 4 * h);
    char* wb = lds + 16384 + w * 9216;
    const int lrow = lane >> 3, lpc = lane & 7;
    const u16* ikb = p.IK + ((size_t)(b * PP) + lrow) * 64 + lpc * 8;
    u32x4 st[8];
    if (1 + w <= cmax) {
      const u16* kp = ikb + (size_t)(1 + w) * 64 * 64;
#pragma unroll
      for (int j = 0; j < 8; ++j) st[j] = *(const u32x4*)(kp + (size_t)j * 8 * 64);
#pragma unroll
      for (int j = 0; j < 8; ++j) *(u32x4*)(wb + (lrow + 8 * j) * 144 + lpc * 16) = st[j];
    }
#pragma unroll
    for (int i = 0; i < 17; ++i) {
      const int c = 1 + w + 8 * i;
      if (c <= cmax) {
        const bool more = c + 8 <= cmax;
        if (more) {
          const u16* kp = ikb + (size_t)(c + 8) * 64 * 64;
#pragma unroll
          for (int j = 0; j < 8; ++j) st[j] = *(const u32x4*)(kp + (size_t)j * 8 * 64);
        }
        bf16x8 b0[4], b1[4];
#pragma unroll
        for (int ks = 0; ks < 4; ++ks) {
          b0[ks] = *(const bf16x8*)(wb + r * 144 + ks * 32 + h * 16);
          b1[ks] = *(const bf16x8*)(wb + (32 + r) * 144 + ks * 32 + h * 16);
        }
        __builtin_amdgcn_sched_barrier(0);
        f32x16 a0, a1;
#pragma unroll
        for (int e = 0; e < 16; ++e) { a0[e] = 0.f; a1[e] = 0.f; }
#pragma unroll
        for (int ks = 0; ks < 4; ++ks) { a0 = MFMA32(af[ks], b0[ks], a0); a1 = MFMA32(af[ks], b1[ks], a1); }
        const int key = c * 64 + lane;
#pragma unroll
        for (int qi = 0; qi < 4; ++qi) {
          float p0 = 0.f, p1 = 0.f;
#pragma unroll
          for (int e = 0; e < 4; ++e) {
            p0 += fmaxf(a0[4 * qi + e], 0.f) * iw[qi][e];
            p1 += fmaxf(a1[4 * qi + e], 0.f) * iw[qi][e];
          }
          const u32x2 sw = __builtin_amdgcn_permlane32_swap(__float_as_uint(p0), __float_as_uint(p1), false, false);
          float mine = __uint_as_float(sw[0]) + __uint_as_float(sw[1]);
          mine += 0.0f;
          unsigned u = __float_as_uint(mine);
          u = (u & 0x80000000u) ? ~u : (u | 0x80000000u);
          if (key > t0 + qi || key < LEAD) u = 0u;
          sc[i][qi] = u;
        }
        if (more) {
#pragma unroll
          for (int j = 0; j < 8; ++j) *(u32x4*)(wb + (lrow + 8 * j) * 144 + lpc * 16) = st[j];
        }
      } else {
#pragma unroll
        for (int qi = 0; qi < 4; ++qi) sc[i][qi] = 0u;
      }
    }
  }
  int* ng = (int*)(lds + 256);
  unsigned long long* mg = (unsigned long long*)(lds + 1024);
  unsigned long long* me = mg + 4 * 132;
  int* bg = (int*)(me + 4 * 132);
  int* be = bg + 4 * 132;
  unsigned T[4];
  {
    unsigned* hist = (unsigned*)(lds + 16384);
    int* sel = (int*)(lds + 512);
    unsigned pref[4] = {0u, 0u, 0u, 0u};
    int chi[4] = {0, 0, 0, 0};
    bool few[4] = {false, false, false, false};
    __syncthreads();
#pragma unroll
    for (int pass = 0; pass < 3; ++pass) {
      {
        const u32x4 z = {0u, 0u, 0u, 0u};
#pragma unroll
        for (int j = 0; j < 8; ++j) ((u32x4*)hist)[tid + 512 * j] = z;
      }
      __syncthreads();
#pragma unroll
      for (int i = 0; i < 17; ++i) {
#pragma unroll
        for (int q = 0; q < 4; ++q) {
          const unsigned u = sc[i][q];
          bool part; unsigned bin;
          if (pass == 0) { part = (u != 0u); bin = (u >> 22) + (lane & 3) * 1024; }
          else if (pass == 1) { part = (u != 0u) && ((u >> 22) == pref[q]) && !few[q]; bin = ((u >> 12) & 1023u) + (lane & 3) * 1024; }
          else { part = (u != 0u) && ((u >> 12) == pref[q]) && !few[q]; bin = u & 4095u; }
          if (part) atomicAdd(hist + q * 4096 + bin, 1u);
        }
      }
      __syncthreads();
      if (w < 4) {
        const int q = w;
        const unsigned* hq = hist + q * 4096;
        const int need = 256 - chi[q];
        int G = 0;
        if (pass < 2) {
#pragma unroll
          for (int rep = 0; rep < 4; ++rep)
#pragma unroll
            for (int j = 0; j < 16; ++j) G += (int)hq[rep * 1024 + 16 * lane + ((j + lane) & 15)];
        } else {
#pragma unroll 8
          for (int j = 0; j < 64; ++j) G += (int)hq[64 * lane + ((j + lane) & 63)];
        }
        int S = G;
        for (int o = 1; o < 64; o <<= 1) { int x = __shfl_down(S, o); if (lane + o < 64) S += x; }
        const unsigned long long mk = __ballot(S >= need);
        int B = 0, cg2 = 0, fw = 0;
        if (mk == 0ull) {
          fw = 1;
        } else {
          const int ks = 63 - __clzll(mk);
          const int above = (ks < 63) ? __shfl(S, ks + 1) : 0;
          int hh;
          if (pass < 2) {
            hh = 0;
            if (lane < 16) hh = (int)(hq[16 * ks + lane] + hq[1024 + 16 * ks + lane] + hq[2048 + 16 * ks + lane] + hq[3072 + 16 * ks + lane]);
          } else {
            hh = (int)hq[64 * ks + lane];
          }
          int s2 = hh;
          for (int o = 1; o < 64; o <<= 1) { int x = __shfl_down(s2, o); if (lane + o < 64) s2 += x; }
          const unsigned long long m2 = __ballot(above + s2 >= need);
          const int Ls = 63 - __clzll(m2);
          B = (pass < 2 ? 16 : 64) * ks + Ls;
          cg2 = above + __shfl(s2, Ls) - __shfl(hh, Ls);
        }
        if (lane == 0) { sel[q * 4 + 0] = B; sel[q * 4 + 1] = chi[q] + cg2; sel[q * 4 + 2] = fw; }
      }
      __syncthreads();
#pragma unroll
      for (int q = 0; q < 4; ++q) {
        if (!few[q]) {
          pref[q] = (pref[q] << (pass < 2 ? 10 : 12)) | (unsigned)sel[q * 4 + 0];
          chi[q] = sel[q * 4 + 1];
          if (pass == 0) few[q] = sel[q * 4 + 2] != 0;
        }
      }
    }
#pragma unroll
    for (int q = 0; q < 4; ++q) T[q] = few[q] ? 0u : pref[q];
  }
  unsigned* cntb = (unsigned*)mg;
  unsigned* baseb = (unsigned*)bg;
#pragma unroll
  for (int i = 0; i < 17; ++i) {
    const int c = 1 + w + 8 * i;
    if (c <= cmax) {
      unsigned mine = 0u;
#pragma unroll
      for (int q = 0; q < 4; ++q) {
        const unsigned pk = (unsigned)__popcll(__ballot(sc[i][q] > T[q])) | ((unsigned)__popcll(__ballot(sc[i][q] == T[q])) << 16);
        mine = (lane == q) ? pk : mine;
      }
      if (lane < 4) cntb[lane * 132 + c] = mine;
    }
  }
  __syncthreads();
  if (w < 4) {
    const int q = w;
    int cg_ = 0, ce_ = 0;
    for (int base = 0; base <= cmax; base += 64) {
      const int c = base + lane;
      const bool in = (c >= 1) && (c <= cmax);
      const unsigned cv = in ? cntb[q * 132 + c] : 0u;
      const int v1 = (int)(cv & 0xffffu), v2 = (int)(cv >> 16);
      int i1 = v1, i2 = v2;
      for (int o = 1; o < 64; o <<= 1) {
        int x1 = __shfl_up(i1, o), x2 = __shfl_up(i2, o);
        if (lane >= o) { i1 += x1; i2 += x2; }
      }
      if (in) baseb[q * 132 + c] = (unsigned)(cg_ + i1 - v1) | ((unsigned)(ce_ + i2 - v2) << 16);
      cg_ += __shfl(i1, 63);
      ce_ += __shfl(i2, 63);
    }
    if (lane == 0) ng[q] = cg_;
  }
  __syncthreads();
  const unsigned long long lt = (1ull << lane) - 1ull;
#pragma unroll
  for (int i = 0; i < 17; ++i) {
    const int c = 1 + w + 8 * i;
    if (c <= cmax) {
      const int key = c * 64 + lane;
#pragma unroll
      for (int q = 0; q < 4; ++q) {
        u16* out = p.IDX + (size_t)(b * PP + t0 + q) * 256;
        const bool gt = sc[i][q] > T[q];
        const bool eq = (sc[i][q] == T[q]) && (T[q] != 0u);
        const unsigned long long m1 = __ballot(gt), m2 = __ballot(eq);
        if ((m1 | m2) != 0ull) {
          const unsigned bb = baseb[q * 132 + c];
          if (gt) out[(int)(bb & 0xffffu) + __popcll(m1 & lt)] = (u16)key;
          if (eq) { const int pos = ng[q] + (int)(bb >> 16) + __popcll(m2 & lt); if (pos < 256) out[pos] = (u16)key; }
        }
      }
    }
  }
#pragma unroll
  for (int q = 0; q < 4; ++q) {
    if (T[q] == 0u) {
      u16* out = p.IDX + (size_t)(b * PP + t0 + q) * 256;
      if (tid < 256 && tid >= ng[q]) out[tid] = (u16)0xFFFF;
    }
  }
}

constexpr int AT_STAGE = 23040;
template <int DK, int MODE>
DI void attn_unit(const Params& p, int l, int b, int head, int qu, char* lds) {
  const int tid = opaque_tid(), lane = tid & 63, w = tid >> 6, r = lane & 31, h = lane >> 5;
  constexpr int KS = DK / 16, KST = DK + 8;
  const int q0 = qu * 256, qw0 = q0 + w * 32, qw = qw0 + r;
  const size_t tokq = (size_t)b * PP + qw;
  const u16 *qptr, *kptr, *vtptr, *gptr;
  int ldk;
  if (MODE == 0) {
    qptr = p.H + tokq * LDH + HQ_A + head * 64; kptr = p.H + (size_t)b * PP * LDH + HK_A + head * 64; ldk = LDH;
    vtptr = p.VtA + ((size_t)b * 512 + head * 64) * PP; gptr = p.H + tokq * LDH + HG_A + head * 64;
  } else if (MODE == 1) {
    qptr = p.Qm + tokq * 768 + head * 96; kptr = p.Km + (size_t)b * PP * 512 + head * 64; ldk = 512;
    vtptr = p.VtB + ((size_t)b * 512 + head * 64) * PP; gptr = p.H + tokq * LDH + HG_B + head * 64;
  } else {
    qptr = p.H + tokq * LDH + HQ_D + head * 64; kptr = p.H + (size_t)b * PP * LDH + HK_D + (head >> 2) * 64; ldk = LDH;
    vtptr = p.VtD + ((size_t)b * 128 + (head >> 2) * 64) * PP; gptr = p.H + tokq * LDH + HG_D + head * 64;
  }
  const float* cum = p.CUM + (size_t)(b * 8 + head) * PP;
  float* btab = (float*)(lds + 2 * AT_STAGE);
  bf16x8 qf[KS];
#pragma unroll
  for (int ks = 0; ks < KS; ++ks) qf[ks] = *(const bf16x8*)(qptr + ks * 16 + 8 * h);
  float cref = 0.f;
  if (MODE == 0) cref = cum[q0];
  if (MODE == 2) { if (tid < 128) btab[tid] = p.rel_bias[t5_bucket(tid) * 16 + 8 + head] * LOG2E; }
  const float sc2 = (MODE == 1 ? 0.10206207261596577f : 0.125f) * LOG2E;
  const int kt_hi = qu * 4 + 3;
  int kt_lo = 1;
  if (MODE == 2) { kt_lo = qu * 4 - 2; if (kt_lo < 1) kt_lo = 1; }
  u32x4 rk, rk2, rv;
  float re = 0.f;
  const int srow = tid >> 3, sc8 = tid & 7;
  auto gload = [&](int kt) {
    const int k0 = kt * 64;
    rk = *(const u32x4*)(kptr + (size_t)(k0 + srow) * ldk + sc8 * 8);
    if (MODE == 1) { if (tid < 256) rk2 = *(const u32x4*)(p.Kpe + ((size_t)b * PP + k0 + (tid >> 2)) * 32 + (tid & 3) * 8); }
    rv = *(const u32x4*)(vtptr + (size_t)srow * PP + k0 + sc8 * 8);
    if (MODE == 0) { if (tid < 64) re = (cum[k0 + tid] - cref) * LOG2E; }
  };
  auto lstore = [&](int st) {
    char* base = lds + st * AT_STAGE;
    *(u32x4*)(base + (srow * KST + sc8 * 8) * 2) = rk;
    if (MODE == 1) { if (tid < 256) *(u32x4*)(base + ((tid >> 2) * KST + 64 + (tid & 3) * 8) * 2) = rk2; }
    char* vb = base + 64 * KST * 2;
    u32x2 lo = {rv[0], rv[1]}, hi = {rv[2], rv[3]};
    *(u32x2*)(vb + (srow * 68 + sc8 * 8) * 2) = lo;
    *(u32x2*)(vb + (srow * 68 + sc8 * 8 + 4) * 2) = hi;
    if (MODE == 0) { if (tid < 64) *(float*)(vb + 64 * 68 * 2 + tid * 4) = re; }
  };
  f32x16 o[2];
#pragma unroll
  for (int d = 0; d < 2; ++d)
#pragma unroll
    for (int i = 0; i < 16; ++i) o[d][i] = 0.f;
  float m = NEGL, lsum = 0.f;
  float qn = 0.f, kmx = 0.f;
  int* stopf = (int*)(lds + 2 * AT_STAGE + 1024);
  if (MODE == 0) {
#pragma unroll
    for (int ks = 0; ks < KS; ++ks) {
      const u32x4 qq = __builtin_bit_cast(u32x4, qf[ks]);
#pragma unroll
      for (int e = 0; e < 4; ++e) { const float a = bf_lo(qq[e]), b2 = bf_hi(qq[e]); qn += a * a + b2 * b2; }
    }
    qn += __shfl_xor(qn, 32);
    qn = sqrtf(qn) * 1.01f;
    kmx = __uint_as_float(p.ctr[64 + l * 16 + b * 8 + head]);
  }
  gload(kt_hi); lstore(0);
  __syncthreads();
  for (int kt = kt_hi; kt >= kt_lo; --kt) {
    const bool more = kt > kt_lo;
    if (more) gload(kt - 1);
    float cnext = 0.f;
    if (MODE == 0) { if (more) cnext = cum[(kt - 1) * 64 + 63]; }
    const int st = (kt_hi - kt) & 1;
    const int k0 = kt * 64;
    bool active = k0 <= qw0 + 31;
    if (MODE == 2) active = active && (k0 + 63 >= qw0 - 127);
    if (active) {
      const char* kb = lds + st * AT_STAGE;
      const char* vb = kb + 64 * KST * 2;
      f32x16 s[2];
      bf16x8 kf[2][KS];
#pragma unroll
      for (int kr = 0; kr < 2; ++kr)
#pragma unroll
        for (int ks = 0; ks < KS; ++ks) kf[kr][ks] = *(const bf16x8*)(kb + ((kr * 32 + r) * KST + ks * 16 + 8 * h) * 2);
      __builtin_amdgcn_sched_barrier(0);
#pragma unroll
      for (int kr = 0; kr < 2; ++kr) {
#pragma unroll
        for (int i = 0; i < 16; ++i) s[kr][i] = 0.f;
#pragma unroll
        for (int ks = 0; ks < KS; ++ks) s[kr] = MFMA32(kf[kr][ks], qf[ks], s[kr]);
      }
      u32x4 vfr[2][2][2];
#pragma unroll
      for (int kr = 0; kr < 2; ++kr)
#pragma unroll
        for (int s2 = 0; s2 < 2; ++s2)
#pragma unroll
          for (int d = 0; d < 2; ++d) {
            const char* va = vb + ((d * 32 + r) * 68 + kr * 32 + s2 * 16 + 4 * h) * 2;
            const u32x2 lo = *(const u32x2*)va;
            const u32x2 hi = *(const u32x2*)(va + 16);
            vfr[kr][s2][d] = (u32x4){lo[0], lo[1], hi[0], hi[1]};
          }
      __builtin_amdgcn_sched_barrier(0);
      const bool need_mask = (MODE == 2) || (k0 + 63 > qw0) || (k0 < LEAD);
      const bool rawpath = (MODE == 1) && !need_mask;
      float tmax = NEGL;
      const f32x2 sc2v = {sc2, sc2};
      if (rawpath) {
#pragma unroll
        for (int kr = 0; kr < 2; ++kr)
#pragma unroll
          for (int i = 0; i < 16; ++i) tmax = fmaxf(tmax, s[kr][i]);
        tmax *= sc2;
      } else {
#pragma unroll
        for (int kr = 0; kr < 2; ++kr) {
#pragma unroll
          for (int g = 0; g < 4; ++g) {
            f32x4 ev = {0.f, 0.f, 0.f, 0.f};
            if (MODE == 0) ev = *(const f32x4*)(vb + 64 * 68 * 2 + (kr * 32 + 8 * g + 4 * h) * 4);
#pragma unroll
            for (int e2 = 0; e2 < 2; ++e2) {
              const int i = 4 * g + 2 * e2;
              f32x2 v2 = {s[kr][i], s[kr][i + 1]};
              if (MODE == 0) { const f32x2 e2v = {ev[2 * e2], ev[2 * e2 + 1]}; v2 = v2 * sc2v - e2v; }
              else v2 = v2 * sc2v;
#pragma unroll
              for (int e1 = 0; e1 < 2; ++e1) {
                const int key = k0 + kr * 32 + 8 * g + 4 * h + 2 * e2 + e1;
                float v = v2[e1];
                if (MODE == 2) v += btab[(qw - key) & 127];
                if (need_mask) {
                  bool ok = (key <= qw) && (key >= LEAD);
                  if (MODE == 2) ok = ok && (qw - key < 128);
                  v = ok ? v : NEGL;
                }
                s[kr][i + e1] = v;
                tmax = fmaxf(tmax, v);
              }
            }
          }
        }
      }
      tmax = fmaxf(tmax, __shfl_xor(tmax, 32));
      const float mn = fmaxf(m, tmax);
      const float alpha = __builtin_amdgcn_exp2f(m - mn);
      const bool resc = __any(m != mn);
      m = mn;
      f32x2 ps2 = {0.f, 0.f};
      const f32x2 mnv = {mn, mn};
      const f32x2 scx = rawpath ? sc2v : (f32x2){1.f, 1.f};
#pragma unroll
      for (int kr = 0; kr < 2; ++kr)
#pragma unroll
        for (int i = 0; i < 16; i += 2) {
          f32x2 v2 = {s[kr][i], s[kr][i + 1]};
          v2 = v2 * scx - mnv;
          f32x2 p2 = {__builtin_amdgcn_exp2f(v2[0]), __builtin_amdgcn_exp2f(v2[1])};
          s[kr][i] = p2[0]; s[kr][i + 1] = p2[1];
          ps2 += p2;
        }
      const float ps = ps2[0] + ps2[1];
      lsum = lsum * alpha + ps;
      if (resc)
#pragma unroll
      for (int d = 0; d < 2; ++d)
#pragma unroll
        for (int i = 0; i < 16; ++i) o[d][i] *= alpha;
#pragma unroll
      for (int kr = 0; kr < 2; ++kr) {
#pragma unroll
        for (int s2 = 0; s2 < 2; ++s2) {
          u32x4 pp = {pk2(s[kr][8 * s2], s[kr][8 * s2 + 1]), pk2(s[kr][8 * s2 + 2], s[kr][8 * s2 + 3]),
                      pk2(s[kr][8 * s2 + 4], s[kr][8 * s2 + 5]), pk2(s[kr][8 * s2 + 6], s[kr][8 * s2 + 7])};
          bf16x8 pf = __builtin_bit_cast(bf16x8, pp);
#pragma unroll
          for (int d = 0; d < 2; ++d) o[d] = MFMA32(__builtin_bit_cast(bf16x8, vfr[kr][s2][d]), pf, o[d]);
        }
      }
    }
    if (more) lstore(st ^ 1);
    if (MODE == 0) {
      if (more) {
        const float enext = (cnext - cref) * LOG2E;
        const bool okl = (qn * kmx * sc2 - enext) <= (m - 40.f);
        const bool okw = __all(okl);
        if (lane == 0) stopf[(kt & 1) * 8 + w] = okw ? 1 : 0;
      }
    }
    __syncthreads();
    if (MODE == 0) {
      if (more) {
        const int* sf = stopf + (kt & 1) * 8;
        if (sf[0] & sf[1] & sf[2] & sf[3] & sf[4] & sf[5] & sf[6] & sf[7]) break;
      }
    }
  }
  lsum += __shfl_xor(lsum, 32);
  float f;
  if (MODE == 2) {
    const float s2 = p.sinks[l * 8 + head] * LOG2E;
    const float mf = fmaxf(m, s2);
    const float em = __builtin_amdgcn_exp2f(m - mf);
    f = em / (lsum * em + __builtin_amdgcn_exp2f(s2 - mf));
  } else {
    f = lsum > 0.f ? 1.f / lsum : 0.f;
  }
  f *= (MODE == 0 ? SC_FOX : (MODE == 1 ? SC_MLA : SC_SWA));
  u16* mp = p.Mix + tokq * 2048 + (MODE == 0 ? 0 : (MODE == 1 ? 512 : 1536)) + head * 64;
#pragma unroll
  for (int d = 0; d < 2; ++d)
#pragma unroll
    for (int g = 0; g < 4; ++g) {
      const int dd = d * 32 + 8 * g + 4 * h;
      u32x2 gv = *(const u32x2*)(gptr + dd);
      float g0 = silu(bf_lo(gv[0])), g1 = silu(bf_hi(gv[0])), g2 = silu(bf_lo(gv[1])), g3 = silu(bf_hi(gv[1]));
      u32x2 ov = {pk2(o[d][4 * g] * f * g0, o[d][4 * g + 1] * f * g1), pk2(o[d][4 * g + 2] * f * g2, o[d][4 * g + 3] * f * g3)};
      *(u32x2*)(mp + dd) = ov;
    }
}

DI void dsa_job(const Params& p, int b, int tq0, char* lds) {
  const int tid = opaque_tid(), lane = tid & 63, w = tid >> 6;
  float* biasC = (float*)(lds + 143360);
  int* btab = (int*)(lds + 143360 + 1024);
  char* wl = lds + w * 17920;
  float* Pl = (float*)wl;
  int* kid = (int*)(wl + 8192);
  const int tq = tq0 + w;
  const size_t tok = (size_t)b * PP + tq;
  const u16* Hb = p.H + (size_t)b * PP * LDH;
  int kk[4], ku[4];
  {
    u32x2 iv = *(const u32x2*)(p.IDX + tok * 256 + 4 * lane);
    kk[0] = iv[0] & 0xffff; kk[1] = iv[0] >> 16; kk[2] = iv[1] & 0xffff; kk[3] = iv[1] >> 16;
#pragma unroll
    for (int j = 0; j < 4; ++j) ku[j] = (kk[j] == 0xFFFF) ? LEAD : kk[j];
    u32x4 kv4 = {(unsigned)ku[0], (unsigned)ku[1], (unsigned)ku[2], (unsigned)ku[3]};
    ((u32x4*)kid)[lane] = kv4;
  }
  u32x4 gvp[4];
#pragma unroll
  for (int hh = 0; hh < 4; ++hh) gvp[hh] = *(const u32x4*)(p.H + tok * LDH + HG_C + (((lane >> 3) & 1) * 4 + hh) * 64 + (lane & 7) * 8);
  __builtin_amdgcn_wave_barrier();
  const int ksub = lane >> 4, g = (lane >> 3) & 1, dc = lane & 7;
  {
    const int r = lane & 31, h = lane >> 5, pc = lane & 15;
    char* kst = wl + 9216;
    bf16x8 qb[8];
#pragma unroll
    for (int ks = 0; ks < 8; ++ks) {
      u32x4 v = {0u, 0u, 0u, 0u};
      if (r < 8 && (ks >> 2) == (r >> 2)) v = *(const u32x4*)(p.H + tok * LDH + HQ_C + r * 64 + (ks & 3) * 16 + 8 * h);
      qb[ks] = __builtin_bit_cast(bf16x8, v);
    }
    const u16* kbase = Hb + HK_C + pc * 8;
    u32x4 st0[8], st1[8];
#pragma unroll
    for (int s2 = 0; s2 < 8; ++s2) st0[s2] = *(const u32x4*)(kbase + (size_t)kid[4 * s2 + ksub] * LDH);
#pragma unroll
    for (int s2 = 0; s2 < 8; ++s2) st1[s2] = *(const u32x4*)(kbase + (size_t)kid[32 + 4 * s2 + ksub] * LDH);
    auto chunk = [&](int c, u32x4* stc) {
#pragma unroll
      for (int s2 = 0; s2 < 8; ++s2) *(u32x4*)(kst + (4 * s2 + ksub) * 272 + pc * 16) = stc[s2];
      if (c + 2 < 8) {
#pragma unroll
        for (int s2 = 0; s2 < 8; ++s2) stc[s2] = *(const u32x4*)(kbase + (size_t)kid[32 * (c + 2) + 4 * s2 + ksub] * LDH);
      }
      bf16x8 af[8];
#pragma unroll
      for (int ks = 0; ks < 8; ++ks) af[ks] = *(const bf16x8*)(kst + r * 272 + ks * 32 + 16 * h);
      __builtin_amdgcn_sched_barrier(0);
      f32x16 acc0, acc1;
#pragma unroll
      for (int i = 0; i < 16; ++i) { acc0[i] = 0.f; acc1[i] = 0.f; }
#pragma unroll
      for (int ks = 0; ks < 8; ks += 2) { acc0 = MFMA32(af[ks], qb[ks], acc0); acc1 = MFMA32(af[ks + 1], qb[ks + 1], acc1); }
      if (r < 8) {
#pragma unroll
        for (int i = 0; i < 16; ++i) Pl[(32 * c + crow(i, h)) * 8 + r] = acc0[i] + acc1[i];
      }
    };
#pragma unroll 1
    for (int c = 0; c < 8; c += 2) { chunk(c, st0); chunk(c + 1, st1); }
  }
  __builtin_amdgcn_wave_barrier();
  float lg[4][8];
#pragma unroll
  for (int j = 0; j < 4; ++j) {
    const f32x4 v0 = *(const f32x4*)(Pl + (4 * lane + j) * 8), v1 = *(const f32x4*)(Pl + (4 * lane + j) * 8 + 4);
#pragma unroll
    for (int e = 0; e < 4; ++e) { lg[j][e] = v0[e]; lg[j][4 + e] = v1[e]; }
  }
  int bk[4];
#pragma unroll
  for (int j = 0; j < 4; ++j) { int dist = tq - ku[j]; bk[j] = (dist < 128) ? btab[dist & 127] : 31; }
#pragma unroll
  for (int hd = 0; hd < 8; ++hd) {
    float mx = NEGL;
#pragma unroll
    for (int j = 0; j < 4; ++j) {
      float v = lg[j][hd] * 0.125f + biasC[bk[j] * 8 + hd];
      v = (kk[j] == 0xFFFF) ? NEGL : v;
      lg[j][hd] = v;
      mx = fmaxf(mx, v);
    }
    mx = wmax(mx);
    float sm = 0.f;
#pragma unroll
    for (int j = 0; j < 4; ++j) { float e = __expf(lg[j][hd] - mx); lg[j][hd] = e; sm += e; }
    sm = wsum(sm);
    const float inv = 1.f / sm;
#pragma unroll
    for (int j = 0; j < 4; ++j) lg[j][hd] *= inv;
  }
#pragma unroll
  for (int j = 0; j < 4; ++j) {
    f32x4 v0 = {lg[j][0], lg[j][1], lg[j][2], lg[j][3]}, v1 = {lg[j][4], lg[j][5], lg[j][6], lg[j][7]};
    *(f32x4*)(Pl + (4 * lane + j) * 8) = v0;
    *(f32x4*)(Pl + (4 * lane + j) * 8 + 4) = v1;
  }
  __builtin_amdgcn_wave_barrier();
  const u16* vb = Hb + HV_C + g * 64 + dc * 8;
  f32x2 acc2[4][4];
#pragma unroll
  for (int hh = 0; hh < 4; ++hh)
#pragma unroll
    for (int e = 0; e < 4; ++e) { acc2[hh][e][0] = 0.f; acc2[hh][e][1] = 0.f; }
  u32x4 vA[16], vB[16];
  auto pv_load = [&](int grp, u32x4* dst) {
#pragma unroll
    for (int s = 0; s < 16; ++s) dst[s] = *(const u32x4*)(vb + (size_t)kid[4 * (grp * 16 + s) + ksub] * LDH);
  };
  auto pv_fma = [&](int grp, const u32x4* src) {
#pragma unroll
    for (int s = 0; s < 16; ++s) {
      const int slot = 4 * (grp * 16 + s) + ksub;
      const f32x4 pp = *(const f32x4*)(Pl + slot * 8 + g * 4);
      const u32x4 vv = src[s];
#pragma unroll
      for (int hh = 0; hh < 4; ++hh) {
        const f32x2 ph = {pp[hh], pp[hh]};
#pragma unroll
        for (int e = 0; e < 4; ++e) {
          const f32x2 vf2 = {bf_lo(vv[e]), bf_hi(vv[e])};
          acc2[hh][e] += ph * vf2;
        }
      }
    }
  };
  pv_load(0, vA);
  pv_load(1, vB);
  pv_fma(0, vA);
  pv_load(2, vA);
  pv_fma(1, vB);
  pv_load(3, vB);
  pv_fma(2, vA);
  pv_fma(3, vB);
  float acc[4][8];
#pragma unroll
  for (int hh = 0; hh < 4; ++hh)
#pragma unroll
    for (int e = 0; e < 8; ++e) { float v = acc2[hh][e >> 1][e & 1]; v += __shfl_xor(v, 16); v += __shfl_xor(v, 32); acc[hh][e] = v; }
  if (ksub == 0) {
#pragma unroll
    for (int hh = 0; hh < 4; ++hh) {
      const int hd = g * 4 + hh;
      const u32x4 gv = gvp[hh];
      u32x4 ov;
#pragma unroll
      for (int e = 0; e < 4; ++e) ov[e] = pk2(acc[hh][2 * e] * SC_DSA * silu(bf_lo(gv[e])), acc[hh][2 * e + 1] * SC_DSA * silu(bf_hi(gv[e])));
      *(u32x4*)(p.Mix + tok * 2048 + 1024 + hd * 64 + dc * 8) = ov;
    }
  }
}

DI void outproj_tile(const Params& p, int mt, int nt, char* lds) {
  const int tid = opaque_tid(), lane = tid & 63, w = tid >> 6, r = lane & 31, h = lane >> 5;
  const int wm = w & 3, wn = w >> 2;
  const int m0 = mt * 256;
  gemm_tile<true>(p.Mix + (size_t)m0 * 2048, 2048, p.Wt_out + (size_t)nt * 128 * 2048, 2048, 2048, lds, [&](int mi, int ni, const f32x16& a) {
    const int tok = m0 + wm * 64 + mi * 32 + r;
    float* rp = p.R + (size_t)tok * DM + nt * 128 + wn * 64 + ni * 32;
#pragma unroll
    for (int g = 0; g < 4; ++g) {
      f32x4 v = *(const f32x4*)(rp + 8 * g + 4 * h);
#pragma unroll
      for (int e = 0; e < 4; ++e) v[e] = ALPHA * v[e] + a[4 * g + e];
      *(f32x4*)(rp + 8 * g + 4 * h) = v;
    }
  });
}

DI void ln_rows(const Params& p, int l) {
  const int tid = opaque_tid(), lane = tid & 63, w = tid >> 6;
  const float* gg = l < 0 ? p.ln0_g : p.ln_g + l * DM;
  const float* bb = l < 0 ? p.ln0_b : p.ln_b + l * DM;
  for (int row = blockIdx.x * 8 + w; row < MT; row += gridDim.x * 8) {
    const int b = row / PP, t = row - b * PP;
    f32x4 v[4];
    if (l < 0) {
      const float* src = nullptr;
      if (t >= 128 && t < PV) src = p.x + ((size_t)b * SEQ + (t - 128)) * DM;
      else if (t >= LEAD && t < 128) src = p.meta + (size_t)(t - LEAD) * DM;
#pragma unroll
      for (int j = 0; j < 4; ++j) {
        if (src) v[j] = *(const f32x4*)(src + lane * 4 + 256 * j);
        else { v[j][0] = 0.f; v[j][1] = 0.f; v[j][2] = 0.f; v[j][3] = 0.f; }
      }
    } else {
#pragma unroll
      for (int j = 0; j < 4; ++j) v[j] = *(const f32x4*)(p.R + (size_t)row * DM + lane * 4 + 256 * j);
    }
    float s = 0.f;
#pragma unroll
    for (int j = 0; j < 4; ++j) s += v[j][0] + v[j][1] + v[j][2] + v[j][3];
    const float mu = wsum(s) * (1.f / DM);
    float q = 0.f;
#pragma unroll
    for (int j = 0; j < 4; ++j)
#pragma unroll
      for (int e = 0; e < 4; ++e) { float d = v[j][e] - mu; q += d * d; }
    const float rstd = rsqrtf(wsum(q) * (1.f / DM) + 1e-5f);
#pragma unroll
    for (int j = 0; j < 4; ++j) {
      const int c = lane * 4 + 256 * j;
      f32x4 g4 = *(const f32x4*)(gg + c), b4 = *(const f32x4*)(bb + c);
      f32x4 y;
#pragma unroll
      for (int e = 0; e < 4; ++e) y[e] = (v[j][e] - mu) * rstd * g4[e] + b4[e];
      if (l == 3) {
        if (t >= 128 && t < PV) *(f32x4*)(p.out + ((size_t)b * SEQ + (t - 128)) * DM + c) = y;
      } else {
        *(f32x4*)(p.R + (size_t)row * DM + c) = y;
        u32x2 yb = {pk2(y[0], y[1]), pk2(y[2], y[3])};
        *(u32x2*)(p.Xb + (size_t)row * DM + c) = yb;
      }
    }
  }
}

DI int map_in(int n) {
  if (n < 512) return n;
  if (n < 1024) return n;
  if (n < 1536) return 1544 + (n - 1024);
  if (n < 1792) return 2056 + (n - 1536);
  if (n < 1920) return 2312 + (n - 1792);
  if (n < 2432) return 2472 + (n - 1920);
  if (n < 2944) return 2984 + (n - 2432);
  if (n < 3072) return 3496 + (n - 2944);
  if (n < 3200) return 3624 + (n - 3072);
  if (n < 3712) return 3752 + (n - 3200);
  if (n < 4224) return 4336 + (n - 3712);
  if (n < 4736) return 4848 + (n - 4224);
  if (n < 4864) return 5360 + (n - 4736);
  if (n < 5376) return 5616 + (n - 4864);
  if (n < 5408) return 2440 + (n - 5376);
  if (n < 5472) return 4264 + (n - 5408);
  if (n < 5480) return 1536 + (n - 5472);
  if (n < 5488) return 4328 + (n - 5480);
  if (n < 5504) return -1;
  if (n < 6016) return 1024 + (n - 5504);
  return 5488 + (n - 6016);
}
DI void conv_weights(const Params& p, int l, char* lds) {
  const int tid = opaque_tid();
  float* tile = (float*)lds;
  for (int tI = blockIdx.x; tI < 2128; tI += gridDim.x) {
    const float* src; const float* ksc = nullptr; u16* dst; int ldsrc, K, kind, kt, ntile;
    if (tI < 1536) { kind = 0; kt = tI / 96; ntile = tI % 96; src = p.w_in + (size_t)l * DM * D_IN; ldsrc = D_IN; K = DM; dst = p.Wt_in; }
    else if (tI < 2048) { int u = tI - 1536; kind = 1; kt = u / 16; ntile = u % 16; src = p.w_out + (size_t)l * 2048 * DM; ldsrc = DM; K = 2048; dst = p.Wt_out; }
    else if (tI < 2096) { int u = tI - 2048; kind = 2; kt = u / 12; ntile = u % 12; src = p.w_uq + (size_t)l * 256 * 768; ldsrc = 768; K = 256; dst = p.Wt_uq; ksc = p.gq + l * 256; }
    else { int u = tI - 2096; kind = 3; kt = u / 16; ntile = u % 16; src = p.w_ukv + (size_t)l * 128 * 1024; ldsrc = 1024; K = 128; dst = p.Wt_ukv; ksc = p.gkv + l * 128; }
    const int k0 = kt * 64, n0 = ntile * 64;
    {
      const int nn = tid & 63;
      const int n = n0 + nn;
      int sc;
      if (kind == 0) sc = map_in(n);
      else if (kind == 3) sc = (n < 512) ? ((n >> 6) * 128 + (n & 63)) : (((n - 512) >> 6) * 128 + 64 + (n & 63));
      else sc = n;
#pragma unroll
      for (int j = 0; j < 8; ++j) {
        const int kk = (tid >> 6) + 8 * j;
        float v = 0.f;
        if (sc >= 0) v = src[(size_t)(k0 + kk) * ldsrc + sc];
        if (ksc) v *= ksc[k0 + kk];
        tile[nn * 65 + kk] = v;
      }
    }
    __syncthreads();
    {
      const int nn = tid >> 3, kc = (tid & 7) * 8;
      const float* tp = tile + nn * 65 + kc;
      u32x4 ov = {pk2(tp[0], tp[1]), pk2(tp[2], tp[3]), pk2(tp[4], tp[5]), pk2(tp[6], tp[7])};
      *(u32x4*)(dst + (size_t)(n0 + nn) * K + k0 + kc) = ov;
    }
    __syncthreads();
  }
}
DI void rope_table(const Params& p) {
  const int gt = blockIdx.x * NTHREADS + threadIdx.x;
  for (int i = gt; i < PP * 16; i += gridDim.x * NTHREADS) {
    const int t = i >> 4, c = i & 15;
    const float freq = powf(10000.f, -(float)c / 16.f);
    const float ang = (float)(t - LEAD) * freq;
    float sn, cs;
    sincosf(ang, &sn, &cs);
    p.ROPE[(size_t)t * 32 + c] = cs;
    p.ROPE[(size_t)t * 32 + 16 + c] = sn;
  }
}


#define XB_TMO      128
#define XB_XCNT(j)  (256  + 64 * (j))
#define XB_XSUB(j)  (1280 + 64 * (j))
#define XB_XGEN(j)  (2304 + 64 * (j))
#define XB_TOP      3328
#define XB_TOPGEN   3392
#define XCD_BAR_WORDS 3456
#define XB_SPIN_CAP (1u << 18)
DI unsigned xb_ld(unsigned* p) { return __hip_atomic_load(p, __ATOMIC_RELAXED, __HIP_MEMORY_SCOPE_AGENT); }
DI unsigned xb_add(unsigned* p, unsigned v) { return __hip_atomic_fetch_add(p, v, __ATOMIC_RELAXED, __HIP_MEMORY_SCOPE_AGENT); }
DI unsigned xb_xcc_id() { return (unsigned)__builtin_amdgcn_s_getreg((3 << 11) | 20) & 0xFu; }
#define XB_SPIN(cond, bar) do { unsigned _sp = 0; while (cond) { __builtin_amdgcn_s_sleep(1); \
    if ((++_sp & 255u) == 0u) { if (xb_ld(&(bar)[XB_TMO])) break; if (_sp > XB_SPIN_CAP) { atomicAdd(&(bar)[XB_TMO], 1u); break; } } } } while (0)
struct XcdBarrier { unsigned* bar; unsigned x; volatile unsigned* st; };
DI XcdBarrier xcd_barrier_post(unsigned* bar, volatile unsigned* st) {
  XcdBarrier b; b.bar = bar; b.x = xb_xcc_id(); b.st = st;
  if (threadIdx.x == 0) (void)xb_add(&bar[XB_XCNT(b.x)], 1u);
  return b;
}
DI void xcd_barrier_complete(unsigned* bar, unsigned x, unsigned& nloc, unsigned& nx) {
  const unsigned G = gridDim.x * gridDim.y * gridDim.z;
  unsigned sum, cnt, mine, sp = 0u;
  for (;;) {
    sum = 0u; cnt = 0u; mine = 0u;
#pragma unroll
    for (unsigned j = 0; j < 16; ++j) { const unsigned c = xb_ld(&bar[XB_XCNT(j)]); sum += c; cnt += (c > 0u) ? 1u : 0u; mine = (j == x) ? c : mine; }
    if (sum == G) break;
    __builtin_amdgcn_s_sleep(1);
    if ((++sp & 255u) == 0u) { if (xb_ld(&bar[XB_TMO])) break; if (sp > XB_SPIN_CAP) { atomicAdd(&bar[XB_TMO], 1u); break; } }
  }
  nloc = mine > 0u ? mine : 1u; nx = cnt > 0u ? cnt : 1u;
}
DI void xcd_barrier(const XcdBarrier& b) {
  asm volatile("s_waitcnt vmcnt(0)" ::: "memory");
  __syncthreads();
  if (threadIdx.x == 0) {
    unsigned* bar = b.bar;
    __builtin_amdgcn_s_waitcnt(0);
    unsigned nloc = b.st[0], nx = b.st[1];
    if (nloc == 0u) { xcd_barrier_complete(bar, b.x, nloc, nx); b.st[0] = nloc; b.st[1] = nx; }
    const unsigned old = xb_add(&bar[XB_XSUB(b.x)], 1u);
    const unsigned gen = old / nloc;
    if (old + 1u == (gen + 1u) * nloc) {
      __builtin_amdgcn_fence(__ATOMIC_RELEASE, "agent");
      asm volatile("s_waitcnt vmcnt(0)" ::: "memory");
      const unsigned og = xb_add(&bar[XB_TOP], 1u);
      const unsigned tg = og / nx;
      if (og + 1u == (tg + 1u) * nx) xb_add(&bar[XB_TOPGEN], 1u);
      else XB_SPIN(xb_ld(&bar[XB_TOPGEN]) == tg, bar);
      __builtin_amdgcn_fence(__ATOMIC_ACQUIRE, "agent");
      xb_add(&bar[XB_XGEN(b.x)], 1u);
      asm volatile("s_waitcnt vmcnt(0)" ::: "memory");
    } else {
      XB_SPIN(xb_ld(&bar[XB_XGEN(b.x)]) == gen, bar);
      __builtin_amdgcn_fence(__ATOMIC_ACQUIRE, "agent");
      asm volatile("s_waitcnt vmcnt(0)" ::: "memory");
    }
  }
  __syncthreads();
}

__global__ void __launch_bounds__(NTHREADS) mega(Params p) {
  extern __shared__ __attribute__((aligned(16))) char lds[];
  cg::grid_group grid = cg::this_grid();
  ln_rows(p, -1);
  conv_weights(p, 0, lds);
  rope_table(p);
  if (blockIdx.x == 0) {
    if (threadIdx.x < 256) p.ctr[threadIdx.x] = 0u;
    for (int i = threadIdx.x; i < XCD_BAR_WORDS; i += NTHREADS) p.bar[i] = 0u;
  }
  volatile unsigned* xst = (volatile unsigned*)(lds + LDS_JOB + 16);
  if (threadIdx.x == 0) { xst[0] = 0u; xst[1] = 0u; }
  grid.sync();
  const XcdBarrier xb = xcd_barrier_post(p.bar, xst);
  for (int l = 0; l < 4; ++l) {
    for (int rep = 0; rep < REP_P1; ++rep) {
      for (int j = blockIdx.x; j < 66 * 48; j += gridDim.x) inproj_tile(p, l, j / 48, j % 48, lds);
      xcd_barrier(xb);
    }
    for (int rep = 0; rep < REP_P2; ++rep) {
      constexpr int NTK = 2 * 2052, NUP = 66 * 14, NJ = NTK + NUP + 16;
      int pending = 0;
      if (threadIdx.x == 0) pending = (int)atomicAdd(p.ctr + l * 2 + 8 * rep, 1u);
      for (;;) {
        const int j = next_job(p.ctr + l * 2 + 8 * rep, lds, pending, NJ);
        if (j >= NJ) break;
        if (j < 16) {
          cumsum_job(p, j, lds);
        } else if (j < 16 + NTK) {
          const int jj = j - 16;
          const int b = jj & 1, q = 2051 - (jj >> 1);
          topk_job(p, b, LEAD + 4 * q, lds);
        } else {
          const int u = j - 16 - NTK;
          upproj_tile(p, u / 14, u % 14, lds);
        }
      }
      xcd_barrier(xb);
    }
    for (int rep = 0; rep < REP_P3; ++rep) {
      constexpr int ND = 1056, NS = 528, NC = 2 * 1026, NJ = ND + NS + NC;
      {
        float* biasC = (float*)(lds + 143360);
        int* btab = (int*)(lds + 143360 + 1024);
        if (threadIdx.x < 256) biasC[threadIdx.x] = p.rel_bias[(threadIdx.x >> 3) * 16 + (threadIdx.x & 7)];
        if (threadIdx.x < 128) btab[threadIdx.x] = t5_bucket(threadIdx.x);
      }
      int pending = 0;
      if (threadIdx.x == 0) pending = (int)atomicAdd(p.ctr + l * 2 + 1 + 8 * rep, 1u);
      for (;;) {
        const int j = next_job(p.ctr + l * 2 + 1 + 8 * rep, lds, pending, NJ);
        if (j >= NJ) break;
        if (j < ND) {
          const int qu = 32 - (j >> 5), rem = j & 31, kind = rem >> 4, b = (rem >> 3) & 1, head = rem & 7;
          if (kind == 0) attn_unit<64, 0>(p, l, b, head, qu, lds);
          else attn_unit<96, 1>(p, l, b, head, qu, lds);
        } else if (j < ND + NS) {
          const int u = j - ND;
          attn_unit<64, 2>(p, l, (u >> 3) & 1, u & 7, u >> 4, lds);
        } else {
          const int u = j - ND - NS;
          dsa_job(p, u & 1, LEAD + 8 * (u >> 1), lds);
        }
      }
      xcd_barrier(xb);
    }
    for (int j = blockIdx.x; j < 66 * 8; j += gridDim.x) {
      const int x = j & 7, a = j >> 3;
      outproj_tile(p, 2 * (a >> 1) + (x >> 2), 2 * (x & 3) + (a & 1), lds);
    }
    xcd_barrier(xb);
    ln_rows(p, l);
    if (l < 3) { conv_weights(p, l + 1, lds); xcd_barrier(xb); }
  }
}

extern "C" void kernel_launch(void* const* d_in, const int* in_sizes, int n_in, void* d_out, int out_size, void* d_ws, size_t ws_size,
                              hipStream_t stream) {
  static int grid = 0;
  if (grid == 0) {
    int dev = 0, cus = 0, per_cu = 0;
    hipGetDevice(&dev);
    hipDeviceGetAttribute(&cus, hipDeviceAttributeMultiprocessorCount, dev);
    if (hipFuncSetAttribute((const void*)mega, hipFuncAttributeMaxDynamicSharedMemorySize, LDS_BYTES) != hipSuccess) { fprintf(stderr, "hipFuncSetAttribute failed\n"); grid = -1; return; }
    hipOccupancyMaxActiveBlocksPerMultiprocessor(&per_cu, (const void*)mega, NTHREADS, LDS_BYTES);
    if (per_cu < 1) { fprintf(stderr, "occupancy query: %d\n", per_cu); grid = -1; return; }
    grid = cus * per_cu;
  }
  if (grid < 0) return;
  size_t off = 0;
  auto take = [&](size_t bytes) { size_t o = off; off += (bytes + 255) & ~(size_t)255; return (char*)d_ws + o; };
  Params p{};
  p.x = (const float*)d_in[0]; p.meta = (const float*)d_in[1]; p.ln0_g = (const float*)d_in[2]; p.ln0_b = (const float*)d_in[3];
  p.rel_bias = (const float*)d_in[4]; p.w_in = (const float*)d_in[5]; p.b_f = (const float*)d_in[6]; p.gq = (const float*)d_in[7];
  p.gkv = (const float*)d_in[8]; p.w_uq = (const float*)d_in[9]; p.w_ukv = (const float*)d_in[10]; p.sinks = (const float*)d_in[11];
  p.w_out = (const float*)d_in[12]; p.ln_g = (const float*)d_in[13]; p.ln_b = (const float*)d_in[14];
  p.out = (float*)d_out;
  p.ctr = (unsigned*)take(1024);
  p.bar = (unsigned*)take(XCD_BAR_WORDS * 4);
  p.Wt_in = (u16*)take((size_t)NIN * DM * 2);
  p.Wt_out = (u16*)take((size_t)DM * 2048 * 2);
  p.Wt_uq = (u16*)take((size_t)768 * 256 * 2);
  p.Wt_ukv = (u16*)take((size_t)1024 * 128 * 2);
  p.H = (u16*)take((size_t)MT * LDH * 2);
  p.Mix = (u16*)take((size_t)MT * 2048 * 2);
  p.Xb = p.Mix;
  p.VtA = (u16*)take((size_t)NB * 512 * PP * 2);
  p.VtD = (u16*)take((size_t)NB * 128 * PP * 2);
  p.R = (float*)take((size_t)MT * DM * 4);
  p.IDX = (u16*)take((size_t)MT * 256 * 2);
  p.IK = (u16*)take((size_t)MT * 64 * 2);
  p.Kpe = (u16*)take((size_t)MT * 32 * 2);
  p.IW = (float*)take((size_t)MT * 8 * 4);
  p.LOGF = (float*)take((size_t)NB * 8 * PP * 4);
  p.CUM = (float*)take((size_t)NB * 8 * PP * 4);
  p.ROPE = (float*)take((size_t)PP * 32 * 4);
  if (off > ws_size) { fprintf(stderr, "workspace too small: need %zu have %zu\n", off, ws_size); return; }
  {
    char* ob = (char*)d_out;
    p.Qm = (u16*)ob; ob += (size_t)MT * 768 * 2;
    p.Km = (u16*)ob; ob += (size_t)MT * 512 * 2;
    p.VtB = (u16*)ob; ob += (size_t)NB * 512 * PP * 2;
    if ((size_t)(ob - (char*)d_out) > (size_t)out_size * 4) { fprintf(stderr, "d_out too small for scratch\n"); return; }
  }
  hipMemsetAsync(p.ctr, 0, 1024 + XCD_BAR_WORDS * 4, stream);
  void* args[] = {&p};
  hipError_t e = hipLaunchCooperativeKernel((const void*)mega, dim3(grid), dim3(NTHREADS), args, LDS_BYTES, stream);
  if (e != hipSuccess) fprintf(stderr, "cooperative launch failed: %s (grid %d)\n", hipGetErrorString(e), grid);
}
```

```cpp
#include <hip/hip_runtime.h>
#include <hip/hip_cooperative_groups.h>
#include <cstdio>
namespace cg = cooperative_groups;

#define DI __device__ __forceinline__
typedef __attribute__((ext_vector_type(8))) short bf16x8;
typedef __attribute__((ext_vector_type(16))) float f32x16;
typedef __attribute__((ext_vector_type(4))) float f32x4;
typedef __attribute__((ext_vector_type(2))) float f32x2;
typedef __attribute__((ext_vector_type(2))) __bf16 bf2_t;
typedef __attribute__((ext_vector_type(4))) unsigned u32x4;
typedef __attribute__((ext_vector_type(2))) unsigned u32x2;
typedef unsigned short u16;
#define MFMA32(a, b, c) __builtin_amdgcn_mfma_f32_32x32x16_bf16((a), (b), (c), 0, 0, 0)

constexpr int NB = 2, PP = 8448, PV = 8320, LEAD = 112, DM = 1024, MT = NB * PP, SEQ = 8192;
constexpr int LDH = 5376, NIN = 6144;
constexpr int HQ_A = 0, HK_A = 512, HG_A = 1024, HCQ_B = 1536, HCKV_B = 1792, HG_B = 1920, HQ_C = 2432, HK_C = 2944, HV_C = 3072,
              HIQ_C = 3200, HG_C = 3712, HQ_D = 4224, HK_D = 4736, HG_D = 4864;
constexpr int D_IN = 6128;
constexpr float LOG2E = 1.4426950408889634f;
constexpr float NEGL = -1e30f;
constexpr float ALPHA = 1.681792830507429f;
constexpr int LDS_JOB = 147456;
constexpr int LDS_BYTES = LDS_JOB + 64;
constexpr int GEMM_STAGE = 55296;
constexpr int NTHREADS = 512;
#define REP_P1 1
#define REP_P2 1
#define REP_P3 1
#define SC_FOX 1.0f
#define SC_MLA 1.0f
#define SC_SWA 1.0f
#define SC_DSA 1.0f

struct Params {
  const float *x, *meta, *ln0_g, *ln0_b, *rel_bias, *w_in, *b_f, *gq, *gkv, *w_uq, *w_ukv, *sinks, *w_out, *ln_g, *ln_b;
  float* out;
  u16 *Wt_in, *Wt_out, *Wt_uq, *Wt_ukv;
  u16 *H, *Xb, *Mix, *VtA, *VtD, *VtB, *Qm, *Km, *Kpe, *IK, *IDX;
  float *R, *LOGF, *CUM, *IW, *ROPE;
  unsigned* ctr;
  unsigned* bar;
};

DI unsigned pk2(float a, float b) { f32x2 v = {a, b}; return __builtin_bit_cast(unsigned, __builtin_convertvector(v, bf2_t)); }
DI float bf_lo(unsigned u) { return __uint_as_float(u << 16); }
DI float bf_hi(unsigned u) { return __uint_as_float(u & 0xffff0000u); }
DI int opaque_tid() { int t = threadIdx.x; asm volatile("" : "+v"(t)); return t; }
DI int crow(int i, int h) { return (i & 3) + 8 * (i >> 2) + 4 * h; }
template <int CTRL> DI float dpp_mov(float v) { return __int_as_float(__builtin_amdgcn_mov_dpp(__float_as_int(v), CTRL, 0xF, 0xF, true)); }
DI float wsum(float v) {
  v += dpp_mov<0xB1>(v); v += dpp_mov<0x4E>(v); v += dpp_mov<0x141>(v); v += dpp_mov<0x140>(v);
  u32x2 r = __builtin_amdgcn_permlane16_swap(__float_as_uint(v), __float_as_uint(v), false, false);
  v = __uint_as_float(r[0]) + __uint_as_float(r[1]);
  r = __builtin_amdgcn_permlane32_swap(__float_as_uint(v), __float_as_uint(v), false, false);
  return __uint_as_float(r[0]) + __uint_as_float(r[1]);
}
DI float wmax(float v) {
  v = fmaxf(v, dpp_mov<0xB1>(v)); v = fmaxf(v, dpp_mov<0x4E>(v)); v = fmaxf(v, dpp_mov<0x141>(v)); v = fmaxf(v, dpp_mov<0x140>(v));
  u32x2 r = __builtin_amdgcn_permlane16_swap(__float_as_uint(v), __float_as_uint(v), false, false);
  v = fmaxf(__uint_as_float(r[0]), __uint_as_float(r[1]));
  r = __builtin_amdgcn_permlane32_swap(__float_as_uint(v), __float_as_uint(v), false, false);
  return fmaxf(__uint_as_float(r[0]), __uint_as_float(r[1]));
}
DI int wsumi(int v) { for (int o = 32; o > 0; o >>= 1) v += __shfl_xor(v, o); return v; }
DI float silu(float g) { return g / (1.f + __expf(-g)); }
DI float dot2(unsigned a, unsigned b, float c) { return __builtin_amdgcn_fdot2_f32_bf16(__builtin_bit_cast(bf2_t, a), __builtin_bit_cast(bf2_t, b), c, false); }
template <int CTRL> DI float dpp_add(float v) { return v + __int_as_float(__builtin_amdgcn_mov_dpp(__float_as_int(v), CTRL, 0xF, 0xF, true)); }
DI int t5_bucket(int n) {
  if (n < 16) return n;
  int lg = 16 + (int)(logf((float)n / 16.f) / logf(8.f) * 16.f);
  return lg < 31 ? lg : 31;
}

DI int next_job(unsigned* ctr, char* lds, int& pending, int njobs) {
  int* sj = (int*)(lds + LDS_JOB);
  __syncthreads();
  if (threadIdx.x == 0) *sj = pending;
  __syncthreads();
  const int j = *sj;
  if (threadIdx.x == 0 && j < njobs) pending = (int)atomicAdd(ctr, 1u);
  return j;
}

template <bool SWAP, class Epi>
DI void gemm_tile(const u16* __restrict__ A, int lda, const u16* __restrict__ Bw, int ldb, int K, char* lds, Epi epi) {
  const int tid = opaque_tid(), lane = tid & 63, w = tid >> 6, r = lane & 31, h = lane >> 5;
  const int wm = w & 3, wn = w >> 2;
  f32x16 acc[2][2];
#pragma unroll
  for (int a = 0; a < 2; ++a)
#pragma unroll
    for (int b = 0; b < 2; ++b)
#pragma unroll
      for (int i = 0; i < 16; ++i) acc[a][b][i] = 0.f;
  const int lrow = tid >> 3, lkc = tid & 7;
  u32x4 ra0[4], rb0[2], ra1[4], rb1[2];
  const u16* ap = A + (size_t)lrow * lda + lkc * 8;
  const u16* bp = Bw + (size_t)lrow * ldb + lkc * 8;
  const int nk = K >> 6;
  auto gload = [&](int kt, u32x4* ra, u32x4* rb) {
#pragma unroll
    for (int j = 0; j < 4; ++j) ra[j] = *(const u32x4*)(ap + (size_t)(64 * j) * lda + kt * 64);
#pragma unroll
    for (int j = 0; j < 2; ++j) rb[j] = *(const u32x4*)(bp + (size_t)(64 * j) * ldb + kt * 64);
  };
  auto lstore = [&](int st, const u32x4* ra, const u32x4* rb) {
    char* base = lds + st * GEMM_STAGE;
#pragma unroll
    for (int j = 0; j < 4; ++j) *(u32x4*)(base + ((lrow + 64 * j) * 72 + lkc * 8) * 2) = ra[j];
#pragma unroll
    for (int j = 0; j < 2; ++j) *(u32x4*)(base + 36864 + ((lrow + 64 * j) * 72 + lkc * 8) * 2) = rb[j];
  };
  auto compute = [&](int st) {
    const char* as = lds + st * GEMM_STAGE;
    const char* bs = as + 36864;
#pragma unroll
    for (int ks = 0; ks < 4; ++ks) {
      bf16x8 af[2], bfr[2];
#pragma unroll
      for (int mi = 0; mi < 2; ++mi) af[mi] = *(const bf16x8*)(as + ((wm * 64 + mi * 32 + r) * 72 + ks * 16 + 8 * h) * 2);
#pragma unroll
      for (int ni = 0; ni < 2; ++ni) bfr[ni] = *(const bf16x8*)(bs + ((wn * 64 + ni * 32 + r) * 72 + ks * 16 + 8 * h) * 2);
#pragma unroll
      for (int mi = 0; mi < 2; ++mi)
#pragma unroll
        for (int ni = 0; ni < 2; ++ni) {
          if (SWAP) acc[mi][ni] = MFMA32(bfr[ni], af[mi], acc[mi][ni]);
          else acc[mi][ni] = MFMA32(af[mi], bfr[ni], acc[mi][ni]);
        }
    }
  };
  gload(0, ra0, rb0);
  lstore(0, ra0, rb0);
  gload(1, ra1, rb1);
  __syncthreads();
  for (int kt = 0; kt < nk; kt += 2) {
    if (kt + 2 < nk) gload(kt + 2, ra0, rb0);
    compute(0);
    lstore(1, ra1, rb1);
    __syncthreads();
    if (kt + 3 < nk) gload(kt + 3, ra1, rb1);
    compute(1);
    if (kt + 2 < nk) lstore(0, ra0, rb0);
    __syncthreads();
  }
#pragma unroll
  for (int mi = 0; mi < 2; ++mi)
#pragma unroll
    for (int ni = 0; ni < 2; ++ni) epi(mi, ni, acc[mi][ni]);
}

DI void store_rowmajor(u16* dst, const f32x16& a, int h, float sc) {
#pragma unroll
  for (int kp = 0; kp < 2; ++kp) {
    const int g = 2 * kp;
    unsigned ax = pk2(a[4 * g] * sc, a[4 * g + 1] * sc), ay = pk2(a[4 * g + 2] * sc, a[4 * g + 3] * sc);
    unsigned bx = pk2(a[4 * g + 4] * sc, a[4 * g + 5] * sc), by = pk2(a[4 * g + 6] * sc, a[4 * g + 7] * sc);
    const u32x2 rx = __builtin_amdgcn_permlane32_swap(ax, bx, false, false);
    const u32x2 ry = __builtin_amdgcn_permlane32_swap(ay, by, false, false);
    const u32x4 v = {rx[0], ry[0], rx[1], ry[1]};
    *(u32x4*)(dst + 8 * (g + h)) = v;
  }
}
DI void store_rope(u16* dst, const f32x16& a, int h, float sc, const float* rp) {
#pragma unroll
  for (int g = 0; g < 2; ++g) {
    f32x4 cs = *(const f32x4*)(rp + 8 * g + 4 * h);
    f32x4 sn = *(const f32x4*)(rp + 16 + 8 * g + 4 * h);
    float o1[4], o2[4];
#pragma unroll
    for (int e = 0; e < 4; ++e) {
      float x1 = a[4 * g + e] * sc, x2 = a[8 + 4 * g + e] * sc;
      o1[e] = x1 * cs[e] - x2 * sn[e];
      o2[e] = x1 * sn[e] + x2 * cs[e];
    }
    u32x2 v1 = {pk2(o1[0], o1[1]), pk2(o1[2], o1[3])};
    u32x2 v2 = {pk2(o2[0], o2[1]), pk2(o2[2], o2[3])};
    *(u32x2*)(dst + 8 * g + 4 * h) = v1;
    *(u32x2*)(dst + 16 + 8 * g + 4 * h) = v2;
  }
}
DI void store_transposed(u16* dst, const f32x16& a, int h, const float* rs  ) {
#pragma unroll
  for (int g = 0; g < 4; ++g) {
    float s0 = 1.f, s1 = 1.f, s2 = 1.f, s3 = 1.f;
    if (rs) { f32x4 sv = *(const f32x4*)(rs + 8 * g + 4 * h); s0 = sv[0]; s1 = sv[1]; s2 = sv[2]; s3 = sv[3]; }
    u32x2 v = {pk2(a[4 * g] * s0, a[4 * g + 1] * s1), pk2(a[4 * g + 2] * s2, a[4 * g + 3] * s3)};
    *(u32x2*)(dst + 8 * g + 4 * h) = v;
  }
}

DI void inproj_tile(const Params& p, int l, int mt, int nt, char* lds) {
  const int tid = opaque_tid(), lane = tid & 63, w = tid >> 6, r = lane & 31, h = lane >> 5;
  const int wm = w & 3, wn = w >> 2;
  const int m0 = mt * 256;
  const u16* A = p.Xb + (size_t)m0 * DM;
  const u16* Bw = p.Wt_in + (size_t)nt * 128 * DM;
  if (nt < 42) {
    float ssq = 0.f;
    gemm_tile<true>(A, DM, Bw, DM, DM, lds, [&](int mi, int ni, const f32x16& a) {
      const int tok = m0 + wm * 64 + mi * 32 + r;
      store_rowmajor(p.H + (size_t)tok * LDH + nt * 128 + wn * 64 + ni * 32, a, h, 1.f);
      if (nt >= 4 && nt < 8) {
        if (ni == 0) ssq = 0.f;
#pragma unroll
        for (int i = 0; i < 16; ++i) ssq += a[i] * a[i];
        if (ni == 1) {
          float tot = ssq + __shfl_xor(ssq, 32);
          tot = wmax(tot);
          if (lane == 0) atomicMax(p.ctr + 64 + l * 16 + (m0 / PP) * 8 + (nt - 4) * 2 + wn, __float_as_uint(sqrtf(tot) * 1.01f));
        }
      }
    });
  } else if (nt == 42) {
    gemm_tile<true>(A, DM, Bw, DM, DM, lds, [&](int mi, int ni, const f32x16& a) {
      const int tok = m0 + wm * 64 + mi * 32 + r;
      const int b = tok / PP, t = tok - b * PP;
      const int sub = wn * 2 + ni;
      if (sub == 0) {
        store_rope(p.Kpe + (size_t)tok * 32, a, h, 1.f, p.ROPE + (size_t)t * 32);
      } else if (sub == 1) {
        store_rowmajor(p.IK + (size_t)tok * 64, a, h, 1.f);
      } else if (sub == 2) {
        store_rowmajor(p.IK + (size_t)tok * 64 + 32, a, h, 1.f);
      } else {
#pragma unroll
        for (int e = 0; e < 4; ++e) {
          const int hd = e + 4 * h;
          float xv = a[e] + p.b_f[l * 8 + hd];
          float lf = fminf(xv, 0.f) - log1pf(expf(-fabsf(xv)));
          p.LOGF[(size_t)(b * 8 + hd) * PP + t] = lf;
          p.IW[(size_t)tok * 8 + hd] = a[4 + e];
        }
      }
    });
  } else {
    u16* vt; int nv, c0;
    if (nt < 47) { vt = p.VtA; nv = 512; c0 = (nt - 43) * 128; } else { vt = p.VtD; nv = 128; c0 = 0; }
    gemm_tile<false>(A, DM, Bw, DM, DM, lds, [&](int mi, int ni, const f32x16& a) {
      const int b = m0 / PP, t0 = m0 - b * PP + wm * 64 + mi * 32;
      const int col = c0 + wn * 64 + ni * 32 + r;
      store_transposed(vt + ((size_t)b * nv + col) * PP + t0, a, h, nullptr);
    });
  }
}

DI void upproj_tile(const Params& p, int mt, int nt14, char* lds) {
  const int tid = opaque_tid(), lane = tid & 63, w = tid >> 6, r = lane & 31, h = lane >> 5;
  const int wm = w & 3, wn = w >> 2;
  const int m0 = mt * 256;
  float* rs = (float*)(lds + 2 * GEMM_STAGE);
  const bool isq = nt14 < 6;
  {
    const int row = tid >> 1, half = tid & 1;
    const int kw = isq ? 128 : 64;
    const u16* src = p.H + (size_t)(m0 + row) * LDH + (isq ? HCQ_B : HCKV_B) + half * kw;
    float ss = 0.f;
    u32x4 rv[16];
#pragma unroll
    for (int c = 0; c < 8; ++c) rv[c] = *(const u32x4*)(src + c * 8);
    if (isq) {
#pragma unroll
      for (int c = 8; c < 16; ++c) rv[c] = *(const u32x4*)(src + c * 8);
    } else {
#pragma unroll
      for (int c = 8; c < 16; ++c) { rv[c][0] = 0u; rv[c][1] = 0u; rv[c][2] = 0u; rv[c][3] = 0u; }
    }
#pragma unroll
    for (int c = 0; c < 16; ++c)
#pragma unroll
      for (int e = 0; e < 4; ++e) { float a = bf_lo(rv[c][e]), b2 = bf_hi(rv[c][e]); ss += a * a + b2 * b2; }
    ss += __shfl_xor(ss, 1);
    if (half == 0) rs[row] = rsqrtf(ss / (isq ? 256.f : 128.f) + 1e-6f);
  }
  __syncthreads();
  if (isq) {
    const int nt = nt14;
    gemm_tile<true>(p.H + (size_t)m0 * LDH + HCQ_B, LDH, p.Wt_uq + (size_t)nt * 128 * 256, 256, 256, lds, [&](int mi, int ni, const f32x16& a) {
      const int lr = wm * 64 + mi * 32 + r;
      const int tok = m0 + lr;
      const int t = tok % PP;
      const int j32 = nt * 4 + wn * 2 + ni;
      const float sc = rs[lr];
      u16* dst = p.Qm + (size_t)tok * 768 + j32 * 32;
      if (j32 % 3 == 2) store_rope(dst, a, h, sc, p.ROPE + (size_t)t * 32);
      else store_rowmajor(dst, a, h, sc);
    });
  } else {
    const int nt = nt14 - 6;
    const u16* A = p.H + (size_t)m0 * LDH + HCKV_B;
    const u16* Bw = p.Wt_ukv + (size_t)nt * 128 * 128;
    if (nt < 4) {
      gemm_tile<true>(A, LDH, Bw, 128, 128, lds, [&](int mi, int ni, const f32x16& a) {
        const int lr = wm * 64 + mi * 32 + r;
        store_rowmajor(p.Km + (size_t)(m0 + lr) * 512 + nt * 128 + wn * 64 + ni * 32, a, h, rs[lr]);
      });
    } else {
      gemm_tile<false>(A, LDH, Bw, 128, 128, lds, [&](int mi, int ni, const f32x16& a) {
        const int b = m0 / PP, t0 = m0 - b * PP + wm * 64 + mi * 32;
        const int col = (nt - 4) * 128 + wn * 64 + ni * 32 + r;
        store_transposed(p.VtB + ((size_t)b * 512 + col) * PP + t0, a, h, rs + wm * 64 + mi * 32);
      });
    }
  }
}

DI void cumsum_job(const Params& p, int j, char* lds) {
  const int tid = opaque_tid(), lane = tid & 63, w = tid >> 6;
  const float* src = p.LOGF + (size_t)j * PP;
  float* dst = p.CUM + (size_t)j * PP;
  float* wt = (float*)lds;
  float v[17];
#pragma unroll
  for (int rr = 0; rr < 17; ++rr) {
    const int o = rr * 64 + lane, i = w * 1056 + o;
    v[rr] = (o < 1056 && i >= LEAD) ? src[i] : 0.f;
  }
  float carry = 0.f;
#pragma unroll
  for (int rr = 0; rr < 17; ++rr) {
    float inc = v[rr];
    for (int o = 1; o < 64; o <<= 1) { float x = __shfl_up(inc, o); if (lane >= o) inc += x; }
    v[rr] = inc + carry;
    carry += __shfl(inc, 63);
  }
  if (lane == 0) wt[w] = carry;
  __syncthreads();
  float base = 0.f;
  for (int k = 0; k < w; ++k) base += wt[k];
#pragma unroll
  for (int rr = 0; rr < 17; ++rr) {
    const int o = rr * 64 + lane;
    if (o < 1056) dst[w * 1056 + o] = v[rr] + base;
  }
}

DI void topk_job(const Params& p, int b, int t0, char* lds) {
  const int tid = opaque_tid(), lane = tid & 63, w = tid >> 6, r = lane & 31, h = lane >> 5;
  const int cmax = (t0 + 3) >> 6;
  unsigned sc[17][4];
  {
    const u16* iqp = p.H + (size_t)(b * PP + t0 + (r >> 3)) * LDH + HIQ_C + (r & 7) * 64 + 8 * h;
    bf16x8 af[4];
#pragma unroll
    for (int ks = 0; ks < 4; ++ks) af[ks] = *(const bf16x8*)(iqp + ks * 16);
    f32x4 iw[4];
#pragma unroll
    for (int qi = 0; qi < 4; ++qi) iw[qi] = *(const f32x4*)(p.IW + (size_t)(b * PP + t0 + qi) * 8 + 4 * h);
    char* wb = lds + 16384 + w * 9216;
    const int lrow = lane >> 3, lpc = lane & 7;
    const u16* ikb = p.IK + ((size_t)(b * PP) + lrow) * 64 + lpc * 8;
    u32x4 st[8];
    if (1 + w <= cmax) {
      const u16* kp = ikb + (size_t)(1 + w) * 64 * 64;
#pragma unroll
      for (int j = 0; j < 8; ++j) st[j] = *(const u32x4*)(kp + (size_t)j * 8 * 64);
#pragma unroll
      for (int j = 0; j < 8; ++j) *(u32x4*)(wb + (lrow + 8 * j) * 144 + lpc * 16) = st[j];
    }
#pragma unroll
    for (int i = 0; i < 17; ++i) {
      const int c = 1 + w + 8 * i;
      if (c <= cmax) {
        const bool more = c + 8 <= cmax;
        if (more) {
          const u16* kp = ikb + (size_t)(c + 8) * 64 * 64;
#pragma unroll
          for (int j = 0; j < 8; ++j) st[j] = *(const u32x4*)(kp + (size_t)j * 8 * 64);
        }
        bf16x8 b0[4], b1[4];
#pragma unroll
        for (int ks = 0; ks < 4; ++ks) {
          b0[ks] = *(const bf16x8*)(wb + r * 144 + ks * 32 + h * 16);
          b1[ks] = *(const bf16x8*)(wb + (32 + r) * 144 + ks * 32 + h * 16);
        }
        __builtin_amdgcn_sched_barrier(0);
        f32x16 a0, a1;
#pragma unroll
        for (int e = 0; e < 16; ++e) { a0[e] = 0.f; a1[e] = 0.f; }
#pragma unroll
        for (int ks = 0; ks < 4; ++ks) { a0 = MFMA32(af[ks], b0[ks], a0); a1 = MFMA32(af[ks], b1[ks], a1); }
        const int key = c * 64 + lane;
#pragma unroll
        for (int qi = 0; qi < 4; ++qi) {
          float p0 = 0.f, p1 = 0.f;
#pragma unroll
          for (int e = 0; e < 4; ++e) {
            p0 += fmaxf(a0[4 * qi + e], 0.f) * iw[qi][e];
            p1 += fmaxf(a1[4 * qi + e], 0.f) * iw[qi][e];
          }
          const u32x2 sw = __builtin_amdgcn_permlane32_swap(__float_as_uint(p0), __float_as_uint(p1), false, false);
          float mine = __uint_as_float(sw[0]) + __uint_as_float(sw[1]);
          mine += 0.0f;
          unsigned u = __float_as_uint(mine);
          u = (u & 0x80000000u) ? ~u : (u | 0x80000000u);
          if (key > t0 + qi || key < LEAD) u = 0u;
          sc[i][qi] = u;
        }
        if (more) {
#pragma unroll
          for (int j = 0; j < 8; ++j) *(u32x4*)(wb + (lrow + 8 * j) * 144 + lpc * 16) = st[j];
        }
      } else {
#pragma unroll
        for (int qi = 0; qi < 4; ++qi) sc[i][qi] = 0u;
      }
    }
  }
  int* ng = (int*)(lds + 256);
  unsigned long long* mg = (unsigned long long*)(lds + 1024);
  unsigned long long* me = mg + 4 * 132;
  int* bg = (int*)(me + 4 * 132);
  int* be = bg + 4 * 132;
  unsigned T[4];
  {
    unsigned* hist = (unsigned*)(lds + 16384);
    int* sel = (int*)(lds + 512);
    unsigned pref[4] = {0u, 0u, 0u, 0u};
    int chi[4] = {0, 0, 0, 0};
    bool few[4] = {false, false, false, false};
    __syncthreads();
    bool small = false;
    int nb[4] = {0, 0, 0, 0};
#pragma unroll
    for (int pass = 0; pass < 3; ++pass) {
      if (pass == 2) {
        small = true;
#pragma unroll
        for (int q = 0; q < 4; ++q) small = small && (few[q] || nb[q] <= 64);
        if (small) break;
      }
      {
        const u32x4 z = {0u, 0u, 0u, 0u};
#pragma unroll
        for (int j = 0; j < 8; ++j) ((u32x4*)hist)[tid + 512 * j] = z;
      }
      __syncthreads();
#pragma unroll
      for (int i = 0; i < 17; ++i) {
#pragma unroll
        for (int q = 0; q < 4; ++q) {
          const unsigned u = sc[i][q];
          bool part; unsigned bin;
          if (pass == 0) { part = (u != 0u); bin = (u >> 22) + (lane & 3) * 1024; }
          else if (pass == 1) { part = (u != 0u) && ((u >> 22) == pref[q]) && !few[q]; bin = ((u >> 12) & 1023u) + (lane & 3) * 1024; }
          else { part = (u != 0u) && ((u >> 12) == pref[q]) && !few[q]; bin = u & 4095u; }
          if (part) atomicAdd(hist + q * 4096 + bin, 1u);
        }
      }
      __syncthreads();
      if (w < 4) {
        const int q = w;
        const unsigned* hq = hist + q * 4096;
        const int need = 256 - chi[q];
        int G = 0;
        if (pass < 2) {
#pragma unroll
          for (int rep = 0; rep < 4; ++rep)
#pragma unroll
            for (int j = 0; j < 16; ++j) G += (int)hq[rep * 1024 + 16 * lane + ((j + lane) & 15)];
        } else {
#pragma unroll 8
          for (int j = 0; j < 64; ++j) G += (int)hq[64 * lane + ((j + lane) & 63)];
        }
        int S = G;
        for (int o = 1; o < 64; o <<= 1) { int x = __shfl_down(S, o); if (lane + o < 64) S += x; }
        const unsigned long long mk = __ballot(S >= need);
        int B = 0, cg2 = 0, fw = 0, nbin = 0;
        if (mk == 0ull) {
          fw = 1;
        } else {
          const int ks = 63 - __clzll(mk);
          const int above = (ks < 63) ? __shfl(S, ks + 1) : 0;
          int hh;
          if (pass < 2) {
            hh = 0;
            if (lane < 16) hh = (int)(hq[16 * ks + lane] + hq[1024 + 16 * ks + lane] + hq[2048 + 16 * ks + lane] + hq[3072 + 16 * ks + lane]);
          } else {
            hh = (int)hq[64 * ks + lane];
          }
          int s2 = hh;
          for (int o = 1; o < 64; o <<= 1) { int x = __shfl_down(s2, o); if (lane + o < 64) s2 += x; }
          const unsigned long long m2 = __ballot(above + s2 >= need);
          const int Ls = 63 - __clzll(m2);
          B = (pass < 2 ? 16 : 64) * ks + Ls;
          nbin = __shfl(hh, Ls);
          cg2 = above + __shfl(s2, Ls) - nbin;
        }
        if (lane == 0) { sel[q * 4 + 0] = B; sel[q * 4 + 1] = chi[q] + cg2; sel[q * 4 + 2] = fw; sel[q * 4 + 3] = nbin; }
      }
      __syncthreads();
#pragma unroll
      for (int q = 0; q < 4; ++q) {
        if (!few[q]) {
          pref[q] = (pref[q] << (pass < 2 ? 10 : 12)) | (unsigned)sel[q * 4 + 0];
          chi[q] = sel[q * 4 + 1];
          nb[q] = sel[q * 4 + 3];
          if (pass == 0) few[q] = sel[q * 4 + 2] != 0;
        }
      }
    }
    if (small) {
      unsigned* lst = hist;
      int* lcnt = sel + 16;
      if (tid < 4) lcnt[tid] = 0;
      __syncthreads();
#pragma unroll
      for (int i = 0; i < 17; ++i)
#pragma unroll
        for (int q = 0; q < 4; ++q) {
          const unsigned u = sc[i][q];
          if (!few[q] && u != 0u && (u >> 12) == pref[q]) { const int pos = atomicAdd(lcnt + q, 1); lst[q * 64 + pos] = u; }
        }
      __syncthreads();
      if (w < 4) {
        const int q = w, n = lcnt[q], need = 256 - chi[q];
        const unsigned e = lane < n ? lst[q * 64 + lane] : 0u;
        int rank = 0;
        for (int k = 0; k < n; ++k) rank += (lst[q * 64 + k] > e) ? 1 : 0;
        unsigned cand = (lane < n && rank <= need - 1) ? e : 0xFFFFFFFFu;
        for (int o = 32; o > 0; o >>= 1) { const unsigned x = (unsigned)__shfl_xor((int)cand, o); cand = x < cand ? x : cand; }
        if (lane == 0) sel[q * 4 + 0] = (int)cand;
      }
      __syncthreads();
#pragma unroll
      for (int q = 0; q < 4; ++q) T[q] = few[q] ? 0u : (unsigned)sel[q * 4 + 0];
    } else {
#pragma unroll
      for (int q = 0; q < 4; ++q) T[q] = few[q] ? 0u : pref[q];
    }
  }
  unsigned* cntb = (unsigned*)mg;
  unsigned* baseb = (unsigned*)bg;
#pragma unroll
  for (int i = 0; i < 17; ++i) {
    const int c = 1 + w + 8 * i;
    if (c <= cmax) {
      unsigned mine = 0u;
#pragma unroll
      for (int q = 0; q < 4; ++q) {
        const unsigned pk = (unsigned)__popcll(__ballot(sc[i][q] > T[q])) | ((unsigned)__popcll(__ballot(sc[i][q] == T[q])) << 16);
        mine = (lane == q) ? pk : mine;
      }
      if (lane < 4) cntb[lane * 132 + c] = mine;
    }
  }
  __syncthreads();
  if (w < 4) {
    const int q = w;
    int cg_ = 0, ce_ = 0;
    for (int base = 0; base <= cmax; base += 64) {
      const int c = base + lane;
      const bool in = (c >= 1) && (c <= cmax);
      const unsigned cv = in ? cntb[q * 132 + c] : 0u;
      const int v1 = (int)(cv & 0xffffu), v2 = (int)(cv >> 16);
      int i1 = v1, i2 = v2;
      for (int o = 1; o < 64; o <<= 1) {
        int x1 = __shfl_up(i1, o), x2 = __shfl_up(i2, o);
        if (lane >= o) { i1 += x1; i2 += x2; }
      }
      if (in) baseb[q * 132 + c] = (unsigned)(cg_ + i1 - v1) | ((unsigned)(ce_ + i2 - v2) << 16);
      cg_ += __shfl(i1, 63);
      ce_ += __shfl(i2, 63);
    }
    if (lane == 0) ng[q] = cg_;
  }
  __syncthreads();
  const unsigned long long lt = (1ull << lane) - 1ull;
#pragma unroll
  for (int i = 0; i < 17; ++i) {
    const int c = 1 + w + 8 * i;
    if (c <= cmax) {
      const int key = c * 64 + lane;
#pragma unroll
      for (int q = 0; q < 4; ++q) {
        u16* out = p.IDX + (size_t)(b * PP + t0 + q) * 256;
        const bool gt = sc[i][q] > T[q];
        const bool eq = (sc[i][q] == T[q]) && (T[q] != 0u);
        const unsigned long long m1 = __ballot(gt), m2 = __ballot(eq);
        if ((m1 | m2) != 0ull) {
          const unsigned bb = baseb[q * 132 + c];
          if (gt) out[(int)(bb & 0xffffu) + __popcll(m1 & lt)] = (u16)key;
          if (eq) { const int pos = ng[q] + (int)(bb >> 16) + __popcll(m2 & lt); if (pos < 256) out[pos] = (u16)key; }
        }
      }
    }
  }
#pragma unroll
  for (int q = 0; q < 4; ++q) {
    if (T[q] == 0u) {
      u16* out = p.IDX + (size_t)(b * PP + t0 + q) * 256;
      if (tid < 256 && tid >= ng[q]) out[tid] = (u16)0xFFFF;
    }
  }
}

constexpr int AT_STAGE = 23040;
template <int DK, int MODE>
DI void attn_unit(const Params& p, int l, int b, int head, int qu, char* lds) {
  const int tid = opaque_tid(), lane = tid & 63, w = tid >> 6, r = lane & 31, h = lane >> 5;
  constexpr int KS = DK / 16, KST = DK + 8;
  const int q0 = qu * 256, qw0 = q0 + w * 32, qw = qw0 + r;
  const size_t tokq = (size_t)b * PP + qw;
  const u16 *qptr, *kptr, *vtptr, *gptr;
  int ldk;
  if (MODE == 0) {
    qptr = p.H + tokq * LDH + HQ_A + head * 64; kptr = p.H + (size_t)b * PP * LDH + HK_A + head * 64; ldk = LDH;
    vtptr = p.VtA + ((size_t)b * 512 + head * 64) * PP; gptr = p.H + tokq * LDH + HG_A + head * 64;
  } else if (MODE == 1) {
    qptr = p.Qm + tokq * 768 + head * 96; kptr = p.Km + (size_t)b * PP * 512 + head * 64; ldk = 512;
    vtptr = p.VtB + ((size_t)b * 512 + head * 64) * PP; gptr = p.H + tokq * LDH + HG_B + head * 64;
  } else {
    qptr = p.H + tokq * LDH + HQ_D + head * 64; kptr = p.H + (size_t)b * PP * LDH + HK_D + (head >> 2) * 64; ldk = LDH;
    vtptr = p.VtD + ((size_t)b * 128 + (head >> 2) * 64) * PP; gptr = p.H + tokq * LDH + HG_D + head * 64;
  }
  const float* cum = p.CUM + (size_t)(b * 8 + head) * PP;
  float* btab = (float*)(lds + 2 * AT_STAGE);
  bf16x8 qf[KS];
#pragma unroll
  for (int ks = 0; ks < KS; ++ks) qf[ks] = *(const bf16x8*)(qptr + ks * 16 + 8 * h);
  float cref = 0.f;
  if (MODE == 0) cref = cum[q0];
  if (MODE == 2) { if (tid < 128) btab[tid] = p.rel_bias[t5_bucket(tid) * 16 + 8 + head] * LOG2E; }
  const float sc2 = (MODE == 1 ? 0.10206207261596577f : 0.125f) * LOG2E;
  const int kt_hi = qu * 4 + 3;
  int kt_lo = 1;
  if (MODE == 2) { kt_lo = qu * 4 - 2; if (kt_lo < 1) kt_lo = 1; }
  u32x4 rk, rk2, rv;
  float re = 0.f;
  const int srow = tid >> 3, sc8 = tid & 7;
  auto gload = [&](int kt) {
    const int k0 = kt * 64;
    rk = *(const u32x4*)(kptr + (size_t)(k0 + srow) * ldk + sc8 * 8);
    if (MODE == 1) { if (tid < 256) rk2 = *(const u32x4*)(p.Kpe + ((size_t)b * PP + k0 + (tid >> 2)) * 32 + (tid & 3) * 8); }
    rv = *(const u32x4*)(vtptr + (size_t)srow * PP + k0 + sc8 * 8);
    if (MODE == 0) { if (tid < 64) re = (cum[k0 + tid] - cref) * LOG2E; }
  };
  auto lstore = [&](int st) {
    char* base = lds + st * AT_STAGE;
    *(u32x4*)(base + (srow * KST + sc8 * 8) * 2) = rk;
    if (MODE == 1) { if (tid < 256) *(u32x4*)(base + ((tid >> 2) * KST + 64 + (tid & 3) * 8) * 2) = rk2; }
    char* vb = base + 64 * KST * 2;
    u32x2 lo = {rv[0], rv[1]}, hi = {rv[2], rv[3]};
    *(u32x2*)(vb + (srow * 68 + sc8 * 8) * 2) = lo;
    *(u32x2*)(vb + (srow * 68 + sc8 * 8 + 4) * 2) = hi;
    if (MODE == 0) { if (tid < 64) *(float*)(vb + 64 * 68 * 2 + tid * 4) = re; }
  };
  f32x16 o[2];
#pragma unroll
  for (int d = 0; d < 2; ++d)
#pragma unroll
    for (int i = 0; i < 16; ++i) o[d][i] = 0.f;
  float m = NEGL, lsum = 0.f;
  float qn = 0.f, kmx = 0.f;
  int* stopf = (int*)(lds + 2 * AT_STAGE + 1024);
  if (MODE == 0) {
#pragma unroll
    for (int ks = 0; ks < KS; ++ks) {
      const u32x4 qq = __builtin_bit_cast(u32x4, qf[ks]);
#pragma unroll
      for (int e = 0; e < 4; ++e) { const float a = bf_lo(qq[e]), b2 = bf_hi(qq[e]); qn += a * a + b2 * b2; }
    }
    qn += __shfl_xor(qn, 32);
    qn = sqrtf(qn) * 1.01f;
    kmx = __uint_as_float(p.ctr[64 + l * 16 + b * 8 + head]);
  }
  gload(kt_hi); lstore(0);
  __syncthreads();
  for (int kt = kt_hi; kt >= kt_lo; --kt) {
    const bool more = kt > kt_lo;
    if (more) gload(kt - 1);
    float cnext = 0.f;
    if (MODE == 0) { if (more) cnext = cum[(kt - 1) * 64 + 63]; }
    const int st = (kt_hi - kt) & 1;
    const int k0 = kt * 64;
    bool active = k0 <= qw0 + 31;
    if (MODE == 2) active = active && (k0 + 63 >= qw0 - 127);
    if (active) {
      const char* kb = lds + st * AT_STAGE;
      const char* vb = kb + 64 * KST * 2;
      f32x16 s[2];
      bf16x8 kf[2][KS];
#pragma unroll
      for (int kr = 0; kr < 2; ++kr)
#pragma unroll
        for (int ks = 0; ks < KS; ++ks) kf[kr][ks] = *(const bf16x8*)(kb + ((kr * 32 + r) * KST + ks * 16 + 8 * h) * 2);
      __builtin_amdgcn_sched_barrier(0);
#pragma unroll
      for (int kr = 0; kr < 2; ++kr) {
#pragma unroll
        for (int i = 0; i < 16; ++i) s[kr][i] = 0.f;
#pragma unroll
        for (int ks = 0; ks < KS; ++ks) s[kr] = MFMA32(kf[kr][ks], qf[ks], s[kr]);
      }
      u32x4 vfr[2][2][2];
#pragma unroll
      for (int kr = 0; kr < 2; ++kr)
#pragma unroll
        for (int s2 = 0; s2 < 2; ++s2)
#pragma unroll
          for (int d = 0; d < 2; ++d) {
            const char* va = vb + ((d * 32 + r) * 68 + kr * 32 + s2 * 16 + 4 * h) * 2;
            const u32x2 lo = *(const u32x2*)va;
            const u32x2 hi = *(const u32x2*)(va + 16);
            vfr[kr][s2][d] = (u32x4){lo[0], lo[1], hi[0], hi[1]};
          }
      __builtin_amdgcn_sched_barrier(0);
      const bool need_mask = (MODE == 2) || (k0 + 63 > qw0) || (k0 < LEAD);
      const bool rawpath = (MODE == 1) && !need_mask;
      float tmax = NEGL;
      const f32x2 sc2v = {sc2, sc2};
      if (rawpath) {
#pragma unroll
        for (int kr = 0; kr < 2; ++kr)
#pragma unroll
          for (int i = 0; i < 16; ++i) tmax = fmaxf(tmax, s[kr][i]);
        tmax *= sc2;
      } else {
#pragma unroll
        for (int kr = 0; kr < 2; ++kr) {
#pragma unroll
          for (int g = 0; g < 4; ++g) {
            f32x4 ev = {0.f, 0.f, 0.f, 0.f};
            if (MODE == 0) ev = *(const f32x4*)(vb + 64 * 68 * 2 + (kr * 32 + 8 * g + 4 * h) * 4);
#pragma unroll
            for (int e2 = 0; e2 < 2; ++e2) {
              const int i = 4 * g + 2 * e2;
              f32x2 v2 = {s[kr][i], s[kr][i + 1]};
              if (MODE == 0) { const f32x2 e2v = {ev[2 * e2], ev[2 * e2 + 1]}; v2 = v2 * sc2v - e2v; }
              else v2 = v2 * sc2v;
#pragma unroll
              for (int e1 = 0; e1 < 2; ++e1) {
                const int key = k0 + kr * 32 + 8 * g + 4 * h + 2 * e2 + e1;
                float v = v2[e1];
                if (MODE == 2) v += btab[(qw - key) & 127];
                if (need_mask) {
                  bool ok = (key <= qw) && (key >= LEAD);
                  if (MODE == 2) ok = ok && (qw - key < 128);
                  v = ok ? v : NEGL;
                }
                s[kr][i + e1] = v;
                tmax = fmaxf(tmax, v);
              }
            }
          }
        }
      }
      tmax = fmaxf(tmax, __shfl_xor(tmax, 32));
      const float mn = fmaxf(m, tmax);
      const float alpha = __builtin_amdgcn_exp2f(m - mn);
      const bool resc = __any(m != mn);
      m = mn;
      f32x2 ps2 = {0.f, 0.f};
      const f32x2 mnv = {mn, mn};
      const f32x2 scx = rawpath ? sc2v : (f32x2){1.f, 1.f};
#pragma unroll
      for (int kr = 0; kr < 2; ++kr)
#pragma unroll
        for (int i = 0; i < 16; i += 2) {
          f32x2 v2 = {s[kr][i], s[kr][i + 1]};
          v2 = v2 * scx - mnv;
          f32x2 p2 = {__builtin_amdgcn_exp2f(v2[0]), __builtin_amdgcn_exp2f(v2[1])};
          s[kr][i] = p2[0]; s[kr][i + 1] = p2[1];
          ps2 += p2;
        }
      const float ps = ps2[0] + ps2[1];
      lsum = lsum * alpha + ps;
      if (resc)
#pragma unroll
      for (int d = 0; d < 2; ++d)
#pragma unroll
        for (int i = 0; i < 16; ++i) o[d][i] *= alpha;
#pragma unroll
      for (int kr = 0; kr < 2; ++kr) {
#pragma unroll
        for (int s2 = 0; s2 < 2; ++s2) {
          u32x4 pp = {pk2(s[kr][8 * s2], s[kr][8 * s2 + 1]), pk2(s[kr][8 * s2 + 2], s[kr][8 * s2 + 3]),
                      pk2(s[kr][8 * s2 + 4], s[kr][8 * s2 + 5]), pk2(s[kr][8 * s2 + 6], s[kr][8 * s2 + 7])};
          bf16x8 pf = __builtin_bit_cast(bf16x8, pp);
#pragma unroll
          for (int d = 0; d < 2; ++d) o[d] = MFMA32(__builtin_bit_cast(bf16x8, vfr[kr][s2][d]), pf, o[d]);
        }
      }
    }
    if (more) lstore(st ^ 1);
    if (MODE == 0) {
      if (more) {
        const float enext = (cnext - cref) * LOG2E;
        const bool okl = (qn * kmx * sc2 - enext) <= (m - 40.f);
        const bool okw = __all(okl);
        if (lane == 0) stopf[(kt & 1) * 8 + w] = okw ? 1 : 0;
      }
    }
    __syncthreads();
    if (MODE == 0) {
      if (more) {
        const int* sf = stopf + (kt & 1) * 8;
        if (sf[0] & sf[1] & sf[2] & sf[3] & sf[4] & sf[5] & sf[6] & sf[7]) break;
      }
    }
  }
  lsum += __shfl_xor(lsum, 32);
  float f;
  if (MODE == 2) {
    const float s2 = p.sinks[l * 8 + head] * LOG2E;
    const float mf = fmaxf(m, s2);
    const float em = __builtin_amdgcn_exp2f(m - mf);
    f = em / (lsum * em + __builtin_amdgcn_exp2f(s2 - mf));
  } else {
    f = lsum > 0.f ? 1.f / lsum : 0.f;
  }
  f *= (MODE == 0 ? SC_FOX : (MODE == 1 ? SC_MLA : SC_SWA));
  u16* mp = p.Mix + tokq * 2048 + (MODE == 0 ? 0 : (MODE == 1 ? 512 : 1536)) + head * 64;
#pragma unroll
  for (int d = 0; d < 2; ++d)
#pragma unroll
    for (int g = 0; g < 4; ++g) {
      const int dd = d * 32 + 8 * g + 4 * h;
      u32x2 gv = *(const u32x2*)(gptr + dd);
      float g0 = silu(bf_lo(gv[0])), g1 = silu(bf_hi(gv[0])), g2 = silu(bf_lo(gv[1])), g3 = silu(bf_hi(gv[1]));
      u32x2 ov = {pk2(o[d][4 * g] * f * g0, o[d][4 * g + 1] * f * g1), pk2(o[d][4 * g + 2] * f * g2, o[d][4 * g + 3] * f * g3)};
      *(u32x2*)(mp + dd) = ov;
    }
}

DI void dsa_job(const Params& p, int b, int tq0, char* lds) {
  const int tid = opaque_tid(), lane = tid & 63, w = tid >> 6;
  float* biasC = (float*)(lds + 143360);
  int* btab = (int*)(lds + 143360 + 1024);
  char* wl = lds + w * 17920;
  float* Pl = (float*)wl;
  int* kid = (int*)(wl + 8192);
  const int tq = tq0 + w;
  const size_t tok = (size_t)b * PP + tq;
  const u16* Hb = p.H + (size_t)b * PP * LDH;
  int kk[4], ku[4];
  {
    u32x2 iv = *(const u32x2*)(p.IDX + tok * 256 + 4 * lane);
    kk[0] = iv[0] & 0xffff; kk[1] = iv[0] >> 16; kk[2] = iv[1] & 0xffff; kk[3] = iv[1] >> 16;
#pragma unroll
    for (int j = 0; j < 4; ++j) ku[j] = (kk[j] == 0xFFFF) ? LEAD : kk[j];
    u32x4 kv4 = {(unsigned)ku[0], (unsigned)ku[1], (unsigned)ku[2], (unsigned)ku[3]};
    ((u32x4*)kid)[lane] = kv4;
  }
  u32x4 gvp[4];
#pragma unroll
  for (int hh = 0; hh < 4; ++hh) gvp[hh] = *(const u32x4*)(p.H + tok * LDH + HG_C + (((lane >> 3) & 1) * 4 + hh) * 64 + (lane & 7) * 8);
  __builtin_amdgcn_wave_barrier();
  const int ksub = lane >> 4, g = (lane >> 3) & 1, dc = lane & 7;
  {
    const int r = lane & 31, h = lane >> 5, pc = lane & 15;
    char* kst = wl + 9216;
    bf16x8 qb[8];
#pragma unroll
    for (int ks = 0; ks < 8; ++ks) {
      u32x4 v = {0u, 0u, 0u, 0u};
      if (r < 8 && (ks >> 2) == (r >> 2)) v = *(const u32x4*)(p.H + tok * LDH + HQ_C + r * 64 + (ks & 3) * 16 + 8 * h);
      qb[ks] = __builtin_bit_cast(bf16x8, v);
    }
    const u16* kbase = Hb + HK_C + pc * 8;
    u32x4 st0[8], st1[8];
#pragma unroll
    for (int s2 = 0; s2 < 8; ++s2) st0[s2] = *(const u32x4*)(kbase + (size_t)kid[4 * s2 + ksub] * LDH);
#pragma unroll
    for (int s2 = 0; s2 < 8; ++s2) st1[s2] = *(const u32x4*)(kbase + (size_t)kid[32 + 4 * s2 + ksub] * LDH);
    auto chunk = [&](int c, u32x4* stc) {
#pragma unroll
      for (int s2 = 0; s2 < 8; ++s2) *(u32x4*)(kst + (4 * s2 + ksub) * 272 + pc * 16) = stc[s2];
      if (c + 2 < 8) {
#pragma unroll
        for (int s2 = 0; s2 < 8; ++s2) stc[s2] = *(const u32x4*)(kbase + (size_t)kid[32 * (c + 2) + 4 * s2 + ksub] * LDH);
      }
      bf16x8 af[8];
#pragma unroll
      for (int ks = 0; ks < 8; ++ks) af[ks] = *(const bf16x8*)(kst + r * 272 + ks * 32 + 16 * h);
      __builtin_amdgcn_sched_barrier(0);
      f32x16 acc0, acc1;
#pragma unroll
      for (int i = 0; i < 16; ++i) { acc0[i] = 0.f; acc1[i] = 0.f; }
#pragma unroll
      for (int ks = 0; ks < 8; ks += 2) { acc0 = MFMA32(af[ks], qb[ks], acc0); acc1 = MFMA32(af[ks + 1], qb[ks + 1], acc1); }
      if (r < 8) {
#pragma unroll
        for (int i = 0; i < 16; ++i) Pl[(32 * c + crow(i, h)) * 8 + r] = acc0[i] + acc1[i];
      }
    };
#pragma unroll 1
    for (int c = 0; c < 8; c += 2) { chunk(c, st0); chunk(c + 1, st1); }
  }
  __builtin_amdgcn_wave_barrier();
  float lg[4][8];
#pragma unroll
  for (int j = 0; j < 4; ++j) {
    const f32x4 v0 = *(const f32x4*)(Pl + (4 * lane + j) * 8), v1 = *(const f32x4*)(Pl + (4 * lane + j) * 8 + 4);
#pragma unroll
    for (int e = 0; e < 4; ++e) { lg[j][e] = v0[e]; lg[j][4 + e] = v1[e]; }
  }
  int bk[4];
#pragma unroll
  for (int j = 0; j < 4; ++j) { int dist = tq - ku[j]; bk[j] = (dist < 128) ? btab[dist & 127] : 31; }
#pragma unroll
  for (int hd = 0; hd < 8; ++hd) {
    float mx = NEGL;
#pragma unroll
    for (int j = 0; j < 4; ++j) {
      float v = lg[j][hd] * 0.125f + biasC[bk[j] * 8 + hd];
      v = (kk[j] == 0xFFFF) ? NEGL : v;
      lg[j][hd] = v;
      mx = fmaxf(mx, v);
    }
    mx = wmax(mx);
    float sm = 0.f;
#pragma unroll
    for (int j = 0; j < 4; ++j) { float e = __expf(lg[j][hd] - mx); lg[j][hd] = e; sm += e; }
    sm = wsum(sm);
    const float inv = 1.f / sm;
#pragma unroll
    for (int j = 0; j < 4; ++j) lg[j][hd] *= inv;
  }
#pragma unroll
  for (int j = 0; j < 4; ++j) {
    f32x4 v0 = {lg[j][0], lg[j][1], lg[j][2], lg[j][3]}, v1 = {lg[j][4], lg[j][5], lg[j][6], lg[j][7]};
    *(f32x4*)(Pl + (4 * lane + j) * 8) = v0;
    *(f32x4*)(Pl + (4 * lane + j) * 8 + 4) = v1;
  }
  __builtin_amdgcn_wave_barrier();
  const u16* vb = Hb + HV_C + g * 64 + dc * 8;
  f32x2 acc2[4][4];
#pragma unroll
  for (int hh = 0; hh < 4; ++hh)
#pragma unroll
    for (int e = 0; e < 4; ++e) { acc2[hh][e][0] = 0.f; acc2[hh][e][1] = 0.f; }
  u32x4 vA[16], vB[16];
  auto pv_load = [&](int grp, u32x4* dst) {
#pragma unroll
    for (int s = 0; s < 16; ++s) dst[s] = *(const u32x4*)(vb + (size_t)kid[4 * (grp * 16 + s) + ksub] * LDH);
  };
  auto pv_fma = [&](int grp, const u32x4* src) {
#pragma unroll
    for (int s = 0; s < 16; ++s) {
      const int slot = 4 * (grp * 16 + s) + ksub;
      const f32x4 pp = *(const f32x4*)(Pl + slot * 8 + g * 4);
      const u32x4 vv = src[s];
#pragma unroll
      for (int hh = 0; hh < 4; ++hh) {
        const f32x2 ph = {pp[hh], pp[hh]};
#pragma unroll
        for (int e = 0; e < 4; ++e) {
          const f32x2 vf2 = {bf_lo(vv[e]), bf_hi(vv[e])};
          acc2[hh][e] += ph * vf2;
        }
      }
    }
  };
  pv_load(0, vA);
  pv_load(1, vB);
  pv_fma(0, vA);
  pv_load(2, vA);
  pv_fma(1, vB);
  pv_load(3, vB);
  pv_fma(2, vA);
  pv_fma(3, vB);
  float acc[4][8];
#pragma unroll
  for (int hh = 0; hh < 4; ++hh)
#pragma unroll
    for (int e = 0; e < 8; ++e) { float v = acc2[hh][e >> 1][e & 1]; v += __shfl_xor(v, 16); v += __shfl_xor(v, 32); acc[hh][e] = v; }
  if (ksub == 0) {
#pragma unroll
    for (int hh = 0; hh < 4; ++hh) {
      const int hd = g * 4 + hh;
      const u32x4 gv = gvp[hh];
      u32x4 ov;
#pragma unroll
      for (int e = 0; e < 4; ++e) ov[e] = pk2(acc[hh][2 * e] * SC_DSA * silu(bf_lo(gv[e])), acc[hh][2 * e + 1] * SC_DSA * silu(bf_hi(gv[e])));
      *(u32x4*)(p.Mix + tok * 2048 + 1024 + hd * 64 + dc * 8) = ov;
    }
  }
}

DI void outproj_tile(const Params& p, int mt, int nt, char* lds) {
  const int tid = opaque_tid(), lane = tid & 63, w = tid >> 6, r = lane & 31, h = lane >> 5;
  const int wm = w & 3, wn = w >> 2;
  const int m0 = mt * 256;
  gemm_tile<true>(p.Mix + (size_t)m0 * 2048, 2048, p.Wt_out + (size_t)nt * 128 * 2048, 2048, 2048, lds, [&](int mi, int ni, const f32x16& a) {
    const int tok = m0 + wm * 64 + mi * 32 + r;
    float* rp = p.R + (size_t)tok * DM + nt * 128 + wn * 64 + ni * 32;
#pragma unroll
    for (int g = 0; g < 4; ++g) {
      f32x4 v = *(const f32x4*)(rp + 8 * g + 4 * h);
#pragma unroll
      for (int e = 0; e < 4; ++e) v[e] = ALPHA * v[e] + a[4 * g + e];
      *(f32x4*)(rp + 8 * g + 4 * h) = v;
    }
  });
}

DI void ln_rows(const Params& p, int l) {
  const int tid = opaque_tid(), lane = tid & 63, w = tid >> 6;
  const float* gg = l < 0 ? p.ln0_g : p.ln_g + l * DM;
  const float* bb = l < 0 ? p.ln0_b : p.ln_b + l * DM;
  for (int row = blockIdx.x * 8 + w; row < MT; row += gridDim.x * 8) {
    const int b = row / PP, t = row - b * PP;
    f32x4 v[4];
    if (l < 0) {
      const float* src = nullptr;
      if (t >= 128 && t < PV) src = p.x + ((size_t)b * SEQ + (t - 128)) * DM;
      else if (t >= LEAD && t < 128) src = p.meta + (size_t)(t - LEAD) * DM;
#pragma unroll
      for (int j = 0; j < 4; ++j) {
        if (src) v[j] = *(const f32x4*)(src + lane * 4 + 256 * j);
        else { v[j][0] = 0.f; v[j][1] = 0.f; v[j][2] = 0.f; v[j][3] = 0.f; }
      }
    } else {
#pragma unroll
      for (int j = 0; j < 4; ++j) v[j] = *(const f32x4*)(p.R + (size_t)row * DM + lane * 4 + 256 * j);
    }
    float s = 0.f;
#pragma unroll
    for (int j = 0; j < 4; ++j) s += v[j][0] + v[j][1] + v[j][2] + v[j][3];
    const float mu = wsum(s) * (1.f / DM);
    float q = 0.f;
#pragma unroll
    for (int j = 0; j < 4; ++j)
#pragma unroll
      for (int e = 0; e < 4; ++e) { float d = v[j][e] - mu; q += d * d; }
    const float rstd = rsqrtf(wsum(q) * (1.f / DM) + 1e-5f);
#pragma unroll
    for (int j = 0; j < 4; ++j) {
      const int c = lane * 4 + 256 * j;
      f32x4 g4 = *(const f32x4*)(gg + c), b4 = *(const f32x4*)(bb + c);
      f32x4 y;
#pragma unroll
      for (int e = 0; e < 4; ++e) y[e] = (v[j][e] - mu) * rstd * g4[e] + b4[e];
      if (l == 3) {
        if (t >= 128 && t < PV) *(f32x4*)(p.out + ((size_t)b * SEQ + (t - 128)) * DM + c) = y;
      } else {
        *(f32x4*)(p.R + (size_t)row * DM + c) = y;
        u32x2 yb = {pk2(y[0], y[1]), pk2(y[2], y[3])};
        *(u32x2*)(p.Xb + (size_t)row * DM + c) = yb;
      }
    }
  }
}

DI int map_in(int n) {
  if (n < 512) return n;
  if (n < 1024) return n;
  if (n < 1536) return 1544 + (n - 1024);
  if (n < 1792) return 2056 + (n - 1536);
  if (n < 1920) return 2312 + (n - 1792);
  if (n < 2432) return 2472 + (n - 1920);
  if (n < 2944) return 2984 + (n - 2432);
  if (n < 3072) return 3496 + (n - 2944);
  if (n < 3200) return 3624 + (n - 3072);
  if (n < 3712) return 3752 + (n - 3200);
  if (n < 4224) return 4336 + (n - 3712);
  if (n < 4736) return 4848 + (n - 4224);
  if (n < 4864) return 5360 + (n - 4736);
  if (n < 5376) return 5616 + (n - 4864);
  if (n < 5408) return 2440 + (n - 5376);
  if (n < 5472) return 4264 + (n - 5408);
  if (n < 5480) return 1536 + (n - 5472);
  if (n < 5488) return 4328 + (n - 5480);
  if (n < 5504) return -1;
  if (n < 6016) return 1024 + (n - 5504);
  return 5488 + (n - 6016);
}
DI void conv_weights(const Params& p, int l, char* lds) {
  const int tid = opaque_tid();
  float* tile = (float*)lds;
  for (int tI = blockIdx.x; tI < 2128; tI += gridDim.x) {
    const float* src; const float* ksc = nullptr; u16* dst; int ldsrc, K, kind, kt, ntile;
    if (tI < 1536) { kind = 0; kt = tI / 96; ntile = tI % 96; src = p.w_in + (size_t)l * DM * D_IN; ldsrc = D_IN; K = DM; dst = p.Wt_in; }
    else if (tI < 2048) { int u = tI - 1536; kind = 1; kt = u / 16; ntile = u % 16; src = p.w_out + (size_t)l * 2048 * DM; ldsrc = DM; K = 2048; dst = p.Wt_out; }
    else if (tI < 2096) { int u = tI - 2048; kind = 2; kt = u / 12; ntile = u % 12; src = p.w_uq + (size_t)l * 256 * 768; ldsrc = 768; K = 256; dst = p.Wt_uq; ksc = p.gq + l * 256; }
    else { int u = tI - 2096; kind = 3; kt = u / 16; ntile = u % 16; src = p.w_ukv + (size_t)l * 128 * 1024; ldsrc = 1024; K = 128; dst = p.Wt_ukv; ksc = p.gkv + l * 128; }
    const int k0 = kt * 64, n0 = ntile * 64;
    {
      const int nn = tid & 63;
      const int n = n0 + nn;
      int sc;
      if (kind == 0) sc = map_in(n);
      else if (kind == 3) sc = (n < 512) ? ((n >> 6) * 128 + (n & 63)) : (((n - 512) >> 6) * 128 + 64 + (n & 63));
      else sc = n;
#pragma unroll
      for (int j = 0; j < 8; ++j) {
        const int kk = (tid >> 6) + 8 * j;
        float v = 0.f;
        if (sc >= 0) v = src[(size_t)(k0 + kk) * ldsrc + sc];
        if (ksc) v *= ksc[k0 + kk];
        tile[nn * 65 + kk] = v;
      }
    }
    __syncthreads();
    {
      const int nn = tid >> 3, kc = (tid & 7) * 8;
      const float* tp = tile + nn * 65 + kc;
      u32x4 ov = {pk2(tp[0], tp[1]), pk2(tp[2], tp[3]), pk2(tp[4], tp[5]), pk2(tp[6], tp[7])};
      *(u32x4*)(dst + (size_t)(n0 + nn) * K + k0 + kc) = ov;
    }
    __syncthreads();
  }
}
DI void rope_table(const Params& p) {
  const int gt = blockIdx.x * NTHREADS + threadIdx.x;
  for (int i = gt; i < PP * 16; i += gridDim.x * NTHREADS) {
    const int t = i >> 4, c = i & 15;
    const float freq = powf(10000.f, -(float)c / 16.f);
    const float ang = (float)(t - LEAD) * freq;
    float sn, cs;
    sincosf(ang, &sn, &cs);
    p.ROPE[(size_t)t * 32 + c] = cs;
    p.ROPE[(size_t)t * 32 + 16 + c] = sn;
  }
}


#define XB_TMO      128
#define XB_XCNT(j)  (256  + 64 * (j))
#define XB_XSUB(j)  (1280 + 64 * (j))
#define XB_XGEN(j)  (2304 + 64 * (j))
#define XB_TOP      3328
#define XB_TOPGEN   3392
#define XCD_BAR_WORDS 3456
#define XB_SPIN_CAP (1u << 18)
DI unsigned xb_ld(unsigned* p) { return __hip_atomic_load(p, __ATOMIC_RELAXED, __HIP_MEMORY_SCOPE_AGENT); }
DI unsigned xb_add(unsigned* p, unsigned v) { return __hip_atomic_fetch_add(p, v, __ATOMIC_RELAXED, __HIP_MEMORY_SCOPE_AGENT); }
DI unsigned xb_xcc_id() { return (unsigned)__builtin_amdgcn_s_getreg((3 << 11) | 20) & 0xFu; }
#define XB_SPIN(cond, bar) do { unsigned _sp = 0; while (cond) { __builtin_amdgcn_s_sleep(1); \
    if ((++_sp & 255u) == 0u) { if (xb_ld(&(bar)[XB_TMO])) break; if (_sp > XB_SPIN_CAP) { atomicAdd(&(bar)[XB_TMO], 1u); break; } } } } while (0)
struct XcdBarrier { unsigned* bar; unsigned x; volatile unsigned* st; };
DI XcdBarrier xcd_barrier_post(unsigned* bar, volatile unsigned* st) {
  XcdBarrier b; b.bar = bar; b.x = xb_xcc_id(); b.st = st;
  if (threadIdx.x == 0) (void)xb_add(&bar[XB_XCNT(b.x)], 1u);
  return b;
}
DI void xcd_barrier_complete(unsigned* bar, unsigned x, unsigned& nloc, unsigned& nx) {
  const unsigned G = gridDim.x * gridDim.y * gridDim.z;
  unsigned sum, cnt, mine, sp = 0u;
  for (;;) {
    sum = 0u; cnt = 0u; mine = 0u;
#pragma unroll
    for (unsigned j = 0; j < 16; ++j) { const unsigned c = xb_ld(&bar[XB_XCNT(j)]); sum += c; cnt += (c > 0u) ? 1u : 0u; mine = (j == x) ? c : mine; }
    if (sum == G) break;
    __builtin_amdgcn_s_sleep(1);
    if ((++sp & 255u) == 0u) { if (xb_ld(&bar[XB_TMO])) break; if (sp > XB_SPIN_CAP) { atomicAdd(&bar[XB_TMO], 1u); break; } }
  }
  nloc = mine > 0u ? mine : 1u; nx = cnt > 0u ? cnt : 1u;
}
DI void xcd_barrier(const XcdBarrier& b) {
  asm volatile("s_waitcnt vmcnt(0)" ::: "memory");
  __syncthreads();
  if (threadIdx.x == 0) {
    unsigned* bar = b.bar;
    __builtin_amdgcn_s_waitcnt(0);
    unsigned nloc = b.st[0], nx = b.st[1];
    if (nloc == 0u) { xcd_barrier_complete(bar, b.x, nloc, nx); b.st[0] = nloc; b.st[1] = nx; }
    const unsigned old = xb_add(&bar[XB_XSUB(b.x)], 1u);
    const unsigned gen = old / nloc;
    if (old + 1u == (gen + 1u) * nloc) {
      __builtin_amdgcn_fence(__ATOMIC_RELEASE, "agent");
      asm volatile("s_waitcnt vmcnt(0)" ::: "memory");
      const unsigned og = xb_add(&bar[XB_TOP], 1u);
      const unsigned tg = og / nx;
      if (og + 1u == (tg + 1u) * nx) xb_add(&bar[XB_TOPGEN], 1u);
      else XB_SPIN(xb_ld(&bar[XB_TOPGEN]) == tg, bar);
      __builtin_amdgcn_fence(__ATOMIC_ACQUIRE, "agent");
      xb_add(&bar[XB_XGEN(b.x)], 1u);
      asm volatile("s_waitcnt vmcnt(0)" ::: "memory");
    } else {
      XB_SPIN(xb_ld(&bar[XB_XGEN(b.x)]) == gen, bar);
      __builtin_amdgcn_fence(__ATOMIC_ACQUIRE, "agent");
      asm volatile("s_waitcnt vmcnt(0)" ::: "memory");
    }
  }
  __syncthreads();
}

__global__ void __launch_bounds__(NTHREADS) mega(Params p) {
  extern __shared__ __attribute__((aligned(16))) char lds[];
  cg::grid_group grid = cg::this_grid();
  ln_rows(p, -1);
  conv_weights(p, 0, lds);
  rope_table(p);
  if (blockIdx.x == 0) {
    if (threadIdx.x < 256) p.ctr[threadIdx.x] = 0u;
    for (int i = threadIdx.x; i < XCD_BAR_WORDS; i += NTHREADS) p.bar[i] = 0u;
  }
  volatile unsigned* xst = (volatile unsigned*)(lds + LDS_JOB + 16);
  if (threadIdx.x == 0) { xst[0] = 0u; xst[1] = 0u; }
  grid.sync();
  const XcdBarrier xb = xcd_barrier_post(p.bar, xst);
  for (int l = 0; l < 4; ++l) {
    for (int rep = 0; rep < REP_P1; ++rep) {
      for (int j = blockIdx.x; j < 66 * 48; j += gridDim.x) inproj_tile(p, l, j / 48, j % 48, lds);
      xcd_barrier(xb);
    }
    for (int rep = 0; rep < REP_P2; ++rep) {
      constexpr int NTK = 2 * 2052, NUP = 66 * 14, NJ = NTK + NUP + 16;
      int pending = 0;
      if (threadIdx.x == 0) pending = (int)atomicAdd(p.ctr + l * 2 + 8 * rep, 1u);
      for (;;) {
        const int j = next_job(p.ctr + l * 2 + 8 * rep, lds, pending, NJ);
        if (j >= NJ) break;
        if (j < 16) {
          cumsum_job(p, j, lds);
        } else if (j < 16 + NTK) {
          const int jj = j - 16;
          const int b = jj & 1, q = 2051 - (jj >> 1);
          topk_job(p, b, LEAD + 4 * q, lds);
        } else {
          const int u = j - 16 - NTK;
          upproj_tile(p, u / 14, u % 14, lds);
        }
      }
      xcd_barrier(xb);
    }
    for (int rep = 0; rep < REP_P3; ++rep) {
      constexpr int ND = 1056, NS = 528, NC = 2 * 1026, NJ = ND + NS + NC;
      {
        float* biasC = (float*)(lds + 143360);
        int* btab = (int*)(lds + 143360 + 1024);
        if (threadIdx.x < 256) biasC[threadIdx.x] = p.rel_bias[(threadIdx.x >> 3) * 16 + (threadIdx.x & 7)];
        if (threadIdx.x < 128) btab[threadIdx.x] = t5_bucket(threadIdx.x);
      }
      int pending = 0;
      if (threadIdx.x == 0) pending = (int)atomicAdd(p.ctr + l * 2 + 1 + 8 * rep, 1u);
      for (;;) {
        const int j = next_job(p.ctr + l * 2 + 1 + 8 * rep, lds, pending, NJ);
        if (j >= NJ) break;
        if (j < ND) {
          const int qu = 32 - (j >> 5), rem = j & 31, kind = rem >> 4, b = (rem >> 3) & 1, head = rem & 7;
          if (kind == 0) attn_unit<64, 0>(p, l, b, head, qu, lds);
          else attn_unit<96, 1>(p, l, b, head, qu, lds);
        } else if (j < ND + NS) {
          const int u = j - ND;
          attn_unit<64, 2>(p, l, (u >> 3) & 1, u & 7, u >> 4, lds);
        } else {
          const int u = j - ND - NS;
          dsa_job(p, u & 1, LEAD + 8 * (u >> 1), lds);
        }
      }
      xcd_barrier(xb);
    }
    for (int j = blockIdx.x; j < 66 * 8; j += gridDim.x) {
      const int x = j & 7, a = j >> 3;
      outproj_tile(p, 2 * (a >> 1) + (x >> 2), 2 * (x & 3) + (a & 1), lds);
    }
    xcd_barrier(xb);
    ln_rows(p, l);
    if (l < 3) { conv_weights(p, l + 1, lds); xcd_barrier(xb); }
  }
}

extern "C" void kernel_launch(void* const* d_in, const int* in_sizes, int n_in, void* d_out, int out_size, void* d_ws, size_t ws_size,
                              hipStream_t stream) {
  static int grid = 0;
  if (grid == 0) {
    int dev = 0, cus = 0, per_cu = 0;
    hipGetDevice(&dev);
    hipDeviceGetAttribute(&cus, hipDeviceAttributeMultiprocessorCount, dev);
    if (hipFuncSetAttribute((const void*)mega, hipFuncAttributeMaxDynamicSharedMemorySize, LDS_BYTES) != hipSuccess) { fprintf(stderr, "hipFuncSetAttribute failed\n"); grid = -1; return; }
    hipOccupancyMaxActiveBlocksPerMultiprocessor(&per_cu, (const void*)mega, NTHREADS, LDS_BYTES);
    if (per_cu < 1) { fprintf(stderr, "occupancy query: %d\n", per_cu); grid = -1; return; }
    grid = cus * per_cu;
  }
  if (grid < 0) return;
  size_t off = 0;
  auto take = [&](size_t bytes) { size_t o = off; off += (bytes + 255) & ~(size_t)255; return (char*)d_ws + o; };
  Params p{};
  p.x = (const float*)d_in[0]; p.meta = (const float*)d_in[1]; p.ln0_g = (const float*)d_in[2]; p.ln0_b = (const float*)d_in[3];
  p.rel_bias = (const float*)d_in[4]; p.w_in = (const float*)d_in[5]; p.b_f = (const float*)d_in[6]; p.gq = (const float*)d_in[7];
  p.gkv = (const float*)d_in[8]; p.w_uq = (const float*)d_in[9]; p.w_ukv = (const float*)d_in[10]; p.sinks = (const float*)d_in[11];
  p.w_out = (const float*)d_in[12]; p.ln_g = (const float*)d_in[13]; p.ln_b = (const float*)d_in[14];
  p.out = (float*)d_out;
  p.ctr = (unsigned*)take(1024);
  p.bar = (unsigned*)take(XCD_BAR_WORDS * 4);
  p.Wt_in = (u16*)take((size_t)NIN * DM * 2);
  p.Wt_out = (u16*)take((size_t)DM * 2048 * 2);
  p.Wt_uq = (u16*)take((size_t)768 * 256 * 2);
  p.Wt_ukv = (u16*)take((size_t)1024 * 128 * 2);
  p.H = (u16*)take((size_t)MT * LDH * 2);
  p.Mix = (u16*)take((size_t)MT * 2048 * 2);
  p.Xb = p.Mix;
  p.VtA = (u16*)take((size_t)NB * 512 * PP * 2);
  p.VtD = (u16*)take((size_t)NB * 128 * PP * 2);
  p.R = (float*)take((size_t)MT * DM * 4);
  p.IDX = (u16*)take((size_t)MT * 256 * 2);
  p.IK = (u16*)take((size_t)MT * 64 * 2);
  p.Kpe = (u16*)take((size_t)MT * 32 * 2);
  p.IW = (float*)take((size_t)MT * 8 * 4);
  p.LOGF = (float*)take((size_t)NB * 8 * PP * 4);
  p.CUM = (float*)take((size_t)NB * 8 * PP * 4);
  p.ROPE = (float*)take((size_t)PP * 32 * 4);
  if (off > ws_size) { fprintf(stderr, "workspace too small: need %zu have %zu\n", off, ws_size); return; }
  {
    char* ob = (char*)d_out;
    p.Qm = (u16*)ob; ob += (size_t)MT * 768 * 2;
    p.Km = (u16*)ob; ob += (size_t)MT * 512 * 2;
    p.VtB = (u16*)ob; ob += (size_t)NB * 512 * PP * 2;
    if ((size_t)(ob - (char*)d_out) > (size_t)out_size * 4) { fprintf(stderr, "d_out too small for scratch\n"); return; }
  }
  hipMemsetAsync(p.ctr, 0, 1024 + XCD_BAR_WORDS * 4, stream);
  void* args[] = {&p};
  hipError_t e = hipLaunchCooperativeKernel((const void*)mega, dim3(grid), dim3(NTHREADS), args, LDS_BYTES, stream);
  if (e != hipSuccess) fprintf(stderr, "cooperative launch failed: %s (grid %d)\n", hipGetErrorString(e), grid);
}
```

```cpp
#include <hip/hip_runtime.h>
#include <hip/hip_cooperative_groups.h>
#include <cstdio>
namespace cg = cooperative_groups;

#define DI __device__ __forceinline__
typedef __attribute__((ext_vector_type(8))) short bf16x8;
typedef __attribute__((ext_vector_type(16))) float f32x16;
typedef __attribute__((ext_vector_type(4))) float f32x4;
typedef __attribute__((ext_vector_type(2))) float f32x2;
typedef __attribute__((ext_vector_type(2))) __bf16 bf2_t;
typedef __attribute__((ext_vector_type(4))) unsigned u32x4;
typedef __attribute__((ext_vector_type(2))) unsigned u32x2;
typedef unsigned short u16;
#define MFMA32(a, b, c) __builtin_amdgcn_mfma_f32_32x32x16_bf16((a), (b), (c), 0, 0, 0)

constexpr int NB = 2, PP = 8448, PV = 8320, LEAD = 112, DM = 1024, MT = NB * PP, SEQ = 8192;
constexpr int LDH = 5376, NIN = 6144;
constexpr int HQ_A = 0, HK_A = 512, HG_A = 1024, HCQ_B = 1536, HCKV_B = 1792, HG_B = 1920, HQ_C = 2432, HK_C = 2944, HV_C = 3072,
              HIQ_C = 3200, HG_C = 3712, HQ_D = 4224, HK_D = 4736, HG_D = 4864;
constexpr int D_IN = 6128;
constexpr float LOG2E = 1.4426950408889634f;
constexpr float NEGL = -1e30f;
constexpr float ALPHA = 1.681792830507429f;
constexpr int LDS_JOB = 147456;
constexpr int LDS_BYTES = LDS_JOB + 64;
constexpr int GEMM_STAGE = 55296;
constexpr int NTHREADS = 512;
#define REP_P1 1
#define REP_P2 1
#define REP_P3 1
#define SC_FOX 1.0f
#define SC_MLA 1.0f
#define SC_SWA 1.0f
#define SC_DSA 1.0f

struct Params {
  const float *x, *meta, *ln0_g, *ln0_b, *rel_bias, *w_in, *b_f, *gq, *gkv, *w_uq, *w_ukv, *sinks, *w_out, *ln_g, *ln_b;
  float* out;
  u16 *Wt_in, *Wt_out, *Wt_uq, *Wt_ukv;
  u16 *H, *Xb, *Mix, *VtA, *VtD, *VtB, *Qm, *Km, *Kpe, *IK, *IDX;
  float *R, *LOGF, *CUM, *IW, *ROPE;
  unsigned* ctr;
  unsigned* bar;
};

DI unsigned pk2(float a, float b) { f32x2 v = {a, b}; return __builtin_bit_cast(unsigned, __builtin_convertvector(v, bf2_t)); }
DI float bf_lo(unsigned u) { return __uint_as_float(u << 16); }
DI float bf_hi(unsigned u) { return __uint_as_float(u & 0xffff0000u); }
DI int opaque_tid() { int t = threadIdx.x; asm volatile("" : "+v"(t)); return t; }
DI int crow(int i, int h) { return (i & 3) + 8 * (i >> 2) + 4 * h; }
template <int CTRL> DI float dpp_mov(float v) { return __int_as_float(__builtin_amdgcn_mov_dpp(__float_as_int(v), CTRL, 0xF, 0xF, true)); }
DI float wsum(float v) {
  v += dpp_mov<0xB1>(v); v += dpp_mov<0x4E>(v); v += dpp_mov<0x141>(v); v += dpp_mov<0x140>(v);
  u32x2 r = __builtin_amdgcn_permlane16_swap(__float_as_uint(v), __float_as_uint(v), false, false);
  v = __uint_as_float(r[0]) + __uint_as_float(r[1]);
  r = __builtin_amdgcn_permlane32_swap(__float_as_uint(v), __float_as_uint(v), false, false);
  return __uint_as_float(r[0]) + __uint_as_float(r[1]);
}
DI float wmax(float v) {
  v = fmaxf(v, dpp_mov<0xB1>(v)); v = fmaxf(v, dpp_mov<0x4E>(v)); v = fmaxf(v, dpp_mov<0x141>(v)); v = fmaxf(v, dpp_mov<0x140>(v));
  u32x2 r = __builtin_amdgcn_permlane16_swap(__float_as_uint(v), __float_as_uint(v), false, false);
  v = fmaxf(__uint_as_float(r[0]), __uint_as_float(r[1]));
  r = __builtin_amdgcn_permlane32_swap(__float_as_uint(v), __float_as_uint(v), false, false);
  return fmaxf(__uint_as_float(r[0]), __uint_as_float(r[1]));
}
DI int wsumi(int v) { for (int o = 32; o > 0; o >>= 1) v += __shfl_xor(v, o); return v; }
DI float silu(float g) { return g / (1.f + __expf(-g)); }
DI float dot2(unsigned a, unsigned b, float c) { return __builtin_amdgcn_fdot2_f32_bf16(__builtin_bit_cast(bf2_t, a), __builtin_bit_cast(bf2_t, b), c, false); }
template <int CTRL> DI float dpp_add(float v) { return v + __int_as_float(__builtin_amdgcn_mov_dpp(__float_as_int(v), CTRL, 0xF, 0xF, true)); }
DI int t5_bucket(int n) {
  if (n < 16) return n;
  int lg = 16 + (int)(logf((float)n / 16.f) / logf(8.f) * 16.f);
  return lg < 31 ? lg : 31;
}

DI int next_job(unsigned* ctr, char* lds, int& pending, int njobs) {
  int* sj = (int*)(lds + LDS_JOB);
  __syncthreads();
  if (threadIdx.x == 0) *sj = pending;
  __syncthreads();
  const int j = *sj;
  if (threadIdx.x == 0 && j < njobs) pending = (int)atomicAdd(ctr, 1u);
  return j;
}

template <bool SWAP, class Epi>
DI void gemm_tile(const u16* __restrict__ A, int lda, const u16* __restrict__ Bw, int ldb, int K, char* lds, Epi epi) {
  const int tid = opaque_tid(), lane = tid & 63, w = tid >> 6, r = lane & 31, h = lane >> 5;
  const int wm = w & 3, wn = w >> 2;
  f32x16 acc[2][2];
#pragma unroll
  for (int a = 0; a < 2; ++a)
#pragma unroll
    for (int b = 0; b < 2; ++b)
#pragma unroll
      for (int i = 0; i < 16; ++i) acc[a][b][i] = 0.f;
  const int lrow = tid >> 3, lkc = tid & 7;
  u32x4 ra0[4], rb0[2], ra1[4], rb1[2];
  const u16* ap = A + (size_t)lrow * lda + lkc * 8;
  const u16* bp = Bw + (size_t)lrow * ldb + lkc * 8;
  const int nk = K >> 6;
  auto gload = [&](int kt, u32x4* ra, u32x4* rb) {
#pragma unroll
    for (int j = 0; j < 4; ++j) ra[j] = *(const u32x4*)(ap + (size_t)(64 * j) * lda + kt * 64);
#pragma unroll
    for (int j = 0; j < 2; ++j) rb[j] = *(const u32x4*)(bp + (size_t)(64 * j) * ldb + kt * 64);
  };
  auto lstore = [&](int st, const u32x4* ra, const u32x4* rb) {
    char* base = lds + st * GEMM_STAGE;
#pragma unroll
    for (int j = 0; j < 4; ++j) *(u32x4*)(base + ((lrow + 64 * j) * 72 + lkc * 8) * 2) = ra[j];
#pragma unroll
    for (int j = 0; j < 2; ++j) *(u32x4*)(base + 36864 + ((lrow + 64 * j) * 72 + lkc * 8) * 2) = rb[j];
  };
  auto compute = [&](int st) {
    const char* as = lds + st * GEMM_STAGE;
    const char* bs = as + 36864;
#pragma unroll
    for (int ks = 0; ks < 4; ++ks) {
      bf16x8 af[2], bfr[2];
#pragma unroll
      for (int mi = 0; mi < 2; ++mi) af[mi] = *(const bf16x8*)(as + ((wm * 64 + mi * 32 + r) * 72 + ks * 16 + 8 * h) * 2);
#pragma unroll
      for (int ni = 0; ni < 2; ++ni) bfr[ni] = *(const bf16x8*)(bs + ((wn * 64 + ni * 32 + r) * 72 + ks * 16 + 8 * h) * 2);
#pragma unroll
      for (int mi = 0; mi < 2; ++mi)
#pragma unroll
        for (int ni = 0; ni < 2; ++ni) {
          if (SWAP) acc[mi][ni] = MFMA32(bfr[ni], af[mi], acc[mi][ni]);
          else acc[mi][ni] = MFMA32(af[mi], bfr[ni], acc[mi][ni]);
        }
    }
  };
  gload(0, ra0, rb0);
  lstore(0, ra0, rb0);
  gload(1, ra1, rb1);
  __syncthreads();
  for (int kt = 0; kt < nk; kt += 2) {
    if (kt + 2 < nk) gload(kt + 2, ra0, rb0);
    compute(0);
    lstore(1, ra1, rb1);
    __syncthreads();
    if (kt + 3 < nk) gload(kt + 3, ra1, rb1);
    compute(1);
    if (kt + 2 < nk) lstore(0, ra0, rb0);
    __syncthreads();
  }
#pragma unroll
  for (int mi = 0; mi < 2; ++mi)
#pragma unroll
    for (int ni = 0; ni < 2; ++ni) epi(mi, ni, acc[mi][ni]);
}

DI void store_rowmajor(u16* dst, const f32x16& a, int h, float sc) {
#pragma unroll
  for (int kp = 0; kp < 2; ++kp) {
    const int g = 2 * kp;
    unsigned ax = pk2(a[4 * g] * sc, a[4 * g + 1] * sc), ay = pk2(a[4 * g + 2] * sc, a[4 * g + 3] * sc);
    unsigned bx = pk2(a[4 * g + 4] * sc, a[4 * g + 5] * sc), by = pk2(a[4 * g + 6] * sc, a[4 * g + 7] * sc);
    const u32x2 rx = __builtin_amdgcn_permlane32_swap(ax, bx, false, false);
    const u32x2 ry = __builtin_amdgcn_permlane32_swap(ay, by, false, false);
    const u32x4 v = {rx[0], ry[0], rx[1], ry[1]};
    *(u32x4*)(dst + 8 * (g + h)) = v;
  }
}
DI void store_rope(u16* dst, const f32x16& a, int h, float sc, const float* rp) {
#pragma unroll
  for (int g = 0; g < 2; ++g) {
    f32x4 cs = *(const f32x4*)(rp + 8 * g + 4 * h);
    f32x4 sn = *(const f32x4*)(rp + 16 + 8 * g + 4 * h);
    float o1[4], o2[4];
#pragma unroll
    for (int e = 0; e < 4; ++e) {
      float x1 = a[4 * g + e] * sc, x2 = a[8 + 4 * g + e] * sc;
      o1[e] = x1 * cs[e] - x2 * sn[e];
      o2[e] = x1 * sn[e] + x2 * cs[e];
    }
    u32x2 v1 = {pk2(o1[0], o1[1]), pk2(o1[2], o1[3])};
    u32x2 v2 = {pk2(o2[0], o2[1]), pk2(o2[2], o2[3])};
    *(u32x2*)(dst + 8 * g + 4 * h) = v1;
    *(u32x2*)(dst + 16 + 8 * g + 4 * h) = v2;
  }
}
DI void store_transposed(u16* dst, const f32x16& a, int h, const float* rs  ) {
#pragma unroll
  for (int g = 0; g < 4; ++g) {
    float s0 = 1.f, s1 = 1.f, s2 = 1.f, s3 = 1.f;
    if (rs) { f32x4 sv = *(const f32x4*)(rs + 8 * g + 4 * h); s0 = sv[0]; s1 = sv[1]; s2 = sv[2]; s3 = sv[3]; }
    u32x2 v = {pk2(a[4 * g] * s0, a[4 * g + 1] * s1), pk2(a[4 * g + 2] * s2, a[4 * g + 3] * s3)};
    *(u32x2*)(dst + 8 * g + 4 * h) = v;
  }
}

DI void inproj_tile(const Params& p, int l, int mt, int nt, char* lds) {
  const int tid = opaque_tid(), lane = tid & 63, w = tid >> 6, r = lane & 31, h = lane >> 5;
  const int wm = w & 3, wn = w >> 2;
  const int m0 = mt * 256;
  const u16* A = p.Xb + (size_t)m0 * DM;
  const u16* Bw = p.Wt_in + (size_t)nt * 128 * DM;
  if (nt < 42) {
    float ssq = 0.f;
    gemm_tile<true>(A, DM, Bw, DM, DM, lds, [&](int mi, int ni, const f32x16& a) {
      const int tok = m0 + wm * 64 + mi * 32 + r;
      store_rowmajor(p.H + (size_t)tok * LDH + nt * 128 + wn * 64 + ni * 32, a, h, 1.f);
      if (nt >= 4 && nt < 8) {
        if (ni == 0) ssq = 0.f;
#pragma unroll
        for (int i = 0; i < 16; ++i) ssq += a[i] * a[i];
        if (ni == 1) {
          float tot = ssq + __shfl_xor(ssq, 32);
          tot = wmax(tot);
          if (lane == 0) atomicMax(p.ctr + 64 + l * 16 + (m0 / PP) * 8 + (nt - 4) * 2 + wn, __float_as_uint(sqrtf(tot) * 1.01f));
        }
      }
    });
  } else if (nt == 42) {
    gemm_tile<true>(A, DM, Bw, DM, DM, lds, [&](int mi, int ni, const f32x16& a) {
      const int tok = m0 + wm * 64 + mi * 32 + r;
      const int b = tok / PP, t = tok - b * PP;
      const int sub = wn * 2 + ni;
      if (sub == 0) {
        store_rope(p.Kpe + (size_t)tok * 32, a, h, 1.f, p.ROPE + (size_t)t * 32);
      } else if (sub == 1) {
        store_rowmajor(p.IK + (size_t)tok * 64, a, h, 1.f);
      } else if (sub == 2) {
        store_rowmajor(p.IK + (size_t)tok * 64 + 32, a, h, 1.f);
      } else {
#pragma unroll
        for (int e = 0; e < 4; ++e) {
          const int hd = e + 4 * h;
          float xv = a[e] + p.b_f[l * 8 + hd];
          float lf = fminf(xv, 0.f) - log1pf(expf(-fabsf(xv)));
          p.LOGF[(size_t)(b * 8 + hd) * PP + t] = lf;
          p.IW[(size_t)tok * 8 + hd] = a[4 + e];
        }
      }
    });
  } else {
    u16* vt; int nv, c0;
    if (nt < 47) { vt = p.VtA; nv = 512; c0 = (nt - 43) * 128; } else { vt = p.VtD; nv = 128; c0 = 0; }
    gemm_tile<false>(A, DM, Bw, DM, DM, lds, [&](int mi, int ni, const f32x16& a) {
      const int b = m0 / PP, t0 = m0 - b * PP + wm * 64 + mi * 32;
      const int col = c0 + wn * 64 + ni * 32 + r;
      store_transposed(vt + ((size_t)b * nv + col) * PP + t0, a, h, nullptr);
    });
  }
}

DI void upproj_tile(const Params& p, int mt, int nt14, char* lds) {
  const int tid = opaque_tid(), lane = tid & 63, w = tid >> 6, r = lane & 31, h = lane >> 5;
  const int wm = w & 3, wn = w >> 2;
  const int m0 = mt * 256;
  float* rs = (float*)(lds + 2 * GEMM_STAGE);
  const bool isq = nt14 < 6;
  {
    const int row = tid >> 1, half = tid & 1;
    const int kw = isq ? 128 : 64;
    const u16* src = p.H + (size_t)(m0 + row) * LDH + (isq ? HCQ_B : HCKV_B) + half * kw;
    float ss = 0.f;
    u32x4 rv[16];
#pragma unroll
    for (int c = 0; c < 8; ++c) rv[c] = *(const u32x4*)(src + c * 8);
    if (isq) {
#pragma unroll
      for (int c = 8; c < 16; ++c) rv[c] = *(const u32x4*)(src + c * 8);
    } else {
#pragma unroll
      for (int c = 8; c < 16; ++c) { rv[c][0] = 0u; rv[c][1] = 0u; rv[c][2] = 0u; rv[c][3] = 0u; }
    }
#pragma unroll
    for (int c = 0; c < 16; ++c)
#pragma unroll
      for (int e = 0; e < 4; ++e) { float a = bf_lo(rv[c][e]), b2 = bf_hi(rv[c][e]); ss += a * a + b2 * b2; }
    ss += __shfl_xor(ss, 1);
    if (half == 0) rs[row] = rsqrtf(ss / (isq ? 256.f : 128.f) + 1e-6f);
  }
  __syncthreads();
  if (isq) {
    const int nt = nt14;
    gemm_tile<true>(p.H + (size_t)m0 * LDH + HCQ_B, LDH, p.Wt_uq + (size_t)nt * 128 * 256, 256, 256, lds, [&](int mi, int ni, const f32x16& a) {
      const int lr = wm * 64 + mi * 32 + r;
      const int tok = m0 + lr;
      const int t = tok % PP;
      const int j32 = nt * 4 + wn * 2 + ni;
      const float sc = rs[lr];
      u16* dst = p.Qm + (size_t)tok * 768 + j32 * 32;
      if (j32 % 3 == 2) store_rope(dst, a, h, sc, p.ROPE + (size_t)t * 32);
      else store_rowmajor(dst, a, h, sc);
    });
  } else {
    const int nt = nt14 - 6;
    const u16* A = p.H + (size_t)m0 * LDH + HCKV_B;
    const u16* Bw = p.Wt_ukv + (size_t)nt * 128 * 128;
    if (nt < 4) {
      gemm_tile<true>(A, LDH, Bw, 128, 128, lds, [&](int mi, int ni, const f32x16& a) {
        const int lr = wm * 64 + mi * 32 + r;
        store_rowmajor(p.Km + (size_t)(m0 + lr) * 512 + nt * 128 + wn * 64 + ni * 32, a, h, rs[lr]);
      });
    } else {
      gemm_tile<false>(A, LDH, Bw, 128, 128, lds, [&](int mi, int ni, const f32x16& a) {
        const int b = m0 / PP, t0 = m0 - b * PP + wm * 64 + mi * 32;
        const int col = (nt - 4) * 128 + wn * 64 + ni * 32 + r;
        store_transposed(p.VtB + ((size_t)b * 512 + col) * PP + t0, a, h, rs + wm * 64 + mi * 32);
      });
    }
  }
}

DI void cumsum_job(const Params& p, int j, char* lds) {
  const int tid = opaque_tid(), lane = tid & 63, w = tid >> 6;
  const float* src = p.LOGF + (size_t)j * PP;
  float* dst = p.CUM + (size_t)j * PP;
  float* wt = (float*)lds;
  float v[17];
#pragma unroll
  for (int rr = 0; rr < 17; ++rr) {
    const int o = rr * 64 + lane, i = w * 1056 + o;
    v[rr] = (o < 1056 && i >= LEAD) ? src[i] : 0.f;
  }
  float carry = 0.f;
#pragma unroll
  for (int rr = 0; rr < 17; ++rr) {
    float inc = v[rr];
    for (int o = 1; o < 64; o <<= 1) { float x = __shfl_up(inc, o); if (lane >= o) inc += x; }
    v[rr] = inc + carry;
    carry += __shfl(inc, 63);
  }
  if (lane == 0) wt[w] = carry;
  __syncthreads();
  float base = 0.f;
  for (int k = 0; k < w; ++k) base += wt[k];
#pragma unroll
  for (int rr = 0; rr < 17; ++rr) {
    const int o = rr * 64 + lane;
    if (o < 1056) dst[w * 1056 + o] = v[rr] + base;
  }
}

DI void topk_job(const Params& p, int b, int t0, char* lds) {
  const int tid = opaque_tid(), lane = tid & 63, w = tid >> 6, r = lane & 31, h = lane >> 5;
  const int cmax = (t0 + 3) >> 6;
  unsigned sc[17][4];
  {
    const u16* iqp = p.H + (size_t)(b * PP + t0 + (r >> 3)) * LDH + HIQ_C + (r & 7) * 64 + 8 * h;
    bf16x8 af[4];
#pragma unroll
    for (int ks = 0; ks < 4; ++ks) af[ks] = *(const bf16x8*)(iqp + ks * 16);
    f32x4 iw[4];
#pragma unroll
    for (int qi = 0; qi < 4; ++qi) iw[qi] = *(const f32x4*)(p.IW + (size_t)(b * PP + t0 + qi) * 8 + 4 * h);
    char* wb = lds + 16384 + w * 9216;
    const int lrow = lane >> 3, lpc = lane & 7;
    const u16* ikb = p.IK + ((size_t)(b * PP) + lrow) * 64 + lpc * 8;
    u32x4 st[8];
    if (1 + w <= cmax) {
      const u16* kp = ikb + (size_t)(1 + w) * 64 * 64;
#pragma unroll
      for (int j = 0; j < 8; ++j) st[j] = *(const u32x4*)(kp + (size_t)j * 8 * 64);
#pragma unroll
      for (int j = 0; j < 8; ++j) *(u32x4*)(wb + (lrow + 8 * j) * 144 + lpc * 16) = st[j];
    }
#pragma unroll
    for (int i = 0; i < 17; ++i) {
      const int c = 1 + w + 8 * i;
      if (c <= cmax) {
        const bool more = c + 8 <= cmax;
        if (more) {
          const u16* kp = ikb + (size_t)(c + 8) * 64 * 64;
#pragma unroll
          for (int j = 0; j < 8; ++j) st[j] = *(const u32x4*)(kp + (size_t)j * 8 * 64);
        }
        bf16x8 b0[4], b1[4];
#pragma unroll
        for (int ks = 0; ks < 4; ++ks) {
          b0[ks] = *(const bf16x8*)(wb + r * 144 + ks * 32 + h * 16);
          b1[ks] = *(const bf16x8*)(wb + (32 + r) * 144 + ks * 32 + h * 16);
        }
        __builtin_amdgcn_sched_barrier(0);
        f32x16 a0, a1;
#pragma unroll
        for (int e = 0; e < 16; ++e) { a0[e] = 0.f; a1[e] = 0.f; }
#pragma unroll
        for (int ks = 0; ks < 4; ++ks) { a0 = MFMA32(af[ks], b0[ks], a0); a1 = MFMA32(af[ks], b1[ks], a1); }
        const int key = c * 64 + lane;
#pragma unroll
        for (int qi = 0; qi < 4; ++qi) {
          f32x2 pp2 = {0.f, 0.f};
#pragma unroll
          for (int e = 0; e < 4; ++e) {
            const f32x2 rl = {fmaxf(a0[4 * qi + e], 0.f), fmaxf(a1[4 * qi + e], 0.f)};
            const f32x2 wv = {iw[qi][e], iw[qi][e]};
            pp2 += rl * wv;
          }
          const float p0 = pp2[0], p1 = pp2[1];
          const u32x2 sw = __builtin_amdgcn_permlane32_swap(__float_as_uint(p0), __float_as_uint(p1), false, false);
          float mine = __uint_as_float(sw[0]) + __uint_as_float(sw[1]);
          mine += 0.0f;
          unsigned u = __float_as_uint(mine);
          u = (u & 0x80000000u) ? ~u : (u | 0x80000000u);
          if (key > t0 + qi || key < LEAD) u = 0u;
          sc[i][qi] = u;
        }
        if (more) {
#pragma unroll
          for (int j = 0; j < 8; ++j) *(u32x4*)(wb + (lrow + 8 * j) * 144 + lpc * 16) = st[j];
        }
      } else {
#pragma unroll
        for (int qi = 0; qi < 4; ++qi) sc[i][qi] = 0u;
      }
    }
  }
  int* ng = (int*)(lds + 256);
  unsigned long long* mg = (unsigned long long*)(lds + 1024);
  unsigned long long* me = mg + 4 * 132;
  int* bg = (int*)(me + 4 * 132);
  int* be = bg + 4 * 132;
  unsigned T[4];
  {
    unsigned* hist = (unsigned*)(lds + 16384);
    int* sel = (int*)(lds + 512);
    unsigned pref[4] = {0u, 0u, 0u, 0u};
    int chi[4] = {0, 0, 0, 0};
    bool few[4] = {false, false, false, false};
    __syncthreads();
    bool small = false;
    int nb[4] = {0, 0, 0, 0};
#pragma unroll
    for (int pass = 0; pass < 3; ++pass) {
      if (pass == 2) {
        small = true;
#pragma unroll
        for (int q = 0; q < 4; ++q) small = small && (few[q] || nb[q] <= 64);
        if (small) break;
      }
      {
        const u32x4 z = {0u, 0u, 0u, 0u};
#pragma unroll
        for (int j = 0; j < 8; ++j) ((u32x4*)hist)[tid + 512 * j] = z;
      }
      __syncthreads();
#pragma unroll
      for (int i = 0; i < 17; ++i) {
#pragma unroll
        for (int q = 0; q < 4; ++q) {
          const unsigned u = sc[i][q];
          bool part; unsigned bin;
          if (pass == 0) { part = (u != 0u); bin = (u >> 22) + (lane & 3) * 1024; }
          else if (pass == 1) { part = (u != 0u) && ((u >> 22) == pref[q]) && !few[q]; bin = ((u >> 12) & 1023u) + (lane & 3) * 1024; }
          else { part = (u != 0u) && ((u >> 12) == pref[q]) && !few[q]; bin = u & 4095u; }
          if (part) atomicAdd(hist + q * 4096 + bin, 1u);
        }
      }
      __syncthreads();
      if (w < 4) {
        const int q = w;
        const unsigned* hq = hist + q * 4096;
        const int need = 256 - chi[q];
        int G = 0;
        if (pass < 2) {
#pragma unroll
          for (int rep = 0; rep < 4; ++rep)
#pragma unroll
            for (int j = 0; j < 16; ++j) G += (int)hq[rep * 1024 + 16 * lane + ((j + lane) & 15)];
        } else {
#pragma unroll 8
          for (int j = 0; j < 64; ++j) G += (int)hq[64 * lane + ((j + lane) & 63)];
        }
        int S = G;
        for (int o = 1; o < 64; o <<= 1) { int x = __shfl_down(S, o); if (lane + o < 64) S += x; }
        const unsigned long long mk = __ballot(S >= need);
        int B = 0, cg2 = 0, fw = 0, nbin = 0;
        if (mk == 0ull) {
          fw = 1;
        } else {
          const int ks = 63 - __clzll(mk);
          const int above = (ks < 63) ? __shfl(S, ks + 1) : 0;
          int hh;
          if (pass < 2) {
            hh = 0;
            if (lane < 16) hh = (int)(hq[16 * ks + lane] + hq[1024 + 16 * ks + lane] + hq[2048 + 16 * ks + lane] + hq[3072 + 16 * ks + lane]);
          } else {
            hh = (int)hq[64 * ks + lane];
          }
          int s2 = hh;
          for (int o = 1; o < 64; o <<= 1) { int x = __shfl_down(s2, o); if (lane + o < 64) s2 += x; }
          const unsigned long long m2 = __ballot(above + s2 >= need);
          const int Ls = 63 - __clzll(m2);
          B = (pass < 2 ? 16 : 64) * ks + Ls;
          nbin = __shfl(hh, Ls);
          cg2 = above + __shfl(s2, Ls) - nbin;
        }
        if (lane == 0) { sel[q * 4 + 0] = B; sel[q * 4 + 1] = chi[q] + cg2; sel[q * 4 + 2] = fw; sel[q * 4 + 3] = nbin; }
      }
      __syncthreads();
#pragma unroll
      for (int q = 0; q < 4; ++q) {
        if (!few[q]) {
          pref[q] = (pref[q] << (pass < 2 ? 10 : 12)) | (unsigned)sel[q * 4 + 0];
          chi[q] = sel[q * 4 + 1];
          nb[q] = sel[q * 4 + 3];
          if (pass == 0) few[q] = sel[q * 4 + 2] != 0;
        }
      }
    }
    if (small) {
      unsigned* lst = hist;
      int* lcnt = sel + 16;
      if (tid < 4) lcnt[tid] = 0;
      __syncthreads();
#pragma unroll
      for (int i = 0; i < 17; ++i)
#pragma unroll
        for (int q = 0; q < 4; ++q) {
          const unsigned u = sc[i][q];
          if (!few[q] && u != 0u && (u >> 12) == pref[q]) { const int pos = atomicAdd(lcnt + q, 1); lst[q * 64 + pos] = u; }
        }
      __syncthreads();
      if (w < 4) {
        const int q = w, n = lcnt[q], need = 256 - chi[q];
        const unsigned e = lane < n ? lst[q * 64 + lane] : 0u;
        int rank = 0;
        for (int k = 0; k < n; ++k) rank += (lst[q * 64 + k] > e) ? 1 : 0;
        unsigned cand = (lane < n && rank <= need - 1) ? e : 0xFFFFFFFFu;
        for (int o = 32; o > 0; o >>= 1) { const unsigned x = (unsigned)__shfl_xor((int)cand, o); cand = x < cand ? x : cand; }
        if (lane == 0) sel[q * 4 + 0] = (int)cand;
      }
      __syncthreads();
#pragma unroll
      for (int q = 0; q < 4; ++q) T[q] = few[q] ? 0u : (unsigned)sel[q * 4 + 0];
    } else {
#pragma unroll
      for (int q = 0; q < 4; ++q) T[q] = few[q] ? 0u : pref[q];
    }
  }
  unsigned* cntb = (unsigned*)mg;
  unsigned* baseb = (unsigned*)bg;
#pragma unroll
  for (int i = 0; i < 17; ++i) {
    const int c = 1 + w + 8 * i;
    if (c <= cmax) {
      unsigned mine = 0u;
#pragma unroll
      for (int q = 0; q < 4; ++q) {
        const unsigned pk = (unsigned)__popcll(__ballot(sc[i][q] > T[q])) | ((unsigned)__popcll(__ballot(sc[i][q] == T[q])) << 16);
        mine = (lane == q) ? pk : mine;
      }
      if (lane < 4) cntb[lane * 132 + c] = mine;
    }
  }
  __syncthreads();
  if (w < 4) {
    const int q = w;
    int cg_ = 0, ce_ = 0;
    for (int base = 0; base <= cmax; base += 64) {
      const int c = base + lane;
      const bool in = (c >= 1) && (c <= cmax);
      const unsigned cv = in ? cntb[q * 132 + c] : 0u;
      const int v1 = (int)(cv & 0xffffu), v2 = (int)(cv >> 16);
      int i1 = v1, i2 = v2;
      for (int o = 1; o < 64; o <<= 1) {
        int x1 = __shfl_up(i1, o), x2 = __shfl_up(i2, o);
        if (lane >= o) { i1 += x1; i2 += x2; }
      }
      if (in) baseb[q * 132 + c] = (unsigned)(cg_ + i1 - v1) | ((unsigned)(ce_ + i2 - v2) << 16);
      cg_ += __shfl(i1, 63);
      ce_ += __shfl(i2, 63);
    }
    if (lane == 0) ng[q] = cg_;
  }
  __syncthreads();
  const unsigned long long lt = (1ull << lane) - 1ull;
#pragma unroll
  for (int i = 0; i < 17; ++i) {
    const int c = 1 + w + 8 * i;
    if (c <= cmax) {
      const int key = c * 64 + lane;
#pragma unroll
      for (int q = 0; q < 4; ++q) {
        u16* out = p.IDX + (size_t)(b * PP + t0 + q) * 256;
        const bool gt = sc[i][q] > T[q];
        const bool eq = (sc[i][q] == T[q]) && (T[q] != 0u);
        const unsigned long long m1 = __ballot(gt), m2 = __ballot(eq);
        if ((m1 | m2) != 0ull) {
          const unsigned bb = baseb[q * 132 + c];
          if (gt) out[(int)(bb & 0xffffu) + __popcll(m1 & lt)] = (u16)key;
          if (eq) { const int pos = ng[q] + (int)(bb >> 16) + __popcll(m2 & lt); if (pos < 256) out[pos] = (u16)key; }
        }
      }
    }
  }
#pragma unroll
  for (int q = 0; q < 4; ++q) {
    if (T[q] == 0u) {
      u16* out = p.IDX + (size_t)(b * PP + t0 + q) * 256;
      if (tid < 256 && tid >= ng[q]) out[tid] = (u16)0xFFFF;
    }
  }
}

constexpr int AT_STAGE = 23040;
template <int DK, int MODE>
DI void attn_unit(const Params& p, int l, int b, int head, int qu, char* lds) {
  const int tid = opaque_tid(), lane = tid & 63, w = tid >> 6, r = lane & 31, h = lane >> 5;
  constexpr int KS = DK / 16, KST = DK + 8;
  const int q0 = qu * 256, qw0 = q0 + w * 32, qw = qw0 + r;
  const size_t tokq = (size_t)b * PP + qw;
  const u16 *qptr, *kptr, *vtptr, *gptr;
  int ldk;
  if (MODE == 0) {
    qptr = p.H + tokq * LDH + HQ_A + head * 64; kptr = p.H + (size_t)b * PP * LDH + HK_A + head * 64; ldk = LDH;
    vtptr = p.VtA + ((size_t)b * 512 + head * 64) * PP; gptr = p.H + tokq * LDH + HG_A + head * 64;
  } else if (MODE == 1) {
    qptr = p.Qm + tokq * 768 + head * 96; kptr = p.Km + (size_t)b * PP * 512 + head * 64; ldk = 512;
    vtptr = p.VtB + ((size_t)b * 512 + head * 64) * PP; gptr = p.H + tokq * LDH + HG_B + head * 64;
  } else {
    qptr = p.H + tokq * LDH + HQ_D + head * 64; kptr = p.H + (size_t)b * PP * LDH + HK_D + (head >> 2) * 64; ldk = LDH;
    vtptr = p.VtD + ((size_t)b * 128 + (head >> 2) * 64) * PP; gptr = p.H + tokq * LDH + HG_D + head * 64;
  }
  const float* cum = p.CUM + (size_t)(b * 8 + head) * PP;
  float* btab = (float*)(lds + 2 * AT_STAGE);
  bf16x8 qf[KS];
#pragma unroll
  for (int ks = 0; ks < KS; ++ks) qf[ks] = *(const bf16x8*)(qptr + ks * 16 + 8 * h);
  float cref = 0.f;
  if (MODE == 0) cref = cum[q0];
  if (MODE == 2) { if (tid < 128) btab[tid] = p.rel_bias[t5_bucket(tid) * 16 + 8 + head] * LOG2E; }
  const float sc2 = (MODE == 1 ? 0.10206207261596577f : 0.125f) * LOG2E;
  const int kt_hi = qu * 4 + 3;
  int kt_lo = 1;
  if (MODE == 2) { kt_lo = qu * 4 - 2; if (kt_lo < 1) kt_lo = 1; }
  u32x4 rk, rk2, rv;
  float re = 0.f;
  const int srow = tid >> 3, sc8 = tid & 7;
  auto gload = [&](int kt) {
    const int k0 = kt * 64;
    rk = *(const u32x4*)(kptr + (size_t)(k0 + srow) * ldk + sc8 * 8);
    if (MODE == 1) { if (tid < 256) rk2 = *(const u32x4*)(p.Kpe + ((size_t)b * PP + k0 + (tid >> 2)) * 32 + (tid & 3) * 8); }
    rv = *(const u32x4*)(vtptr + (size_t)srow * PP + k0 + sc8 * 8);
    if (MODE == 0) { if (tid < 64) re = (cum[k0 + tid] - cref) * LOG2E; }
  };
  auto lstore = [&](int st) {
    char* base = lds + st * AT_STAGE;
    *(u32x4*)(base + (srow * KST + sc8 * 8) * 2) = rk;
    if (MODE == 1) { if (tid < 256) *(u32x4*)(base + ((tid >> 2) * KST + 64 + (tid & 3) * 8) * 2) = rk2; }
    char* vb = base + 64 * KST * 2;
    u32x2 lo = {rv[0], rv[1]}, hi = {rv[2], rv[3]};
    *(u32x2*)(vb + (srow * 68 + sc8 * 8) * 2) = lo;
    *(u32x2*)(vb + (srow * 68 + sc8 * 8 + 4) * 2) = hi;
    if (MODE == 0) { if (tid < 64) *(float*)(vb + 64 * 68 * 2 + tid * 4) = re; }
  };
  f32x16 o[2];
#pragma unroll
  for (int d = 0; d < 2; ++d)
#pragma unroll
    for (int i = 0; i < 16; ++i) o[d][i] = 0.f;
  float m = NEGL, lsum = 0.f;
  float qn = 0.f, kmx = 0.f;
  int* stopf = (int*)(lds + 2 * AT_STAGE + 1024);
  if (MODE == 0) {
#pragma unroll
    for (int ks = 0; ks < KS; ++ks) {
      const u32x4 qq = __builtin_bit_cast(u32x4, qf[ks]);
#pragma unroll
      for (int e = 0; e < 4; ++e) { const float a = bf_lo(qq[e]), b2 = bf_hi(qq[e]); qn += a * a + b2 * b2; }
    }
    qn += __shfl_xor(qn, 32);
    qn = sqrtf(qn) * 1.01f;
    kmx = __uint_as_float(p.ctr[64 + l * 16 + b * 8 + head]);
  }
  gload(kt_hi); lstore(0);
  __syncthreads();
  for (int kt = kt_hi; kt >= kt_lo; --kt) {
    const bool more = kt > kt_lo;
    if (more) gload(kt - 1);
    float cnext = 0.f;
    if (MODE == 0) { if (more) cnext = cum[(kt - 1) * 64 + 63]; }
    const int st = (kt_hi - kt) & 1;
    const int k0 = kt * 64;
    bool active = k0 <= qw0 + 31;
    if (MODE == 2) active = active && (k0 + 63 >= qw0 - 127);
    if (active) {
      const char* kb = lds + st * AT_STAGE;
      const char* vb = kb + 64 * KST * 2;
      f32x16 s[2];
      bf16x8 kf[2][KS];
#pragma unroll
      for (int kr = 0; kr < 2; ++kr)
#pragma unroll
        for (int ks = 0; ks < KS; ++ks) kf[kr][ks] = *(const bf16x8*)(kb + ((kr * 32 + r) * KST + ks * 16 + 8 * h) * 2);
      __builtin_amdgcn_sched_barrier(0);
#pragma unroll
      for (int kr = 0; kr < 2; ++kr) {
#pragma unroll
        for (int i = 0; i < 16; ++i) s[kr][i] = 0.f;
#pragma unroll
        for (int ks = 0; ks < KS; ++ks) s[kr] = MFMA32(kf[kr][ks], qf[ks], s[kr]);
      }
      u32x4 vfr[2][2][2];
#pragma unroll
      for (int kr = 0; kr < 2; ++kr)
#pragma unroll
        for (int s2 = 0; s2 < 2; ++s2)
#pragma unroll
          for (int d = 0; d < 2; ++d) {
            const char* va = vb + ((d * 32 + r) * 68 + kr * 32 + s2 * 16 + 4 * h) * 2;
            const u32x2 lo = *(const u32x2*)va;
            const u32x2 hi = *(const u32x2*)(va + 16);
            vfr[kr][s2][d] = (u32x4){lo[0], lo[1], hi[0], hi[1]};
          }
      __builtin_amdgcn_sched_barrier(0);
      const bool need_mask = (MODE == 2) || (k0 + 63 > qw0) || (k0 < LEAD);
      const bool rawpath = (MODE == 1) && !need_mask;
      float tmax = NEGL;
      const f32x2 sc2v = {sc2, sc2};
      if (rawpath) {
#pragma unroll
        for (int kr = 0; kr < 2; ++kr)
#pragma unroll
          for (int i = 0; i < 16; ++i) tmax = fmaxf(tmax, s[kr][i]);
        tmax *= sc2;
      } else {
#pragma unroll
        for (int kr = 0; kr < 2; ++kr) {
#pragma unroll
          for (int g = 0; g < 4; ++g) {
            f32x4 ev = {0.f, 0.f, 0.f, 0.f};
            if (MODE == 0) ev = *(const f32x4*)(vb + 64 * 68 * 2 + (kr * 32 + 8 * g + 4 * h) * 4);
#pragma unroll
            for (int e2 = 0; e2 < 2; ++e2) {
              const int i = 4 * g + 2 * e2;
              f32x2 v2 = {s[kr][i], s[kr][i + 1]};
              if (MODE == 0) { const f32x2 e2v = {ev[2 * e2], ev[2 * e2 + 1]}; v2 = v2 * sc2v - e2v; }
              else v2 = v2 * sc2v;
#pragma unroll
              for (int e1 = 0; e1 < 2; ++e1) {
                const int key = k0 + kr * 32 + 8 * g + 4 * h + 2 * e2 + e1;
                float v = v2[e1];
                if (MODE == 2) v += btab[(qw - key) & 127];
                if (need_mask) {
                  bool ok = (key <= qw) && (key >= LEAD);
                  if (MODE == 2) ok = ok && (qw - key < 128);
                  v = ok ? v : NEGL;
                }
                s[kr][i + e1] = v;
                tmax = fmaxf(tmax, v);
              }
            }
          }
        }
      }
      tmax = fmaxf(tmax, __shfl_xor(tmax, 32));
      const float mn = fmaxf(m, tmax);
      const float alpha = __builtin_amdgcn_exp2f(m - mn);
      const bool resc = __any(m != mn);
      m = mn;
      f32x2 ps2 = {0.f, 0.f};
      const f32x2 mnv = {mn, mn};
      const f32x2 scx = rawpath ? sc2v : (f32x2){1.f, 1.f};
#pragma unroll
      for (int kr = 0; kr < 2; ++kr)
#pragma unroll
        for (int i = 0; i < 16; i += 2) {
          f32x2 v2 = {s[kr][i], s[kr][i + 1]};
          v2 = v2 * scx - mnv;
          f32x2 p2 = {__builtin_amdgcn_exp2f(v2[0]), __builtin_amdgcn_exp2f(v2[1])};
          s[kr][i] = p2[0]; s[kr][i + 1] = p2[1];
          ps2 += p2;
        }
      const float ps = ps2[0] + ps2[1];
      lsum = lsum * alpha + ps;
      if (resc)
#pragma unroll
      for (int d = 0; d < 2; ++d)
#pragma unroll
        for (int i = 0; i < 16; ++i) o[d][i] *= alpha;
#pragma unroll
      for (int kr = 0; kr < 2; ++kr) {
#pragma unroll
        for (int s2 = 0; s2 < 2; ++s2) {
          u32x4 pp = {pk2(s[kr][8 * s2], s[kr][8 * s2 + 1]), pk2(s[kr][8 * s2 + 2], s[kr][8 * s2 + 3]),
                      pk2(s[kr][8 * s2 + 4], s[kr][8 * s2 + 5]), pk2(s[kr][8 * s2 + 6], s[kr][8 * s2 + 7])};
          bf16x8 pf = __builtin_bit_cast(bf16x8, pp);
#pragma unroll
          for (int d = 0; d < 2; ++d) o[d] = MFMA32(__builtin_bit_cast(bf16x8, vfr[kr][s2][d]), pf, o[d]);
        }
      }
    }
    if (more) lstore(st ^ 1);
    if (MODE == 0) {
      if (more) {
        const float enext = (cnext - cref) * LOG2E;
        const bool okl = (qn * kmx * sc2 - enext) <= (m - 40.f);
        const bool okw = __all(okl);
        if (lane == 0) stopf[(kt & 1) * 8 + w] = okw ? 1 : 0;
      }
    }
    __syncthreads();
    if (MODE == 0) {
      if (more) {
        const int* sf = stopf + (kt & 1) * 8;
        if (sf[0] & sf[1] & sf[2] & sf[3] & sf[4] & sf[5] & sf[6] & sf[7]) break;
      }
    }
  }
  lsum += __shfl_xor(lsum, 32);
  float f;
  if (MODE == 2) {
    const float s2 = p.sinks[l * 8 + head] * LOG2E;
    const float mf = fmaxf(m, s2);
    const float em = __builtin_amdgcn_exp2f(m - mf);
    f = em / (lsum * em + __builtin_amdgcn_exp2f(s2 - mf));
  } else {
    f = lsum > 0.f ? 1.f / lsum : 0.f;
  }
  f *= (MODE == 0 ? SC_FOX : (MODE == 1 ? SC_MLA : SC_SWA));
  u16* mp = p.Mix + tokq * 2048 + (MODE == 0 ? 0 : (MODE == 1 ? 512 : 1536)) + head * 64;
#pragma unroll
  for (int d = 0; d < 2; ++d)
#pragma unroll
    for (int g = 0; g < 4; ++g) {
      const int dd = d * 32 + 8 * g + 4 * h;
      u32x2 gv = *(const u32x2*)(gptr + dd);
      float g0 = silu(bf_lo(gv[0])), g1 = silu(bf_hi(gv[0])), g2 = silu(bf_lo(gv[1])), g3 = silu(bf_hi(gv[1]));
      u32x2 ov = {pk2(o[d][4 * g] * f * g0, o[d][4 * g + 1] * f * g1), pk2(o[d][4 * g + 2] * f * g2, o[d][4 * g + 3] * f * g3)};
      *(u32x2*)(mp + dd) = ov;
    }
}

DI void dsa_job(const Params& p, int b, int tq0, char* lds) {
  const int tid = opaque_tid(), lane = tid & 63, w = tid >> 6;
  float* biasC = (float*)(lds + 143360);
  int* btab = (int*)(lds + 143360 + 1024);
  char* wl = lds + w * 17920;
  float* Pl = (float*)wl;
  int* kid = (int*)(wl + 8192);
  const int tq = tq0 + w;
  const size_t tok = (size_t)b * PP + tq;
  const u16* Hb = p.H + (size_t)b * PP * LDH;
  int kk[4], ku[4];
  {
    u32x2 iv = *(const u32x2*)(p.IDX + tok * 256 + 4 * lane);
    kk[0] = iv[0] & 0xffff; kk[1] = iv[0] >> 16; kk[2] = iv[1] & 0xffff; kk[3] = iv[1] >> 16;
#pragma unroll
    for (int j = 0; j < 4; ++j) ku[j] = (kk[j] == 0xFFFF) ? LEAD : kk[j];
    u32x4 kv4 = {(unsigned)ku[0], (unsigned)ku[1], (unsigned)ku[2], (unsigned)ku[3]};
    ((u32x4*)kid)[lane] = kv4;
  }
  u32x4 gvp[4];
#pragma unroll
  for (int hh = 0; hh < 4; ++hh) gvp[hh] = *(const u32x4*)(p.H + tok * LDH + HG_C + (((lane >> 3) & 1) * 4 + hh) * 64 + (lane & 7) * 8);
  __builtin_amdgcn_wave_barrier();
  const int ksub = lane >> 4, g = (lane >> 3) & 1, dc = lane & 7;
  {
    const int r = lane & 31, h = lane >> 5, pc = lane & 15;
    char* kst = wl + 9216;
    bf16x8 qb[8];
#pragma unroll
    for (int ks = 0; ks < 8; ++ks) {
      u32x4 v = {0u, 0u, 0u, 0u};
      if (r < 8 && (ks >> 2) == (r >> 2)) v = *(const u32x4*)(p.H + tok * LDH + HQ_C + r * 64 + (ks & 3) * 16 + 8 * h);
      qb[ks] = __builtin_bit_cast(bf16x8, v);
    }
    const u16* kbase = Hb + HK_C + pc * 8;
    u32x4 st0[8], st1[8];
#pragma unroll
    for (int s2 = 0; s2 < 8; ++s2) st0[s2] = *(const u32x4*)(kbase + (size_t)kid[4 * s2 + ksub] * LDH);
#pragma unroll
    for (int s2 = 0; s2 < 8; ++s2) st1[s2] = *(const u32x4*)(kbase + (size_t)kid[32 + 4 * s2 + ksub] * LDH);
    auto chunk = [&](int c, u32x4* stc) {
#pragma unroll
      for (int s2 = 0; s2 < 8; ++s2) *(u32x4*)(kst + (4 * s2 + ksub) * 272 + pc * 16) = stc[s2];
      if (c + 2 < 8) {
#pragma unroll
        for (int s2 = 0; s2 < 8; ++s2) stc[s2] = *(const u32x4*)(kbase + (size_t)kid[32 * (c + 2) + 4 * s2 + ksub] * LDH);
      }
      bf16x8 af[8];
#pragma unroll
      for (int ks = 0; ks < 8; ++ks) af[ks] = *(const bf16x8*)(kst + r * 272 + ks * 32 + 16 * h);
      __builtin_amdgcn_sched_barrier(0);
      f32x16 acc0, acc1;
#pragma unroll
      for (int i = 0; i < 16; ++i) { acc0[i] = 0.f; acc1[i] = 0.f; }
#pragma unroll
      for (int ks = 0; ks < 8; ks += 2) { acc0 = MFMA32(af[ks], qb[ks], acc0); acc1 = MFMA32(af[ks + 1], qb[ks + 1], acc1); }
      if (r < 8) {
#pragma unroll
        for (int i = 0; i < 16; ++i) Pl[(32 * c + crow(i, h)) * 8 + r] = acc0[i] + acc1[i];
      }
    };
#pragma unroll 1
    for (int c = 0; c < 8; c += 2) { chunk(c, st0); chunk(c + 1, st1); }
  }
  __builtin_amdgcn_wave_barrier();
  float lg[4][8];
#pragma unroll
  for (int j = 0; j < 4; ++j) {
    const f32x4 v0 = *(const f32x4*)(Pl + (4 * lane + j) * 8), v1 = *(const f32x4*)(Pl + (4 * lane + j) * 8 + 4);
#pragma unroll
    for (int e = 0; e < 4; ++e) { lg[j][e] = v0[e]; lg[j][4 + e] = v1[e]; }
  }
  int bk[4];
#pragma unroll
  for (int j = 0; j < 4; ++j) { int dist = tq - ku[j]; bk[j] = (dist < 128) ? btab[dist & 127] : 31; }
#pragma unroll
  for (int hd = 0; hd < 8; ++hd) {
    float mx = NEGL;
#pragma unroll
    for (int j = 0; j < 4; ++j) {
      float v = lg[j][hd] * 0.125f + biasC[bk[j] * 8 + hd];
      v = (kk[j] == 0xFFFF) ? NEGL : v;
      lg[j][hd] = v;
      mx = fmaxf(mx, v);
    }
    mx = wmax(mx);
    float sm = 0.f;
#pragma unroll
    for (int j = 0; j < 4; ++j) { float e = __expf(lg[j][hd] - mx); lg[j][hd] = e; sm += e; }
    sm = wsum(sm);
    const float inv = 1.f / sm;
#pragma unroll
    for (int j = 0; j < 4; ++j) lg[j][hd] *= inv;
  }
#pragma unroll
  for (int j = 0; j < 4; ++j) {
    f32x4 v0 = {lg[j][0], lg[j][1], lg[j][2], lg[j][3]}, v1 = {lg[j][4], lg[j][5], lg[j][6], lg[j][7]};
    *(f32x4*)(Pl + (4 * lane + j) * 8) = v0;
    *(f32x4*)(Pl + (4 * lane + j) * 8 + 4) = v1;
  }
  __builtin_amdgcn_wave_barrier();
  const u16* vb = Hb + HV_C + g * 64 + dc * 8;
  f32x2 acc2[4][4];
#pragma unroll
  for (int hh = 0; hh < 4; ++hh)
#pragma unroll
    for (int e = 0; e < 4; ++e) { acc2[hh][e][0] = 0.f; acc2[hh][e][1] = 0.f; }
  u32x4 vA[16], vB[16];
  auto pv_load = [&](int grp, u32x4* dst) {
#pragma unroll
    for (int s = 0; s < 16; ++s) dst[s] = *(const u32x4*)(vb + (size_t)kid[4 * (grp * 16 + s) + ksub] * LDH);
  };
  auto pv_fma = [&](int grp, const u32x4* src) {
#pragma unroll
    for (int s = 0; s < 16; ++s) {
      const int slot = 4 * (grp * 16 + s) + ksub;
      const f32x4 pp = *(const f32x4*)(Pl + slot * 8 + g * 4);
      const u32x4 vv = src[s];
#pragma unroll
      for (int hh = 0; hh < 4; ++hh) {
        const f32x2 ph = {pp[hh], pp[hh]};
#pragma unroll
        for (int e = 0; e < 4; ++e) {
          const f32x2 vf2 = {bf_lo(vv[e]), bf_hi(vv[e])};
          acc2[hh][e] += ph * vf2;
        }
      }
    }
  };
  pv_load(0, vA);
  pv_load(1, vB);
  pv_fma(0, vA);
  pv_load(2, vA);
  pv_fma(1, vB);
  pv_load(3, vB);
  pv_fma(2, vA);
  pv_fma(3, vB);
  float acc[4][8];
#pragma unroll
  for (int hh = 0; hh < 4; ++hh)
#pragma unroll
    for (int e = 0; e < 8; ++e) { float v = acc2[hh][e >> 1][e & 1]; v += __shfl_xor(v, 16); v += __shfl_xor(v, 32); acc[hh][e] = v; }
  if (ksub == 0) {
#pragma unroll
    for (int hh = 0; hh < 4; ++hh) {
      const int hd = g * 4 + hh;
      const u32x4 gv = gvp[hh];
      u32x4 ov;
#pragma unroll
      for (int e = 0; e < 4; ++e) ov[e] = pk2(acc[hh][2 * e] * SC_DSA * silu(bf_lo(gv[e])), acc[hh][2 * e + 1] * SC_DSA * silu(bf_hi(gv[e])));
      *(u32x4*)(p.Mix + tok * 2048 + 1024 + hd * 64 + dc * 8) = ov;
    }
  }
}

DI void outproj_tile(const Params& p, int mt, int nt, char* lds) {
  const int tid = opaque_tid(), lane = tid & 63, w = tid >> 6, r = lane & 31, h = lane >> 5;
  const int wm = w & 3, wn = w >> 2;
  const int m0 = mt * 256;
  gemm_tile<true>(p.Mix + (size_t)m0 * 2048, 2048, p.Wt_out + (size_t)nt * 128 * 2048, 2048, 2048, lds, [&](int mi, int ni, const f32x16& a) {
    const int tok = m0 + wm * 64 + mi * 32 + r;
    float* rp = p.R + (size_t)tok * DM + nt * 128 + wn * 64 + ni * 32;
#pragma unroll
    for (int g = 0; g < 4; ++g) {
      f32x4 v = *(const f32x4*)(rp + 8 * g + 4 * h);
#pragma unroll
      for (int e = 0; e < 4; ++e) v[e] = ALPHA * v[e] + a[4 * g + e];
      *(f32x4*)(rp + 8 * g + 4 * h) = v;
    }
  });
}

DI void ln_rows(const Params& p, int l) {
  const int tid = opaque_tid(), lane = tid & 63, w = tid >> 6;
  const float* gg = l < 0 ? p.ln0_g : p.ln_g + l * DM;
  const float* bb = l < 0 ? p.ln0_b : p.ln_b + l * DM;
  for (int row = blockIdx.x * 8 + w; row < MT; row += gridDim.x * 8) {
    const int b = row / PP, t = row - b * PP;
    f32x4 v[4];
    if (l < 0) {
      const float* src = nullptr;
      if (t >= 128 && t < PV) src = p.x + ((size_t)b * SEQ + (t - 128)) * DM;
      else if (t >= LEAD && t < 128) src = p.meta + (size_t)(t - LEAD) * DM;
#pragma unroll
      for (int j = 0; j < 4; ++j) {
        if (src) v[j] = *(const f32x4*)(src + lane * 4 + 256 * j);
        else { v[j][0] = 0.f; v[j][1] = 0.f; v[j][2] = 0.f; v[j][3] = 0.f; }
      }
    } else {
#pragma unroll
      for (int j = 0; j < 4; ++j) v[j] = *(const f32x4*)(p.R + (size_t)row * DM + lane * 4 + 256 * j);
    }
    float s = 0.f;
#pragma unroll
    for (int j = 0; j < 4; ++j) s += v[j][0] + v[j][1] + v[j][2] + v[j][3];
    const float mu = wsum(s) * (1.f / DM);
    float q = 0.f;
#pragma unroll
    for (int j = 0; j < 4; ++j)
#pragma unroll
      for (int e = 0; e < 4; ++e) { float d = v[j][e] - mu; q += d * d; }
    const float rstd = rsqrtf(wsum(q) * (1.f / DM) + 1e-5f);
#pragma unroll
    for (int j = 0; j < 4; ++j) {
      const int c = lane * 4 + 256 * j;
      f32x4 g4 = *(const f32x4*)(gg + c), b4 = *(const f32x4*)(bb + c);
      f32x4 y;
#pragma unroll
      for (int e = 0; e < 4; ++e) y[e] = (v[j][e] - mu) * rstd * g4[e] + b4[e];
      if (l == 3) {
        if (t >= 128 && t < PV) *(f32x4*)(p.out + ((size_t)b * SEQ + (t - 128)) * DM + c) = y;
      } else {
        *(f32x4*)(p.R + (size_t)row * DM + c) = y;
        u32x2 yb = {pk2(y[0], y[1]), pk2(y[2], y[3])};
        *(u32x2*)(p.Xb + (size_t)row * DM + c) = yb;
      }
    }
  }
}

DI int map_in(int n) {
  if (n < 512) return n;
  if (n < 1024) return n;
  if (n < 1536) return 1544 + (n - 1024);
  if (n < 1792) return 2056 + (n - 1536);
  if (n < 1920) return 2312 + (n - 1792);
  if (n < 2432) return 2472 + (n - 1920);
  if (n < 2944) return 2984 + (n - 2432);
  if (n < 3072) return 3496 + (n - 2944);
  if (n < 3200) return 3624 + (n - 3072);
  if (n < 3712) return 3752 + (n - 3200);
  if (n < 4224) return 4336 + (n - 3712);
  if (n < 4736) return 4848 + (n - 4224);
  if (n < 4864) return 5360 + (n - 4736);
  if (n < 5376) return 5616 + (n - 4864);
  if (n < 5408) return 2440 + (n - 5376);
  if (n < 5472) return 4264 + (n - 5408);
  if (n < 5480) return 1536 + (n - 5472);
  if (n < 5488) return 4328 + (n - 5480);
  if (n < 5504) return -1;
  if (n < 6016) return 1024 + (n - 5504);
  return 5488 + (n - 6016);
}
DI void conv_weights(const Params& p, int l, char* lds) {
  const int tid = opaque_tid();
  float* tile = (float*)lds;
  for (int tI = blockIdx.x; tI < 2128; tI += gridDim.x) {
    const float* src; const float* ksc = nullptr; u16* dst; int ldsrc, K, kind, kt, ntile;
    if (tI < 1536) { kind = 0; kt = tI / 96; ntile = tI % 96; src = p.w_in + (size_t)l * DM * D_IN; ldsrc = D_IN; K = DM; dst = p.Wt_in; }
    else if (tI < 2048) { int u = tI - 1536; kind = 1; kt = u / 16; ntile = u % 16; src = p.w_out + (size_t)l * 2048 * DM; ldsrc = DM; K = 2048; dst = p.Wt_out; }
    else if (tI < 2096) { int u = tI - 2048; kind = 2; kt = u / 12; ntile = u % 12; src = p.w_uq + (size_t)l * 256 * 768; ldsrc = 768; K = 256; dst = p.Wt_uq; ksc = p.gq + l * 256; }
    else { int u = tI - 2096; kind = 3; kt = u / 16; ntile = u % 16; src = p.w_ukv + (size_t)l * 128 * 1024; ldsrc = 1024; K = 128; dst = p.Wt_ukv; ksc = p.gkv + l * 128; }
    const int k0 = kt * 64, n0 = ntile * 64;
    {
      const int nn = tid & 63;
      const int n = n0 + nn;
      int sc;
      if (kind == 0) sc = map_in(n);
      else if (kind == 3) sc = (n < 512) ? ((n >> 6) * 128 + (n & 63)) : (((n - 512) >> 6) * 128 + 64 + (n & 63));
      else sc = n;
#pragma unroll
      for (int j = 0; j < 8; ++j) {
        const int kk = (tid >> 6) + 8 * j;
        float v = 0.f;
        if (sc >= 0) v = src[(size_t)(k0 + kk) * ldsrc + sc];
        if (ksc) v *= ksc[k0 + kk];
        tile[nn * 65 + kk] = v;
      }
    }
    __syncthreads();
    {
      const int nn = tid >> 3, kc = (tid & 7) * 8;
      const float* tp = tile + nn * 65 + kc;
      u32x4 ov = {pk2(tp[0], tp[1]), pk2(tp[2], tp[3]), pk2(tp[4], tp[5]), pk2(tp[6], tp[7])};
      *(u32x4*)(dst + (size_t)(n0 + nn) * K + k0 + kc) = ov;
    }
    __syncthreads();
  }
}
DI void rope_table(const Params& p) {
  const int gt = blockIdx.x * NTHREADS + threadIdx.x;
  for (int i = gt; i < PP * 16; i += gridDim.x * NTHREADS) {
    const int t = i >> 4, c = i & 15;
    const float freq = powf(10000.f, -(float)c / 16.f);
    const float ang = (float)(t - LEAD) * freq;
    float sn, cs;
    sincosf(ang, &sn, &cs);
    p.ROPE[(size_t)t * 32 + c] = cs;
    p.ROPE[(size_t)t * 32 + 16 + c] = sn;
  }
}


#define XB_TMO      128
#define XB_XCNT(j)  (256  + 64 * (j))
#define XB_XSUB(j)  (1280 + 64 * (j))
#define XB_XGEN(j)  (2304 + 64 * (j))
#define XB_TOP      3328
#define XB_TOPGEN   3392
#define XCD_BAR_WORDS 3456
#define XB_SPIN_CAP (1u << 18)
DI unsigned xb_ld(unsigned* p) { return __hip_atomic_load(p, __ATOMIC_RELAXED, __HIP_MEMORY_SCOPE_AGENT); }
DI unsigned xb_add(unsigned* p, unsigned v) { return __hip_atomic_fetch_add(p, v, __ATOMIC_RELAXED, __HIP_MEMORY_SCOPE_AGENT); }
DI unsigned xb_xcc_id() { return (unsigned)__builtin_amdgcn_s_getreg((3 << 11) | 20) & 0xFu; }
#define XB_SPIN(cond, bar) do { unsigned _sp = 0; while (cond) { __builtin_amdgcn_s_sleep(1); \
    if ((++_sp & 255u) == 0u) { if (xb_ld(&(bar)[XB_TMO])) break; if (_sp > XB_SPIN_CAP) { atomicAdd(&(bar)[XB_TMO], 1u); break; } } } } while (0)
struct XcdBarrier { unsigned* bar; unsigned x; volatile unsigned* st; };
DI XcdBarrier xcd_barrier_post(unsigned* bar, volatile unsigned* st) {
  XcdBarrier b; b.bar = bar; b.x = xb_xcc_id(); b.st = st;
  if (threadIdx.x == 0) (void)xb_add(&bar[XB_XCNT(b.x)], 1u);
  return b;
}
DI void xcd_barrier_complete(unsigned* bar, unsigned x, unsigned& nloc, unsigned& nx) {
  const unsigned G = gridDim.x * gridDim.y * gridDim.z;
  unsigned sum, cnt, mine, sp = 0u;
  for (;;) {
    sum = 0u; cnt = 0u; mine = 0u;
#pragma unroll
    for (unsigned j = 0; j < 16; ++j) { const unsigned c = xb_ld(&bar[XB_XCNT(j)]); sum += c; cnt += (c > 0u) ? 1u : 0u; mine = (j == x) ? c : mine; }
    if (sum == G) break;
    __builtin_amdgcn_s_sleep(1);
    if ((++sp & 255u) == 0u) { if (xb_ld(&bar[XB_TMO])) break; if (sp > XB_SPIN_CAP) { atomicAdd(&bar[XB_TMO], 1u); break; } }
  }
  nloc = mine > 0u ? mine : 1u; nx = cnt > 0u ? cnt : 1u;
}
DI void xcd_barrier(const XcdBarrier& b) {
  asm volatile("s_waitcnt vmcnt(0)" ::: "memory");
  __syncthreads();
  if (threadIdx.x == 0) {
    unsigned* bar = b.bar;
    __builtin_amdgcn_s_waitcnt(0);
    unsigned nloc = b.st[0], nx = b.st[1];
    if (nloc == 0u) { xcd_barrier_complete(bar, b.x, nloc, nx); b.st[0] = nloc; b.st[1] = nx; }
    const unsigned old = xb_add(&bar[XB_XSUB(b.x)], 1u);
    const unsigned gen = old / nloc;
    if (old + 1u == (gen + 1u) * nloc) {
      __builtin_amdgcn_fence(__ATOMIC_RELEASE, "agent");
      asm volatile("s_waitcnt vmcnt(0)" ::: "memory");
      const unsigned og = xb_add(&bar[XB_TOP], 1u);
      const unsigned tg = og / nx;
      if (og + 1u == (tg + 1u) * nx) xb_add(&bar[XB_TOPGEN], 1u);
      else XB_SPIN(xb_ld(&bar[XB_TOPGEN]) == tg, bar);
      __builtin_amdgcn_fence(__ATOMIC_ACQUIRE, "agent");
      xb_add(&bar[XB_XGEN(b.x)], 1u);
      asm volatile("s_waitcnt vmcnt(0)" ::: "memory");
    } else {
      XB_SPIN(xb_ld(&bar[XB_XGEN(b.x)]) == gen, bar);
      __builtin_amdgcn_fence(__ATOMIC_ACQUIRE, "agent");
      asm volatile("s_waitcnt vmcnt(0)" ::: "memory");
    }
  }
  __syncthreads();
}

__global__ void __launch_bounds__(NTHREADS) mega(Params p) {
  extern __shared__ __attribute__((aligned(16))) char lds[];
  cg::grid_group grid = cg::this_grid();
  ln_rows(p, -1);
  conv_weights(p, 0, lds);
  rope_table(p);
  if (blockIdx.x == 0) {
    if (threadIdx.x < 256) p.ctr[threadIdx.x] = 0u;
    for (int i = threadIdx.x; i < XCD_BAR_WORDS; i += NTHREADS) p.bar[i] = 0u;
  }
  volatile unsigned* xst = (volatile unsigned*)(lds + LDS_JOB + 16);
  if (threadIdx.x == 0) { xst[0] = 0u; xst[1] = 0u; }
  grid.sync();
  const XcdBarrier xb = xcd_barrier_post(p.bar, xst);
  for (int l = 0; l < 4; ++l) {
    for (int rep = 0; rep < REP_P1; ++rep) {
      for (int j = blockIdx.x; j < 66 * 48; j += gridDim.x) inproj_tile(p, l, j / 48, j % 48, lds);
      xcd_barrier(xb);
    }
    for (int rep = 0; rep < REP_P2; ++rep) {
      constexpr int NTK = 2 * 2052, NUP = 66 * 14, NJ = NTK + NUP + 16;
      int pending = 0;
      if (threadIdx.x == 0) pending = (int)atomicAdd(p.ctr + l * 2 + 8 * rep, 1u);
      for (;;) {
        const int j = next_job(p.ctr + l * 2 + 8 * rep, lds, pending, NJ);
        if (j >= NJ) break;
        if (j < 16) {
          cumsum_job(p, j, lds);
        } else if (j < 16 + NTK) {
          const int jj = j - 16;
          const int b = jj & 1, q = 2051 - (jj >> 1);
          topk_job(p, b, LEAD + 4 * q, lds);
        } else {
          const int u = j - 16 - NTK;
          upproj_tile(p, u / 14, u % 14, lds);
        }
      }
      xcd_barrier(xb);
    }
    for (int rep = 0; rep < REP_P3; ++rep) {
      constexpr int ND = 1056, NS = 528, NC = 2 * 1026, NJ = ND + NS + NC;
      {
        float* biasC = (float*)(lds + 143360);
        int* btab = (int*)(lds + 143360 + 1024);
        if (threadIdx.x < 256) biasC[threadIdx.x] = p.rel_bias[(threadIdx.x >> 3) * 16 + (threadIdx.x & 7)];
        if (threadIdx.x < 128) btab[threadIdx.x] = t5_bucket(threadIdx.x);
      }
      int pending = 0;
      if (threadIdx.x == 0) pending = (int)atomicAdd(p.ctr + l * 2 + 1 + 8 * rep, 1u);
      for (;;) {
        const int j = next_job(p.ctr + l * 2 + 1 + 8 * rep, lds, pending, NJ);
        if (j >= NJ) break;
        if (j < ND) {
          const int qu = 32 - (j >> 5), rem = j & 31, kind = rem >> 4, b = (rem >> 3) & 1, head = rem & 7;
          if (kind == 0) attn_unit<64, 0>(p, l, b, head, qu, lds);
          else attn_unit<96, 1>(p, l, b, head, qu, lds);
        } else if (j < ND + NS) {
          const int u = j - ND;
          attn_unit<64, 2>(p, l, (u >> 3) & 1, u & 7, u >> 4, lds);
        } else {
          const int u = j - ND - NS;
          dsa_job(p, u & 1, LEAD + 8 * (u >> 1), lds);
        }
      }
      xcd_barrier(xb);
    }
    for (int j = blockIdx.x; j < 66 * 8; j += gridDim.x) {
      const int x = j & 7, a = j >> 3;
      outproj_tile(p, 2 * (a >> 1) + (x >> 2), 2 * (x & 3) + (a & 1), lds);
    }
    xcd_barrier(xb);
    ln_rows(p, l);
    if (l < 3) { conv_weights(p, l + 1, lds); xcd_barrier(xb); }
  }
}

extern "C" void kernel_launch(void* const* d_in, const int* in_sizes, int n_in, void* d_out, int out_size, void* d_ws, size_t ws_size,
                              hipStream_t stream) {
  static int grid = 0;
  if (grid == 0) {
    int dev = 0, cus = 0, per_cu = 0;
    hipGetDevice(&dev);
    hipDeviceGetAttribute(&cus, hipDeviceAttributeMultiprocessorCount, dev);
    if (hipFuncSetAttribute((const void*)mega, hipFuncAttributeMaxDynamicSharedMemorySize, LDS_BYTES) != hipSuccess) { fprintf(stderr, "hipFuncSetAttribute failed\n"); grid = -1; return; }
    hipOccupancyMaxActiveBlocksPerMultiprocessor(&per_cu, (const void*)mega, NTHREADS, LDS_BYTES);
    if (per_cu < 1) { fprintf(stderr, "occupancy query: %d\n", per_cu); grid = -1; return; }
    grid = cus * per_cu;
  }
  if (grid < 0) return;
  size_t off = 0;
  auto take = [&](size_t bytes) { size_t o = off; off += (bytes + 255) & ~(size_t)255; return (char*)d_ws + o; };
  Params p{};
  p.x = (const float*)d_in[0]; p.meta = (const float*)d_in[1]; p.ln0_g = (const float*)d_in[2]; p.ln0_b = (const float*)d_in[3];
  p.rel_bias = (const float*)d_in[4]; p.w_in = (const float*)d_in[5]; p.b_f = (const float*)d_in[6]; p.gq = (const float*)d_in[7];
  p.gkv = (const float*)d_in[8]; p.w_uq = (const float*)d_in[9]; p.w_ukv = (const float*)d_in[10]; p.sinks = (const float*)d_in[11];
  p.w_out = (const float*)d_in[12]; p.ln_g = (const float*)d_in[13]; p.ln_b = (const float*)d_in[14];
  p.out = (float*)d_out;
  p.ctr = (unsigned*)take(1024);
  p.bar = (unsigned*)take(XCD_BAR_WORDS * 4);
  p.Wt_in = (u16*)take((size_t)NIN * DM * 2);
  p.Wt_out = (u16*)take((size_t)DM * 2048 * 2);
  p.Wt_uq = (u16*)take((size_t)768 * 256 * 2);
  p.Wt_ukv = (u16*)take((size_t)1024 * 128 * 2);
  p.H = (u16*)take((size_t)MT * LDH * 2);
  p.Mix = (u16*)take((size_t)MT * 2048 * 2);
  p.Xb = p.Mix;
  p.VtA = (u16*)take((size_t)NB * 512 * PP * 2);
  p.VtD = (u16*)take((size_t)NB * 128 * PP * 2);
  p.R = (float*)take((size_t)MT * DM * 4);
  p.IDX = (u16*)take((size_t)MT * 256 * 2);
  p.IK = (u16*)take((size_t)MT * 64 * 2);
  p.Kpe = (u16*)take((size_t)MT * 32 * 2);
  p.IW = (float*)take((size_t)MT * 8 * 4);
  p.LOGF = (float*)take((size_t)NB * 8 * PP * 4);
  p.CUM = (float*)take((size_t)NB * 8 * PP * 4);
  p.ROPE = (float*)take((size_t)PP * 32 * 4);
  if (off > ws_size) { fprintf(stderr, "workspace too small: need %zu have %zu\n", off, ws_size); return; }
  {
    char* ob = (char*)d_out;
    p.Qm = (u16*)ob; ob += (size_t)MT * 768 * 2;
    p.Km = (u16*)ob; ob += (size_t)MT * 512 * 2;
    p.VtB = (u16*)ob; ob += (size_t)NB * 512 * PP * 2;
    if ((size_t)(ob - (char*)d_out) > (size_t)out_size * 4) { fprintf(stderr, "d_out too small for scratch\n"); return; }
  }
  hipMemsetAsync(p.ctr, 0, 1024 + XCD_BAR_WORDS * 4, stream);
  void* args[] = {&p};
  hipError_t e = hipLaunchCooperativeKernel((const void*)mega, dim3(grid), dim3(NTHREADS), args, LDS_BYTES, stream);
  if (e != hipSuccess) fprintf(stderr, "cooperative launch failed: %s (grid %d)\n", hipGetErrorString(e), grid);
}
```

```cpp
#include <hip/hip_runtime.h>
#include <hip/hip_cooperative_groups.h>
#include <cstdio>
namespace cg = cooperative_groups;

#define DI __device__ __forceinline__
typedef __attribute__((ext_vector_type(8))) short bf16x8;
typedef __attribute__((ext_vector_type(16))) float f32x16;
typedef __attribute__((ext_vector_type(4))) float f32x4;
typedef __attribute__((ext_vector_type(2))) float f32x2;
typedef __attribute__((ext_vector_type(2))) __bf16 bf2_t;
typedef __attribute__((ext_vector_type(4))) unsigned u32x4;
typedef __attribute__((ext_vector_type(2))) unsigned u32x2;
typedef unsigned short u16;
#define MFMA32(a, b, c) __builtin_amdgcn_mfma_f32_32x32x16_bf16((a), (b), (c), 0, 0, 0)

constexpr int NB = 2, PP = 8448, PV = 8320, LEAD = 112, DM = 1024, MT = NB * PP, SEQ = 8192;
constexpr int LDH = 5376, NIN = 6144;
constexpr int HQ_A = 0, HK_A = 512, HG_A = 1024, HCQ_B = 1536, HCKV_B = 1792, HG_B = 1920, HQ_C = 2432, HK_C = 2944, HV_C = 3072,
              HIQ_C = 3200, HG_C = 3712, HQ_D = 4224, HK_D = 4736, HG_D = 4864;
constexpr int D_IN = 6128;
constexpr float LOG2E = 1.4426950408889634f;
constexpr float NEGL = -1e30f;
constexpr float ALPHA = 1.681792830507429f;
constexpr int LDS_JOB = 147456;
constexpr int LDS_BYTES = LDS_JOB + 64;
constexpr int GEMM_STAGE = 55296;
constexpr int NTHREADS = 512;
#define REP_P1 1
#define REP_P2 1
#define REP_P3 1
#define SC_FOX 1.0f
#define SC_MLA 1.0f
#define SC_SWA 1.0f
#define SC_DSA 1.0f

struct Params {
  const float *x, *meta, *ln0_g, *ln0_b, *rel_bias, *w_in, *b_f, *gq, *gkv, *w_uq, *w_ukv, *sinks, *w_out, *ln_g, *ln_b;
  float* out;
  u16 *Wt_in, *Wt_out, *Wt_uq, *Wt_ukv;
  u16 *H, *Xb, *Mix, *VtA, *VtD, *VtB, *Qm, *Km, *Kpe, *IK, *IDX;
  float *R, *LOGF, *CUM, *IW, *ROPE;
  unsigned* ctr;
  unsigned* bar;
};

DI unsigned pk2(float a, float b) { f32x2 v = {a, b}; return __builtin_bit_cast(unsigned, __builtin_convertvector(v, bf2_t)); }
DI float bf_lo(unsigned u) { return __uint_as_float(u << 16); }
DI float bf_hi(unsigned u) { return __uint_as_float(u & 0xffff0000u); }
DI int opaque_tid() { int t = threadIdx.x; asm volatile("" : "+v"(t)); return t; }
DI int crow(int i, int h) { return (i & 3) + 8 * (i >> 2) + 4 * h; }
template <int CTRL> DI float dpp_mov(float v) { return __int_as_float(__builtin_amdgcn_mov_dpp(__float_as_int(v), CTRL, 0xF, 0xF, true)); }
DI float wsum(float v) {
  v += dpp_mov<0xB1>(v); v += dpp_mov<0x4E>(v); v += dpp_mov<0x141>(v); v += dpp_mov<0x140>(v);
  u32x2 r = __builtin_amdgcn_permlane16_swap(__float_as_uint(v), __float_as_uint(v), false, false);
  v = __uint_as_float(r[0]) + __uint_as_float(r[1]);
  r = __builtin_amdgcn_permlane32_swap(__float_as_uint(v), __float_as_uint(v), false, false);
  return __uint_as_float(r[0]) + __uint_as_float(r[1]);
}
DI float wmax(float v) {
  v = fmaxf(v, dpp_mov<0xB1>(v)); v = fmaxf(v, dpp_mov<0x4E>(v)); v = fmaxf(v, dpp_mov<0x141>(v)); v = fmaxf(v, dpp_mov<0x140>(v));
  u32x2 r = __builtin_amdgcn_permlane16_swap(__float_as_uint(v), __float_as_uint(v), false, false);
  v = fmaxf(__uint_as_float(r[0]), __uint_as_float(r[1]));
  r = __builtin_amdgcn_permlane32_swap(__float_as_uint(v), __float_as_uint(v), false, false);
  return fmaxf(__uint_as_float(r[0]), __uint_as_float(r[1]));
}
DI int wsumi(int v) { for (int o = 32; o > 0; o >>= 1) v += __shfl_xor(v, o); return v; }
DI float silu(float g) { return g / (1.f + __expf(-g)); }
DI float dot2(unsigned a, unsigned b, float c) { return __builtin_amdgcn_fdot2_f32_bf16(__builtin_bit_cast(bf2_t, a), __builtin_bit_cast(bf2_t, b), c, false); }
template <int CTRL> DI float dpp_add(float v) { return v + __int_as_float(__builtin_amdgcn_mov_dpp(__float_as_int(v), CTRL, 0xF, 0xF, true)); }
DI int t5_bucket(int n) {
  if (n < 16) return n;
  int lg = 16 + (int)(logf((float)n / 16.f) / logf(8.f) * 16.f);
  return lg < 31 ? lg : 31;
}

DI int next_job(unsigned* ctr, char* lds, int& pending, int njobs, int& par) {
  int* sj = (int*)(lds + LDS_JOB);
  if (threadIdx.x == 0) sj[par] = pending;
  __syncthreads();
  const int j = sj[par];
  par ^= 1;
  if (threadIdx.x == 0 && j < njobs) pending = (int)atomicAdd(ctr, 1u);
  return j;
}

template <bool SWAP, class Epi>
DI void gemm_tile(const u16* __restrict__ A, int lda, const u16* __restrict__ Bw, int ldb, int K, char* lds, Epi epi) {
  const int tid = opaque_tid(), lane = tid & 63, w = tid >> 6, r = lane & 31, h = lane >> 5;
  const int wm = w & 3, wn = w >> 2;
  f32x16 acc[2][2];
#pragma unroll
  for (int a = 0; a < 2; ++a)
#pragma unroll
    for (int b = 0; b < 2; ++b)
#pragma unroll
      for (int i = 0; i < 16; ++i) acc[a][b][i] = 0.f;
  const int lrow = tid >> 3, lkc = tid & 7;
  u32x4 ra0[4], rb0[2], ra1[4], rb1[2];
  const u16* ap = A + (size_t)lrow * lda + lkc * 8;
  const u16* bp = Bw + (size_t)lrow * ldb + lkc * 8;
  const int nk = K >> 6;
  auto gload = [&](int kt, u32x4* ra, u32x4* rb) {
#pragma unroll
    for (int j = 0; j < 4; ++j) ra[j] = *(const u32x4*)(ap + (size_t)(64 * j) * lda + kt * 64);
#pragma unroll
    for (int j = 0; j < 2; ++j) rb[j] = *(const u32x4*)(bp + (size_t)(64 * j) * ldb + kt * 64);
  };
  auto lstore = [&](int st, const u32x4* ra, const u32x4* rb) {
    char* base = lds + st * GEMM_STAGE;
#pragma unroll
    for (int j = 0; j < 4; ++j) *(u32x4*)(base + ((lrow + 64 * j) * 72 + lkc * 8) * 2) = ra[j];
#pragma unroll
    for (int j = 0; j < 2; ++j) *(u32x4*)(base + 36864 + ((lrow + 64 * j) * 72 + lkc * 8) * 2) = rb[j];
  };
  auto compute = [&](int st) {
    const char* as = lds + st * GEMM_STAGE;
    const char* bs = as + 36864;
#pragma unroll
    for (int ks = 0; ks < 4; ++ks) {
      bf16x8 af[2], bfr[2];
#pragma unroll
      for (int mi = 0; mi < 2; ++mi) af[mi] = *(const bf16x8*)(as + ((wm * 64 + mi * 32 + r) * 72 + ks * 16 + 8 * h) * 2);
#pragma unroll
      for (int ni = 0; ni < 2; ++ni) bfr[ni] = *(const bf16x8*)(bs + ((wn * 64 + ni * 32 + r) * 72 + ks * 16 + 8 * h) * 2);
#pragma unroll
      for (int mi = 0; mi < 2; ++mi)
#pragma unroll
        for (int ni = 0; ni < 2; ++ni) {
          if (SWAP) acc[mi][ni] = MFMA32(bfr[ni], af[mi], acc[mi][ni]);
          else acc[mi][ni] = MFMA32(af[mi], bfr[ni], acc[mi][ni]);
        }
    }
  };
  gload(0, ra0, rb0);
  lstore(0, ra0, rb0);
  gload(1, ra1, rb1);
  __syncthreads();
  for (int kt = 0; kt < nk; kt += 2) {
    if (kt + 2 < nk) gload(kt + 2, ra0, rb0);
    compute(0);
    lstore(1, ra1, rb1);
    __syncthreads();
    if (kt + 3 < nk) gload(kt + 3, ra1, rb1);
    compute(1);
    if (kt + 2 < nk) lstore(0, ra0, rb0);
    __syncthreads();
  }
#pragma unroll
  for (int mi = 0; mi < 2; ++mi)
#pragma unroll
    for (int ni = 0; ni < 2; ++ni) epi(mi, ni, acc[mi][ni]);
}

DI void store_rowmajor(u16* dst, const f32x16& a, int h, float sc) {
#pragma unroll
  for (int kp = 0; kp < 2; ++kp) {
    const int g = 2 * kp;
    unsigned ax = pk2(a[4 * g] * sc, a[4 * g + 1] * sc), ay = pk2(a[4 * g + 2] * sc, a[4 * g + 3] * sc);
    unsigned bx = pk2(a[4 * g + 4] * sc, a[4 * g + 5] * sc), by = pk2(a[4 * g + 6] * sc, a[4 * g + 7] * sc);
    const u32x2 rx = __builtin_amdgcn_permlane32_swap(ax, bx, false, false);
    const u32x2 ry = __builtin_amdgcn_permlane32_swap(ay, by, false, false);
    const u32x4 v = {rx[0], ry[0], rx[1], ry[1]};
    *(u32x4*)(dst + 8 * (g + h)) = v;
  }
}
DI void store_rope(u16* dst, const f32x16& a, int h, float sc, const float* rp) {
#pragma unroll
  for (int g = 0; g < 2; ++g) {
    f32x4 cs = *(const f32x4*)(rp + 8 * g + 4 * h);
    f32x4 sn = *(const f32x4*)(rp + 16 + 8 * g + 4 * h);
    float o1[4], o2[4];
#pragma unroll
    for (int e = 0; e < 4; ++e) {
      float x1 = a[4 * g + e] * sc, x2 = a[8 + 4 * g + e] * sc;
      o1[e] = x1 * cs[e] - x2 * sn[e];
      o2[e] = x1 * sn[e] + x2 * cs[e];
    }
    u32x2 v1 = {pk2(o1[0], o1[1]), pk2(o1[2], o1[3])};
    u32x2 v2 = {pk2(o2[0], o2[1]), pk2(o2[2], o2[3])};
    *(u32x2*)(dst + 8 * g + 4 * h) = v1;
    *(u32x2*)(dst + 16 + 8 * g + 4 * h) = v2;
  }
}
DI void store_transposed(u16* dst, const f32x16& a, int h, const float* rs  ) {
#pragma unroll
  for (int g = 0; g < 4; ++g) {
    float s0 = 1.f, s1 = 1.f, s2 = 1.f, s3 = 1.f;
    if (rs) { f32x4 sv = *(const f32x4*)(rs + 8 * g + 4 * h); s0 = sv[0]; s1 = sv[1]; s2 = sv[2]; s3 = sv[3]; }
    u32x2 v = {pk2(a[4 * g] * s0, a[4 * g + 1] * s1), pk2(a[4 * g + 2] * s2, a[4 * g + 3] * s3)};
    *(u32x2*)(dst + 8 * g + 4 * h) = v;
  }
}

DI void inproj_tile(const Params& p, int l, int mt, int nt, char* lds) {
  const int tid = opaque_tid(), lane = tid & 63, w = tid >> 6, r = lane & 31, h = lane >> 5;
  const int wm = w & 3, wn = w >> 2;
  const int m0 = mt * 256;
  const u16* A = p.Xb + (size_t)m0 * DM;
  const u16* Bw = p.Wt_in + (size_t)nt * 128 * DM;
  if (nt < 42) {
    float ssq = 0.f;
    gemm_tile<true>(A, DM, Bw, DM, DM, lds, [&](int mi, int ni, const f32x16& a) {
      const int tok = m0 + wm * 64 + mi * 32 + r;
      store_rowmajor(p.H + (size_t)tok * LDH + nt * 128 + wn * 64 + ni * 32, a, h, 1.f);
      if (nt >= 4 && nt < 8) {
        if (ni == 0) ssq = 0.f;
#pragma unroll
        for (int i = 0; i < 16; ++i) ssq += a[i] * a[i];
        if (ni == 1) {
          float tot = ssq + __shfl_xor(ssq, 32);
          tot = wmax(tot);
          if (lane == 0) atomicMax(p.ctr + 64 + l * 16 + (m0 / PP) * 8 + (nt - 4) * 2 + wn, __float_as_uint(sqrtf(tot) * 1.01f));
        }
      }
    });
  } else if (nt == 42) {
    gemm_tile<true>(A, DM, Bw, DM, DM, lds, [&](int mi, int ni, const f32x16& a) {
      const int tok = m0 + wm * 64 + mi * 32 + r;
      const int b = tok / PP, t = tok - b * PP;
      const int sub = wn * 2 + ni;
      if (sub == 0) {
        store_rope(p.Kpe + (size_t)tok * 32, a, h, 1.f, p.ROPE + (size_t)t * 32);
      } else if (sub == 1) {
        store_rowmajor(p.IK + (size_t)tok * 64, a, h, 1.f);
      } else if (sub == 2) {
        store_rowmajor(p.IK + (size_t)tok * 64 + 32, a, h, 1.f);
      } else {
#pragma unroll
        for (int e = 0; e < 4; ++e) {
          const int hd = e + 4 * h;
          float xv = a[e] + p.b_f[l * 8 + hd];
          float lf = fminf(xv, 0.f) - log1pf(expf(-fabsf(xv)));
          p.LOGF[(size_t)(b * 8 + hd) * PP + t] = lf;
          p.IW[(size_t)tok * 8 + hd] = a[4 + e];
        }
      }
    });
  } else {
    u16* vt; int nv, c0;
    if (nt < 47) { vt = p.VtA; nv = 512; c0 = (nt - 43) * 128; } else { vt = p.VtD; nv = 128; c0 = 0; }
    gemm_tile<false>(A, DM, Bw, DM, DM, lds, [&](int mi, int ni, const f32x16& a) {
      const int b = m0 / PP, t0 = m0 - b * PP + wm * 64 + mi * 32;
      const int col = c0 + wn * 64 + ni * 32 + r;
      store_transposed(vt + ((size_t)b * nv + col) * PP + t0, a, h, nullptr);
    });
  }
}

DI void upproj_tile(const Params& p, int mt, int nt14, char* lds) {
  const int tid = opaque_tid(), lane = tid & 63, w = tid >> 6, r = lane & 31, h = lane >> 5;
  const int wm = w & 3, wn = w >> 2;
  const int m0 = mt * 256;
  float* rs = (float*)(lds + 2 * GEMM_STAGE);
  const bool isq = nt14 < 6;
  {
    const int row = tid >> 1, half = tid & 1;
    const int kw = isq ? 128 : 64;
    const u16* src = p.H + (size_t)(m0 + row) * LDH + (isq ? HCQ_B : HCKV_B) + half * kw;
    float ss = 0.f;
    u32x4 rv[16];
#pragma unroll
    for (int c = 0; c < 8; ++c) rv[c] = *(const u32x4*)(src + c * 8);
    if (isq) {
#pragma unroll
      for (int c = 8; c < 16; ++c) rv[c] = *(const u32x4*)(src + c * 8);
    } else {
#pragma unroll
      for (int c = 8; c < 16; ++c) { rv[c][0] = 0u; rv[c][1] = 0u; rv[c][2] = 0u; rv[c][3] = 0u; }
    }
#pragma unroll
    for (int c = 0; c < 16; ++c)
#pragma unroll
      for (int e = 0; e < 4; ++e) { float a = bf_lo(rv[c][e]), b2 = bf_hi(rv[c][e]); ss += a * a + b2 * b2; }
    ss += __shfl_xor(ss, 1);
    if (half == 0) rs[row] = rsqrtf(ss / (isq ? 256.f : 128.f) + 1e-6f);
  }
  __syncthreads();
  if (isq) {
    const int nt = nt14;
    gemm_tile<true>(p.H + (size_t)m0 * LDH + HCQ_B, LDH, p.Wt_uq + (size_t)nt * 128 * 256, 256, 256, lds, [&](int mi, int ni, const f32x16& a) {
      const int lr = wm * 64 + mi * 32 + r;
      const int tok = m0 + lr;
      const int t = tok % PP;
      const int j32 = nt * 4 + wn * 2 + ni;
      const float sc = rs[lr];
      u16* dst = p.Qm + (size_t)tok * 768 + j32 * 32;
      if (j32 % 3 == 2) store_rope(dst, a, h, sc, p.ROPE + (size_t)t * 32);
      else store_rowmajor(dst, a, h, sc);
    });
  } else {
    const int nt = nt14 - 6;
    const u16* A = p.H + (size_t)m0 * LDH + HCKV_B;
    const u16* Bw = p.Wt_ukv + (size_t)nt * 128 * 128;
    if (nt < 4) {
      gemm_tile<true>(A, LDH, Bw, 128, 128, lds, [&](int mi, int ni, const f32x16& a) {
        const int lr = wm * 64 + mi * 32 + r;
        store_rowmajor(p.Km + (size_t)(m0 + lr) * 512 + nt * 128 + wn * 64 + ni * 32, a, h, rs[lr]);
      });
    } else {
      gemm_tile<false>(A, LDH, Bw, 128, 128, lds, [&](int mi, int ni, const f32x16& a) {
        const int b = m0 / PP, t0 = m0 - b * PP + wm * 64 + mi * 32;
        const int col = (nt - 4) * 128 + wn * 64 + ni * 32 + r;
        store_transposed(p.VtB + ((size_t)b * 512 + col) * PP + t0, a, h, rs + wm * 64 + mi * 32);
      });
    }
  }
}

DI void cumsum_job(const Params& p, int j, char* lds) {
  const int tid = opaque_tid(), lane = tid & 63, w = tid >> 6;
  const float* src = p.LOGF + (size_t)j * PP;
  float* dst = p.CUM + (size_t)j * PP;
  float* wt = (float*)lds;
  float v[17];
#pragma unroll
  for (int rr = 0; rr < 17; ++rr) {
    const int o = rr * 64 + lane, i = w * 1056 + o;
    v[rr] = (o < 1056 && i >= LEAD) ? src[i] : 0.f;
  }
  float carry = 0.f;
#pragma unroll
  for (int rr = 0; rr < 17; ++rr) {
    float inc = v[rr];
    for (int o = 1; o < 64; o <<= 1) { float x = __shfl_up(inc, o); if (lane >= o) inc += x; }
    v[rr] = inc + carry;
    carry += __shfl(inc, 63);
  }
  if (lane == 0) wt[w] = carry;
  __syncthreads();
  float base = 0.f;
  for (int k = 0; k < w; ++k) base += wt[k];
#pragma unroll
  for (int rr = 0; rr < 17; ++rr) {
    const int o = rr * 64 + lane;
    if (o < 1056) dst[w * 1056 + o] = v[rr] + base;
  }
}

DI void topk_job(const Params& p, int b, int t0, char* lds) {
  const int tid = opaque_tid(), lane = tid & 63, w = tid >> 6, r = lane & 31, h = lane >> 5;
  const int cmax = (t0 + 3) >> 6;
  unsigned sc[17][4];
  {
    const u16* iqp = p.H + (size_t)(b * PP + t0 + (r >> 3)) * LDH + HIQ_C + (r & 7) * 64 + 8 * h;
    bf16x8 af[4];
#pragma unroll
    for (int ks = 0; ks < 4; ++ks) af[ks] = *(const bf16x8*)(iqp + ks * 16);
    f32x4 iw[4];
#pragma unroll
    for (int qi = 0; qi < 4; ++qi) iw[qi] = *(const f32x4*)(p.IW + (size_t)(b * PP + t0 + qi) * 8 + 4 * h);
    char* wb = lds + 16384 + w * 9216;
    const int lrow = lane >> 3, lpc = lane & 7;
    const u16* ikb = p.IK + ((size_t)(b * PP) + lrow) * 64 + lpc * 8;
    u32x4 st[8];
    if (1 + w <= cmax) {
      const u16* kp = ikb + (size_t)(1 + w) * 64 * 64;
#pragma unroll
      for (int j = 0; j < 8; ++j) st[j] = *(const u32x4*)(kp + (size_t)j * 8 * 64);
#pragma unroll
      for (int j = 0; j < 8; ++j) *(u32x4*)(wb + (lrow + 8 * j) * 144 + lpc * 16) = st[j];
    }
#pragma unroll
    for (int i = 0; i < 17; ++i) {
      const int c = 1 + w + 8 * i;
      if (c <= cmax) {
        const bool more = c + 8 <= cmax;
        if (more) {
          const u16* kp = ikb + (size_t)(c + 8) * 64 * 64;
#pragma unroll
          for (int j = 0; j < 8; ++j) st[j] = *(const u32x4*)(kp + (size_t)j * 8 * 64);
        }
        bf16x8 b0[4], b1[4];
#pragma unroll
        for (int ks = 0; ks < 4; ++ks) {
          b0[ks] = *(const bf16x8*)(wb + r * 144 + ks * 32 + h * 16);
          b1[ks] = *(const bf16x8*)(wb + (32 + r) * 144 + ks * 32 + h * 16);
        }
        __builtin_amdgcn_sched_barrier(0);
        f32x16 a0, a1;
#pragma unroll
        for (int e = 0; e < 16; ++e) { a0[e] = 0.f; a1[e] = 0.f; }
#pragma unroll
        for (int ks = 0; ks < 4; ++ks) { a0 = MFMA32(af[ks], b0[ks], a0); a1 = MFMA32(af[ks], b1[ks], a1); }
        const int key = c * 64 + lane;
#pragma unroll
        for (int qi = 0; qi < 4; ++qi) {
          f32x2 pp2 = {0.f, 0.f};
#pragma unroll
          for (int e = 0; e < 4; ++e) {
            const f32x2 rl = {fmaxf(a0[4 * qi + e], 0.f), fmaxf(a1[4 * qi + e], 0.f)};
            const f32x2 wv = {iw[qi][e], iw[qi][e]};
            pp2 += rl * wv;
          }
          const float p0 = pp2[0], p1 = pp2[1];
          const u32x2 sw = __builtin_amdgcn_permlane32_swap(__float_as_uint(p0), __float_as_uint(p1), false, false);
          float mine = __uint_as_float(sw[0]) + __uint_as_float(sw[1]);
          mine += 0.0f;
          unsigned u = __float_as_uint(mine);
          u = (u & 0x80000000u) ? ~u : (u | 0x80000000u);
          if (key > t0 + qi || key < LEAD) u = 0u;
          sc[i][qi] = u;
        }
        if (more) {
#pragma unroll
          for (int j = 0; j < 8; ++j) *(u32x4*)(wb + (lrow + 8 * j) * 144 + lpc * 16) = st[j];
        }
      } else {
#pragma unroll
        for (int qi = 0; qi < 4; ++qi) sc[i][qi] = 0u;
      }
    }
  }
  int* ng = (int*)(lds + 256);
  unsigned long long* mg = (unsigned long long*)(lds + 1024);
  unsigned long long* me = mg + 4 * 132;
  int* bg = (int*)(me + 4 * 132);
  int* be = bg + 4 * 132;
  unsigned T[4];
  {
    unsigned* hist = (unsigned*)(lds + 16384);
    int* sel = (int*)(lds + 512);
    unsigned pref[4] = {0u, 0u, 0u, 0u};
    int chi[4] = {0, 0, 0, 0};
    bool few[4] = {false, false, false, false};
    __syncthreads();
    bool small = false;
    int nb[4] = {0, 0, 0, 0};
#pragma unroll
    for (int pass = 0; pass < 3; ++pass) {
      if (pass == 2) {
        small = true;
#pragma unroll
        for (int q = 0; q < 4; ++q) small = small && (few[q] || nb[q] <= 64);
        if (small) break;
      }
      {
        const u32x4 z = {0u, 0u, 0u, 0u};
#pragma unroll
        for (int j = 0; j < 8; ++j) ((u32x4*)hist)[tid + 512 * j] = z;
      }
      __syncthreads();
#pragma unroll
      for (int i = 0; i < 17; ++i) {
#pragma unroll
        for (int q = 0; q < 4; ++q) {
          const unsigned u = sc[i][q];
          bool part; unsigned bin;
          if (pass == 0) { part = (u != 0u); bin = (u >> 22) + (lane & 3) * 1024; }
          else if (pass == 1) { part = (u != 0u) && ((u >> 22) == pref[q]) && !few[q]; bin = ((u >> 12) & 1023u) + (lane & 3) * 1024; }
          else { part = (u != 0u) && ((u >> 12) == pref[q]) && !few[q]; bin = u & 4095u; }
          if (part) atomicAdd(hist + q * 4096 + bin, 1u);
        }
      }
      __syncthreads();
      if (w < 4) {
        const int q = w;
        const unsigned* hq = hist + q * 4096;
        const int need = 256 - chi[q];
        int G = 0;
        if (pass < 2) {
#pragma unroll
          for (int rep = 0; rep < 4; ++rep)
#pragma unroll
            for (int j = 0; j < 16; ++j) G += (int)hq[rep * 1024 + 16 * lane + ((j + lane) & 15)];
        } else {
#pragma unroll 8
          for (int j = 0; j < 64; ++j) G += (int)hq[64 * lane + ((j + lane) & 63)];
        }
        int S = G;
        for (int o = 1; o < 64; o <<= 1) { int x = __shfl_down(S, o); if (lane + o < 64) S += x; }
        const unsigned long long mk = __ballot(S >= need);
        int B = 0, cg2 = 0, fw = 0, nbin = 0;
        if (mk == 0ull) {
          fw = 1;
        } else {
          const int ks = 63 - __clzll(mk);
          const int above = (ks < 63) ? __shfl(S, ks + 1) : 0;
          int hh;
          if (pass < 2) {
            hh = 0;
            if (lane < 16) hh = (int)(hq[16 * ks + lane] + hq[1024 + 16 * ks + lane] + hq[2048 + 16 * ks + lane] + hq[3072 + 16 * ks + lane]);
          } else {
            hh = (int)hq[64 * ks + lane];
          }
          int s2 = hh;
          for (int o = 1; o < 64; o <<= 1) { int x = __shfl_down(s2, o); if (lane + o < 64) s2 += x; }
          const unsigned long long m2 = __ballot(above + s2 >= need);
          const int Ls = 63 - __clzll(m2);
          B = (pass < 2 ? 16 : 64) * ks + Ls;
          nbin = __shfl(hh, Ls);
          cg2 = above + __shfl(s2, Ls) - nbin;
        }
        if (lane == 0) { sel[q * 4 + 0] = B; sel[q * 4 + 1] = chi[q] + cg2; sel[q * 4 + 2] = fw; sel[q * 4 + 3] = nbin; }
      }
      __syncthreads();
#pragma unroll
      for (int q = 0; q < 4; ++q) {
        if (!few[q]) {
          pref[q] = (pref[q] << (pass < 2 ? 10 : 12)) | (unsigned)sel[q * 4 + 0];
          chi[q] = sel[q * 4 + 1];
          nb[q] = sel[q * 4 + 3];
          if (pass == 0) few[q] = sel[q * 4 + 2] != 0;
        }
      }
    }
    if (small) {
      unsigned* lst = hist;
      int* lcnt = sel + 16;
      if (tid < 4) lcnt[tid] = 0;
      __syncthreads();
#pragma unroll
      for (int i = 0; i < 17; ++i)
#pragma unroll
        for (int q = 0; q < 4; ++q) {
          const unsigned u = sc[i][q];
          if (!few[q] && u != 0u && (u >> 12) == pref[q]) { const int pos = atomicAdd(lcnt + q, 1); lst[q * 64 + pos] = u; }
        }
      __syncthreads();
      if (w < 4) {
        const int q = w, n = lcnt[q], need = 256 - chi[q];
        const unsigned e = lane < n ? lst[q * 64 + lane] : 0u;
        int rank = 0;
        for (int k = 0; k < n; ++k) rank += (lst[q * 64 + k] > e) ? 1 : 0;
        unsigned cand = (lane < n && rank <= need - 1) ? e : 0xFFFFFFFFu;
        for (int o = 32; o > 0; o >>= 1) { const unsigned x = (unsigned)__shfl_xor((int)cand, o); cand = x < cand ? x : cand; }
        if (lane == 0) sel[q * 4 + 0] = (int)cand;
      }
      __syncthreads();
#pragma unroll
      for (int q = 0; q < 4; ++q) T[q] = few[q] ? 0u : (unsigned)sel[q * 4 + 0];
    } else {
#pragma unroll
      for (int q = 0; q < 4; ++q) T[q] = few[q] ? 0u : pref[q];
    }
  }
  unsigned* cntb = (unsigned*)mg;
  unsigned* baseb = (unsigned*)bg;
#pragma unroll
  for (int i = 0; i < 17; ++i) {
    const int c = 1 + w + 8 * i;
    if (c <= cmax) {
      unsigned mine = 0u;
#pragma unroll
      for (int q = 0; q < 4; ++q) {
        const unsigned pk = (unsigned)__popcll(__ballot(sc[i][q] > T[q])) | ((unsigned)__popcll(__ballot(sc[i][q] == T[q])) << 16);
        mine = (lane == q) ? pk : mine;
      }
      if (lane < 4) cntb[lane * 132 + c] = mine;
    }
  }
  __syncthreads();
  if (w < 4) {
    const int q = w;
    int cg_ = 0, ce_ = 0;
    for (int base = 0; base <= cmax; base += 64) {
      const int c = base + lane;
      const bool in = (c >= 1) && (c <= cmax);
      const unsigned cv = in ? cntb[q * 132 + c] : 0u;
      const int v1 = (int)(cv & 0xffffu), v2 = (int)(cv >> 16);
      int i1 = v1, i2 = v2;
      for (int o = 1; o < 64; o <<= 1) {
        int x1 = __shfl_up(i1, o), x2 = __shfl_up(i2, o);
        if (lane >= o) { i1 += x1; i2 += x2; }
      }
      if (in) baseb[q * 132 + c] = (unsigned)(cg_ + i1 - v1) | ((unsigned)(ce_ + i2 - v2) << 16);
      cg_ += __shfl(i1, 63);
      ce_ += __shfl(i2, 63);
    }
    if (lane == 0) ng[q] = cg_;
  }
  __syncthreads();
  const unsigned long long lt = (1ull << lane) - 1ull;
#pragma unroll
  for (int i = 0; i < 17; ++i) {
    const int c = 1 + w + 8 * i;
    if (c <= cmax) {
      const int key = c * 64 + lane;
#pragma unroll
      for (int q = 0; q < 4; ++q) {
        u16* out = p.IDX + (size_t)(b * PP + t0 + q) * 256;
        const bool gt = sc[i][q] > T[q];
        const bool eq = (sc[i][q] == T[q]) && (T[q] != 0u);
        const unsigned long long m1 = __ballot(gt), m2 = __ballot(eq);
        if ((m1 | m2) != 0ull) {
          const unsigned bb = baseb[q * 132 + c];
          if (gt) out[(int)(bb & 0xffffu) + __popcll(m1 & lt)] = (u16)key;
          if (eq) { const int pos = ng[q] + (int)(bb >> 16) + __popcll(m2 & lt); if (pos < 256) out[pos] = (u16)key; }
        }
      }
    }
  }
#pragma unroll
  for (int q = 0; q < 4; ++q) {
    if (T[q] == 0u) {
      u16* out = p.IDX + (size_t)(b * PP + t0 + q) * 256;
      if (tid < 256 && tid >= ng[q]) out[tid] = (u16)0xFFFF;
    }
  }
}

constexpr int AT_STAGE = 23040;
template <int DK, int MODE>
DI void attn_unit(const Params& p, int l, int b, int head, int qu, char* lds) {
  const int tid = opaque_tid(), lane = tid & 63, w = tid >> 6, r = lane & 31, h = lane >> 5;
  constexpr int KS = DK / 16, KST = DK + 8;
  const int q0 = qu * 256, qw0 = q0 + w * 32, qw = qw0 + r;
  const size_t tokq = (size_t)b * PP + qw;
  const u16 *qptr, *kptr, *vtptr, *gptr;
  int ldk;
  if (MODE == 0) {
    qptr = p.H + tokq * LDH + HQ_A + head * 64; kptr = p.H + (size_t)b * PP * LDH + HK_A + head * 64; ldk = LDH;
    vtptr = p.VtA + ((size_t)b * 512 + head * 64) * PP; gptr = p.H + tokq * LDH + HG_A + head * 64;
  } else if (MODE == 1) {
    qptr = p.Qm + tokq * 768 + head * 96; kptr = p.Km + (size_t)b * PP * 512 + head * 64; ldk = 512;
    vtptr = p.VtB + ((size_t)b * 512 + head * 64) * PP; gptr = p.H + tokq * LDH + HG_B + head * 64;
  } else {
    qptr = p.H + tokq * LDH + HQ_D + head * 64; kptr = p.H + (size_t)b * PP * LDH + HK_D + (head >> 2) * 64; ldk = LDH;
    vtptr = p.VtD + ((size_t)b * 128 + (head >> 2) * 64) * PP; gptr = p.H + tokq * LDH + HG_D + head * 64;
  }
  const float* cum = p.CUM + (size_t)(b * 8 + head) * PP;
  float* btab = (float*)(lds + 2 * AT_STAGE);
  u32x2 gpre[2][4];
#pragma unroll
  for (int d = 0; d < 2; ++d)
#pragma unroll
    for (int g = 0; g < 4; ++g) gpre[d][g] = *(const u32x2*)(gptr + d * 32 + 8 * g + 4 * h);
  bf16x8 qf[KS];
#pragma unroll
  for (int ks = 0; ks < KS; ++ks) qf[ks] = *(const bf16x8*)(qptr + ks * 16 + 8 * h);
  float cref = 0.f;
  if (MODE == 0) cref = cum[q0];
  if (MODE == 2) { if (tid < 128) btab[tid] = p.rel_bias[t5_bucket(tid) * 16 + 8 + head] * LOG2E; }
  const float sc2 = (MODE == 1 ? 0.10206207261596577f : 0.125f) * LOG2E;
  const int kt_hi = qu * 4 + 3;
  int kt_lo = 1;
  if (MODE == 2) { kt_lo = qu * 4 - 2; if (kt_lo < 1) kt_lo = 1; }
  u32x4 rk, rk2, rv;
  float re = 0.f;
  const int srow = tid >> 3, sc8 = tid & 7;
  auto gload = [&](int kt) {
    const int k0 = kt * 64;
    rk = *(const u32x4*)(kptr + (size_t)(k0 + srow) * ldk + sc8 * 8);
    if (MODE == 1) { if (tid < 256) rk2 = *(const u32x4*)(p.Kpe + ((size_t)b * PP + k0 + (tid >> 2)) * 32 + (tid & 3) * 8); }
    rv = *(const u32x4*)(vtptr + (size_t)srow * PP + k0 + sc8 * 8);
    if (MODE == 0) { if (tid < 64) re = (cum[k0 + tid] - cref) * LOG2E; }
  };
  auto lstore = [&](int st) {
    char* base = lds + st * AT_STAGE;
    *(u32x4*)(base + (srow * KST + sc8 * 8) * 2) = rk;
    if (MODE == 1) { if (tid < 256) *(u32x4*)(base + ((tid >> 2) * KST + 64 + (tid & 3) * 8) * 2) = rk2; }
    char* vb = base + 64 * KST * 2;
    u32x2 lo = {rv[0], rv[1]}, hi = {rv[2], rv[3]};
    *(u32x2*)(vb + (srow * 68 + sc8 * 8) * 2) = lo;
    *(u32x2*)(vb + (srow * 68 + sc8 * 8 + 4) * 2) = hi;
    if (MODE == 0) { if (tid < 64) *(float*)(vb + 64 * 68 * 2 + tid * 4) = re; }
  };
  f32x16 o[2];
#pragma unroll
  for (int d = 0; d < 2; ++d)
#pragma unroll
    for (int i = 0; i < 16; ++i) o[d][i] = 0.f;
  float m = NEGL, lsum = 0.f;
  float qn = 0.f, kmx = 0.f;
  int* stopf = (int*)(lds + 2 * AT_STAGE + 1024);
  if (MODE == 0) {
#pragma unroll
    for (int ks = 0; ks < KS; ++ks) {
      const u32x4 qq = __builtin_bit_cast(u32x4, qf[ks]);
#pragma unroll
      for (int e = 0; e < 4; ++e) { const float a = bf_lo(qq[e]), b2 = bf_hi(qq[e]); qn += a * a + b2 * b2; }
    }
    qn += __shfl_xor(qn, 32);
    qn = sqrtf(qn) * 1.01f;
    kmx = __uint_as_float(p.ctr[64 + l * 16 + b * 8 + head]);
  }
  gload(kt_hi); lstore(0);
  __syncthreads();
  for (int kt = kt_hi; kt >= kt_lo; --kt) {
    const bool more = kt > kt_lo;
    if (more) gload(kt - 1);
    float cnext = 0.f;
    if (MODE == 0) { if (more) cnext = cum[(kt - 1) * 64 + 63]; }
    const int st = (kt_hi - kt) & 1;
    const int k0 = kt * 64;
    bool active = k0 <= qw0 + 31;
    if (MODE == 2) active = active && (k0 + 63 >= qw0 - 127);
    if (active) {
      const char* kb = lds + st * AT_STAGE;
      const char* vb = kb + 64 * KST * 2;
      f32x16 s[2];
      bf16x8 kf[2][KS];
#pragma unroll
      for (int kr = 0; kr < 2; ++kr)
#pragma unroll
        for (int ks = 0; ks < KS; ++ks) kf[kr][ks] = *(const bf16x8*)(kb + ((kr * 32 + r) * KST + ks * 16 + 8 * h) * 2);
      __builtin_amdgcn_sched_barrier(0);
#pragma unroll
      for (int kr = 0; kr < 2; ++kr) {
#pragma unroll
        for (int i = 0; i < 16; ++i) s[kr][i] = 0.f;
#pragma unroll
        for (int ks = 0; ks < KS; ++ks) s[kr] = MFMA32(kf[kr][ks], qf[ks], s[kr]);
      }
      u32x4 vfr[2][2][2];
#pragma unroll
      for (int kr = 0; kr < 2; ++kr)
#pragma unroll
        for (int s2 = 0; s2 < 2; ++s2)
#pragma unroll
          for (int d = 0; d < 2; ++d) {
            const char* va = vb + ((d * 32 + r) * 68 + kr * 32 + s2 * 16 + 4 * h) * 2;
            const u32x2 lo = *(const u32x2*)va;
            const u32x2 hi = *(const u32x2*)(va + 16);
            vfr[kr][s2][d] = (u32x4){lo[0], lo[1], hi[0], hi[1]};
          }
      __builtin_amdgcn_sched_barrier(0);
      const bool need_mask = (MODE == 2) || (k0 + 63 > qw0) || (k0 < LEAD);
      const bool rawpath = (MODE == 1) && !need_mask;
      float tmax = NEGL;
      const f32x2 sc2v = {sc2, sc2};
      if (rawpath) {
#pragma unroll
        for (int kr = 0; kr < 2; ++kr)
#pragma unroll
          for (int i = 0; i < 16; ++i) tmax = fmaxf(tmax, s[kr][i]);
        tmax *= sc2;
      } else {
#pragma unroll
        for (int kr = 0; kr < 2; ++kr) {
#pragma unroll
          for (int g = 0; g < 4; ++g) {
            f32x4 ev = {0.f, 0.f, 0.f, 0.f};
            if (MODE == 0) ev = *(const f32x4*)(vb + 64 * 68 * 2 + (kr * 32 + 8 * g + 4 * h) * 4);
#pragma unroll
            for (int e2 = 0; e2 < 2; ++e2) {
              const int i = 4 * g + 2 * e2;
              f32x2 v2 = {s[kr][i], s[kr][i + 1]};
              if (MODE == 0) { const f32x2 e2v = {ev[2 * e2], ev[2 * e2 + 1]}; v2 = v2 * sc2v - e2v; }
              else v2 = v2 * sc2v;
#pragma unroll
              for (int e1 = 0; e1 < 2; ++e1) {
                const int key = k0 + kr * 32 + 8 * g + 4 * h + 2 * e2 + e1;
                float v = v2[e1];
                if (MODE == 2) v += btab[(qw - key) & 127];
                if (need_mask) {
                  bool ok = (key <= qw) && (key >= LEAD);
                  if (MODE == 2) ok = ok && (qw - key < 128);
                  v = ok ? v : NEGL;
                }
                s[kr][i + e1] = v;
                tmax = fmaxf(tmax, v);
              }
            }
          }
        }
      }
      tmax = fmaxf(tmax, __shfl_xor(tmax, 32));
      const float mn = fmaxf(m, tmax);
      const float alpha = __builtin_amdgcn_exp2f(m - mn);
      const bool resc = __any(m != mn);
      m = mn;
      f32x2 ps2 = {0.f, 0.f};
      const f32x2 mnv = {mn, mn};
      const f32x2 scx = rawpath ? sc2v : (f32x2){1.f, 1.f};
#pragma unroll
      for (int kr = 0; kr < 2; ++kr)
#pragma unroll
        for (int i = 0; i < 16; i += 2) {
          f32x2 v2 = {s[kr][i], s[kr][i + 1]};
          v2 = v2 * scx - mnv;
          f32x2 p2 = {__builtin_amdgcn_exp2f(v2[0]), __builtin_amdgcn_exp2f(v2[1])};
          s[kr][i] = p2[0]; s[kr][i + 1] = p2[1];
          ps2 += p2;
        }
      const float ps = ps2[0] + ps2[1];
      lsum = lsum * alpha + ps;
      if (resc)
#pragma unroll
      for (int d = 0; d < 2; ++d)
#pragma unroll
        for (int i = 0; i < 16; ++i) o[d][i] *= alpha;
#pragma unroll
      for (int kr = 0; kr < 2; ++kr) {
#pragma unroll
        for (int s2 = 0; s2 < 2; ++s2) {
          u32x4 pp = {pk2(s[kr][8 * s2], s[kr][8 * s2 + 1]), pk2(s[kr][8 * s2 + 2], s[kr][8 * s2 + 3]),
                      pk2(s[kr][8 * s2 + 4], s[kr][8 * s2 + 5]), pk2(s[kr][8 * s2 + 6], s[kr][8 * s2 + 7])};
          bf16x8 pf = __builtin_bit_cast(bf16x8, pp);
#pragma unroll
          for (int d = 0; d < 2; ++d) o[d] = MFMA32(__builtin_bit_cast(bf16x8, vfr[kr][s2][d]), pf, o[d]);
        }
      }
    }
    if (more) lstore(st ^ 1);
    if (MODE == 0) {
      if (more) {
        const float enext = (cnext - cref) * LOG2E;
        const bool okl = (qn * kmx * sc2 - enext) <= (m - 40.f);
        const bool okw = __all(okl);
        if (lane == 0) stopf[(kt & 1) * 8 + w] = okw ? 1 : 0;
      }
    }
    __syncthreads();
    if (MODE == 0) {
      if (more) {
        const int* sf = stopf + (kt & 1) * 8;
        if (sf[0] & sf[1] & sf[2] & sf[3] & sf[4] & sf[5] & sf[6] & sf[7]) break;
      }
    }
  }
  lsum += __shfl_xor(lsum, 32);
  float f;
  if (MODE == 2) {
    const float s2 = p.sinks[l * 8 + head] * LOG2E;
    const float mf = fmaxf(m, s2);
    const float em = __builtin_amdgcn_exp2f(m - mf);
    f = em / (lsum * em + __builtin_amdgcn_exp2f(s2 - mf));
  } else {
    f = lsum > 0.f ? 1.f / lsum : 0.f;
  }
  f *= (MODE == 0 ? SC_FOX : (MODE == 1 ? SC_MLA : SC_SWA));
  u16* mp = p.Mix + tokq * 2048 + (MODE == 0 ? 0 : (MODE == 1 ? 512 : 1536)) + head * 64;
#pragma unroll
  for (int d = 0; d < 2; ++d)
#pragma unroll
    for (int g = 0; g < 4; ++g) {
      const int dd = d * 32 + 8 * g + 4 * h;
      const u32x2 gv = gpre[d][g];
      float g0 = silu(bf_lo(gv[0])), g1 = silu(bf_hi(gv[0])), g2 = silu(bf_lo(gv[1])), g3 = silu(bf_hi(gv[1]));
      u32x2 ov = {pk2(o[d][4 * g] * f * g0, o[d][4 * g + 1] * f * g1), pk2(o[d][4 * g + 2] * f * g2, o[d][4 * g + 3] * f * g3)};
      *(u32x2*)(mp + dd) = ov;
    }
}

DI void dsa_job(const Params& p, int b, int tq0, char* lds) {
  const int tid = opaque_tid(), lane = tid & 63, w = tid >> 6;
  float* biasC = (float*)(lds + 143360);
  int* btab = (int*)(lds + 143360 + 1024);
  char* wl = lds + w * 17920;
  float* Pl = (float*)wl;
  int* kid = (int*)(wl + 8192);
  const int tq = tq0 + w;
  const size_t tok = (size_t)b * PP + tq;
  const u16* Hb = p.H + (size_t)b * PP * LDH;
  int kk[4], ku[4];
  {
    u32x2 iv = *(const u32x2*)(p.IDX + tok * 256 + 4 * lane);
    kk[0] = iv[0] & 0xffff; kk[1] = iv[0] >> 16; kk[2] = iv[1] & 0xffff; kk[3] = iv[1] >> 16;
#pragma unroll
    for (int j = 0; j < 4; ++j) ku[j] = (kk[j] == 0xFFFF) ? LEAD : kk[j];
    u32x4 kv4 = {(unsigned)ku[0], (unsigned)ku[1], (unsigned)ku[2], (unsigned)ku[3]};
    ((u32x4*)kid)[lane] = kv4;
  }
  u32x4 gvp[4];
#pragma unroll
  for (int hh = 0; hh < 4; ++hh) gvp[hh] = *(const u32x4*)(p.H + tok * LDH + HG_C + (((lane >> 3) & 1) * 4 + hh) * 64 + (lane & 7) * 8);
  __builtin_amdgcn_wave_barrier();
  const int ksub = lane >> 4, g = (lane >> 3) & 1, dc = lane & 7;
  {
    const int r = lane & 31, h = lane >> 5, pc = lane & 15;
    char* kst = wl + 9216;
    bf16x8 qb[8];
#pragma unroll
    for (int ks = 0; ks < 8; ++ks) {
      u32x4 v = {0u, 0u, 0u, 0u};
      if (r < 8 && (ks >> 2) == (r >> 2)) v = *(const u32x4*)(p.H + tok * LDH + HQ_C + r * 64 + (ks & 3) * 16 + 8 * h);
      qb[ks] = __builtin_bit_cast(bf16x8, v);
    }
    const u16* kbase = Hb + HK_C + pc * 8;
    u32x4 st0[8], st1[8];
#pragma unroll
    for (int s2 = 0; s2 < 8; ++s2) st0[s2] = *(const u32x4*)(kbase + (size_t)kid[4 * s2 + ksub] * LDH);
#pragma unroll
    for (int s2 = 0; s2 < 8; ++s2) st1[s2] = *(const u32x4*)(kbase + (size_t)kid[32 + 4 * s2 + ksub] * LDH);
    auto chunk = [&](int c, u32x4* stc) {
#pragma unroll
      for (int s2 = 0; s2 < 8; ++s2) *(u32x4*)(kst + (4 * s2 + ksub) * 272 + pc * 16) = stc[s2];
      if (c + 2 < 8) {
#pragma unroll
        for (int s2 = 0; s2 < 8; ++s2) stc[s2] = *(const u32x4*)(kbase + (size_t)kid[32 * (c + 2) + 4 * s2 + ksub] * LDH);
      }
      bf16x8 af[8];
#pragma unroll
      for (int ks = 0; ks < 8; ++ks) af[ks] = *(const bf16x8*)(kst + r * 272 + ks * 32 + 16 * h);
      __builtin_amdgcn_sched_barrier(0);
      f32x16 acc0, acc1;
#pragma unroll
      for (int i = 0; i < 16; ++i) { acc0[i] = 0.f; acc1[i] = 0.f; }
#pragma unroll
      for (int ks = 0; ks < 8; ks += 2) { acc0 = MFMA32(af[ks], qb[ks], acc0); acc1 = MFMA32(af[ks + 1], qb[ks + 1], acc1); }
      if (r < 8) {
#pragma unroll
        for (int i = 0; i < 16; ++i) Pl[(32 * c + crow(i, h)) * 8 + r] = acc0[i] + acc1[i];
      }
    };
#pragma unroll 1
    for (int c = 0; c < 8; c += 2) { chunk(c, st0); chunk(c + 1, st1); }
  }
  __builtin_amdgcn_wave_barrier();
  float lg[4][8];
#pragma unroll
  for (int j = 0; j < 4; ++j) {
    const f32x4 v0 = *(const f32x4*)(Pl + (4 * lane + j) * 8), v1 = *(const f32x4*)(Pl + (4 * lane + j) * 8 + 4);
#pragma unroll
    for (int e = 0; e < 4; ++e) { lg[j][e] = v0[e]; lg[j][4 + e] = v1[e]; }
  }
  int bk[4];
#pragma unroll
  for (int j = 0; j < 4; ++j) { int dist = tq - ku[j]; bk[j] = (dist < 128) ? btab[dist & 127] : 31; }
#pragma unroll
  for (int hd = 0; hd < 8; ++hd) {
    float mx = NEGL;
#pragma unroll
    for (int j = 0; j < 4; ++j) {
      float v = lg[j][hd] * 0.125f + biasC[bk[j] * 8 + hd];
      v = (kk[j] == 0xFFFF) ? NEGL : v;
      lg[j][hd] = v;
      mx = fmaxf(mx, v);
    }
    mx = wmax(mx);
    float sm = 0.f;
#pragma unroll
    for (int j = 0; j < 4; ++j) { float e = __expf(lg[j][hd] - mx); lg[j][hd] = e; sm += e; }
    sm = wsum(sm);
    const float inv = 1.f / sm;
#pragma unroll
    for (int j = 0; j < 4; ++j) lg[j][hd] *= inv;
  }
#pragma unroll
  for (int j = 0; j < 4; ++j) {
    f32x4 v0 = {lg[j][0], lg[j][1], lg[j][2], lg[j][3]}, v1 = {lg[j][4], lg[j][5], lg[j][6], lg[j][7]};
    *(f32x4*)(Pl + (4 * lane + j) * 8) = v0;
    *(f32x4*)(Pl + (4 * lane + j) * 8 + 4) = v1;
  }
  __builtin_amdgcn_wave_barrier();
  const u16* vb = Hb + HV_C + g * 64 + dc * 8;
  f32x2 acc2[4][4];
#pragma unroll
  for (int hh = 0; hh < 4; ++hh)
#pragma unroll
    for (int e = 0; e < 4; ++e) { acc2[hh][e][0] = 0.f; acc2[hh][e][1] = 0.f; }
  u32x4 vA[16], vB[16];
  auto pv_load = [&](int grp, u32x4* dst) {
#pragma unroll
    for (int s = 0; s < 16; ++s) dst[s] = *(const u32x4*)(vb + (size_t)kid[4 * (grp * 16 + s) + ksub] * LDH);
  };
  auto pv_fma = [&](int grp, const u32x4* src) {
#pragma unroll
    for (int s = 0; s < 16; ++s) {
      const int slot = 4 * (grp * 16 + s) + ksub;
      const f32x4 pp = *(const f32x4*)(Pl + slot * 8 + g * 4);
      const u32x4 vv = src[s];
#pragma unroll
      for (int hh = 0; hh < 4; ++hh) {
        const f32x2 ph = {pp[hh], pp[hh]};
#pragma unroll
        for (int e = 0; e < 4; ++e) {
          const f32x2 vf2 = {bf_lo(vv[e]), bf_hi(vv[e])};
          acc2[hh][e] += ph * vf2;
        }
      }
    }
  };
  pv_load(0, vA);
  pv_load(1, vB);
  pv_fma(0, vA);
  pv_load(2, vA);
  pv_fma(1, vB);
  pv_load(3, vB);
  pv_fma(2, vA);
  pv_fma(3, vB);
  float acc[4][8];
#pragma unroll
  for (int hh = 0; hh < 4; ++hh)
#pragma unroll
    for (int e = 0; e < 8; ++e) { float v = acc2[hh][e >> 1][e & 1]; v += __shfl_xor(v, 16); v += __shfl_xor(v, 32); acc[hh][e] = v; }
  if (ksub == 0) {
#pragma unroll
    for (int hh = 0; hh < 4; ++hh) {
      const int hd = g * 4 + hh;
      const u32x4 gv = gvp[hh];
      u32x4 ov;
#pragma unroll
      for (int e = 0; e < 4; ++e) ov[e] = pk2(acc[hh][2 * e] * SC_DSA * silu(bf_lo(gv[e])), acc[hh][2 * e + 1] * SC_DSA * silu(bf_hi(gv[e])));
      *(u32x4*)(p.Mix + tok * 2048 + 1024 + hd * 64 + dc * 8) = ov;
    }
  }
}

DI void outproj_tile(const Params& p, int mt, int nt, char* lds) {
  const int tid = opaque_tid(), lane = tid & 63, w = tid >> 6, r = lane & 31, h = lane >> 5;
  const int wm = w & 3, wn = w >> 2;
  const int m0 = mt * 256;
  gemm_tile<true>(p.Mix + (size_t)m0 * 2048, 2048, p.Wt_out + (size_t)nt * 128 * 2048, 2048, 2048, lds, [&](int mi, int ni, const f32x16& a) {
    const int tok = m0 + wm * 64 + mi * 32 + r;
    float* rp = p.R + (size_t)tok * DM + nt * 128 + wn * 64 + ni * 32;
#pragma unroll
    for (int g = 0; g < 4; ++g) {
      f32x4 v = *(const f32x4*)(rp + 8 * g + 4 * h);
#pragma unroll
      for (int e = 0; e < 4; ++e) v[e] = ALPHA * v[e] + a[4 * g + e];
      *(f32x4*)(rp + 8 * g + 4 * h) = v;
    }
  });
}

DI void ln_rows(const Params& p, int l) {
  const int tid = opaque_tid(), lane = tid & 63, w = tid >> 6;
  const float* gg = l < 0 ? p.ln0_g : p.ln_g + l * DM;
  const float* bb = l < 0 ? p.ln0_b : p.ln_b + l * DM;
  for (int row = blockIdx.x * 8 + w; row < MT; row += gridDim.x * 8) {
    const int b = row / PP, t = row - b * PP;
    f32x4 v[4];
    if (l < 0) {
      const float* src = nullptr;
      if (t >= 128 && t < PV) src = p.x + ((size_t)b * SEQ + (t - 128)) * DM;
      else if (t >= LEAD && t < 128) src = p.meta + (size_t)(t - LEAD) * DM;
#pragma unroll
      for (int j = 0; j < 4; ++j) {
        if (src) v[j] = *(const f32x4*)(src + lane * 4 + 256 * j);
        else { v[j][0] = 0.f; v[j][1] = 0.f; v[j][2] = 0.f; v[j][3] = 0.f; }
      }
    } else {
#pragma unroll
      for (int j = 0; j < 4; ++j) v[j] = *(const f32x4*)(p.R + (size_t)row * DM + lane * 4 + 256 * j);
    }
    float s = 0.f;
#pragma unroll
    for (int j = 0; j < 4; ++j) s += v[j][0] + v[j][1] + v[j][2] + v[j][3];
    const float mu = wsum(s) * (1.f / DM);
    float q = 0.f;
#pragma unroll
    for (int j = 0; j < 4; ++j)
#pragma unroll
      for (int e = 0; e < 4; ++e) { float d = v[j][e] - mu; q += d * d; }
    const float rstd = rsqrtf(wsum(q) * (1.f / DM) + 1e-5f);
#pragma unroll
    for (int j = 0; j < 4; ++j) {
      const int c = lane * 4 + 256 * j;
      f32x4 g4 = *(const f32x4*)(gg + c), b4 = *(const f32x4*)(bb + c);
      f32x4 y;
#pragma unroll
      for (int e = 0; e < 4; ++e) y[e] = (v[j][e] - mu) * rstd * g4[e] + b4[e];
      if (l == 3) {
        if (t >= 128 && t < PV) *(f32x4*)(p.out + ((size_t)b * SEQ + (t - 128)) * DM + c) = y;
      } else {
        *(f32x4*)(p.R + (size_t)row * DM + c) = y;
        u32x2 yb = {pk2(y[0], y[1]), pk2(y[2], y[3])};
        *(u32x2*)(p.Xb + (size_t)row * DM + c) = yb;
      }
    }
  }
}

DI int map_in(int n) {
  if (n < 512) return n;
  if (n < 1024) return n;
  if (n < 1536) return 1544 + (n - 1024);
  if (n < 1792) return 2056 + (n - 1536);
  if (n < 1920) return 2312 + (n - 1792);
  if (n < 2432) return 2472 + (n - 1920);
  if (n < 2944) return 2984 + (n - 2432);
  if (n < 3072) return 3496 + (n - 2944);
  if (n < 3200) return 3624 + (n - 3072);
  if (n < 3712) return 3752 + (n - 3200);
  if (n < 4224) return 4336 + (n - 3712);
  if (n < 4736) return 4848 + (n - 4224);
  if (n < 4864) return 5360 + (n - 4736);
  if (n < 5376) return 5616 + (n - 4864);
  if (n < 5408) return 2440 + (n - 5376);
  if (n < 5472) return 4264 + (n - 5408);
  if (n < 5480) return 1536 + (n - 5472);
  if (n < 5488) return 4328 + (n - 5480);
  if (n < 5504) return -1;
  if (n < 6016) return 1024 + (n - 5504);
  return 5488 + (n - 6016);
}
DI void conv_weights(const Params& p, int l, char* lds) {
  const int tid = opaque_tid();
  float* tile = (float*)lds;
  for (int tI = blockIdx.x; tI < 2128; tI += gridDim.x) {
    const float* src; const float* ksc = nullptr; u16* dst; int ldsrc, K, kind, kt, ntile;
    if (tI < 1536) { kind = 0; kt = tI / 96; ntile = tI % 96; src = p.w_in + (size_t)l * DM * D_IN; ldsrc = D_IN; K = DM; dst = p.Wt_in; }
    else if (tI < 2048) { int u = tI - 1536; kind = 1; kt = u / 16; ntile = u % 16; src = p.w_out + (size_t)l * 2048 * DM; ldsrc = DM; K = 2048; dst = p.Wt_out; }
    else if (tI < 2096) { int u = tI - 2048; kind = 2; kt = u / 12; ntile = u % 12; src = p.w_uq + (size_t)l * 256 * 768; ldsrc = 768; K = 256; dst = p.Wt_uq; ksc = p.gq + l * 256; }
    else { int u = tI - 2096; kind = 3; kt = u / 16; ntile = u % 16; src = p.w_ukv + (size_t)l * 128 * 1024; ldsrc = 1024; K = 128; dst = p.Wt_ukv; ksc = p.gkv + l * 128; }
    const int k0 = kt * 64, n0 = ntile * 64;
    {
      const int nn = tid & 63;
      const int n = n0 + nn;
      int sc;
      if (kind == 0) sc = map_in(n);
      else if (kind == 3) sc = (n < 512) ? ((n >> 6) * 128 + (n & 63)) : (((n - 512) >> 6) * 128 + 64 + (n & 63));
      else sc = n;
#pragma unroll
      for (int j = 0; j < 8; ++j) {
        const int kk = (tid >> 6) + 8 * j;
        float v = 0.f;
        if (sc >= 0) v = src[(size_t)(k0 + kk) * ldsrc + sc];
        if (ksc) v *= ksc[k0 + kk];
        tile[nn * 65 + kk] = v;
      }
    }
    __syncthreads();
    {
      const int nn = tid >> 3, kc = (tid & 7) * 8;
      const float* tp = tile + nn * 65 + kc;
      u32x4 ov = {pk2(tp[0], tp[1]), pk2(tp[2], tp[3]), pk2(tp[4], tp[5]), pk2(tp[6], tp[7])};
      *(u32x4*)(dst + (size_t)(n0 + nn) * K + k0 + kc) = ov;
    }
    __syncthreads();
  }
}
DI void rope_table(const Params& p) {
  const int gt = blockIdx.x * NTHREADS + threadIdx.x;
  for (int i = gt; i < PP * 16; i += gridDim.x * NTHREADS) {
    const int t = i >> 4, c = i & 15;
    const float freq = powf(10000.f, -(float)c / 16.f);
    const float ang = (float)(t - LEAD) * freq;
    float sn, cs;
    sincosf(ang, &sn, &cs);
    p.ROPE[(size_t)t * 32 + c] = cs;
    p.ROPE[(size_t)t * 32 + 16 + c] = sn;
  }
}


#define XB_TMO      128
#define XB_XCNT(j)  (256  + 64 * (j))
#define XB_XSUB(j)  (1280 + 64 * (j))
#define XB_XGEN(j)  (2304 + 64 * (j))
#define XB_TOP      3328
#define XB_TOPGEN   3392
#define XCD_BAR_WORDS 3456
#define XB_SPIN_CAP (1u << 18)
DI unsigned xb_ld(unsigned* p) { return __hip_atomic_load(p, __ATOMIC_RELAXED, __HIP_MEMORY_SCOPE_AGENT); }
DI unsigned xb_add(unsigned* p, unsigned v) { return __hip_atomic_fetch_add(p, v, __ATOMIC_RELAXED, __HIP_MEMORY_SCOPE_AGENT); }
DI unsigned xb_xcc_id() { return (unsigned)__builtin_amdgcn_s_getreg((3 << 11) | 20) & 0xFu; }
#define XB_SPIN(cond, bar) do { unsigned _sp = 0; while (cond) { __builtin_amdgcn_s_sleep(1); \
    if ((++_sp & 255u) == 0u) { if (xb_ld(&(bar)[XB_TMO])) break; if (_sp > XB_SPIN_CAP) { atomicAdd(&(bar)[XB_TMO], 1u); break; } } } } while (0)
struct XcdBarrier { unsigned* bar; unsigned x; volatile unsigned* st; };
DI XcdBarrier xcd_barrier_post(unsigned* bar, volatile unsigned* st) {
  XcdBarrier b; b.bar = bar; b.x = xb_xcc_id(); b.st = st;
  if (threadIdx.x == 0) (void)xb_add(&bar[XB_XCNT(b.x)], 1u);
  return b;
}
DI void xcd_barrier_complete(unsigned* bar, unsigned x, unsigned& nloc, unsigned& nx) {
  const unsigned G = gridDim.x * gridDim.y * gridDim.z;
  unsigned sum, cnt, mine, sp = 0u;
  for (;;) {
    sum = 0u; cnt = 0u; mine = 0u;
#pragma unroll
    for (unsigned j = 0; j < 16; ++j) { const unsigned c = xb_ld(&bar[XB_XCNT(j)]); sum += c; cnt += (c > 0u) ? 1u : 0u; mine = (j == x) ? c : mine; }
    if (sum == G) break;
    __builtin_amdgcn_s_sleep(1);
    if ((++sp & 255u) == 0u) { if (xb_ld(&bar[XB_TMO])) break; if (sp > XB_SPIN_CAP) { atomicAdd(&bar[XB_TMO], 1u); break; } }
  }
  nloc = mine > 0u ? mine : 1u; nx = cnt > 0u ? cnt : 1u;
}
DI void xcd_barrier(const XcdBarrier& b) {
  asm volatile("s_waitcnt vmcnt(0)" ::: "memory");
  __syncthreads();
  if (threadIdx.x == 0) {
    unsigned* bar = b.bar;
    __builtin_amdgcn_s_waitcnt(0);
    unsigned nloc = b.st[0], nx = b.st[1];
    if (nloc == 0u) { xcd_barrier_complete(bar, b.x, nloc, nx); b.st[0] = nloc; b.st[1] = nx; }
    const unsigned old = xb_add(&bar[XB_XSUB(b.x)], 1u);
    const unsigned gen = old / nloc;
    if (old + 1u == (gen + 1u) * nloc) {
      __builtin_amdgcn_fence(__ATOMIC_RELEASE, "agent");
      asm volatile("s_waitcnt vmcnt(0)" ::: "memory");
      const unsigned og = xb_add(&bar[XB_TOP], 1u);
      const unsigned tg = og / nx;
      if (og + 1u == (tg + 1u) * nx) xb_add(&bar[XB_TOPGEN], 1u);
      else XB_SPIN(xb_ld(&bar[XB_TOPGEN]) == tg, bar);
      __builtin_amdgcn_fence(__ATOMIC_ACQUIRE, "agent");
      xb_add(&bar[XB_XGEN(b.x)], 1u);
      asm volatile("s_waitcnt vmcnt(0)" ::: "memory");
    } else {
      XB_SPIN(xb_ld(&bar[XB_XGEN(b.x)]) == gen, bar);
      __builtin_amdgcn_fence(__ATOMIC_ACQUIRE, "agent");
      asm volatile("s_waitcnt vmcnt(0)" ::: "memory");
    }
  }
  __syncthreads();
}

__global__ void __launch_bounds__(NTHREADS) mega(Params p) {
  extern __shared__ __attribute__((aligned(16))) char lds[];
  cg::grid_group grid = cg::this_grid();
  ln_rows(p, -1);
  conv_weights(p, 0, lds);
  rope_table(p);
  if (blockIdx.x == 0) {
    if (threadIdx.x < 256) p.ctr[threadIdx.x] = 0u;
    for (int i = threadIdx.x; i < XCD_BAR_WORDS; i += NTHREADS) p.bar[i] = 0u;
  }
  volatile unsigned* xst = (volatile unsigned*)(lds + LDS_JOB + 16);
  if (threadIdx.x == 0) { xst[0] = 0u; xst[1] = 0u; }
  grid.sync();
  const XcdBarrier xb = xcd_barrier_post(p.bar, xst);
  for (int l = 0; l < 4; ++l) {
    for (int rep = 0; rep < REP_P1; ++rep) {
      for (int j = blockIdx.x; j < 66 * 48; j += gridDim.x) inproj_tile(p, l, j / 48, j % 48, lds);
      xcd_barrier(xb);
    }
    for (int rep = 0; rep < REP_P2; ++rep) {
      constexpr int NTK = 2 * 2052, NUP = 66 * 14, NJ = NTK + NUP + 16;
      int pending = 0, par = 0;
      if (threadIdx.x == 0) pending = (int)atomicAdd(p.ctr + l * 2 + 8 * rep, 1u);
      for (;;) {
        const int j = next_job(p.ctr + l * 2 + 8 * rep, lds, pending, NJ, par);
        if (j >= NJ) break;
        if (j < 16) {
          cumsum_job(p, j, lds);
        } else if (j < 16 + NTK) {
          const int jj = j - 16;
          const int b = jj & 1, q = 2051 - (jj >> 1);
          topk_job(p, b, LEAD + 4 * q, lds);
        } else {
          const int u = j - 16 - NTK;
          upproj_tile(p, u / 14, u % 14, lds);
        }
      }
      xcd_barrier(xb);
    }
    for (int rep = 0; rep < REP_P3; ++rep) {
      constexpr int ND = 1056, NS = 528, NC = 2 * 1026, NJ = ND + NS + NC;
      {
        float* biasC = (float*)(lds + 143360);
        int* btab = (int*)(lds + 143360 + 1024);
        if (threadIdx.x < 256) biasC[threadIdx.x] = p.rel_bias[(threadIdx.x >> 3) * 16 + (threadIdx.x & 7)];
        if (threadIdx.x < 128) btab[threadIdx.x] = t5_bucket(threadIdx.x);
      }
      int pending = 0, par = 0;
      if (threadIdx.x == 0) pending = (int)atomicAdd(p.ctr + l * 2 + 1 + 8 * rep, 1u);
      for (;;) {
        const int j = next_job(p.ctr + l * 2 + 1 + 8 * rep, lds, pending, NJ, par);
        if (j >= NJ) break;
        if (j < ND) {
          const int qu = 32 - (j >> 5), rem = j & 31, kind = rem >> 4, b = (rem >> 3) & 1, head = rem & 7;
          if (kind == 0) attn_unit<64, 0>(p, l, b, head, qu, lds);
          else attn_unit<96, 1>(p, l, b, head, qu, lds);
        } else if (j < ND + NS) {
          const int u = j - ND;
          attn_unit<64, 2>(p, l, (u >> 3) & 1, u & 7, u >> 4, lds);
        } else {
          const int u = j - ND - NS;
          dsa_job(p, u & 1, LEAD + 8 * (u >> 1), lds);
        }
      }
      xcd_barrier(xb);
    }
    for (int j = blockIdx.x; j < 66 * 8; j += gridDim.x) {
      const int x = j & 7, a = j >> 3;
      outproj_tile(p, 2 * (a >> 1) + (x >> 2), 2 * (x & 3) + (a & 1), lds);
    }
    xcd_barrier(xb);
    ln_rows(p, l);
    if (l < 3) { conv_weights(p, l + 1, lds); xcd_barrier(xb); }
  }
}

extern "C" void kernel_launch(void* const* d_in, const int* in_sizes, int n_in, void* d_out, int out_size, void* d_ws, size_t ws_size,
                              hipStream_t stream) {
  static int grid = 0;
  if (grid == 0) {
    int dev = 0, cus = 0, per_cu = 0;
    hipGetDevice(&dev);
    hipDeviceGetAttribute(&cus, hipDeviceAttributeMultiprocessorCount, dev);
    if (hipFuncSetAttribute((const void*)mega, hipFuncAttributeMaxDynamicSharedMemorySize, LDS_BYTES) != hipSuccess) { fprintf(stderr, "hipFuncSetAttribute failed\n"); grid = -1; return; }
    hipOccupancyMaxActiveBlocksPerMultiprocessor(&per_cu, (const void*)mega, NTHREADS, LDS_BYTES);
    if (per_cu < 1) { fprintf(stderr, "occupancy query: %d\n", per_cu); grid = -1; return; }
    grid = cus * per_cu;
  }
  if (grid < 0) return;
  size_t off = 0;
  auto take = [&](size_t bytes) { size_t o = off; off += (bytes + 255) & ~(size_t)255; return (char*)d_ws + o; };
  Params p{};
  p.x = (const float*)d_in[0]; p.meta = (const float*)d_in[1]; p.ln0_g = (const float*)d_in[2]; p.ln0_b = (const float*)d_in[3];
  p.rel_bias = (const float*)d_in[4]; p.w_in = (const float*)d_in[5]; p.b_f = (const float*)d_in[6]; p.gq = (const float*)d_in[7];
  p.gkv = (const float*)d_in[8]; p.w_uq = (const float*)d_in[9]; p.w_ukv = (const float*)d_in[10]; p.sinks = (const float*)d_in[11];
  p.w_out = (const float*)d_in[12]; p.ln_g = (const float*)d_in[13]; p.ln_b = (const float*)d_in[14];
  p.out = (float*)d_out;
  p.ctr = (unsigned*)take(1024);
  p.bar = (unsigned*)take(XCD_BAR_WORDS * 4);
  p.Wt_in = (u16*)take((size_t)NIN * DM * 2);
  p.Wt_out = (u16*)take((size_t)DM * 2048 * 2);
  p.Wt_uq = (u16*)take((size_t)768 * 256 * 2);
  p.Wt_ukv = (u16*)take((size_t)1024 * 128 * 2);
  p.H = (u16*)take((size_t)MT * LDH * 2);
  p.Mix = (u16*)take((size_t)MT * 2048 * 2);
  p.Xb = p.Mix;
  p.VtA = (u16*)take((size_t)NB * 512 * PP * 2);
  p.VtD = (u16*)take((size_t)NB * 128 * PP * 2);
  p.R = (float*)take((size_t)MT * DM * 4);
  p.IDX = (u16*)take((size_t)MT * 256 * 2);
  p.IK = (u16*)take((size_t)MT * 64 * 2);
  p.Kpe = (u16*)take((size_t)MT * 32 * 2);
  p.IW = (float*)take((size_t)MT * 8 * 4);
  p.LOGF = (float*)take((size_t)NB * 8 * PP * 4);
  p.CUM = (float*)take((size_t)NB * 8 * PP * 4);
  p.ROPE = (float*)take((size_t)PP * 32 * 4);
  if (off > ws_size) { fprintf(stderr, "workspace too small: need %zu have %zu\n", off, ws_size); return; }
  {
    char* ob = (char*)d_out;
    p.Qm = (u16*)ob; ob += (size_t)MT * 768 * 2;
    p.Km = (u16*)ob; ob += (size_t)MT * 512 * 2;
    p.VtB = (u16*)ob; ob += (size_t)NB * 512 * PP * 2;
    if ((size_t)(ob - (char*)d_out) > (size_t)out_size * 4) { fprintf(stderr, "d_out too small for scratch\n"); return; }
  }
  hipMemsetAsync(p.ctr, 0, 1024 + XCD_BAR_WORDS * 4, stream);
  void* args[] = {&p};
  hipError_t e = hipLaunchCooperativeKernel((const void*)mega, dim3(grid), dim3(NTHREADS), args, LDS_BYTES, stream);
  if (e != hipSuccess) fprintf(stderr, "cooperative launch failed: %s (grid %d)\n", hipGetErrorString(e), grid);
}
```

```cpp
#include <hip/hip_runtime.h>
#include <hip/hip_cooperative_groups.h>
#include <cstdio>
namespace cg = cooperative_groups;

#define DI __device__ __forceinline__
typedef __attribute__((ext_vector_type(8))) short bf16x8;
typedef __attribute__((ext_vector_type(16))) float f32x16;
typedef __attribute__((ext_vector_type(4))) float f32x4;
typedef __attribute__((ext_vector_type(2))) float f32x2;
typedef __attribute__((ext_vector_type(2))) __bf16 bf2_t;
typedef __attribute__((ext_vector_type(4))) unsigned u32x4;
typedef __attribute__((ext_vector_type(2))) unsigned u32x2;
typedef unsigned short u16;
#define MFMA32(a, b, c) __builtin_amdgcn_mfma_f32_32x32x16_bf16((a), (b), (c), 0, 0, 0)

constexpr int NB = 2, PP = 8448, PV = 8320, LEAD = 112, DM = 1024, MT = NB * PP, SEQ = 8192;
constexpr int LDH = 5376, NIN = 6144;
constexpr int HQ_A = 0, HK_A = 512, HG_A = 1024, HCQ_B = 1536, HCKV_B = 1792, HG_B = 1920, HQ_C = 2432, HK_C = 2944, HV_C = 3072,
              HIQ_C = 3200, HG_C = 3712, HQ_D = 4224, HK_D = 4736, HG_D = 4864;
constexpr int D_IN = 6128;
constexpr float LOG2E = 1.4426950408889634f;
constexpr float NEGL = -1e30f;
constexpr float ALPHA = 1.681792830507429f;
constexpr int LDS_JOB = 147456;
constexpr int LDS_BYTES = LDS_JOB + 64;
constexpr int GEMM_STAGE = 55296;
constexpr int NTHREADS = 512;
#define REP_P1 1
#define REP_P2 1
#define REP_P3 1
#define SC_FOX 1.0f
#define SC_MLA 1.0f
#define SC_SWA 1.0f
#define SC_DSA 1.0f

struct Params {
  const float *x, *meta, *ln0_g, *ln0_b, *rel_bias, *w_in, *b_f, *gq, *gkv, *w_uq, *w_ukv, *sinks, *w_out, *ln_g, *ln_b;
  float* out;
  u16 *Wt_in, *Wt_out, *Wt_uq, *Wt_ukv;
  u16 *H, *Xb, *Mix, *VtA, *VtD, *VtB, *Qm, *Km, *Kpe, *IK, *IDX;
  float *R, *LOGF, *CUM, *IW, *ROPE;
  unsigned* ctr;
  unsigned* bar;
};

DI unsigned pk2(float a, float b) { f32x2 v = {a, b}; return __builtin_bit_cast(unsigned, __builtin_convertvector(v, bf2_t)); }
DI float bf_lo(unsigned u) { return __uint_as_float(u << 16); }
DI float bf_hi(unsigned u) { return __uint_as_float(u & 0xffff0000u); }
DI int opaque_tid() { int t = threadIdx.x; asm volatile("" : "+v"(t)); return t; }
DI int crow(int i, int h) { return (i & 3) + 8 * (i >> 2) + 4 * h; }
template <int CTRL> DI float dpp_mov(float v) { return __int_as_float(__builtin_amdgcn_mov_dpp(__float_as_int(v), CTRL, 0xF, 0xF, true)); }
DI float wsum(float v) {
  v += dpp_mov<0xB1>(v); v += dpp_mov<0x4E>(v); v += dpp_mov<0x141>(v); v += dpp_mov<0x140>(v);
  u32x2 r = __builtin_amdgcn_permlane16_swap(__float_as_uint(v), __float_as_uint(v), false, false);
  v = __uint_as_float(r[0]) + __uint_as_float(r[1]);
  r = __builtin_amdgcn_permlane32_swap(__float_as_uint(v), __float_as_uint(v), false, false);
  return __uint_as_float(r[0]) + __uint_as_float(r[1]);
}
DI float wmax(float v) {
  v = fmaxf(v, dpp_mov<0xB1>(v)); v = fmaxf(v, dpp_mov<0x4E>(v)); v = fmaxf(v, dpp_mov<0x141>(v)); v = fmaxf(v, dpp_mov<0x140>(v));
  u32x2 r = __builtin_amdgcn_permlane16_swap(__float_as_uint(v), __float_as_uint(v), false, false);
  v = fmaxf(__uint_as_float(r[0]), __uint_as_float(r[1]));
  r = __builtin_amdgcn_permlane32_swap(__float_as_uint(v), __float_as_uint(v), false, false);
  return fmaxf(__uint_as_float(r[0]), __uint_as_float(r[1]));
}
DI int wsumi(int v) { for (int o = 32; o > 0; o >>= 1) v += __shfl_xor(v, o); return v; }
DI float silu(float g) { return g / (1.f + __expf(-g)); }
DI float dot2(unsigned a, unsigned b, float c) { return __builtin_amdgcn_fdot2_f32_bf16(__builtin_bit_cast(bf2_t, a), __builtin_bit_cast(bf2_t, b), c, false); }
template <int CTRL> DI float dpp_add(float v) { return v + __int_as_float(__builtin_amdgcn_mov_dpp(__float_as_int(v), CTRL, 0xF, 0xF, true)); }
DI int t5_bucket(int n) {
  if (n < 16) return n;
  int lg = 16 + (int)(logf((float)n / 16.f) / logf(8.f) * 16.f);
  return lg < 31 ? lg : 31;
}

DI int next_job(unsigned* ctr, char* lds, int& pending, int njobs, int& par) {
  int* sj = (int*)(lds + LDS_JOB);
  if (threadIdx.x == 0) sj[par] = pending;
  __syncthreads();
  const int j = sj[par];
  par ^= 1;
  if (threadIdx.x == 0 && j < njobs) pending = (int)atomicAdd(ctr, 1u);
  return j;
}

template <bool SWAP, class Epi>
DI void gemm_tile(const u16* __restrict__ A, int lda, const u16* __restrict__ Bw, int ldb, int K, char* lds, Epi epi) {
  const int tid = opaque_tid(), lane = tid & 63, w = tid >> 6, r = lane & 31, h = lane >> 5;
  const int wm = w & 3, wn = w >> 2;
  f32x16 acc[2][2];
#pragma unroll
  for (int a = 0; a < 2; ++a)
#pragma unroll
    for (int b = 0; b < 2; ++b)
#pragma unroll
      for (int i = 0; i < 16; ++i) acc[a][b][i] = 0.f;
  const int lrow = tid >> 3, lkc = tid & 7;
  u32x4 ra0[4], rb0[2], ra1[4], rb1[2];
  const u16* ap = A + (size_t)lrow * lda + lkc * 8;
  const u16* bp = Bw + (size_t)lrow * ldb + lkc * 8;
  const int nk = K >> 6;
  auto gload = [&](int kt, u32x4* ra, u32x4* rb) {
#pragma unroll
    for (int j = 0; j < 4; ++j) ra[j] = *(const u32x4*)(ap + (size_t)(64 * j) * lda + kt * 64);
#pragma unroll
    for (int j = 0; j < 2; ++j) rb[j] = *(const u32x4*)(bp + (size_t)(64 * j) * ldb + kt * 64);
  };
  auto lstore = [&](int st, const u32x4* ra, const u32x4* rb) {
    char* base = lds + st * GEMM_STAGE;
#pragma unroll
    for (int j = 0; j < 4; ++j) *(u32x4*)(base + ((lrow + 64 * j) * 72 + lkc * 8) * 2) = ra[j];
#pragma unroll
    for (int j = 0; j < 2; ++j) *(u32x4*)(base + 36864 + ((lrow + 64 * j) * 72 + lkc * 8) * 2) = rb[j];
  };
  auto compute = [&](int st) {
    const char* as = lds + st * GEMM_STAGE;
    const char* bs = as + 36864;
#pragma unroll
    for (int ks = 0; ks < 4; ++ks) {
      bf16x8 af[2], bfr[2];
#pragma unroll
      for (int mi = 0; mi < 2; ++mi) af[mi] = *(const bf16x8*)(as + ((wm * 64 + mi * 32 + r) * 72 + ks * 16 + 8 * h) * 2);
#pragma unroll
      for (int ni = 0; ni < 2; ++ni) bfr[ni] = *(const bf16x8*)(bs + ((wn * 64 + ni * 32 + r) * 72 + ks * 16 + 8 * h) * 2);
#pragma unroll
      for (int mi = 0; mi < 2; ++mi)
#pragma unroll
        for (int ni = 0; ni < 2; ++ni) {
          if (SWAP) acc[mi][ni] = MFMA32(bfr[ni], af[mi], acc[mi][ni]);
          else acc[mi][ni] = MFMA32(af[mi], bfr[ni], acc[mi][ni]);
        }
    }
  };
  gload(0, ra0, rb0);
  lstore(0, ra0, rb0);
  gload(1, ra1, rb1);
  __syncthreads();
  for (int kt = 0; kt < nk; kt += 2) {
    if (kt + 2 < nk) gload(kt + 2, ra0, rb0);
    compute(0);
    lstore(1, ra1, rb1);
    __syncthreads();
    if (kt + 3 < nk) gload(kt + 3, ra1, rb1);
    compute(1);
    if (kt + 2 < nk) lstore(0, ra0, rb0);
    __syncthreads();
  }
#pragma unroll
  for (int mi = 0; mi < 2; ++mi)
#pragma unroll
    for (int ni = 0; ni < 2; ++ni) epi(mi, ni, acc[mi][ni]);
}

DI void store_rowmajor(u16* dst, const f32x16& a, int h, float sc) {
#pragma unroll
  for (int kp = 0; kp < 2; ++kp) {
    const int g = 2 * kp;
    unsigned ax = pk2(a[4 * g] * sc, a[4 * g + 1] * sc), ay = pk2(a[4 * g + 2] * sc, a[4 * g + 3] * sc);
    unsigned bx = pk2(a[4 * g + 4] * sc, a[4 * g + 5] * sc), by = pk2(a[4 * g + 6] * sc, a[4 * g + 7] * sc);
    const u32x2 rx = __builtin_amdgcn_permlane32_swap(ax, bx, false, false);
    const u32x2 ry = __builtin_amdgcn_permlane32_swap(ay, by, false, false);
    const u32x4 v = {rx[0], ry[0], rx[1], ry[1]};
    *(u32x4*)(dst + 8 * (g + h)) = v;
  }
}
DI void store_rope(u16* dst, const f32x16& a, int h, float sc, const float* rp) {
#pragma unroll
  for (int g = 0; g < 2; ++g) {
    f32x4 cs = *(const f32x4*)(rp + 8 * g + 4 * h);
    f32x4 sn = *(const f32x4*)(rp + 16 + 8 * g + 4 * h);
    float o1[4], o2[4];
#pragma unroll
    for (int e = 0; e < 4; ++e) {
      float x1 = a[4 * g + e] * sc, x2 = a[8 + 4 * g + e] * sc;
      o1[e] = x1 * cs[e] - x2 * sn[e];
      o2[e] = x1 * sn[e] + x2 * cs[e];
    }
    u32x2 v1 = {pk2(o1[0], o1[1]), pk2(o1[2], o1[3])};
    u32x2 v2 = {pk2(o2[0], o2[1]), pk2(o2[2], o2[3])};
    *(u32x2*)(dst + 8 * g + 4 * h) = v1;
    *(u32x2*)(dst + 16 + 8 * g + 4 * h) = v2;
  }
}
DI void store_transposed(u16* dst, const f32x16& a, int h, const float* rs  ) {
#pragma unroll
  for (int g = 0; g < 4; ++g) {
    float s0 = 1.f, s1 = 1.f, s2 = 1.f, s3 = 1.f;
    if (rs) { f32x4 sv = *(const f32x4*)(rs + 8 * g + 4 * h); s0 = sv[0]; s1 = sv[1]; s2 = sv[2]; s3 = sv[3]; }
    u32x2 v = {pk2(a[4 * g] * s0, a[4 * g + 1] * s1), pk2(a[4 * g + 2] * s2, a[4 * g + 3] * s3)};
    *(u32x2*)(dst + 8 * g + 4 * h) = v;
  }
}

DI void inproj_tile(const Params& p, int l, int mt, int nt, char* lds) {
  const int tid = opaque_tid(), lane = tid & 63, w = tid >> 6, r = lane & 31, h = lane >> 5;
  const int wm = w & 3, wn = w >> 2;
  const int m0 = mt * 256;
  const u16* A = p.Xb + (size_t)m0 * DM;
  const u16* Bw = p.Wt_in + (size_t)nt * 128 * DM;
  if (nt < 42) {
    float ssq = 0.f;
    gemm_tile<true>(A, DM, Bw, DM, DM, lds, [&](int mi, int ni, const f32x16& a) {
      const int tok = m0 + wm * 64 + mi * 32 + r;
      store_rowmajor(p.H + (size_t)tok * LDH + nt * 128 + wn * 64 + ni * 32, a, h, 1.f);
      if (nt >= 4 && nt < 8) {
        if (ni == 0) ssq = 0.f;
#pragma unroll
        for (int i = 0; i < 16; ++i) ssq += a[i] * a[i];
        if (ni == 1) {
          float tot = ssq + __shfl_xor(ssq, 32);
          tot = wmax(tot);
          if (lane == 0) atomicMax(p.ctr + 64 + l * 16 + (m0 / PP) * 8 + (nt - 4) * 2 + wn, __float_as_uint(sqrtf(tot) * 1.01f));
        }
      }
    });
  } else if (nt == 42) {
    gemm_tile<true>(A, DM, Bw, DM, DM, lds, [&](int mi, int ni, const f32x16& a) {
      const int tok = m0 + wm * 64 + mi * 32 + r;
      const int b = tok / PP, t = tok - b * PP;
      const int sub = wn * 2 + ni;
      if (sub == 0) {
        store_rope(p.Kpe + (size_t)tok * 32, a, h, 1.f, p.ROPE + (size_t)t * 32);
      } else if (sub == 1) {
        store_rowmajor(p.IK + (size_t)tok * 64, a, h, 1.f);
      } else if (sub == 2) {
        store_rowmajor(p.IK + (size_t)tok * 64 + 32, a, h, 1.f);
      } else {
#pragma unroll
        for (int e = 0; e < 4; ++e) {
          const int hd = e + 4 * h;
          float xv = a[e] + p.b_f[l * 8 + hd];
          float lf = fminf(xv, 0.f) - log1pf(expf(-fabsf(xv)));
          p.LOGF[(size_t)(b * 8 + hd) * PP + t] = lf;
          p.IW[(size_t)tok * 8 + hd] = a[4 + e];
        }
      }
    });
  } else {
    u16* vt; int nv, c0;
    if (nt < 47) { vt = p.VtA; nv = 512; c0 = (nt - 43) * 128; } else { vt = p.VtD; nv = 128; c0 = 0; }
    gemm_tile<false>(A, DM, Bw, DM, DM, lds, [&](int mi, int ni, const f32x16& a) {
      const int b = m0 / PP, t0 = m0 - b * PP + wm * 64 + mi * 32;
      const int col = c0 + wn * 64 + ni * 32 + r;
      store_transposed(vt + ((size_t)b * nv + col) * PP + t0, a, h, nullptr);
    });
  }
}

DI void upproj_tile(const Params& p, int mt, int nt14, char* lds) {
  const int tid = opaque_tid(), lane = tid & 63, w = tid >> 6, r = lane & 31, h = lane >> 5;
  const int wm = w & 3, wn = w >> 2;
  const int m0 = mt * 256;
  float* rs = (float*)(lds + 2 * GEMM_STAGE);
  const bool isq = nt14 < 6;
  {
    const int row = tid >> 1, half = tid & 1;
    const int kw = isq ? 128 : 64;
    const u16* src = p.H + (size_t)(m0 + row) * LDH + (isq ? HCQ_B : HCKV_B) + half * kw;
    float ss = 0.f;
    u32x4 rv[16];
#pragma unroll
    for (int c = 0; c < 8; ++c) rv[c] = *(const u32x4*)(src + c * 8);
    if (isq) {
#pragma unroll
      for (int c = 8; c < 16; ++c) rv[c] = *(const u32x4*)(src + c * 8);
    } else {
#pragma unroll
      for (int c = 8; c < 16; ++c) { rv[c][0] = 0u; rv[c][1] = 0u; rv[c][2] = 0u; rv[c][3] = 0u; }
    }
#pragma unroll
    for (int c = 0; c < 16; ++c)
#pragma unroll
      for (int e = 0; e < 4; ++e) { float a = bf_lo(rv[c][e]), b2 = bf_hi(rv[c][e]); ss += a * a + b2 * b2; }
    ss += __shfl_xor(ss, 1);
    if (half == 0) rs[row] = rsqrtf(ss / (isq ? 256.f : 128.f) + 1e-6f);
  }
  __syncthreads();
  if (isq) {
    const int nt = nt14;
    gemm_tile<true>(p.H + (size_t)m0 * LDH + HCQ_B, LDH, p.Wt_uq + (size_t)nt * 128 * 256, 256, 256, lds, [&](int mi, int ni, const f32x16& a) {
      const int lr = wm * 64 + mi * 32 + r;
      const int tok = m0 + lr;
      const int t = tok % PP;
      const int j32 = nt * 4 + wn * 2 + ni;
      const float sc = rs[lr];
      u16* dst = p.Qm + (size_t)tok * 768 + j32 * 32;
      if (j32 % 3 == 2) store_rope(dst, a, h, sc, p.ROPE + (size_t)t * 32);
      else store_rowmajor(dst, a, h, sc);
    });
  } else {
    const int nt = nt14 - 6;
    const u16* A = p.H + (size_t)m0 * LDH + HCKV_B;
    const u16* Bw = p.Wt_ukv + (size_t)nt * 128 * 128;
    if (nt < 4) {
      gemm_tile<true>(A, LDH, Bw, 128, 128, lds, [&](int mi, int ni, const f32x16& a) {
        const int lr = wm * 64 + mi * 32 + r;
        store_rowmajor(p.Km + (size_t)(m0 + lr) * 512 + nt * 128 + wn * 64 + ni * 32, a, h, rs[lr]);
      });
    } else {
      gemm_tile<false>(A, LDH, Bw, 128, 128, lds, [&](int mi, int ni, const f32x16& a) {
        const int b = m0 / PP, t0 = m0 - b * PP + wm * 64 + mi * 32;
        const int col = (nt - 4) * 128 + wn * 64 + ni * 32 + r;
        store_transposed(p.VtB + ((size_t)b * 512 + col) * PP + t0, a, h, rs + wm * 64 + mi * 32);
      });
    }
  }
}

DI void cumsum_job(const Params& p, int j, char* lds) {
  const int tid = opaque_tid(), lane = tid & 63, w = tid >> 6;
  const float* src = p.LOGF + (size_t)j * PP;
  float* dst = p.CUM + (size_t)j * PP;
  float* wt = (float*)lds;
  float v[17];
#pragma unroll
  for (int rr = 0; rr < 17; ++rr) {
    const int o = rr * 64 + lane, i = w * 1056 + o;
    v[rr] = (o < 1056 && i >= LEAD) ? src[i] : 0.f;
  }
  float carry = 0.f;
#pragma unroll
  for (int rr = 0; rr < 17; ++rr) {
    float inc = v[rr];
    for (int o = 1; o < 64; o <<= 1) { float x = __shfl_up(inc, o); if (lane >= o) inc += x; }
    v[rr] = inc + carry;
    carry += __shfl(inc, 63);
  }
  if (lane == 0) wt[w] = carry;
  __syncthreads();
  float base = 0.f;
  for (int k = 0; k < w; ++k) base += wt[k];
#pragma unroll
  for (int rr = 0; rr < 17; ++rr) {
    const int o = rr * 64 + lane;
    if (o < 1056) dst[w * 1056 + o] = v[rr] + base;
  }
}

DI void topk_job(const Params& p, int b, int t0, char* lds) {
  const int tid = opaque_tid(), lane = tid & 63, w = tid >> 6, r = lane & 31, h = lane >> 5;
  const int cmax = (t0 + 3) >> 6;
  unsigned sc[17][4];
  {
    const u16* iqp = p.H + (size_t)(b * PP + t0 + (r >> 3)) * LDH + HIQ_C + (r & 7) * 64 + 8 * h;
    bf16x8 af[4];
#pragma unroll
    for (int ks = 0; ks < 4; ++ks) af[ks] = *(const bf16x8*)(iqp + ks * 16);
    f32x4 iw[4];
#pragma unroll
    for (int qi = 0; qi < 4; ++qi) iw[qi] = *(const f32x4*)(p.IW + (size_t)(b * PP + t0 + qi) * 8 + 4 * h);
    char* wb = lds + 16384 + w * 9216;
    const int lrow = lane >> 3, lpc = lane & 7;
    const u16* ikb = p.IK + ((size_t)(b * PP) + lrow) * 64 + lpc * 8;
    u32x4 st[8];
    if (1 + w <= cmax) {
      const u16* kp = ikb + (size_t)(1 + w) * 64 * 64;
#pragma unroll
      for (int j = 0; j < 8; ++j) st[j] = *(const u32x4*)(kp + (size_t)j * 8 * 64);
#pragma unroll
      for (int j = 0; j < 8; ++j) *(u32x4*)(wb + (lrow + 8 * j) * 144 + lpc * 16) = st[j];
    }
#pragma unroll
    for (int i = 0; i < 17; ++i) {
      const int c = 1 + w + 8 * i;
      if (c <= cmax) {
        const bool more = c + 8 <= cmax;
        if (more) {
          const u16* kp = ikb + (size_t)(c + 8) * 64 * 64;
#pragma unroll
          for (int j = 0; j < 8; ++j) st[j] = *(const u32x4*)(kp + (size_t)j * 8 * 64);
        }
        bf16x8 b0[4], b1[4];
#pragma unroll
        for (int ks = 0; ks < 4; ++ks) {
          b0[ks] = *(const bf16x8*)(wb + r * 144 + ks * 32 + h * 16);
          b1[ks] = *(const bf16x8*)(wb + (32 + r) * 144 + ks * 32 + h * 16);
        }
        __builtin_amdgcn_sched_barrier(0);
        f32x16 a0, a1;
#pragma unroll
        for (int e = 0; e < 16; ++e) { a0[e] = 0.f; a1[e] = 0.f; }
#pragma unroll
        for (int ks = 0; ks < 4; ++ks) { a0 = MFMA32(af[ks], b0[ks], a0); a1 = MFMA32(af[ks], b1[ks], a1); }
        const int key = c * 64 + lane;
#pragma unroll
        for (int qi = 0; qi < 4; ++qi) {
          f32x2 pp2 = {0.f, 0.f};
#pragma unroll
          for (int e = 0; e < 4; ++e) {
            const f32x2 rl = {fmaxf(a0[4 * qi + e], 0.f), fmaxf(a1[4 * qi + e], 0.f)};
            const f32x2 wv = {iw[qi][e], iw[qi][e]};
            pp2 += rl * wv;
          }
          const float p0 = pp2[0], p1 = pp2[1];
          const u32x2 sw = __builtin_amdgcn_permlane32_swap(__float_as_uint(p0), __float_as_uint(p1), false, false);
          float mine = __uint_as_float(sw[0]) + __uint_as_float(sw[1]);
          mine += 0.0f;
          unsigned u = __float_as_uint(mine);
          u = (u & 0x80000000u) ? ~u : (u | 0x80000000u);
          if (key > t0 + qi || key < LEAD) u = 0u;
          sc[i][qi] = u;
        }
        if (more) {
#pragma unroll
          for (int j = 0; j < 8; ++j) *(u32x4*)(wb + (lrow + 8 * j) * 144 + lpc * 16) = st[j];
        }
      } else {
#pragma unroll
        for (int qi = 0; qi < 4; ++qi) sc[i][qi] = 0u;
      }
    }
  }
  int* ng = (int*)(lds + 256);
  unsigned long long* mg = (unsigned long long*)(lds + 1024);
  unsigned long long* me = mg + 4 * 132;
  int* bg = (int*)(me + 4 * 132);
  int* be = bg + 4 * 132;
  unsigned T[4];
  {
    unsigned* hist = (unsigned*)(lds + 16384);
    int* sel = (int*)(lds + 512);
    unsigned pref[4] = {0u, 0u, 0u, 0u};
    int chi[4] = {0, 0, 0, 0};
    bool few[4] = {false, false, false, false};
    __syncthreads();
    bool small = false;
    int nb[4] = {0, 0, 0, 0};
#pragma unroll
    for (int pass = 0; pass < 3; ++pass) {
      if (pass == 2) {
        small = true;
#pragma unroll
        for (int q = 0; q < 4; ++q) small = small && (few[q] || nb[q] <= 64);
        if (small) break;
      }
      {
        const u32x4 z = {0u, 0u, 0u, 0u};
#pragma unroll
        for (int j = 0; j < 8; ++j) ((u32x4*)hist)[tid + 512 * j] = z;
      }
      __syncthreads();
#pragma unroll
      for (int i = 0; i < 17; ++i) {
#pragma unroll
        for (int q = 0; q < 4; ++q) {
          const unsigned u = sc[i][q];
          bool part; unsigned bin;
          if (pass == 0) { part = (u != 0u); bin = (u >> 22) + (lane & 3) * 1024; }
          else if (pass == 1) { part = (u != 0u) && ((u >> 22) == pref[q]) && !few[q]; bin = ((u >> 12) & 1023u) + (lane & 3) * 1024; }
          else { part = (u != 0u) && ((u >> 12) == pref[q]) && !few[q]; bin = u & 4095u; }
          if (part) atomicAdd(hist + q * 4096 + bin, 1u);
        }
      }
      __syncthreads();
      if (w < 4) {
        const int q = w;
        const unsigned* hq = hist + q * 4096;
        const int need = 256 - chi[q];
        int G = 0;
        if (pass < 2) {
#pragma unroll
          for (int rep = 0; rep < 4; ++rep)
#pragma unroll
            for (int j = 0; j < 16; ++j) G += (int)hq[rep * 1024 + 16 * lane + ((j + lane) & 15)];
        } else {
#pragma unroll 8
          for (int j = 0; j < 64; ++j) G += (int)hq[64 * lane + ((j + lane) & 63)];
        }
        int S = G;
        for (int o = 1; o < 64; o <<= 1) { int x = __shfl_down(S, o); if (lane + o < 64) S += x; }
        const unsigned long long mk = __ballot(S >= need);
        int B = 0, cg2 = 0, fw = 0, nbin = 0;
        if (mk == 0ull) {
          fw = 1;
        } else {
          const int ks = 63 - __clzll(mk);
          const int above = (ks < 63) ? __shfl(S, ks + 1) : 0;
          int hh;
          if (pass < 2) {
            hh = 0;
            if (lane < 16) hh = (int)(hq[16 * ks + lane] + hq[1024 + 16 * ks + lane] + hq[2048 + 16 * ks + lane] + hq[3072 + 16 * ks + lane]);
          } else {
            hh = (int)hq[64 * ks + lane];
          }
          int s2 = hh;
          for (int o = 1; o < 64; o <<= 1) { int x = __shfl_down(s2, o); if (lane + o < 64) s2 += x; }
          const unsigned long long m2 = __ballot(above + s2 >= need);
          const int Ls = 63 - __clzll(m2);
          B = (pass < 2 ? 16 : 64) * ks + Ls;
          nbin = __shfl(hh, Ls);
          cg2 = above + __shfl(s2, Ls) - nbin;
        }
        if (lane == 0) { sel[q * 4 + 0] = B; sel[q * 4 + 1] = chi[q] + cg2; sel[q * 4 + 2] = fw; sel[q * 4 + 3] = nbin; }
      }
      __syncthreads();
#pragma unroll
      for (int q = 0; q < 4; ++q) {
        if (!few[q]) {
          pref[q] = (pref[q] << (pass < 2 ? 10 : 12)) | (unsigned)sel[q * 4 + 0];
          chi[q] = sel[q * 4 + 1];
          nb[q] = sel[q * 4 + 3];
          if (pass == 0) few[q] = sel[q * 4 + 2] != 0;
        }
      }
    }
    if (small) {
      unsigned* lst = hist;
      int* lcnt = sel + 16;
      if (tid < 4) lcnt[tid] = 0;
      __syncthreads();
#pragma unroll
      for (int i = 0; i < 17; ++i)
#pragma unroll
        for (int q = 0; q < 4; ++q) {
          const unsigned u = sc[i][q];
          if (!few[q] && u != 0u && (u >> 12) == pref[q]) { const int pos = atomicAdd(lcnt + q, 1); lst[q * 64 + pos] = u; }
        }
      __syncthreads();
      if (w < 4) {
        const int q = w, n = lcnt[q], need = 256 - chi[q];
        const unsigned e = lane < n ? lst[q * 64 + lane] : 0u;
        int rank = 0;
        for (int k = 0; k < n; ++k) rank += (lst[q * 64 + k] > e) ? 1 : 0;
        unsigned cand = (lane < n && rank <= need - 1) ? e : 0xFFFFFFFFu;
        for (int o = 32; o > 0; o >>= 1) { const unsigned x = (unsigned)__shfl_xor((int)cand, o); cand = x < cand ? x : cand; }
        if (lane == 0) sel[q * 4 + 0] = (int)cand;
      }
      __syncthreads();
#pragma unroll
      for (int q = 0; q < 4; ++q) T[q] = few[q] ? 0u : (unsigned)sel[q * 4 + 0];
    } else {
#pragma unroll
      for (int q = 0; q < 4; ++q) T[q] = few[q] ? 0u : pref[q];
    }
  }
  unsigned* cntb = (unsigned*)mg;
  unsigned* baseb = (unsigned*)bg;
#pragma unroll
  for (int i = 0; i < 17; ++i) {
    const int c = 1 + w + 8 * i;
    if (c <= cmax) {
      unsigned mine = 0u;
#pragma unroll
      for (int q = 0; q < 4; ++q) {
        const unsigned pk = (unsigned)__popcll(__ballot(sc[i][q] > T[q])) | ((unsigned)__popcll(__ballot(sc[i][q] == T[q])) << 16);
        mine = (lane == q) ? pk : mine;
      }
      if (lane < 4) cntb[lane * 132 + c] = mine;
    }
  }
  __syncthreads();
  if (w < 4) {
    const int q = w;
    int cg_ = 0, ce_ = 0;
    for (int base = 0; base <= cmax; base += 64) {
      const int c = base + lane;
      const bool in = (c >= 1) && (c <= cmax);
      const unsigned cv = in ? cntb[q * 132 + c] : 0u;
      const int v1 = (int)(cv & 0xffffu), v2 = (int)(cv >> 16);
      int i1 = v1, i2 = v2;
      for (int o = 1; o < 64; o <<= 1) {
        int x1 = __shfl_up(i1, o), x2 = __shfl_up(i2, o);
        if (lane >= o) { i1 += x1; i2 += x2; }
      }
      if (in) baseb[q * 132 + c] = (unsigned)(cg_ + i1 - v1) | ((unsigned)(ce_ + i2 - v2) << 16);
      cg_ += __shfl(i1, 63);
      ce_ += __shfl(i2, 63);
    }
    if (lane == 0) ng[q] = cg_;
  }
  __syncthreads();
  const unsigned long long lt = (1ull << lane) - 1ull;
#pragma unroll
  for (int i = 0; i < 17; ++i) {
    const int c = 1 + w + 8 * i;
    if (c <= cmax) {
      const int key = c * 64 + lane;
#pragma unroll
      for (int q = 0; q < 4; ++q) {
        u16* out = p.IDX + (size_t)(b * PP + t0 + q) * 256;
        const bool gt = sc[i][q] > T[q];
        const bool eq = (sc[i][q] == T[q]) && (T[q] != 0u);
        const unsigned long long m1 = __ballot(gt), m2 = __ballot(eq);
        if ((m1 | m2) != 0ull) {
          const unsigned bb = baseb[q * 132 + c];
          if (gt) out[(int)(bb & 0xffffu) + __popcll(m1 & lt)] = (u16)key;
          if (eq) { const int pos = ng[q] + (int)(bb >> 16) + __popcll(m2 & lt); if (pos < 256) out[pos] = (u16)key; }
        }
      }
    }
  }
#pragma unroll
  for (int q = 0; q < 4; ++q) {
    if (T[q] == 0u) {
      u16* out = p.IDX + (size_t)(b * PP + t0 + q) * 256;
      if (tid < 256 && tid >= ng[q]) out[tid] = (u16)0xFFFF;
    }
  }
}

constexpr int AT_STAGE = 23040;
template <int DK, int MODE>
DI void attn_unit(const Params& p, int l, int b, int head, int qu, char* lds) {
  const int tid = opaque_tid(), lane = tid & 63, w = tid >> 6, r = lane & 31, h = lane >> 5;
  constexpr int KS = DK / 16, KST = DK + 8;
  const int q0 = qu * 256, qw0 = q0 + w * 32, qw = qw0 + r;
  const size_t tokq = (size_t)b * PP + qw;
  const u16 *qptr, *kptr, *vtptr, *gptr;
  int ldk;
  if (MODE == 0) {
    qptr = p.H + tokq * LDH + HQ_A + head * 64; kptr = p.H + (size_t)b * PP * LDH + HK_A + head * 64; ldk = LDH;
    vtptr = p.VtA + ((size_t)b * 512 + head * 64) * PP; gptr = p.H + tokq * LDH + HG_A + head * 64;
  } else if (MODE == 1) {
    qptr = p.Qm + tokq * 768 + head * 96; kptr = p.Km + (size_t)b * PP * 512 + head * 64; ldk = 512;
    vtptr = p.VtB + ((size_t)b * 512 + head * 64) * PP; gptr = p.H + tokq * LDH + HG_B + head * 64;
  } else {
    qptr = p.H + tokq * LDH + HQ_D + head * 64; kptr = p.H + (size_t)b * PP * LDH + HK_D + (head >> 2) * 64; ldk = LDH;
    vtptr = p.VtD + ((size_t)b * 128 + (head >> 2) * 64) * PP; gptr = p.H + tokq * LDH + HG_D + head * 64;
  }
  const float* cum = p.CUM + (size_t)(b * 8 + head) * PP;
  float* btab = (float*)(lds + 2 * AT_STAGE);
  u32x2 gpre[2][4];
#pragma unroll
  for (int d = 0; d < 2; ++d)
#pragma unroll
    for (int g = 0; g < 4; ++g) gpre[d][g] = *(const u32x2*)(gptr + d * 32 + 8 * g + 4 * h);
  bf16x8 qf[KS];
#pragma unroll
  for (int ks = 0; ks < KS; ++ks) qf[ks] = *(const bf16x8*)(qptr + ks * 16 + 8 * h);
  float cref = 0.f;
  if (MODE == 0) cref = cum[q0];
  if (MODE == 2) { if (tid < 128) btab[tid] = p.rel_bias[t5_bucket(tid) * 16 + 8 + head] * LOG2E; }
  const float sc2 = (MODE == 1 ? 0.10206207261596577f : 0.125f) * LOG2E;
  const int kt_hi = qu * 4 + 3;
  int kt_lo = 1;
  if (MODE == 2) { kt_lo = qu * 4 - 2; if (kt_lo < 1) kt_lo = 1; }
  u32x4 rk, rk2, rv;
  float re = 0.f;
  const int srow = tid >> 3, sc8 = tid & 7;
  auto gload = [&](int kt) {
    const int k0 = kt * 64;
    rk = *(const u32x4*)(kptr + (size_t)(k0 + srow) * ldk + sc8 * 8);
    if (MODE == 1) { if (tid < 256) rk2 = *(const u32x4*)(p.Kpe + ((size_t)b * PP + k0 + (tid >> 2)) * 32 + (tid & 3) * 8); }
    rv = *(const u32x4*)(vtptr + (size_t)srow * PP + k0 + sc8 * 8);
    if (MODE == 0) { if (tid < 64) re = (cum[k0 + tid] - cref) * LOG2E; }
  };
  auto lstore = [&](int st) {
    char* base = lds + st * AT_STAGE;
    *(u32x4*)(base + (srow * KST + sc8 * 8) * 2) = rk;
    if (MODE == 1) { if (tid < 256) *(u32x4*)(base + ((tid >> 2) * KST + 64 + (tid & 3) * 8) * 2) = rk2; }
    char* vb = base + 64 * KST * 2;
    u32x2 lo = {rv[0], rv[1]}, hi = {rv[2], rv[3]};
    *(u32x2*)(vb + (srow * 68 + sc8 * 8) * 2) = lo;
    *(u32x2*)(vb + (srow * 68 + sc8 * 8 + 4) * 2) = hi;
    if (MODE == 0) { if (tid < 64) *(float*)(vb + 64 * 68 * 2 + tid * 4) = re; }
  };
  f32x16 o[2];
#pragma unroll
  for (int d = 0; d < 2; ++d)
#pragma unroll
    for (int i = 0; i < 16; ++i) o[d][i] = 0.f;
  float m = NEGL, lsum = 0.f;
  float qn = 0.f, kmx = 0.f;
  int* stopf = (int*)(lds + 2 * AT_STAGE + 1024);
  if (MODE == 0) {
#pragma unroll
    for (int ks = 0; ks < KS; ++ks) {
      const u32x4 qq = __builtin_bit_cast(u32x4, qf[ks]);
#pragma unroll
      for (int e = 0; e < 4; ++e) { const float a = bf_lo(qq[e]), b2 = bf_hi(qq[e]); qn += a * a + b2 * b2; }
    }
    qn += __shfl_xor(qn, 32);
    qn = sqrtf(qn) * 1.01f;
    kmx = __uint_as_float(p.ctr[64 + l * 16 + b * 8 + head]);
  }
  gload(kt_hi); lstore(0);
  __syncthreads();
  for (int kt = kt_hi; kt >= kt_lo; --kt) {
    const bool more = kt > kt_lo;
    if (more) gload(kt - 1);
    float cnext = 0.f;
    if (MODE == 0) { if (more) cnext = cum[(kt - 1) * 64 + 63]; }
    const int st = (kt_hi - kt) & 1;
    const int k0 = kt * 64;
    bool active = k0 <= qw0 + 31;
    if (MODE == 2) active = active && (k0 + 63 >= qw0 - 127);
    if (active) {
      const char* kb = lds + st * AT_STAGE;
      const char* vb = kb + 64 * KST * 2;
      f32x16 s[2];
      bf16x8 kf[2][KS];
#pragma unroll
      for (int kr = 0; kr < 2; ++kr)
#pragma unroll
        for (int ks = 0; ks < KS; ++ks) kf[kr][ks] = *(const bf16x8*)(kb + ((kr * 32 + r) * KST + ks * 16 + 8 * h) * 2);
      __builtin_amdgcn_sched_barrier(0);
#pragma unroll
      for (int kr = 0; kr < 2; ++kr) {
#pragma unroll
        for (int i = 0; i < 16; ++i) s[kr][i] = 0.f;
#pragma unroll
        for (int ks = 0; ks < KS; ++ks) s[kr] = MFMA32(kf[kr][ks], qf[ks], s[kr]);
      }
      u32x4 vfr[2][2][2];
#pragma unroll
      for (int kr = 0; kr < 2; ++kr)
#pragma unroll
        for (int s2 = 0; s2 < 2; ++s2)
#pragma unroll
          for (int d = 0; d < 2; ++d) {
            const char* va = vb + ((d * 32 + r) * 68 + kr * 32 + s2 * 16 + 4 * h) * 2;
            const u32x2 lo = *(const u32x2*)va;
            const u32x2 hi = *(const u32x2*)(va + 16);
            vfr[kr][s2][d] = (u32x4){lo[0], lo[1], hi[0], hi[1]};
          }
      __builtin_amdgcn_sched_barrier(0);
      const bool need_mask = (MODE == 2) || (k0 + 63 > qw0) || (k0 < LEAD);
      const bool rawpath = (MODE == 1) && !need_mask;
      float tmax = NEGL;
      const f32x2 sc2v = {sc2, sc2};
      if (rawpath) {
#pragma unroll
        for (int kr = 0; kr < 2; ++kr)
#pragma unroll
          for (int i = 0; i < 16; ++i) tmax = fmaxf(tmax, s[kr][i]);
        tmax *= sc2;
      } else {
#pragma unroll
        for (int kr = 0; kr < 2; ++kr) {
#pragma unroll
          for (int g = 0; g < 4; ++g) {
            f32x4 ev = {0.f, 0.f, 0.f, 0.f};
            if (MODE == 0) ev = *(const f32x4*)(vb + 64 * 68 * 2 + (kr * 32 + 8 * g + 4 * h) * 4);
#pragma unroll
            for (int e2 = 0; e2 < 2; ++e2) {
              const int i = 4 * g + 2 * e2;
              f32x2 v2 = {s[kr][i], s[kr][i + 1]};
              if (MODE == 0) { const f32x2 e2v = {ev[2 * e2], ev[2 * e2 + 1]}; v2 = v2 * sc2v - e2v; }
              else v2 = v2 * sc2v;
#pragma unroll
              for (int e1 = 0; e1 < 2; ++e1) {
                const int key = k0 + kr * 32 + 8 * g + 4 * h + 2 * e2 + e1;
                float v = v2[e1];
                if (MODE == 2) v += btab[(qw - key) & 127];
                if (need_mask) {
                  bool ok = (key <= qw) && (key >= LEAD);
                  if (MODE == 2) ok = ok && (qw - key < 128);
                  v = ok ? v : NEGL;
                }
                s[kr][i + e1] = v;
                tmax = fmaxf(tmax, v);
              }
            }
          }
        }
      }
      tmax = fmaxf(tmax, __shfl_xor(tmax, 32));
      const float mn = fmaxf(m, tmax);
      const float alpha = __builtin_amdgcn_exp2f(m - mn);
      const bool resc = __any(m != mn);
      m = mn;
      f32x2 ps2 = {0.f, 0.f};
      const f32x2 mnv = {mn, mn};
      const f32x2 scx = rawpath ? sc2v : (f32x2){1.f, 1.f};
#pragma unroll
      for (int kr = 0; kr < 2; ++kr)
#pragma unroll
        for (int i = 0; i < 16; i += 2) {
          f32x2 v2 = {s[kr][i], s[kr][i + 1]};
          v2 = v2 * scx - mnv;
          f32x2 p2 = {__builtin_amdgcn_exp2f(v2[0]), __builtin_amdgcn_exp2f(v2[1])};
          s[kr][i] = p2[0]; s[kr][i + 1] = p2[1];
          ps2 += p2;
        }
      const float ps = ps2[0] + ps2[1];
      lsum = lsum * alpha + ps;
      if (resc)
#pragma unroll
      for (int d = 0; d < 2; ++d)
#pragma unroll
        for (int i = 0; i < 16; ++i) o[d][i] *= alpha;
#pragma unroll
      for (int kr = 0; kr < 2; ++kr) {
#pragma unroll
        for (int s2 = 0; s2 < 2; ++s2) {
          u32x4 pp = {pk2(s[kr][8 * s2], s[kr][8 * s2 + 1]), pk2(s[kr][8 * s2 + 2], s[kr][8 * s2 + 3]),
                      pk2(s[kr][8 * s2 + 4], s[kr][8 * s2 + 5]), pk2(s[kr][8 * s2 + 6], s[kr][8 * s2 + 7])};
          bf16x8 pf = __builtin_bit_cast(bf16x8, pp);
#pragma unroll
          for (int d = 0; d < 2; ++d) o[d] = MFMA32(__builtin_bit_cast(bf16x8, vfr[kr][s2][d]), pf, o[d]);
        }
      }
    }
    if (more) lstore(st ^ 1);
    if (MODE == 0) {
      if (more) {
        const float enext = (cnext - cref) * LOG2E;
        const bool okl = (qn * kmx * sc2 - enext) <= (m - 40.f);
        const bool okw = __all(okl);
        if (lane == 0) stopf[(kt & 1) * 8 + w] = okw ? 1 : 0;
      }
    }
    __syncthreads();
    if (MODE == 0) {
      if (more) {
        const int* sf = stopf + (kt & 1) * 8;
        if (sf[0] & sf[1] & sf[2] & sf[3] & sf[4] & sf[5] & sf[6] & sf[7]) break;
      }
    }
  }
  lsum += __shfl_xor(lsum, 32);
  float f;
  if (MODE == 2) {
    const float s2 = p.sinks[l * 8 + head] * LOG2E;
    const float mf = fmaxf(m, s2);
    const float em = __builtin_amdgcn_exp2f(m - mf);
    f = em / (lsum * em + __builtin_amdgcn_exp2f(s2 - mf));
  } else {
    f = lsum > 0.f ? 1.f / lsum : 0.f;
  }
  f *= (MODE == 0 ? SC_FOX : (MODE == 1 ? SC_MLA : SC_SWA));
  u16* mp = p.Mix + tokq * 2048 + (MODE == 0 ? 0 : (MODE == 1 ? 512 : 1536)) + head * 64;
#pragma unroll
  for (int d = 0; d < 2; ++d)
#pragma unroll
    for (int g = 0; g < 4; ++g) {
      const int dd = d * 32 + 8 * g + 4 * h;
      const u32x2 gv = gpre[d][g];
      float g0 = silu(bf_lo(gv[0])), g1 = silu(bf_hi(gv[0])), g2 = silu(bf_lo(gv[1])), g3 = silu(bf_hi(gv[1]));
      u32x2 ov = {pk2(o[d][4 * g] * f * g0, o[d][4 * g + 1] * f * g1), pk2(o[d][4 * g + 2] * f * g2, o[d][4 * g + 3] * f * g3)};
      *(u32x2*)(mp + dd) = ov;
    }
}

DI void dsa_job(const Params& p, int b, int tq0, char* lds) {
  const int tid = opaque_tid(), lane = tid & 63, w = tid >> 6;
  float* biasC = (float*)(lds + 143360);
  int* btab = (int*)(lds + 143360 + 1024);
  char* wl = lds + w * 17920;
  float* Pl = (float*)wl;
  int* kid = (int*)(wl + 8192);
  const int tq = tq0 + w;
  const size_t tok = (size_t)b * PP + tq;
  const u16* Hb = p.H + (size_t)b * PP * LDH;
  int kk[4], ku[4];
  {
    u32x2 iv = *(const u32x2*)(p.IDX + tok * 256 + 4 * lane);
    kk[0] = iv[0] & 0xffff; kk[1] = iv[0] >> 16; kk[2] = iv[1] & 0xffff; kk[3] = iv[1] >> 16;
#pragma unroll
    for (int j = 0; j < 4; ++j) ku[j] = (kk[j] == 0xFFFF) ? LEAD : kk[j];
    u32x4 kv4 = {(unsigned)ku[0], (unsigned)ku[1], (unsigned)ku[2], (unsigned)ku[3]};
    ((u32x4*)kid)[lane] = kv4;
  }
  u32x4 gvp[4];
#pragma unroll
  for (int hh = 0; hh < 4; ++hh) gvp[hh] = *(const u32x4*)(p.H + tok * LDH + HG_C + (((lane >> 3) & 1) * 4 + hh) * 64 + (lane & 7) * 8);
  __builtin_amdgcn_wave_barrier();
  const int ksub = lane >> 4, g = (lane >> 3) & 1, dc = lane & 7;
  {
    const int r = lane & 31, h = lane >> 5, pc = lane & 15;
    char* kst = wl + 9216;
    bf16x8 qb[8];
#pragma unroll
    for (int ks = 0; ks < 8; ++ks) {
      u32x4 v = {0u, 0u, 0u, 0u};
      if (r < 8 && (ks >> 2) == (r >> 2)) v = *(const u32x4*)(p.H + tok * LDH + HQ_C + r * 64 + (ks & 3) * 16 + 8 * h);
      qb[ks] = __builtin_bit_cast(bf16x8, v);
    }
    const u16* kbase = Hb + HK_C + pc * 8;
    u32x4 st0[8], st1[8];
#pragma unroll
    for (int s2 = 0; s2 < 8; ++s2) st0[s2] = *(const u32x4*)(kbase + (size_t)kid[4 * s2 + ksub] * LDH);
#pragma unroll
    for (int s2 = 0; s2 < 8; ++s2) st1[s2] = *(const u32x4*)(kbase + (size_t)kid[32 + 4 * s2 + ksub] * LDH);
    auto chunk = [&](int c, u32x4* stc) {
#pragma unroll
      for (int s2 = 0; s2 < 8; ++s2) *(u32x4*)(kst + (4 * s2 + ksub) * 272 + pc * 16) = stc[s2];
      if (c + 2 < 8) {
#pragma unroll
        for (int s2 = 0; s2 < 8; ++s2) stc[s2] = *(const u32x4*)(kbase + (size_t)kid[32 * (c + 2) + 4 * s2 + ksub] * LDH);
      }
      bf16x8 af[8];
#pragma unroll
      for (int ks = 0; ks < 8; ++ks) af[ks] = *(const bf16x8*)(kst + r * 272 + ks * 32 + 16 * h);
      __builtin_amdgcn_sched_barrier(0);
      f32x16 acc0, acc1;
#pragma unroll
      for (int i = 0; i < 16; ++i) { acc0[i] = 0.f; acc1[i] = 0.f; }
#pragma unroll
      for (int ks = 0; ks < 8; ks += 2) { acc0 = MFMA32(af[ks], qb[ks], acc0); acc1 = MFMA32(af[ks + 1], qb[ks + 1], acc1); }
      if (r < 8) {
#pragma unroll
        for (int i = 0; i < 16; ++i) Pl[(32 * c + crow(i, h)) * 8 + r] = acc0[i] + acc1[i];
      }
    };
#pragma unroll 1
    for (int c = 0; c < 8; c += 2) { chunk(c, st0); chunk(c + 1, st1); }
  }
  __builtin_amdgcn_wave_barrier();
  float lg[4][8];
#pragma unroll
  for (int j = 0; j < 4; ++j) {
    const f32x4 v0 = *(const f32x4*)(Pl + (4 * lane + j) * 8), v1 = *(const f32x4*)(Pl + (4 * lane + j) * 8 + 4);
#pragma unroll
    for (int e = 0; e < 4; ++e) { lg[j][e] = v0[e]; lg[j][4 + e] = v1[e]; }
  }
  int bk[4];
#pragma unroll
  for (int j = 0; j < 4; ++j) { int dist = tq - ku[j]; bk[j] = (dist < 128) ? btab[dist & 127] : 31; }
#pragma unroll
  for (int hd = 0; hd < 8; ++hd) {
    float mx = NEGL;
#pragma unroll
    for (int j = 0; j < 4; ++j) {
      float v = lg[j][hd] * 0.125f + biasC[bk[j] * 8 + hd];
      v = (kk[j] == 0xFFFF) ? NEGL : v;
      lg[j][hd] = v;
      mx = fmaxf(mx, v);
    }
    mx = wmax(mx);
    float sm = 0.f;
#pragma unroll
    for (int j = 0; j < 4; ++j) { float e = __expf(lg[j][hd] - mx); lg[j][hd] = e; sm += e; }
    sm = wsum(sm);
    const float inv = 1.f / sm;
#pragma unroll
    for (int j = 0; j < 4; ++j) lg[j][hd] *= inv;
  }
#pragma unroll
  for (int j = 0; j < 4; ++j) {
    f32x4 v0 = {lg[j][0], lg[j][1], lg[j][2], lg[j][3]}, v1 = {lg[j][4], lg[j][5], lg[j][6], lg[j][7]};
    *(f32x4*)(Pl + (4 * lane + j) * 8) = v0;
    *(f32x4*)(Pl + (4 * lane + j) * 8 + 4) = v1;
  }
  __builtin_amdgcn_wave_barrier();
  const u16* vb = Hb + HV_C + g * 64 + dc * 8;
  f32x2 acc2[4][4];
#pragma unroll
  for (int hh = 0; hh < 4; ++hh)
#pragma unroll
    for (int e = 0; e < 4; ++e) { acc2[hh][e][0] = 0.f; acc2[hh][e][1] = 0.f; }
  u32x4 vA[16], vB[16];
  auto pv_load = [&](int grp, u32x4* dst) {
#pragma unroll
    for (int s = 0; s < 16; ++s) dst[s] = *(const u32x4*)(vb + (size_t)kid[4 * (grp * 16 + s) + ksub] * LDH);
  };
  auto pv_fma = [&](int grp, const u32x4* src) {
#pragma unroll
    for (int s = 0; s < 16; ++s) {
      const int slot = 4 * (grp * 16 + s) + ksub;
      const f32x4 pp = *(const f32x4*)(Pl + slot * 8 + g * 4);
      const u32x4 vv = src[s];
#pragma unroll
      for (int hh = 0; hh < 4; ++hh) {
        const f32x2 ph = {pp[hh], pp[hh]};
#pragma unroll
        for (int e = 0; e < 4; ++e) {
          const f32x2 vf2 = {bf_lo(vv[e]), bf_hi(vv[e])};
          acc2[hh][e] += ph * vf2;
        }
      }
    }
  };
  pv_load(0, vA);
  pv_load(1, vB);
  pv_fma(0, vA);
  pv_load(2, vA);
  pv_fma(1, vB);
  pv_load(3, vB);
  pv_fma(2, vA);
  pv_fma(3, vB);
  float acc[4][8];
#pragma unroll
  for (int hh = 0; hh < 4; ++hh)
#pragma unroll
    for (int e = 0; e < 8; ++e) { float v = acc2[hh][e >> 1][e & 1]; v += __shfl_xor(v, 16); v += __shfl_xor(v, 32); acc[hh][e] = v; }
  if (ksub == 0) {
#pragma unroll
    for (int hh = 0; hh < 4; ++hh) {
      const int hd = g * 4 + hh;
      const u32x4 gv = gvp[hh];
      u32x4 ov;
#pragma unroll
      for (int e = 0; e < 4; ++e) ov[e] = pk2(acc[hh][2 * e] * SC_DSA * silu(bf_lo(gv[e])), acc[hh][2 * e + 1] * SC_DSA * silu(bf_hi(gv[e])));
      *(u32x4*)(p.Mix + tok * 2048 + 1024 + hd * 64 + dc * 8) = ov;
    }
  }
}

DI void outproj_tile(const Params& p, int mt, int nt, char* lds) {
  const int tid = opaque_tid(), lane = tid & 63, w = tid >> 6, r = lane & 31, h = lane >> 5;
  const int wm = w & 3, wn = w >> 2;
  const int m0 = mt * 256;
  gemm_tile<true>(p.Mix + (size_t)m0 * 2048, 2048, p.Wt_out + (size_t)nt * 128 * 2048, 2048, 2048, lds, [&](int mi, int ni, const f32x16& a) {
    const int tok = m0 + wm * 64 + mi * 32 + r;
    float* rp = p.R + (size_t)tok * DM + nt * 128 + wn * 64 + ni * 32;
#pragma unroll
    for (int g = 0; g < 4; ++g) {
      f32x4 v = *(const f32x4*)(rp + 8 * g + 4 * h);
#pragma unroll
      for (int e = 0; e < 4; ++e) v[e] = ALPHA * v[e] + a[4 * g + e];
      *(f32x4*)(rp + 8 * g + 4 * h) = v;
    }
  });
}

DI void ln_rows(const Params& p, int l) {
  const int tid = opaque_tid(), lane = tid & 63, w = tid >> 6;
  const float* gg = l < 0 ? p.ln0_g : p.ln_g + l * DM;
  const float* bb = l < 0 ? p.ln0_b : p.ln_b + l * DM;
  const int stride = gridDim.x * 8;
  auto loadrow = [&](int row, f32x4* dst) {
    if (l < 0) {
      const int b = row / PP, t = row - b * PP;
      const float* src = nullptr;
      if (t >= 128 && t < PV) src = p.x + ((size_t)b * SEQ + (t - 128)) * DM;
      else if (t >= LEAD && t < 128) src = p.meta + (size_t)(t - LEAD) * DM;
#pragma unroll
      for (int j = 0; j < 4; ++j) {
        if (src) dst[j] = *(const f32x4*)(src + lane * 4 + 256 * j);
        else { dst[j][0] = 0.f; dst[j][1] = 0.f; dst[j][2] = 0.f; dst[j][3] = 0.f; }
      }
    } else {
#pragma unroll
      for (int j = 0; j < 4; ++j) dst[j] = *(const f32x4*)(p.R + (size_t)row * DM + lane * 4 + 256 * j);
    }
  };
  f32x4 v[4], vn[4];
  int row = blockIdx.x * 8 + w;
  if (row < MT) loadrow(row, v);
  for (; row < MT; row += stride) {
    const int b = row / PP, t = row - b * PP;
    if (row + stride < MT) loadrow(row + stride, vn);
    float s = 0.f;
#pragma unroll
    for (int j = 0; j < 4; ++j) s += v[j][0] + v[j][1] + v[j][2] + v[j][3];
    const float mu = wsum(s) * (1.f / DM);
    float q = 0.f;
#pragma unroll
    for (int j = 0; j < 4; ++j)
#pragma unroll
      for (int e = 0; e < 4; ++e) { float d = v[j][e] - mu; q += d * d; }
    const float rstd = rsqrtf(wsum(q) * (1.f / DM) + 1e-5f);
#pragma unroll
    for (int j = 0; j < 4; ++j) {
      const int c = lane * 4 + 256 * j;
      f32x4 g4 = *(const f32x4*)(gg + c), b4 = *(const f32x4*)(bb + c);
      f32x4 y;
#pragma unroll
      for (int e = 0; e < 4; ++e) y[e] = (v[j][e] - mu) * rstd * g4[e] + b4[e];
      if (l == 3) {
        if (t >= 128 && t < PV) *(f32x4*)(p.out + ((size_t)b * SEQ + (t - 128)) * DM + c) = y;
      } else {
        *(f32x4*)(p.R + (size_t)row * DM + c) = y;
        u32x2 yb = {pk2(y[0], y[1]), pk2(y[2], y[3])};
        *(u32x2*)(p.Xb + (size_t)row * DM + c) = yb;
      }
    }
#pragma unroll
    for (int j = 0; j < 4; ++j) v[j] = vn[j];
  }
}

DI int map_in(int n) {
  if (n < 512) return n;
  if (n < 1024) return n;
  if (n < 1536) return 1544 + (n - 1024);
  if (n < 1792) return 2056 + (n - 1536);
  if (n < 1920) return 2312 + (n - 1792);
  if (n < 2432) return 2472 + (n - 1920);
  if (n < 2944) return 2984 + (n - 2432);
  if (n < 3072) return 3496 + (n - 2944);
  if (n < 3200) return 3624 + (n - 3072);
  if (n < 3712) return 3752 + (n - 3200);
  if (n < 4224) return 4336 + (n - 3712);
  if (n < 4736) return 4848 + (n - 4224);
  if (n < 4864) return 5360 + (n - 4736);
  if (n < 5376) return 5616 + (n - 4864);
  if (n < 5408) return 2440 + (n - 5376);
  if (n < 5472) return 4264 + (n - 5408);
  if (n < 5480) return 1536 + (n - 5472);
  if (n < 5488) return 4328 + (n - 5480);
  if (n < 5504) return -1;
  if (n < 6016) return 1024 + (n - 5504);
  return 5488 + (n - 6016);
}
DI void conv_weights(const Params& p, int l, char* lds) {
  const int tid = opaque_tid();
  float* tile = (float*)lds;
  for (int tI = blockIdx.x; tI < 2128; tI += gridDim.x) {
    const float* src; const float* ksc = nullptr; u16* dst; int ldsrc, K, kind, kt, ntile;
    if (tI < 1536) { kind = 0; kt = tI / 96; ntile = tI % 96; src = p.w_in + (size_t)l * DM * D_IN; ldsrc = D_IN; K = DM; dst = p.Wt_in; }
    else if (tI < 2048) { int u = tI - 1536; kind = 1; kt = u / 16; ntile = u % 16; src = p.w_out + (size_t)l * 2048 * DM; ldsrc = DM; K = 2048; dst = p.Wt_out; }
    else if (tI < 2096) { int u = tI - 2048; kind = 2; kt = u / 12; ntile = u % 12; src = p.w_uq + (size_t)l * 256 * 768; ldsrc = 768; K = 256; dst = p.Wt_uq; ksc = p.gq + l * 256; }
    else { int u = tI - 2096; kind = 3; kt = u / 16; ntile = u % 16; src = p.w_ukv + (size_t)l * 128 * 1024; ldsrc = 1024; K = 128; dst = p.Wt_ukv; ksc = p.gkv + l * 128; }
    const int k0 = kt * 64, n0 = ntile * 64;
    {
      const int nn = tid & 63;
      const int n = n0 + nn;
      int sc;
      if (kind == 0) sc = map_in(n);
      else if (kind == 3) sc = (n < 512) ? ((n >> 6) * 128 + (n & 63)) : (((n - 512) >> 6) * 128 + 64 + (n & 63));
      else sc = n;
#pragma unroll
      for (int j = 0; j < 8; ++j) {
        const int kk = (tid >> 6) + 8 * j;
        float v = 0.f;
        if (sc >= 0) v = src[(size_t)(k0 + kk) * ldsrc + sc];
        if (ksc) v *= ksc[k0 + kk];
        tile[nn * 65 + kk] = v;
      }
    }
    __syncthreads();
    {
      const int nn = tid >> 3, kc = (tid & 7) * 8;
      const float* tp = tile + nn * 65 + kc;
      u32x4 ov = {pk2(tp[0], tp[1]), pk2(tp[2], tp[3]), pk2(tp[4], tp[5]), pk2(tp[6], tp[7])};
      *(u32x4*)(dst + (size_t)(n0 + nn) * K + k0 + kc) = ov;
    }
    __syncthreads();
  }
}
DI void rope_table(const Params& p) {
  const int gt = blockIdx.x * NTHREADS + threadIdx.x;
  for (int i = gt; i < PP * 16; i += gridDim.x * NTHREADS) {
    const int t = i >> 4, c = i & 15;
    const float freq = powf(10000.f, -(float)c / 16.f);
    const float ang = (float)(t - LEAD) * freq;
    float sn, cs;
    sincosf(ang, &sn, &cs);
    p.ROPE[(size_t)t * 32 + c] = cs;
    p.ROPE[(size_t)t * 32 + 16 + c] = sn;
  }
}


#define XB_TMO      128
#define XB_XCNT(j)  (256  + 64 * (j))
#define XB_XSUB(j)  (1280 + 64 * (j))
#define XB_XGEN(j)  (2304 + 64 * (j))
#define XB_TOP      3328
#define XB_TOPGEN   3392
#define XCD_BAR_WORDS 3456
#define XB_SPIN_CAP (1u << 18)
DI unsigned xb_ld(unsigned* p) { return __hip_atomic_load(p, __ATOMIC_RELAXED, __HIP_MEMORY_SCOPE_AGENT); }
DI unsigned xb_add(unsigned* p, unsigned v) { return __hip_atomic_fetch_add(p, v, __ATOMIC_RELAXED, __HIP_MEMORY_SCOPE_AGENT); }
DI unsigned xb_xcc_id() { return (unsigned)__builtin_amdgcn_s_getreg((3 << 11) | 20) & 0xFu; }
#define XB_SPIN(cond, bar) do { unsigned _sp = 0; while (cond) { __builtin_amdgcn_s_sleep(1); \
    if ((++_sp & 255u) == 0u) { if (xb_ld(&(bar)[XB_TMO])) break; if (_sp > XB_SPIN_CAP) { atomicAdd(&(bar)[XB_TMO], 1u); break; } } } } while (0)
struct XcdBarrier { unsigned* bar; unsigned x; volatile unsigned* st; };
DI XcdBarrier xcd_barrier_post(unsigned* bar, volatile unsigned* st) {
  XcdBarrier b; b.bar = bar; b.x = xb_xcc_id(); b.st = st;
  if (threadIdx.x == 0) (void)xb_add(&bar[XB_XCNT(b.x)], 1u);
  return b;
}
DI void xcd_barrier_complete(unsigned* bar, unsigned x, unsigned& nloc, unsigned& nx) {
  const unsigned G = gridDim.x * gridDim.y * gridDim.z;
  unsigned sum, cnt, mine, sp = 0u;
  for (;;) {
    sum = 0u; cnt = 0u; mine = 0u;
#pragma unroll
    for (unsigned j = 0; j < 16; ++j) { const unsigned c = xb_ld(&bar[XB_XCNT(j)]); sum += c; cnt += (c > 0u) ? 1u : 0u; mine = (j == x) ? c : mine; }
    if (sum == G) break;
    __builtin_amdgcn_s_sleep(1);
    if ((++sp & 255u) == 0u) { if (xb_ld(&bar[XB_TMO])) break; if (sp > XB_SPIN_CAP) { atomicAdd(&bar[XB_TMO], 1u); break; } }
  }
  nloc = mine > 0u ? mine : 1u; nx = cnt > 0u ? cnt : 1u;
}
DI void xcd_barrier(const XcdBarrier& b) {
  asm volatile("s_waitcnt vmcnt(0)" ::: "memory");
  __syncthreads();
  if (threadIdx.x == 0) {
    unsigned* bar = b.bar;
    __builtin_amdgcn_s_waitcnt(0);
    unsigned nloc = b.st[0], nx = b.st[1];
    if (nloc == 0u) { xcd_barrier_complete(bar, b.x, nloc, nx); b.st[0] = nloc; b.st[1] = nx; }
    const unsigned old = xb_add(&bar[XB_XSUB(b.x)], 1u);
    const unsigned gen = old / nloc;
    if (old + 1u == (gen + 1u) * nloc) {
      __builtin_amdgcn_fence(__ATOMIC_RELEASE, "agent");
      asm volatile("s_waitcnt vmcnt(0)" ::: "memory");
      const unsigned og = xb_add(&bar[XB_TOP], 1u);
      const unsigned tg = og / nx;
      if (og + 1u == (tg + 1u) * nx) xb_add(&bar[XB_TOPGEN], 1u);
      else XB_SPIN(xb_ld(&bar[XB_TOPGEN]) == tg, bar);
      __builtin_amdgcn_fence(__ATOMIC_ACQUIRE, "agent");
      xb_add(&bar[XB_XGEN(b.x)], 1u);
      asm volatile("s_waitcnt vmcnt(0)" ::: "memory");
    } else {
      XB_SPIN(xb_ld(&bar[XB_XGEN(b.x)]) == gen, bar);
      __builtin_amdgcn_fence(__ATOMIC_ACQUIRE, "agent");
      asm volatile("s_waitcnt vmcnt(0)" ::: "memory");
    }
  }
  __syncthreads();
}

__global__ void __launch_bounds__(NTHREADS) mega(Params p) {
  extern __shared__ __attribute__((aligned(16))) char lds[];
  cg::grid_group grid = cg::this_grid();
  ln_rows(p, -1);
  conv_weights(p, 0, lds);
  rope_table(p);
  if (blockIdx.x == 0) {
    if (threadIdx.x < 256) p.ctr[threadIdx.x] = 0u;
    for (int i = threadIdx.x; i < XCD_BAR_WORDS; i += NTHREADS) p.bar[i] = 0u;
  }
  volatile unsigned* xst = (volatile unsigned*)(lds + LDS_JOB + 16);
  if (threadIdx.x == 0) { xst[0] = 0u; xst[1] = 0u; }
  grid.sync();
  const XcdBarrier xb = xcd_barrier_post(p.bar, xst);
  for (int l = 0; l < 4; ++l) {
    for (int rep = 0; rep < REP_P1; ++rep) {
      for (int j = blockIdx.x; j < 66 * 48; j += gridDim.x) inproj_tile(p, l, j / 48, j % 48, lds);
      xcd_barrier(xb);
    }
    for (int rep = 0; rep < REP_P2; ++rep) {
      constexpr int NTK = 2 * 2052, NUP = 66 * 14, NJ = NTK + NUP + 16;
      int pending = 0, par = 0;
      if (threadIdx.x == 0) pending = (int)atomicAdd(p.ctr + l * 2 + 8 * rep, 1u);
      for (;;) {
        const int j = next_job(p.ctr + l * 2 + 8 * rep, lds, pending, NJ, par);
        if (j >= NJ) break;
        if (j < 16) {
          cumsum_job(p, j, lds);
        } else if (j < 16 + NTK) {
          const int jj = j - 16;
          const int b = jj & 1, q = 2051 - (jj >> 1);
          topk_job(p, b, LEAD + 4 * q, lds);
        } else {
          const int u = j - 16 - NTK;
          upproj_tile(p, u / 14, u % 14, lds);
        }
      }
      xcd_barrier(xb);
    }
    for (int rep = 0; rep < REP_P3; ++rep) {
      constexpr int ND = 1056, NS = 528, NC = 2 * 1026, NJ = ND + NS + NC;
      {
        float* biasC = (float*)(lds + 143360);
        int* btab = (int*)(lds + 143360 + 1024);
        if (threadIdx.x < 256) biasC[threadIdx.x] = p.rel_bias[(threadIdx.x >> 3) * 16 + (threadIdx.x & 7)];
        if (threadIdx.x < 128) btab[threadIdx.x] = t5_bucket(threadIdx.x);
      }
      int pending = 0, par = 0;
      if (threadIdx.x == 0) pending = (int)atomicAdd(p.ctr + l * 2 + 1 + 8 * rep, 1u);
      for (;;) {
        const int j = next_job(p.ctr + l * 2 + 1 + 8 * rep, lds, pending, NJ, par);
        if (j >= NJ) break;
        if (j < ND) {
          const int qu = 32 - (j >> 5), rem = j & 31, kind = rem >> 4, b = (rem >> 3) & 1, head = rem & 7;
          if (kind == 0) attn_unit<64, 0>(p, l, b, head, qu, lds);
          else attn_unit<96, 1>(p, l, b, head, qu, lds);
        } else if (j < ND + NS) {
          const int u = j - ND;
          attn_unit<64, 2>(p, l, (u >> 3) & 1, u & 7, u >> 4, lds);
        } else {
          const int u = j - ND - NS;
          dsa_job(p, u & 1, LEAD + 8 * (u >> 1), lds);
        }
      }
      xcd_barrier(xb);
    }
    for (int j = blockIdx.x; j < 66 * 8; j += gridDim.x) {
      const int x = j & 7, a = j >> 3;
      outproj_tile(p, 2 * (a >> 1) + (x >> 2), 2 * (x & 3) + (a & 1), lds);
    }
    xcd_barrier(xb);
    ln_rows(p, l);
    if (l < 3) { conv_weights(p, l + 1, lds); xcd_barrier(xb); }
  }
}

extern "C" void kernel_launch(void* const* d_in, const int* in_sizes, int n_in, void* d_out, int out_size, void* d_ws, size_t ws_size,
                              hipStream_t stream) {
  static int grid = 0;
  if (grid == 0) {
    int dev = 0, cus = 0, per_cu = 0;
    hipGetDevice(&dev);
    hipDeviceGetAttribute(&cus, hipDeviceAttributeMultiprocessorCount, dev);
    if (hipFuncSetAttribute((const void*)mega, hipFuncAttributeMaxDynamicSharedMemorySize, LDS_BYTES) != hipSuccess) { fprintf(stderr, "hipFuncSetAttribute failed\n"); grid = -1; return; }
    hipOccupancyMaxActiveBlocksPerMultiprocessor(&per_cu, (const void*)mega, NTHREADS, LDS_BYTES);
    if (per_cu < 1) { fprintf(stderr, "occupancy query: %d\n", per_cu); grid = -1; return; }
    grid = cus * per_cu;
  }
  if (grid < 0) return;
  size_t off = 0;
  auto take = [&](size_t bytes) { size_t o = off; off += (bytes + 255) & ~(size_t)255; return (char*)d_ws + o; };
  Params p{};
  p.x = (const float*)d_in[0]; p.meta = (const float*)d_in[1]; p.ln0_g = (const float*)d_in[2]; p.ln0_b = (const float*)d_in[3];
  p.rel_bias = (const float*)d_in[4]; p.w_in = (const float*)d_in[5]; p.b_f = (const float*)d_in[6]; p.gq = (const float*)d_in[7];
  p.gkv = (const float*)d_in[8]; p.w_uq = (const float*)d_in[9]; p.w_ukv = (const float*)d_in[10]; p.sinks = (const float*)d_in[11];
  p.w_out = (const float*)d_in[12]; p.ln_g = (const float*)d_in[13]; p.ln_b = (const float*)d_in[14];
  p.out = (float*)d_out;
  p.ctr = (unsigned*)take(1024);
  p.bar = (unsigned*)take(XCD_BAR_WORDS * 4);
  p.Wt_in = (u16*)take((size_t)NIN * DM * 2);
  p.Wt_out = (u16*)take((size_t)DM * 2048 * 2);
  p.Wt_uq = (u16*)take((size_t)768 * 256 * 2);
  p.Wt_ukv = (u16*)take((size_t)1024 * 128 * 2);
  p.H = (u16*)take((size_t)MT * LDH * 2);
  p.Mix = (u16*)take((size_t)MT * 2048 * 2);
  p.Xb = p.Mix;
  p.VtA = (u16*)take((size_t)NB * 512 * PP * 2);
  p.VtD = (u16*)take((size_t)NB * 128 * PP * 2);
  p.R = (float*)take((size_t)MT * DM * 4);
  p.IDX = (u16*)take((size_t)MT * 256 * 2);
  p.IK = (u16*)take((size_t)MT * 64 * 2);
  p.Kpe = (u16*)take((size_t)MT * 32 * 2);
  p.IW = (float*)take((size_t)MT * 8 * 4);
  p.LOGF = (float*)take((size_t)NB * 8 * PP * 4);
  p.CUM = (float*)take((size_t)NB * 8 * PP * 4);
  p.ROPE = (float*)take((size_t)PP * 32 * 4);
  if (off > ws_size) { fprintf(stderr, "workspace too small: need %zu have %zu\n", off, ws_size); return; }
  {
    char* ob = (char*)d_out;
    p.Qm = (u16*)ob; ob += (size_t)MT * 768 * 2;
    p.Km = (u16*)ob; ob += (size_t)MT * 512 * 2;
    p.VtB = (u16*)ob; ob += (size_t)NB * 512 * PP * 2;
    if ((size_t)(ob - (char*)d_out) > (size_t)out_size * 4) { fprintf(stderr, "d_out too small for scratch\n"); return; }
  }
  hipMemsetAsync(p.ctr, 0, 1024 + XCD_BAR_WORDS * 4, stream);
  void* args[] = {&p};
  hipError_t e = hipLaunchCooperativeKernel((const void*)mega, dim3(grid), dim3(NTHREADS), args, LDS_BYTES, stream);
  if (e != hipSuccess) fprintf(stderr, "cooperative launch failed: %s (grid %d)\n", hipGetErrorString(e), grid);
}
```

```cpp
#include <hip/hip_runtime.h>
#include <hip/hip_cooperative_groups.h>
#include <cstdio>
namespace cg = cooperative_groups;

#define DI __device__ __forceinline__
typedef __attribute__((ext_vector_type(8))) short bf16x8;
typedef __attribute__((ext_vector_type(16))) float f32x16;
typedef __attribute__((ext_vector_type(4))) float f32x4;
typedef __attribute__((ext_vector_type(2))) float f32x2;
typedef __attribute__((ext_vector_type(2))) __bf16 bf2_t;
typedef __attribute__((ext_vector_type(4))) unsigned u32x4;
typedef __attribute__((ext_vector_type(2))) unsigned u32x2;
typedef unsigned short u16;
#define MFMA32(a, b, c) __builtin_amdgcn_mfma_f32_32x32x16_bf16((a), (b), (c), 0, 0, 0)

constexpr int NB = 2, PP = 8448, PV = 8320, LEAD = 112, DM = 1024, MT = NB * PP, SEQ = 8192;
constexpr int LDH = 5376, NIN = 6144;
constexpr int HQ_A = 0, HK_A = 512, HG_A = 1024, HCQ_B = 1536, HCKV_B = 1792, HG_B = 1920, HQ_C = 2432, HK_C = 2944, HV_C = 3072,
              HIQ_C = 3200, HG_C = 3712, HQ_D = 4224, HK_D = 4736, HG_D = 4864;
constexpr int D_IN = 6128;
constexpr float LOG2E = 1.4426950408889634f;
constexpr float NEGL = -1e30f;
constexpr float ALPHA = 1.681792830507429f;
constexpr int LDS_JOB = 147456;
constexpr int LDS_BYTES = LDS_JOB + 64;
constexpr int GEMM_STAGE = 55296;
constexpr int NTHREADS = 512;
#define REP_P1 1
#define REP_P2 1
#define REP_P3 1
#define SC_FOX 1.0f
#define SC_MLA 1.0f
#define SC_SWA 1.0f
#define SC_DSA 1.0f

struct Params {
  const float *x, *meta, *ln0_g, *ln0_b, *rel_bias, *w_in, *b_f, *gq, *gkv, *w_uq, *w_ukv, *sinks, *w_out, *ln_g, *ln_b;
  float* out;
  u16 *Wt_in, *Wt_out, *Wt_uq, *Wt_ukv;
  u16 *H, *Xb, *Mix, *VtA, *VtD, *VtB, *Qm, *Km, *Kpe, *IK, *IDX;
  float *R, *LOGF, *CUM, *IW, *ROPE;
  unsigned* ctr;
  unsigned* bar;
};

DI unsigned pk2(float a, float b) { f32x2 v = {a, b}; return __builtin_bit_cast(unsigned, __builtin_convertvector(v, bf2_t)); }
DI float bf_lo(unsigned u) { return __uint_as_float(u << 16); }
DI float bf_hi(unsigned u) { return __uint_as_float(u & 0xffff0000u); }
DI int opaque_tid() { int t = threadIdx.x; asm volatile("" : "+v"(t)); return t; }
DI int crow(int i, int h) { return (i & 3) + 8 * (i >> 2) + 4 * h; }
template <int CTRL> DI float dpp_mov(float v) { return __int_as_float(__builtin_amdgcn_mov_dpp(__float_as_int(v), CTRL, 0xF, 0xF, true)); }
DI float wsum(float v) {
  v += dpp_mov<0xB1>(v); v += dpp_mov<0x4E>(v); v += dpp_mov<0x141>(v); v += dpp_mov<0x140>(v);
  u32x2 r = __builtin_amdgcn_permlane16_swap(__float_as_uint(v), __float_as_uint(v), false, false);
  v = __uint_as_float(r[0]) + __uint_as_float(r[1]);
  r = __builtin_amdgcn_permlane32_swap(__float_as_uint(v), __float_as_uint(v), false, false);
  return __uint_as_float(r[0]) + __uint_as_float(r[1]);
}
DI float wmax(float v) {
  v = fmaxf(v, dpp_mov<0xB1>(v)); v = fmaxf(v, dpp_mov<0x4E>(v)); v = fmaxf(v, dpp_mov<0x141>(v)); v = fmaxf(v, dpp_mov<0x140>(v));
  u32x2 r = __builtin_amdgcn_permlane16_swap(__float_as_uint(v), __float_as_uint(v), false, false);
  v = fmaxf(__uint_as_float(r[0]), __uint_as_float(r[1]));
  r = __builtin_amdgcn_permlane32_swap(__float_as_uint(v), __float_as_uint(v), false, false);
  return fmaxf(__uint_as_float(r[0]), __uint_as_float(r[1]));
}
DI int wsumi(int v) { for (int o = 32; o > 0; o >>= 1) v += __shfl_xor(v, o); return v; }
DI float silu(float g) { return g / (1.f + __expf(-g)); }
DI float dot2(unsigned a, unsigned b, float c) { return __builtin_amdgcn_fdot2_f32_bf16(__builtin_bit_cast(bf2_t, a), __builtin_bit_cast(bf2_t, b), c, false); }
template <int CTRL> DI float dpp_add(float v) { return v + __int_as_float(__builtin_amdgcn_mov_dpp(__float_as_int(v), CTRL, 0xF, 0xF, true)); }
DI int t5_bucket(int n) {
  if (n < 16) return n;
  int lg = 16 + (int)(logf((float)n / 16.f) / logf(8.f) * 16.f);
  return lg < 31 ? lg : 31;
}

DI int next_job(unsigned* ctr, char* lds, int& pending, int njobs, int& par) {
  int* sj = (int*)(lds + LDS_JOB);
  if (threadIdx.x == 0) sj[par] = pending;
  __syncthreads();
  const int j = sj[par];
  par ^= 1;
  if (threadIdx.x == 0 && j < njobs) pending = (int)atomicAdd(ctr, 1u);
  return j;
}

template <bool SWAP, class Epi>
DI void gemm_tile(const u16* __restrict__ A, int lda, const u16* __restrict__ Bw, int ldb, int K, char* lds, Epi epi) {
  const int tid = opaque_tid(), lane = tid & 63, w = tid >> 6, r = lane & 31, h = lane >> 5;
  const int wm = w & 3, wn = w >> 2;
  f32x16 acc[2][2];
#pragma unroll
  for (int a = 0; a < 2; ++a)
#pragma unroll
    for (int b = 0; b < 2; ++b)
#pragma unroll
      for (int i = 0; i < 16; ++i) acc[a][b][i] = 0.f;
  const int lrow = tid >> 3, lkc = tid & 7;
  u32x4 ra0[4], rb0[2], ra1[4], rb1[2];
  const u16* ap = A + (size_t)lrow * lda + lkc * 8;
  const u16* bp = Bw + (size_t)lrow * ldb + lkc * 8;
  const int nk = K >> 6;
  auto gload = [&](int kt, u32x4* ra, u32x4* rb) {
#pragma unroll
    for (int j = 0; j < 4; ++j) ra[j] = *(const u32x4*)(ap + (size_t)(64 * j) * lda + kt * 64);
#pragma unroll
    for (int j = 0; j < 2; ++j) rb[j] = *(const u32x4*)(bp + (size_t)(64 * j) * ldb + kt * 64);
  };
  auto lstore = [&](int st, const u32x4* ra, const u32x4* rb) {
    char* base = lds + st * GEMM_STAGE;
#pragma unroll
    for (int j = 0; j < 4; ++j) *(u32x4*)(base + ((lrow + 64 * j) * 72 + lkc * 8) * 2) = ra[j];
#pragma unroll
    for (int j = 0; j < 2; ++j) *(u32x4*)(base + 36864 + ((lrow + 64 * j) * 72 + lkc * 8) * 2) = rb[j];
  };
  auto compute = [&](int st) {
    const char* as = lds + st * GEMM_STAGE;
    const char* bs = as + 36864;
#pragma unroll
    for (int ks = 0; ks < 4; ++ks) {
      bf16x8 af[2], bfr[2];
#pragma unroll
      for (int mi = 0; mi < 2; ++mi) af[mi] = *(const bf16x8*)(as + ((wm * 64 + mi * 32 + r) * 72 + ks * 16 + 8 * h) * 2);
#pragma unroll
      for (int ni = 0; ni < 2; ++ni) bfr[ni] = *(const bf16x8*)(bs + ((wn * 64 + ni * 32 + r) * 72 + ks * 16 + 8 * h) * 2);
#pragma unroll
      for (int mi = 0; mi < 2; ++mi)
#pragma unroll
        for (int ni = 0; ni < 2; ++ni) {
          if (SWAP) acc[mi][ni] = MFMA32(bfr[ni], af[mi], acc[mi][ni]);
          else acc[mi][ni] = MFMA32(af[mi], bfr[ni], acc[mi][ni]);
        }
    }
  };
  gload(0, ra0, rb0);
  lstore(0, ra0, rb0);
  gload(1, ra1, rb1);
  __syncthreads();
  for (int kt = 0; kt < nk; kt += 2) {
    if (kt + 2 < nk) gload(kt + 2, ra0, rb0);
    compute(0);
    lstore(1, ra1, rb1);
    __syncthreads();
    if (kt + 3 < nk) gload(kt + 3, ra1, rb1);
    compute(1);
    if (kt + 2 < nk) lstore(0, ra0, rb0);
    __syncthreads();
  }
#pragma unroll
  for (int mi = 0; mi < 2; ++mi)
#pragma unroll
    for (int ni = 0; ni < 2; ++ni) epi(mi, ni, acc[mi][ni]);
}

DI void store_rowmajor(u16* dst, const f32x16& a, int h, float sc) {
#pragma unroll
  for (int kp = 0; kp < 2; ++kp) {
    const int g = 2 * kp;
    unsigned ax = pk2(a[4 * g] * sc, a[4 * g + 1] * sc), ay = pk2(a[4 * g + 2] * sc, a[4 * g + 3] * sc);
    unsigned bx = pk2(a[4 * g + 4] * sc, a[4 * g + 5] * sc), by = pk2(a[4 * g + 6] * sc, a[4 * g + 7] * sc);
    const u32x2 rx = __builtin_amdgcn_permlane32_swap(ax, bx, false, false);
    const u32x2 ry = __builtin_amdgcn_permlane32_swap(ay, by, false, false);
    const u32x4 v = {rx[0], ry[0], rx[1], ry[1]};
    *(u32x4*)(dst + 8 * (g + h)) = v;
  }
}
DI void store_rope(u16* dst, const f32x16& a, int h, float sc, const float* rp) {
#pragma unroll
  for (int g = 0; g < 2; ++g) {
    f32x4 cs = *(const f32x4*)(rp + 8 * g + 4 * h);
    f32x4 sn = *(const f32x4*)(rp + 16 + 8 * g + 4 * h);
    float o1[4], o2[4];
#pragma unroll
    for (int e = 0; e < 4; ++e) {
      float x1 = a[4 * g + e] * sc, x2 = a[8 + 4 * g + e] * sc;
      o1[e] = x1 * cs[e] - x2 * sn[e];
      o2[e] = x1 * sn[e] + x2 * cs[e];
    }
    u32x2 v1 = {pk2(o1[0], o1[1]), pk2(o1[2], o1[3])};
    u32x2 v2 = {pk2(o2[0], o2[1]), pk2(o2[2], o2[3])};
    *(u32x2*)(dst + 8 * g + 4 * h) = v1;
    *(u32x2*)(dst + 16 + 8 * g + 4 * h) = v2;
  }
}
DI void store_transposed(u16* dst, const f32x16& a, int h, const float* rs  ) {
#pragma unroll
  for (int g = 0; g < 4; ++g) {
    float s0 = 1.f, s1 = 1.f, s2 = 1.f, s3 = 1.f;
    if (rs) { f32x4 sv = *(const f32x4*)(rs + 8 * g + 4 * h); s0 = sv[0]; s1 = sv[1]; s2 = sv[2]; s3 = sv[3]; }
    u32x2 v = {pk2(a[4 * g] * s0, a[4 * g + 1] * s1), pk2(a[4 * g + 2] * s2, a[4 * g + 3] * s3)};
    *(u32x2*)(dst + 8 * g + 4 * h) = v;
  }
}

DI void inproj_tile(const Params& p, int l, int mt, int nt, char* lds) {
  const int tid = opaque_tid(), lane = tid & 63, w = tid >> 6, r = lane & 31, h = lane >> 5;
  const int wm = w & 3, wn = w >> 2;
  const int m0 = mt * 256;
  const u16* A = p.Xb + (size_t)m0 * DM;
  const u16* Bw = p.Wt_in + (size_t)nt * 128 * DM;
  if (nt < 42) {
    float ssq = 0.f;
    gemm_tile<true>(A, DM, Bw, DM, DM, lds, [&](int mi, int ni, const f32x16& a) {
      const int tok = m0 + wm * 64 + mi * 32 + r;
      store_rowmajor(p.H + (size_t)tok * LDH + nt * 128 + wn * 64 + ni * 32, a, h, 1.f);
      if (nt >= 4 && nt < 8) {
        if (ni == 0) ssq = 0.f;
#pragma unroll
        for (int i = 0; i < 16; ++i) ssq += a[i] * a[i];
        if (ni == 1) {
          float tot = ssq + __shfl_xor(ssq, 32);
          tot = wmax(tot);
          if (lane == 0) atomicMax(p.ctr + 64 + l * 16 + (m0 / PP) * 8 + (nt - 4) * 2 + wn, __float_as_uint(sqrtf(tot) * 1.01f));
        }
      }
    });
  } else if (nt == 42) {
    gemm_tile<true>(A, DM, Bw, DM, DM, lds, [&](int mi, int ni, const f32x16& a) {
      const int tok = m0 + wm * 64 + mi * 32 + r;
      const int b = tok / PP, t = tok - b * PP;
      const int sub = wn * 2 + ni;
      if (sub == 0) {
        store_rope(p.Kpe + (size_t)tok * 32, a, h, 1.f, p.ROPE + (size_t)t * 32);
      } else if (sub == 1) {
        store_rowmajor(p.IK + (size_t)tok * 64, a, h, 1.f);
      } else if (sub == 2) {
        store_rowmajor(p.IK + (size_t)tok * 64 + 32, a, h, 1.f);
      } else {
#pragma unroll
        for (int e = 0; e < 4; ++e) {
          const int hd = e + 4 * h;
          float xv = a[e] + p.b_f[l * 8 + hd];
          float lf = fminf(xv, 0.f) - log1pf(expf(-fabsf(xv)));
          p.LOGF[(size_t)(b * 8 + hd) * PP + t] = lf;
          p.IW[(size_t)tok * 8 + hd] = a[4 + e];
        }
      }
    });
  } else {
    u16* vt; int nv, c0;
    if (nt < 47) { vt = p.VtA; nv = 512; c0 = (nt - 43) * 128; } else { vt = p.VtD; nv = 128; c0 = 0; }
    gemm_tile<false>(A, DM, Bw, DM, DM, lds, [&](int mi, int ni, const f32x16& a) {
      const int b = m0 / PP, t0 = m0 - b * PP + wm * 64 + mi * 32;
      const int col = c0 + wn * 64 + ni * 32 + r;
      store_transposed(vt + ((size_t)b * nv + col) * PP + t0, a, h, nullptr);
    });
  }
}

DI void upproj_tile(const Params& p, int mt, int nt14, char* lds) {
  const int tid = opaque_tid(), lane = tid & 63, w = tid >> 6, r = lane & 31, h = lane >> 5;
  const int wm = w & 3, wn = w >> 2;
  const int m0 = mt * 256;
  float* rs = (float*)(lds + 2 * GEMM_STAGE);
  const bool isq = nt14 < 6;
  {
    const int row = tid >> 1, half = tid & 1;
    const int kw = isq ? 128 : 64;
    const u16* src = p.H + (size_t)(m0 + row) * LDH + (isq ? HCQ_B : HCKV_B) + half * kw;
    float ss = 0.f;
    u32x4 rv[16];
#pragma unroll
    for (int c = 0; c < 8; ++c) rv[c] = *(const u32x4*)(src + c * 8);
    if (isq) {
#pragma unroll
      for (int c = 8; c < 16; ++c) rv[c] = *(const u32x4*)(src + c * 8);
    } else {
#pragma unroll
      for (int c = 8; c < 16; ++c) { rv[c][0] = 0u; rv[c][1] = 0u; rv[c][2] = 0u; rv[c][3] = 0u; }
    }
#pragma unroll
    for (int c = 0; c < 16; ++c)
#pragma unroll
      for (int e = 0; e < 4; ++e) { float a = bf_lo(rv[c][e]), b2 = bf_hi(rv[c][e]); ss += a * a + b2 * b2; }
    ss += __shfl_xor(ss, 1);
    if (half == 0) rs[row] = rsqrtf(ss / (isq ? 256.f : 128.f) + 1e-6f);
  }
  __syncthreads();
  if (isq) {
    const int nt = nt14;
    gemm_tile<true>(p.H + (size_t)m0 * LDH + HCQ_B, LDH, p.Wt_uq + (size_t)nt * 128 * 256, 256, 256, lds, [&](int mi, int ni, const f32x16& a) {
      const int lr = wm * 64 + mi * 32 + r;
      const int tok = m0 + lr;
      const int t = tok % PP;
      const int j32 = nt * 4 + wn * 2 + ni;
      const float sc = rs[lr];
      u16* dst = p.Qm + (size_t)tok * 768 + j32 * 32;
      if (j32 % 3 == 2) store_rope(dst, a, h, sc, p.ROPE + (size_t)t * 32);
      else store_rowmajor(dst, a, h, sc);
    });
  } else {
    const int nt = nt14 - 6;
    const u16* A = p.H + (size_t)m0 * LDH + HCKV_B;
    const u16* Bw = p.Wt_ukv + (size_t)nt * 128 * 128;
    if (nt < 4) {
      gemm_tile<true>(A, LDH, Bw, 128, 128, lds, [&](int mi, int ni, const f32x16& a) {
        const int lr = wm * 64 + mi * 32 + r;
        store_rowmajor(p.Km + (size_t)(m0 + lr) * 512 + nt * 128 + wn * 64 + ni * 32, a, h, rs[lr]);
      });
    } else {
      gemm_tile<false>(A, LDH, Bw, 128, 128, lds, [&](int mi, int ni, const f32x16& a) {
        const int b = m0 / PP, t0 = m0 - b * PP + wm * 64 + mi * 32;
        const int col = (nt - 4) * 128 + wn * 64 + ni * 32 + r;
        store_transposed(p.VtB + ((size_t)b * 512 + col) * PP + t0, a, h, rs + wm * 64 + mi * 32);
      });
    }
  }
}

DI void cumsum_job(const Params& p, int j, char* lds) {
  const int tid = opaque_tid(), lane = tid & 63, w = tid >> 6;
  const float* src = p.LOGF + (size_t)j * PP;
  float* dst = p.CUM + (size_t)j * PP;
  float* wt = (float*)lds;
  float v[17];
#pragma unroll
  for (int rr = 0; rr < 17; ++rr) {
    const int o = rr * 64 + lane, i = w * 1056 + o;
    v[rr] = (o < 1056 && i >= LEAD) ? src[i] : 0.f;
  }
  float carry = 0.f;
#pragma unroll
  for (int rr = 0; rr < 17; ++rr) {
    float inc = v[rr];
    for (int o = 1; o < 64; o <<= 1) { float x = __shfl_up(inc, o); if (lane >= o) inc += x; }
    v[rr] = inc + carry;
    carry += __shfl(inc, 63);
  }
  if (lane == 0) wt[w] = carry;
  __syncthreads();
  float base = 0.f;
  for (int k = 0; k < w; ++k) base += wt[k];
#pragma unroll
  for (int rr = 0; rr < 17; ++rr) {
    const int o = rr * 64 + lane;
    if (o < 1056) dst[w * 1056 + o] = v[rr] + base;
  }
}

DI void topk_job(const Params& p, int b, int t0, char* lds) {
  const int tid = opaque_tid(), lane = tid & 63, w = tid >> 6, r = lane & 31, h = lane >> 5;
  const int cmax = (t0 + 3) >> 6;
  unsigned sc[17][4];
  {
    const u16* iqp = p.H + (size_t)(b * PP + t0 + (r >> 3)) * LDH + HIQ_C + (r & 7) * 64 + 8 * h;
    bf16x8 af[4];
#pragma unroll
    for (int ks = 0; ks < 4; ++ks) af[ks] = *(const bf16x8*)(iqp + ks * 16);
    f32x4 iw[4];
#pragma unroll
    for (int qi = 0; qi < 4; ++qi) iw[qi] = *(const f32x4*)(p.IW + (size_t)(b * PP + t0 + qi) * 8 + 4 * h);
    char* wb = lds + 16384 + w * 9216;
    const int lrow = lane >> 3, lpc = lane & 7;
    const u16* ikb = p.IK + ((size_t)(b * PP) + lrow) * 64 + lpc * 8;
    u32x4 st[8];
    if (1 + w <= cmax) {
      const u16* kp = ikb + (size_t)(1 + w) * 64 * 64;
#pragma unroll
      for (int j = 0; j < 8; ++j) st[j] = *(const u32x4*)(kp + (size_t)j * 8 * 64);
#pragma unroll
      for (int j = 0; j < 8; ++j) *(u32x4*)(wb + (lrow + 8 * j) * 144 + lpc * 16) = st[j];
    }
#pragma unroll
    for (int i = 0; i < 17; ++i) {
      const int c = 1 + w + 8 * i;
      if (c <= cmax) {
        const bool more = c + 8 <= cmax;
        if (more) {
          const u16* kp = ikb + (size_t)(c + 8) * 64 * 64;
#pragma unroll
          for (int j = 0; j < 8; ++j) st[j] = *(const u32x4*)(kp + (size_t)j * 8 * 64);
        }
        bf16x8 b0[4], b1[4];
#pragma unroll
        for (int ks = 0; ks < 4; ++ks) {
          b0[ks] = *(const bf16x8*)(wb + r * 144 + ks * 32 + h * 16);
          b1[ks] = *(const bf16x8*)(wb + (32 + r) * 144 + ks * 32 + h * 16);
        }
        __builtin_amdgcn_sched_barrier(0);
        f32x16 a0, a1;
#pragma unroll
        for (int e = 0; e < 16; ++e) { a0[e] = 0.f; a1[e] = 0.f; }
#pragma unroll
        for (int ks = 0; ks < 4; ++ks) { a0 = MFMA32(af[ks], b0[ks], a0); a1 = MFMA32(af[ks], b1[ks], a1); }
        const int key = c * 64 + lane;
#pragma unroll
        for (int qi = 0; qi < 4; ++qi) {
          f32x2 pp2 = {0.f, 0.f};
#pragma unroll
          for (int e = 0; e < 4; ++e) {
            const f32x2 rl = {fmaxf(a0[4 * qi + e], 0.f), fmaxf(a1[4 * qi + e], 0.f)};
            const f32x2 wv = {iw[qi][e], iw[qi][e]};
            pp2 += rl * wv;
          }
          const float p0 = pp2[0], p1 = pp2[1];
          const u32x2 sw = __builtin_amdgcn_permlane32_swap(__float_as_uint(p0), __float_as_uint(p1), false, false);
          float mine = __uint_as_float(sw[0]) + __uint_as_float(sw[1]);
          mine += 0.0f;
          unsigned u = __float_as_uint(mine);
          u = (u & 0x80000000u) ? ~u : (u | 0x80000000u);
          if (key > t0 + qi || key < LEAD) u = 0u;
          sc[i][qi] = u;
        }
        if (more) {
#pragma unroll
          for (int j = 0; j < 8; ++j) *(u32x4*)(wb + (lrow + 8 * j) * 144 + lpc * 16) = st[j];
        }
      } else {
#pragma unroll
        for (int qi = 0; qi < 4; ++qi) sc[i][qi] = 0u;
      }
    }
  }
  int* ng = (int*)(lds + 256);
  unsigned long long* mg = (unsigned long long*)(lds + 1024);
  unsigned long long* me = mg + 4 * 132;
  int* bg = (int*)(me + 4 * 132);
  int* be = bg + 4 * 132;
  unsigned T[4];
  {
    unsigned* hist = (unsigned*)(lds + 16384);
    int* sel = (int*)(lds + 512);
    unsigned pref[4] = {0u, 0u, 0u, 0u};
    int chi[4] = {0, 0, 0, 0};
    bool few[4] = {false, false, false, false};
    __syncthreads();
    bool small = false;
    int nb[4] = {0, 0, 0, 0};
#pragma unroll
    for (int pass = 0; pass < 3; ++pass) {
      if (pass == 2) {
        small = true;
#pragma unroll
        for (int q = 0; q < 4; ++q) small = small && (few[q] || nb[q] <= 64);
        if (small) break;
      }
      {
        const u32x4 z = {0u, 0u, 0u, 0u};
#pragma unroll
        for (int j = 0; j < 8; ++j) ((u32x4*)hist)[tid + 512 * j] = z;
      }
      __syncthreads();
#pragma unroll
      for (int i = 0; i < 17; ++i) {
#pragma unroll
        for (int q = 0; q < 4; ++q) {
          const unsigned u = sc[i][q];
          bool part; unsigned bin;
          if (pass == 0) { part = (u != 0u); bin = (u >> 22) + (lane & 3) * 1024; }
          else if (pass == 1) { part = (u != 0u) && ((u >> 22) == pref[q]) && !few[q]; bin = ((u >> 12) & 1023u) + (lane & 3) * 1024; }
          else { part = (u != 0u) && ((u >> 12) == pref[q]) && !few[q]; bin = u & 4095u; }
          if (part) atomicAdd(hist + q * 4096 + bin, 1u);
        }
      }
      __syncthreads();
      if (w < 4) {
        const int q = w;
        const unsigned* hq = hist + q * 4096;
        const int need = 256 - chi[q];
        int G = 0;
        if (pass < 2) {
#pragma unroll
          for (int rep = 0; rep < 4; ++rep)
#pragma unroll
            for (int j = 0; j < 16; ++j) G += (int)hq[rep * 1024 + 16 * lane + ((j + lane) & 15)];
        } else {
#pragma unroll 8
          for (int j = 0; j < 64; ++j) G += (int)hq[64 * lane + ((j + lane) & 63)];
        }
        int S = G;
        for (int o = 1; o < 64; o <<= 1) { int x = __shfl_down(S, o); if (lane + o < 64) S += x; }
        const unsigned long long mk = __ballot(S >= need);
        int B = 0, cg2 = 0, fw = 0, nbin = 0;
        if (mk == 0ull) {
          fw = 1;
        } else {
          const int ks = 63 - __clzll(mk);
          const int above = (ks < 63) ? __shfl(S, ks + 1) : 0;
          int hh;
          if (pass < 2) {
            hh = 0;
            if (lane < 16) hh = (int)(hq[16 * ks + lane] + hq[1024 + 16 * ks + lane] + hq[2048 + 16 * ks + lane] + hq[3072 + 16 * ks + lane]);
          } else {
            hh = (int)hq[64 * ks + lane];
          }
          int s2 = hh;
          for (int o = 1; o < 64; o <<= 1) { int x = __shfl_down(s2, o); if (lane + o < 64) s2 += x; }
          const unsigned long long m2 = __ballot(above + s2 >= need);
          const int Ls = 63 - __clzll(m2);
          B = (pass < 2 ? 16 : 64) * ks + Ls;
          nbin = __shfl(hh, Ls);
          cg2 = above + __shfl(s2, Ls) - nbin;
        }
        if (lane == 0) { sel[q * 4 + 0] = B; sel[q * 4 + 1] = chi[q] + cg2; sel[q * 4 + 2] = fw; sel[q * 4 + 3] = nbin; }
      }
      __syncthreads();
#pragma unroll
      for (int q = 0; q < 4; ++q) {
        if (!few[q]) {
          pref[q] = (pref[q] << (pass < 2 ? 10 : 12)) | (unsigned)sel[q * 4 + 0];
          chi[q] = sel[q * 4 + 1];
          nb[q] = sel[q * 4 + 3];
          if (pass == 0) few[q] = sel[q * 4 + 2] != 0;
        }
      }
    }
    if (small) {
      unsigned* lst = hist;
      int* lcnt = sel + 16;
      if (tid < 4) lcnt[tid] = 0;
      __syncthreads();
#pragma unroll
      for (int i = 0; i < 17; ++i)
#pragma unroll
        for (int q = 0; q < 4; ++q) {
          const unsigned u = sc[i][q];
          if (!few[q] && u != 0u && (u >> 12) == pref[q]) { const int pos = atomicAdd(lcnt + q, 1); lst[q * 64 + pos] = u; }
        }
      __syncthreads();
      if (w < 4) {
        const int q = w, n = lcnt[q], need = 256 - chi[q];
        const unsigned e = lane < n ? lst[q * 64 + lane] : 0u;
        int rank = 0;
        for (int k = 0; k < n; ++k) rank += (lst[q * 64 + k] > e) ? 1 : 0;
        unsigned cand = (lane < n && rank <= need - 1) ? e : 0xFFFFFFFFu;
        for (int o = 32; o > 0; o >>= 1) { const unsigned x = (unsigned)__shfl_xor((int)cand, o); cand = x < cand ? x : cand; }
        if (lane == 0) sel[q * 4 + 0] = (int)cand;
      }
      __syncthreads();
#pragma unroll
      for (int q = 0; q < 4; ++q) T[q] = few[q] ? 0u : (unsigned)sel[q * 4 + 0];
    } else {
#pragma unroll
      for (int q = 0; q < 4; ++q) T[q] = few[q] ? 0u : pref[q];
    }
  }
  unsigned* cntb = (unsigned*)mg;
  unsigned* baseb = (unsigned*)bg;
#pragma unroll
  for (int i = 0; i < 17; ++i) {
    const int c = 1 + w + 8 * i;
    if (c <= cmax) {
      unsigned mine = 0u;
#pragma unroll
      for (int q = 0; q < 4; ++q) {
        const unsigned pk = (unsigned)__popcll(__ballot(sc[i][q] > T[q])) | ((unsigned)__popcll(__ballot(sc[i][q] == T[q])) << 16);
        mine = (lane == q) ? pk : mine;
      }
      if (lane < 4) cntb[lane * 132 + c] = mine;
    }
  }
  __syncthreads();
  if (w < 4) {
    const int q = w;
    int cg_ = 0, ce_ = 0;
    for (int base = 0; base <= cmax; base += 64) {
      const int c = base + lane;
      const bool in = (c >= 1) && (c <= cmax);
      const unsigned cv = in ? cntb[q * 132 + c] : 0u;
      const int v1 = (int)(cv & 0xffffu), v2 = (int)(cv >> 16);
      int i1 = v1, i2 = v2;
      for (int o = 1; o < 64; o <<= 1) {
        int x1 = __shfl_up(i1, o), x2 = __shfl_up(i2, o);
        if (lane >= o) { i1 += x1; i2 += x2; }
      }
      if (in) baseb[q * 132 + c] = (unsigned)(cg_ + i1 - v1) | ((unsigned)(ce_ + i2 - v2) << 16);
      cg_ += __shfl(i1, 63);
      ce_ += __shfl(i2, 63);
    }
    if (lane == 0) ng[q] = cg_;
  }
  __syncthreads();
  const unsigned long long lt = (1ull << lane) - 1ull;
#pragma unroll
  for (int i = 0; i < 17; ++i) {
    const int c = 1 + w + 8 * i;
    if (c <= cmax) {
      const int key = c * 64 + lane;
#pragma unroll
      for (int q = 0; q < 4; ++q) {
        u16* out = p.IDX + (size_t)(b * PP + t0 + q) * 256;
        const bool gt = sc[i][q] > T[q];
        const bool eq = (sc[i][q] == T[q]) && (T[q] != 0u);
        const unsigned long long m1 = __ballot(gt), m2 = __ballot(eq);
        if ((m1 | m2) != 0ull) {
          const unsigned bb = baseb[q * 132 + c];
          if (gt) out[(int)(bb & 0xffffu) + __popcll(m1 & lt)] = (u16)key;
          if (eq) { const int pos = ng[q] + (int)(bb >> 16) + __popcll(m2 & lt); if (pos < 256) out[pos] = (u16)key; }
        }
      }
    }
  }
#pragma unroll
  for (int q = 0; q < 4; ++q) {
    if (T[q] == 0u) {
      u16* out = p.IDX + (size_t)(b * PP + t0 + q) * 256;
      if (tid < 256 && tid >= ng[q]) out[tid] = (u16)0xFFFF;
    }
  }
}

constexpr int AT_STAGE = 23040;
template <int DK, int MODE>
DI void attn_unit(const Params& p, int l, int b, int head, int qu, char* lds) {
  const int tid = opaque_tid(), lane = tid & 63, w = tid >> 6, r = lane & 31, h = lane >> 5;
  constexpr int KS = DK / 16, KST = DK + 8;
  const int q0 = qu * 256, qw0 = q0 + w * 32, qw = qw0 + r;
  const size_t tokq = (size_t)b * PP + qw;
  const u16 *qptr, *kptr, *vtptr, *gptr;
  int ldk;
  if (MODE == 0) {
    qptr = p.H + tokq * LDH + HQ_A + head * 64; kptr = p.H + (size_t)b * PP * LDH + HK_A + head * 64; ldk = LDH;
    vtptr = p.VtA + ((size_t)b * 512 + head * 64) * PP; gptr = p.H + tokq * LDH + HG_A + head * 64;
  } else if (MODE == 1) {
    qptr = p.Qm + tokq * 768 + head * 96; kptr = p.Km + (size_t)b * PP * 512 + head * 64; ldk = 512;
    vtptr = p.VtB + ((size_t)b * 512 + head * 64) * PP; gptr = p.H + tokq * LDH + HG_B + head * 64;
  } else {
    qptr = p.H + tokq * LDH + HQ_D + head * 64; kptr = p.H + (size_t)b * PP * LDH + HK_D + (head >> 2) * 64; ldk = LDH;
    vtptr = p.VtD + ((size_t)b * 128 + (head >> 2) * 64) * PP; gptr = p.H + tokq * LDH + HG_D + head * 64;
  }
  const float* cum = p.CUM + (size_t)(b * 8 + head) * PP;
  float* btab = (float*)(lds + 2 * AT_STAGE);
  u32x2 gpre[2][4];
#pragma unroll
  for (int d = 0; d < 2; ++d)
#pragma unroll
    for (int g = 0; g < 4; ++g) gpre[d][g] = *(const u32x2*)(gptr + d * 32 + 8 * g + 4 * h);
  bf16x8 qf[KS];
#pragma unroll
  for (int ks = 0; ks < KS; ++ks) qf[ks] = *(const bf16x8*)(qptr + ks * 16 + 8 * h);
  float cref = 0.f;
  if (MODE == 0) cref = cum[q0];
  if (MODE == 2) { if (tid < 128) btab[tid] = p.rel_bias[t5_bucket(tid) * 16 + 8 + head] * LOG2E; }
  const float sc2 = (MODE == 1 ? 0.10206207261596577f : 0.125f) * LOG2E;
  const int kt_hi = qu * 4 + 3;
  int kt_lo = 1;
  if (MODE == 2) { kt_lo = qu * 4 - 2; if (kt_lo < 1) kt_lo = 1; }
  u32x4 rk, rk2, rv;
  float re = 0.f;
  const int srow = tid >> 3, sc8 = tid & 7;
  auto gload = [&](int kt) {
    const int k0 = kt * 64;
    rk = *(const u32x4*)(kptr + (size_t)(k0 + srow) * ldk + sc8 * 8);
    if (MODE == 1) { if (tid < 256) rk2 = *(const u32x4*)(p.Kpe + ((size_t)b * PP + k0 + (tid >> 2)) * 32 + (tid & 3) * 8); }
    rv = *(const u32x4*)(vtptr + (size_t)srow * PP + k0 + sc8 * 8);
    if (MODE == 0) { if (tid < 64) re = (cum[k0 + tid] - cref) * LOG2E; }
  };
  auto lstore = [&](int st) {
    char* base = lds + st * AT_STAGE;
    *(u32x4*)(base + (srow * KST + sc8 * 8) * 2) = rk;
    if (MODE == 1) { if (tid < 256) *(u32x4*)(base + ((tid >> 2) * KST + 64 + (tid & 3) * 8) * 2) = rk2; }
    char* vb = base + 64 * KST * 2;
    u32x2 lo = {rv[0], rv[1]}, hi = {rv[2], rv[3]};
    *(u32x2*)(vb + (srow * 68 + sc8 * 8) * 2) = lo;
    *(u32x2*)(vb + (srow * 68 + sc8 * 8 + 4) * 2) = hi;
    if (MODE == 0) { if (tid < 64) *(float*)(vb + 64 * 68 * 2 + tid * 4) = re; }
  };
  f32x16 o[2];
#pragma unroll
  for (int d = 0; d < 2; ++d)
#pragma unroll
    for (int i = 0; i < 16; ++i) o[d][i] = 0.f;
  float m = NEGL, lsum = 0.f;
  float qn = 0.f, kmx = 0.f;
  int* stopf = (int*)(lds + 2 * AT_STAGE + 1024);
  if (MODE == 0) {
#pragma unroll
    for (int ks = 0; ks < KS; ++ks) {
      const u32x4 qq = __builtin_bit_cast(u32x4, qf[ks]);
#pragma unroll
      for (int e = 0; e < 4; ++e) { const float a = bf_lo(qq[e]), b2 = bf_hi(qq[e]); qn += a * a + b2 * b2; }
    }
    qn += __shfl_xor(qn, 32);
    qn = sqrtf(qn) * 1.01f;
    kmx = __uint_as_float(p.ctr[64 + l * 16 + b * 8 + head]);
  }
  gload(kt_hi); lstore(0);
  __syncthreads();
  for (int kt = kt_hi; kt >= kt_lo; --kt) {
    const bool more = kt > kt_lo;
    if (more) gload(kt - 1);
    float cnext = 0.f;
    if (MODE == 0) { if (more) cnext = cum[(kt - 1) * 64 + 63]; }
    const int st = (kt_hi - kt) & 1;
    const int k0 = kt * 64;
    bool active = k0 <= qw0 + 31;
    if (MODE == 2) active = active && (k0 + 63 >= qw0 - 127);
    if (active) {
      const char* kb = lds + st * AT_STAGE;
      const char* vb = kb + 64 * KST * 2;
      f32x16 s[2];
      bf16x8 kf[2][KS];
#pragma unroll
      for (int kr = 0; kr < 2; ++kr)
#pragma unroll
        for (int ks = 0; ks < KS; ++ks) kf[kr][ks] = *(const bf16x8*)(kb + ((kr * 32 + r) * KST + ks * 16 + 8 * h) * 2);
      __builtin_amdgcn_sched_barrier(0);
#pragma unroll
      for (int kr = 0; kr < 2; ++kr) {
#pragma unroll
        for (int i = 0; i < 16; ++i) s[kr][i] = 0.f;
#pragma unroll
        for (int ks = 0; ks < KS; ++ks) s[kr] = MFMA32(kf[kr][ks], qf[ks], s[kr]);
      }
      u32x4 vfr[2][2][2];
#pragma unroll
      for (int kr = 0; kr < 2; ++kr)
#pragma unroll
        for (int s2 = 0; s2 < 2; ++s2)
#pragma unroll
          for (int d = 0; d < 2; ++d) {
            const char* va = vb + ((d * 32 + r) * 68 + kr * 32 + s2 * 16 + 4 * h) * 2;
            const u32x2 lo = *(const u32x2*)va;
            const u32x2 hi = *(const u32x2*)(va + 16);
            vfr[kr][s2][d] = (u32x4){lo[0], lo[1], hi[0], hi[1]};
          }
      __builtin_amdgcn_sched_barrier(0);
      const bool need_mask = (MODE == 2) || (k0 + 63 > qw0) || (k0 < LEAD);
      const bool rawpath = (MODE == 1) && !need_mask;
      float tmax = NEGL;
      const f32x2 sc2v = {sc2, sc2};
      if (rawpath) {
#pragma unroll
        for (int kr = 0; kr < 2; ++kr)
#pragma unroll
          for (int i = 0; i < 16; ++i) tmax = fmaxf(tmax, s[kr][i]);
        tmax *= sc2;
      } else {
#pragma unroll
        for (int kr = 0; kr < 2; ++kr) {
#pragma unroll
          for (int g = 0; g < 4; ++g) {
            f32x4 ev = {0.f, 0.f, 0.f, 0.f};
            if (MODE == 0) ev = *(const f32x4*)(vb + 64 * 68 * 2 + (kr * 32 + 8 * g + 4 * h) * 4);
#pragma unroll
            for (int e2 = 0; e2 < 2; ++e2) {
              const int i = 4 * g + 2 * e2;
              f32x2 v2 = {s[kr][i], s[kr][i + 1]};
              if (MODE == 0) { const f32x2 e2v = {ev[2 * e2], ev[2 * e2 + 1]}; v2 = v2 * sc2v - e2v; }
              else v2 = v2 * sc2v;
#pragma unroll
              for (int e1 = 0; e1 < 2; ++e1) {
                const int key = k0 + kr * 32 + 8 * g + 4 * h + 2 * e2 + e1;
                float v = v2[e1];
                if (MODE == 2) v += btab[(qw - key) & 127];
                if (need_mask) {
                  bool ok = (key <= qw) && (key >= LEAD);
                  if (MODE == 2) ok = ok && (qw - key < 128);
                  v = ok ? v : NEGL;
                }
                s[kr][i + e1] = v;
                tmax = fmaxf(tmax, v);
              }
            }
          }
        }
      }
      tmax = fmaxf(tmax, __shfl_xor(tmax, 32));
      const float mn = fmaxf(m, tmax);
      const float alpha = __builtin_amdgcn_exp2f(m - mn);
      const bool resc = __any(m != mn);
      m = mn;
      f32x2 ps2 = {0.f, 0.f};
      const f32x2 mnv = {mn, mn};
      const f32x2 scx = rawpath ? sc2v : (f32x2){1.f, 1.f};
#pragma unroll
      for (int kr = 0; kr < 2; ++kr)
#pragma unroll
        for (int i = 0; i < 16; i += 2) {
          f32x2 v2 = {s[kr][i], s[kr][i + 1]};
          v2 = v2 * scx - mnv;
          f32x2 p2 = {__builtin_amdgcn_exp2f(v2[0]), __builtin_amdgcn_exp2f(v2[1])};
          s[kr][i] = p2[0]; s[kr][i + 1] = p2[1];
          ps2 += p2;
        }
      const float ps = ps2[0] + ps2[1];
      lsum = lsum * alpha + ps;
      if (resc)
#pragma unroll
      for (int d = 0; d < 2; ++d)
#pragma unroll
        for (int i = 0; i < 16; ++i) o[d][i] *= alpha;
#pragma unroll
      for (int kr = 0; kr < 2; ++kr) {
#pragma unroll
        for (int s2 = 0; s2 < 2; ++s2) {
          u32x4 pp = {pk2(s[kr][8 * s2], s[kr][8 * s2 + 1]), pk2(s[kr][8 * s2 + 2], s[kr][8 * s2 + 3]),
                      pk2(s[kr][8 * s2 + 4], s[kr][8 * s2 + 5]), pk2(s[kr][8 * s2 + 6], s[kr][8 * s2 + 7])};
          bf16x8 pf = __builtin_bit_cast(bf16x8, pp);
#pragma unroll
          for (int d = 0; d < 2; ++d) o[d] = MFMA32(__builtin_bit_cast(bf16x8, vfr[kr][s2][d]), pf, o[d]);
        }
      }
    }
    if (more) lstore(st ^ 1);
    if (MODE == 0) {
      if (more) {
        const float enext = (cnext - cref) * LOG2E;
        const bool okl = (qn * kmx * sc2 - enext) <= (m - 40.f);
        const bool okw = __all(okl);
        if (lane == 0) stopf[(kt & 1) * 8 + w] = okw ? 1 : 0;
      }
    }
    __syncthreads();
    if (MODE == 0) {
      if (more) {
        const int* sf = stopf + (kt & 1) * 8;
        if (sf[0] & sf[1] & sf[2] & sf[3] & sf[4] & sf[5] & sf[6] & sf[7]) break;
      }
    }
  }
  lsum += __shfl_xor(lsum, 32);
  float f;
  if (MODE == 2) {
    const float s2 = p.sinks[l * 8 + head] * LOG2E;
    const float mf = fmaxf(m, s2);
    const float em = __builtin_amdgcn_exp2f(m - mf);
    f = em / (lsum * em + __builtin_amdgcn_exp2f(s2 - mf));
  } else {
    f = lsum > 0.f ? 1.f / lsum : 0.f;
  }
  f *= (MODE == 0 ? SC_FOX : (MODE == 1 ? SC_MLA : SC_SWA));
  u16* mp = p.Mix + tokq * 2048 + (MODE == 0 ? 0 : (MODE == 1 ? 512 : 1536)) + head * 64;
#pragma unroll
  for (int d = 0; d < 2; ++d)
#pragma unroll
    for (int g = 0; g < 4; ++g) {
      const int dd = d * 32 + 8 * g + 4 * h;
      const u32x2 gv = gpre[d][g];
      float g0 = silu(bf_lo(gv[0])), g1 = silu(bf_hi(gv[0])), g2 = silu(bf_lo(gv[1])), g3 = silu(bf_hi(gv[1]));
      u32x2 ov = {pk2(o[d][4 * g] * f * g0, o[d][4 * g + 1] * f * g1), pk2(o[d][4 * g + 2] * f * g2, o[d][4 * g + 3] * f * g3)};
      *(u32x2*)(mp + dd) = ov;
    }
}

DI void dsa_job(const Params& p, int b, int tq0, char* lds) {
  const int tid = opaque_tid(), lane = tid & 63, w = tid >> 6;
  float* biasC = (float*)(lds + 143360);
  int* btab = (int*)(lds + 143360 + 1024);
  char* wl = lds + w * 17920;
  float* Pl = (float*)wl;
  int* kid = (int*)(wl + 8192);
  const int tq = tq0 + w;
  const size_t tok = (size_t)b * PP + tq;
  const u16* Hb = p.H + (size_t)b * PP * LDH;
  int kk[4], ku[4];
  {
    u32x2 iv = *(const u32x2*)(p.IDX + tok * 256 + 4 * lane);
    kk[0] = iv[0] & 0xffff; kk[1] = iv[0] >> 16; kk[2] = iv[1] & 0xffff; kk[3] = iv[1] >> 16;
#pragma unroll
    for (int j = 0; j < 4; ++j) ku[j] = (kk[j] == 0xFFFF) ? LEAD : kk[j];
    u32x4 kv4 = {(unsigned)ku[0], (unsigned)ku[1], (unsigned)ku[2], (unsigned)ku[3]};
    ((u32x4*)kid)[lane] = kv4;
  }
  u32x4 gvp[4];
#pragma unroll
  for (int hh = 0; hh < 4; ++hh) gvp[hh] = *(const u32x4*)(p.H + tok * LDH + HG_C + (((lane >> 3) & 1) * 4 + hh) * 64 + (lane & 7) * 8);
  __builtin_amdgcn_wave_barrier();
  const int ksub = lane >> 4, g = (lane >> 3) & 1, dc = lane & 7;
  {
    const int r = lane & 31, h = lane >> 5, pc = lane & 15;
    char* kst = wl + 9216;
    bf16x8 qb[8];
#pragma unroll
    for (int ks = 0; ks < 8; ++ks) {
      u32x4 v = {0u, 0u, 0u, 0u};
      if (r < 8 && (ks >> 2) == (r >> 2)) v = *(const u32x4*)(p.H + tok * LDH + HQ_C + r * 64 + (ks & 3) * 16 + 8 * h);
      qb[ks] = __builtin_bit_cast(bf16x8, v);
    }
    const u16* kbase = Hb + HK_C + pc * 8;
    u32x4 st0[8], st1[8];
#pragma unroll
    for (int s2 = 0; s2 < 8; ++s2) st0[s2] = *(const u32x4*)(kbase + (size_t)kid[4 * s2 + ksub] * LDH);
#pragma unroll
    for (int s2 = 0; s2 < 8; ++s2) st1[s2] = *(const u32x4*)(kbase + (size_t)kid[32 + 4 * s2 + ksub] * LDH);
    auto chunk = [&](int c, u32x4* stc) {
#pragma unroll
      for (int s2 = 0; s2 < 8; ++s2) *(u32x4*)(kst + (4 * s2 + ksub) * 272 + pc * 16) = stc[s2];
      if (c + 2 < 8) {
#pragma unroll
        for (int s2 = 0; s2 < 8; ++s2) stc[s2] = *(const u32x4*)(kbase + (size_t)kid[32 * (c + 2) + 4 * s2 + ksub] * LDH);
      }
      bf16x8 af[8];
#pragma unroll
      for (int ks = 0; ks < 8; ++ks) af[ks] = *(const bf16x8*)(kst + r * 272 + ks * 32 + 16 * h);
      __builtin_amdgcn_sched_barrier(0);
      f32x16 acc0, acc1;
#pragma unroll
      for (int i = 0; i < 16; ++i) { acc0[i] = 0.f; acc1[i] = 0.f; }
#pragma unroll
      for (int ks = 0; ks < 8; ks += 2) { acc0 = MFMA32(af[ks], qb[ks], acc0); acc1 = MFMA32(af[ks + 1], qb[ks + 1], acc1); }
      if (r < 8) {
#pragma unroll
        for (int i = 0; i < 16; ++i) Pl[(32 * c + crow(i, h)) * 8 + r] = acc0[i] + acc1[i];
      }
    };
#pragma unroll 1
    for (int c = 0; c < 8; c += 2) { chunk(c, st0); chunk(c + 1, st1); }
  }
  __builtin_amdgcn_wave_barrier();
  float lg[4][8];
#pragma unroll
  for (int j = 0; j < 4; ++j) {
    const f32x4 v0 = *(const f32x4*)(Pl + (4 * lane + j) * 8), v1 = *(const f32x4*)(Pl + (4 * lane + j) * 8 + 4);
#pragma unroll
    for (int e = 0; e < 4; ++e) { lg[j][e] = v0[e]; lg[j][4 + e] = v1[e]; }
  }
  int bk[4];
#pragma unroll
  for (int j = 0; j < 4; ++j) { int dist = tq - ku[j]; bk[j] = (dist < 128) ? btab[dist & 127] : 31; }
#pragma unroll
  for (int hd = 0; hd < 8; ++hd) {
    float mx = NEGL;
#pragma unroll
    for (int j = 0; j < 4; ++j) {
      float v = lg[j][hd] * 0.125f + biasC[bk[j] * 8 + hd];
      v = (kk[j] == 0xFFFF) ? NEGL : v;
      lg[j][hd] = v;
      mx = fmaxf(mx, v);
    }
    mx = wmax(mx);
    float sm = 0.f;
#pragma unroll
    for (int j = 0; j < 4; ++j) { float e = __expf(lg[j][hd] - mx); lg[j][hd] = e; sm += e; }
    sm = wsum(sm);
    const float inv = 1.f / sm;
#pragma unroll
    for (int j = 0; j < 4; ++j) lg[j][hd] *= inv;
  }
#pragma unroll
  for (int j = 0; j < 4; ++j) {
    f32x4 v0 = {lg[j][0], lg[j][1], lg[j][2], lg[j][3]}, v1 = {lg[j][4], lg[j][5], lg[j][6], lg[j][7]};
    *(f32x4*)(Pl + (4 * lane + j) * 8) = v0;
    *(f32x4*)(Pl + (4 * lane + j) * 8 + 4) = v1;
  }
  __builtin_amdgcn_wave_barrier();
  const u16* vb = Hb + HV_C + g * 64 + dc * 8;
  f32x2 acc2[4][4];
#pragma unroll
  for (int hh = 0; hh < 4; ++hh)
#pragma unroll
    for (int e = 0; e < 4; ++e) { acc2[hh][e][0] = 0.f; acc2[hh][e][1] = 0.f; }
  u32x4 vA[16], vB[16];
  auto pv_load = [&](int grp, u32x4* dst) {
#pragma unroll
    for (int s = 0; s < 16; ++s) dst[s] = *(const u32x4*)(vb + (size_t)kid[4 * (grp * 16 + s) + ksub] * LDH);
  };
  auto pv_fma = [&](int grp, const u32x4* src) {
#pragma unroll
    for (int s = 0; s < 16; ++s) {
      const int slot = 4 * (grp * 16 + s) + ksub;
      const f32x4 pp = *(const f32x4*)(Pl + slot * 8 + g * 4);
      const u32x4 vv = src[s];
#pragma unroll
      for (int hh = 0; hh < 4; ++hh) {
        const f32x2 ph = {pp[hh], pp[hh]};
#pragma unroll
        for (int e = 0; e < 4; ++e) {
          const f32x2 vf2 = {bf_lo(vv[e]), bf_hi(vv[e])};
          acc2[hh][e] += ph * vf2;
        }
      }
    }
  };
  pv_load(0, vA);
  pv_load(1, vB);
  pv_fma(0, vA);
  pv_load(2, vA);
  pv_fma(1, vB);
  pv_load(3, vB);
  pv_fma(2, vA);
  pv_fma(3, vB);
  float acc[4][8];
#pragma unroll
  for (int hh = 0; hh < 4; ++hh)
#pragma unroll
    for (int e = 0; e < 8; ++e) { float v = acc2[hh][e >> 1][e & 1]; v += __shfl_xor(v, 16); v += __shfl_xor(v, 32); acc[hh][e] = v; }
  if (ksub == 0) {
#pragma unroll
    for (int hh = 0; hh < 4; ++hh) {
      const int hd = g * 4 + hh;
      const u32x4 gv = gvp[hh];
      u32x4 ov;
#pragma unroll
      for (int e = 0; e < 4; ++e) ov[e] = pk2(acc[hh][2 * e] * SC_DSA * silu(bf_lo(gv[e])), acc[hh][2 * e + 1] * SC_DSA * silu(bf_hi(gv[e])));
      *(u32x4*)(p.Mix + tok * 2048 + 1024 + hd * 64 + dc * 8) = ov;
    }
  }
}

DI void outproj_tile(const Params& p, int mt, int nt, char* lds) {
  const int tid = opaque_tid(), lane = tid & 63, w = tid >> 6, r = lane & 31, h = lane >> 5;
  const int wm = w & 3, wn = w >> 2;
  const int m0 = mt * 256;
  gemm_tile<true>(p.Mix + (size_t)m0 * 2048, 2048, p.Wt_out + (size_t)nt * 128 * 2048, 2048, 2048, lds, [&](int mi, int ni, const f32x16& a) {
    const int tok = m0 + wm * 64 + mi * 32 + r;
    float* rp = p.R + (size_t)tok * DM + nt * 128 + wn * 64 + ni * 32;
#pragma unroll
    for (int g = 0; g < 4; ++g) {
      f32x4 v = *(const f32x4*)(rp + 8 * g + 4 * h);
#pragma unroll
      for (int e = 0; e < 4; ++e) v[e] = ALPHA * v[e] + a[4 * g + e];
      *(f32x4*)(rp + 8 * g + 4 * h) = v;
    }
  });
}

DI void ln_rows(const Params& p, int l) {
  const int tid = opaque_tid(), lane = tid & 63, w = tid >> 6;
  const float* gg = l < 0 ? p.ln0_g : p.ln_g + l * DM;
  const float* bb = l < 0 ? p.ln0_b : p.ln_b + l * DM;
  const int stride = gridDim.x * 8;
  auto loadrow = [&](int row, f32x4* dst) {
    if (l < 0) {
      const int b = row / PP, t = row - b * PP;
      const float* src = nullptr;
      if (t >= 128 && t < PV) src = p.x + ((size_t)b * SEQ + (t - 128)) * DM;
      else if (t >= LEAD && t < 128) src = p.meta + (size_t)(t - LEAD) * DM;
#pragma unroll
      for (int j = 0; j < 4; ++j) {
        if (src) dst[j] = *(const f32x4*)(src + lane * 4 + 256 * j);
        else { dst[j][0] = 0.f; dst[j][1] = 0.f; dst[j][2] = 0.f; dst[j][3] = 0.f; }
      }
    } else {
#pragma unroll
      for (int j = 0; j < 4; ++j) dst[j] = *(const f32x4*)(p.R + (size_t)row * DM + lane * 4 + 256 * j);
    }
  };
  f32x4 v[4], vn[4];
  int row = blockIdx.x * 8 + w;
  if (row < MT) loadrow(row, v);
  for (; row < MT; row += stride) {
    const int b = row / PP, t = row - b * PP;
    if (row + stride < MT) loadrow(row + stride, vn);
    float s = 0.f;
#pragma unroll
    for (int j = 0; j < 4; ++j) s += v[j][0] + v[j][1] + v[j][2] + v[j][3];
    const float mu = wsum(s) * (1.f / DM);
    float q = 0.f;
#pragma unroll
    for (int j = 0; j < 4; ++j)
#pragma unroll
      for (int e = 0; e < 4; ++e) { float d = v[j][e] - mu; q += d * d; }
    const float rstd = rsqrtf(wsum(q) * (1.f / DM) + 1e-5f);
#pragma unroll
    for (int j = 0; j < 4; ++j) {
      const int c = lane * 4 + 256 * j;
      f32x4 g4 = *(const f32x4*)(gg + c), b4 = *(const f32x4*)(bb + c);
      f32x4 y;
#pragma unroll
      for (int e = 0; e < 4; ++e) y[e] = (v[j][e] - mu) * rstd * g4[e] + b4[e];
      if (l == 3) {
        if (t >= 128 && t < PV) *(f32x4*)(p.out + ((size_t)b * SEQ + (t - 128)) * DM + c) = y;
      } else {
        *(f32x4*)(p.R + (size_t)row * DM + c) = y;
        u32x2 yb = {pk2(y[0], y[1]), pk2(y[2], y[3])};
        *(u32x2*)(p.Xb + (size_t)row * DM + c) = yb;
      }
    }
#pragma unroll
    for (int j = 0; j < 4; ++j) v[j] = vn[j];
  }
}

DI int map_in(int n) {
  if (n < 512) return n;
  if (n < 1024) return n;
  if (n < 1536) return 1544 + (n - 1024);
  if (n < 1792) return 2056 + (n - 1536);
  if (n < 1920) return 2312 + (n - 1792);
  if (n < 2432) return 2472 + (n - 1920);
  if (n < 2944) return 2984 + (n - 2432);
  if (n < 3072) return 3496 + (n - 2944);
  if (n < 3200) return 3624 + (n - 3072);
  if (n < 3712) return 3752 + (n - 3200);
  if (n < 4224) return 4336 + (n - 3712);
  if (n < 4736) return 4848 + (n - 4224);
  if (n < 4864) return 5360 + (n - 4736);
  if (n < 5376) return 5616 + (n - 4864);
  if (n < 5408) return 2440 + (n - 5376);
  if (n < 5472) return 4264 + (n - 5408);
  if (n < 5480) return 1536 + (n - 5472);
  if (n < 5488) return 4328 + (n - 5480);
  if (n < 5504) return -1;
  if (n < 6016) return 1024 + (n - 5504);
  return 5488 + (n - 6016);
}
DI void conv_weights(const Params& p, int l, char* lds) {
  const int tid = opaque_tid();
  float* tile = (float*)lds;
  struct TD { u16* dst; int K, k0, n0; };
  const int nn_l = tid & 63;
  auto loadtile = [&](int tI, float* rv, TD& d) {
    const float* src; const float* ksc = nullptr; int ldsrc, kind, kt, ntile;
    if (tI < 1536) { kind = 0; kt = tI / 96; ntile = tI % 96; src = p.w_in + (size_t)l * DM * D_IN; ldsrc = D_IN; d.K = DM; d.dst = p.Wt_in; }
    else if (tI < 2048) { int u = tI - 1536; kind = 1; kt = u / 16; ntile = u % 16; src = p.w_out + (size_t)l * 2048 * DM; ldsrc = DM; d.K = 2048; d.dst = p.Wt_out; }
    else if (tI < 2096) { int u = tI - 2048; kind = 2; kt = u / 12; ntile = u % 12; src = p.w_uq + (size_t)l * 256 * 768; ldsrc = 768; d.K = 256; d.dst = p.Wt_uq; ksc = p.gq + l * 256; }
    else { int u = tI - 2096; kind = 3; kt = u / 16; ntile = u % 16; src = p.w_ukv + (size_t)l * 128 * 1024; ldsrc = 1024; d.K = 128; d.dst = p.Wt_ukv; ksc = p.gkv + l * 128; }
    d.k0 = kt * 64; d.n0 = ntile * 64;
    const int n = d.n0 + nn_l;
    int sc;
    if (kind == 0) sc = map_in(n);
    else if (kind == 3) sc = (n < 512) ? ((n >> 6) * 128 + (n & 63)) : (((n - 512) >> 6) * 128 + 64 + (n & 63));
    else sc = n;
#pragma unroll
    for (int j = 0; j < 8; ++j) {
      const int kk = (tid >> 6) + 8 * j;
      float v = 0.f;
      if (sc >= 0) v = src[(size_t)(d.k0 + kk) * ldsrc + sc];
      if (ksc) v *= ksc[d.k0 + kk];
      rv[j] = v;
    }
  };
  float rv[8], rn[8];
  TD dc, dn;
  int tI = blockIdx.x;
  if (tI < 2128) loadtile(tI, rv, dc);
  for (; tI < 2128; tI += gridDim.x) {
    const int tN = tI + gridDim.x;
    if (tN < 2128) loadtile(tN, rn, dn);
#pragma unroll
    for (int j = 0; j < 8; ++j) tile[nn_l * 65 + (tid >> 6) + 8 * j] = rv[j];
    __syncthreads();
    {
      const int nn = tid >> 3, kc = (tid & 7) * 8;
      const float* tp = tile + nn * 65 + kc;
      u32x4 ov = {pk2(tp[0], tp[1]), pk2(tp[2], tp[3]), pk2(tp[4], tp[5]), pk2(tp[6], tp[7])};
      *(u32x4*)(dc.dst + (size_t)(dc.n0 + nn) * dc.K + dc.k0 + kc) = ov;
    }
    __syncthreads();
#pragma unroll
    for (int j = 0; j < 8; ++j) rv[j] = rn[j];
    dc = dn;
  }
}
DI void rope_table(const Params& p) {
  const int gt = blockIdx.x * NTHREADS + threadIdx.x;
  for (int i = gt; i < PP * 16; i += gridDim.x * NTHREADS) {
    const int t = i >> 4, c = i & 15;
    const float freq = powf(10000.f, -(float)c / 16.f);
    const float ang = (float)(t - LEAD) * freq;
    float sn, cs;
    sincosf(ang, &sn, &cs);
    p.ROPE[(size_t)t * 32 + c] = cs;
    p.ROPE[(size_t)t * 32 + 16 + c] = sn;
  }
}


#define XB_TMO      128
#define XB_XCNT(j)  (256  + 64 * (j))
#define XB_XSUB(j)  (1280 + 64 * (j))
#define XB_XGEN(j)  (2304 + 64 * (j))
#define XB_TOP      3328
#define XB_TOPGEN   3392
#define XCD_BAR_WORDS 3456
#define XB_SPIN_CAP (1u << 18)
DI unsigned xb_ld(unsigned* p) { return __hip_atomic_load(p, __ATOMIC_RELAXED, __HIP_MEMORY_SCOPE_AGENT); }
DI unsigned xb_add(unsigned* p, unsigned v) { return __hip_atomic_fetch_add(p, v, __ATOMIC_RELAXED, __HIP_MEMORY_SCOPE_AGENT); }
DI unsigned xb_xcc_id() { return (unsigned)__builtin_amdgcn_s_getreg((3 << 11) | 20) & 0xFu; }
#define XB_SPIN(cond, bar) do { unsigned _sp = 0; while (cond) { __builtin_amdgcn_s_sleep(1); \
    if ((++_sp & 255u) == 0u) { if (xb_ld(&(bar)[XB_TMO])) break; if (_sp > XB_SPIN_CAP) { atomicAdd(&(bar)[XB_TMO], 1u); break; } } } } while (0)
struct XcdBarrier { unsigned* bar; unsigned x; volatile unsigned* st; };
DI XcdBarrier xcd_barrier_post(unsigned* bar, volatile unsigned* st) {
  XcdBarrier b; b.bar = bar; b.x = xb_xcc_id(); b.st = st;
  if (threadIdx.x == 0) (void)xb_add(&bar[XB_XCNT(b.x)], 1u);
  return b;
}
DI void xcd_barrier_complete(unsigned* bar, unsigned x, unsigned& nloc, unsigned& nx) {
  const unsigned G = gridDim.x * gridDim.y * gridDim.z;
  unsigned sum, cnt, mine, sp = 0u;
  for (;;) {
    sum = 0u; cnt = 0u; mine = 0u;
#pragma unroll
    for (unsigned j = 0; j < 16; ++j) { const unsigned c = xb_ld(&bar[XB_XCNT(j)]); sum += c; cnt += (c > 0u) ? 1u : 0u; mine = (j == x) ? c : mine; }
    if (sum == G) break;
    __builtin_amdgcn_s_sleep(1);
    if ((++sp & 255u) == 0u) { if (xb_ld(&bar[XB_TMO])) break; if (sp > XB_SPIN_CAP) { atomicAdd(&bar[XB_TMO], 1u); break; } }
  }
  nloc = mine > 0u ? mine : 1u; nx = cnt > 0u ? cnt : 1u;
}
DI void xcd_barrier(const XcdBarrier& b) {
  asm volatile("s_waitcnt vmcnt(0)" ::: "memory");
  __syncthreads();
  if (threadIdx.x == 0) {
    unsigned* bar = b.bar;
    __builtin_amdgcn_s_waitcnt(0);
    unsigned nloc = b.st[0], nx = b.st[1];
    if (nloc == 0u) { xcd_barrier_complete(bar, b.x, nloc, nx); b.st[0] = nloc; b.st[1] = nx; }
    const unsigned old = xb_add(&bar[XB_XSUB(b.x)], 1u);
    const unsigned gen = old / nloc;
    if (old + 1u == (gen + 1u) * nloc) {
      __builtin_amdgcn_fence(__ATOMIC_RELEASE, "agent");
      asm volatile("s_waitcnt vmcnt(0)" ::: "memory");
      const unsigned og = xb_add(&bar[XB_TOP], 1u);
      const unsigned tg = og / nx;
      if (og + 1u == (tg + 1u) * nx) xb_add(&bar[XB_TOPGEN], 1u);
      else XB_SPIN(xb_ld(&bar[XB_TOPGEN]) == tg, bar);
      __builtin_amdgcn_fence(__ATOMIC_ACQUIRE, "agent");
      xb_add(&bar[XB_XGEN(b.x)], 1u);
      asm volatile("s_waitcnt vmcnt(0)" ::: "memory");
    } else {
      XB_SPIN(xb_ld(&bar[XB_XGEN(b.x)]) == gen, bar);
      __builtin_amdgcn_fence(__ATOMIC_ACQUIRE, "agent");
      asm volatile("s_waitcnt vmcnt(0)" ::: "memory");
    }
  }
  __syncthreads();
}

__global__ void __launch_bounds__(NTHREADS) mega(Params p) {
  extern __shared__ __attribute__((aligned(16))) char lds[];
  cg::grid_group grid = cg::this_grid();
  ln_rows(p, -1);
  conv_weights(p, 0, lds);
  rope_table(p);
  if (blockIdx.x == 0) {
    if (threadIdx.x < 256) p.ctr[threadIdx.x] = 0u;
    for (int i = threadIdx.x; i < XCD_BAR_WORDS; i += NTHREADS) p.bar[i] = 0u;
  }
  volatile unsigned* xst = (volatile unsigned*)(lds + LDS_JOB + 16);
  if (threadIdx.x == 0) { xst[0] = 0u; xst[1] = 0u; }
  grid.sync();
  const XcdBarrier xb = xcd_barrier_post(p.bar, xst);
  for (int l = 0; l < 4; ++l) {
    for (int rep = 0; rep < REP_P1; ++rep) {
      for (int j = blockIdx.x; j < 66 * 48; j += gridDim.x) inproj_tile(p, l, j / 48, j % 48, lds);
      xcd_barrier(xb);
    }
    for (int rep = 0; rep < REP_P2; ++rep) {
      constexpr int NTK = 2 * 2052, NUP = 66 * 14, NJ = NTK + NUP + 16;
      int pending = 0, par = 0;
      if (threadIdx.x == 0) pending = (int)atomicAdd(p.ctr + l * 2 + 8 * rep, 1u);
      for (;;) {
        const int j = next_job(p.ctr + l * 2 + 8 * rep, lds, pending, NJ, par);
        if (j >= NJ) break;
        if (j < 16) {
          cumsum_job(p, j, lds);
        } else if (j < 16 + NTK) {
          const int jj = j - 16;
          const int b = jj & 1, q = 2051 - (jj >> 1);
          topk_job(p, b, LEAD + 4 * q, lds);
        } else {
          const int u = j - 16 - NTK;
          upproj_tile(p, u / 14, u % 14, lds);
        }
      }
      xcd_barrier(xb);
    }
    for (int rep = 0; rep < REP_P3; ++rep) {
      constexpr int ND = 1056, NS = 528, NC = 2 * 1026, NJ = ND + NS + NC;
      {
        float* biasC = (float*)(lds + 143360);
        int* btab = (int*)(lds + 143360 + 1024);
        if (threadIdx.x < 256) biasC[threadIdx.x] = p.rel_bias[(threadIdx.x >> 3) * 16 + (threadIdx.x & 7)];
        if (threadIdx.x < 128) btab[threadIdx.x] = t5_bucket(threadIdx.x);
      }
      int pending = 0, par = 0;
      if (threadIdx.x == 0) pending = (int)atomicAdd(p.ctr + l * 2 + 1 + 8 * rep, 1u);
      for (;;) {
        const int j = next_job(p.ctr + l * 2 + 1 + 8 * rep, lds, pending, NJ, par);
        if (j >= NJ) break;
        if (j < ND) {
          const int qu = 32 - (j >> 5), rem = j & 31, kind = rem >> 4, b = (rem >> 3) & 1, head = rem & 7;
          if (kind == 0) attn_unit<64, 0>(p, l, b, head, qu, lds);
          else attn_unit<96, 1>(p, l, b, head, qu, lds);
        } else if (j < ND + NS) {
          const int u = j - ND;
          attn_unit<64, 2>(p, l, (u >> 3) & 1, u & 7, u >> 4, lds);
        } else {
          const int u = j - ND - NS;
          dsa_job(p, u & 1, LEAD + 8 * (u >> 1), lds);
        }
      }
      xcd_barrier(xb);
    }
    for (int j = blockIdx.x; j < 66 * 8; j += gridDim.x) {
      const int x = j & 7, a = j >> 3;
      outproj_tile(p, 2 * (a >> 1) + (x >> 2), 2 * (x & 3) + (a & 1), lds);
    }
    xcd_barrier(xb);
    ln_rows(p, l);
    if (l < 3) { conv_weights(p, l + 1, lds); xcd_barrier(xb); }
  }
}

extern "C" void kernel_launch(void* const* d_in, const int* in_sizes, int n_in, void* d_out, int out_size, void* d_ws, size_t ws_size,
                              hipStream_t stream) {
  static int grid = 0;
  if (grid == 0) {
    int dev = 0, cus = 0, per_cu = 0;
    hipGetDevice(&dev);
    hipDeviceGetAttribute(&cus, hipDeviceAttributeMultiprocessorCount, dev);
    if (hipFuncSetAttribute((const void*)mega, hipFuncAttributeMaxDynamicSharedMemorySize, LDS_BYTES) != hipSuccess) { fprintf(stderr, "hipFuncSetAttribute failed\n"); grid = -1; return; }
    hipOccupancyMaxActiveBlocksPerMultiprocessor(&per_cu, (const void*)mega, NTHREADS, LDS_BYTES);
    if (per_cu < 1) { fprintf(stderr, "occupancy query: %d\n", per_cu); grid = -1; return; }
    grid = cus * per_cu;
  }
  if (grid < 0) return;
  size_t off = 0;
  auto take = [&](size_t bytes) { size_t o = off; off += (bytes + 255) & ~(size_t)255; return (char*)d_ws + o; };
  Params p{};
  p.x = (const float*)d_in[0]; p.meta = (const float*)d_in[1]; p.ln0_g = (const float*)d_in[2]; p.ln0_b = (const float*)d_in[3];
  p.rel_bias = (const float*)d_in[4]; p.w_in = (const float*)d_in[5]; p.b_f = (const float*)d_in[6]; p.gq = (const float*)d_in[7];
  p.gkv = (const float*)d_in[8]; p.w_uq = (const float*)d_in[9]; p.w_ukv = (const float*)d_in[10]; p.sinks = (const float*)d_in[11];
  p.w_out = (const float*)d_in[12]; p.ln_g = (const float*)d_in[13]; p.ln_b = (const float*)d_in[14];
  p.out = (float*)d_out;
  p.ctr = (unsigned*)take(1024);
  p.bar = (unsigned*)take(XCD_BAR_WORDS * 4);
  p.Wt_in = (u16*)take((size_t)NIN * DM * 2);
  p.Wt_out = (u16*)take((size_t)DM * 2048 * 2);
  p.Wt_uq = (u16*)take((size_t)768 * 256 * 2);
  p.Wt_ukv = (u16*)take((size_t)1024 * 128 * 2);
  p.H = (u16*)take((size_t)MT * LDH * 2);
  p.Mix = (u16*)take((size_t)MT * 2048 * 2);
  p.Xb = p.Mix;
  p.VtA = (u16*)take((size_t)NB * 512 * PP * 2);
  p.VtD = (u16*)take((size_t)NB * 128 * PP * 2);
  p.R = (float*)take((size_t)MT * DM * 4);
  p.IDX = (u16*)take((size_t)MT * 256 * 2);
  p.IK = (u16*)take((size_t)MT * 64 * 2);
  p.Kpe = (u16*)take((size_t)MT * 32 * 2);
  p.IW = (float*)take((size_t)MT * 8 * 4);
  p.LOGF = (float*)take((size_t)NB * 8 * PP * 4);
  p.CUM = (float*)take((size_t)NB * 8 * PP * 4);
  p.ROPE = (float*)take((size_t)PP * 32 * 4);
  if (off > ws_size) { fprintf(stderr, "workspace too small: need %zu have %zu\n", off, ws_size); return; }
  {
    char* ob = (char*)d_out;
    p.Qm = (u16*)ob; ob += (size_t)MT * 768 * 2;
    p.Km = (u16*)ob; ob += (size_t)MT * 512 * 2;
    p.VtB = (u16*)ob; ob += (size_t)NB * 512 * PP * 2;
    if ((size_t)(ob - (char*)d_out) > (size_t)out_size * 4) { fprintf(stderr, "d_out too small for scratch\n"); return; }
  }
  hipMemsetAsync(p.ctr, 0, 1024 + XCD_BAR_WORDS * 4, stream);
  void* args[] = {&p};
  hipError_t e = hipLaunchCooperativeKernel((const void*)mega, dim3(grid), dim3(NTHREADS), args, LDS_BYTES, stream);
  if (e != hipSuccess) fprintf(stderr, "cooperative launch failed: %s (grid %d)\n", hipGetErrorString(e), grid);
}
```

```cpp
#include <hip/hip_runtime.h>
#include <hip/hip_cooperative_groups.h>
#include <cstdio>
namespace cg = cooperative_groups;

#define DI __device__ __forceinline__
typedef __attribute__((ext_vector_type(8))) short bf16x8;
typedef __attribute__((ext_vector_type(16))) float f32x16;
typedef __attribute__((ext_vector_type(4))) float f32x4;
typedef __attribute__((ext_vector_type(2))) float f32x2;
typedef __attribute__((ext_vector_type(2))) __bf16 bf2_t;
typedef __attribute__((ext_vector_type(4))) unsigned u32x4;
typedef __attribute__((ext_vector_type(2))) unsigned u32x2;
typedef unsigned short u16;
#define MFMA32(a, b, c) __builtin_amdgcn_mfma_f32_32x32x16_bf16((a), (b), (c), 0, 0, 0)

constexpr int NB = 2, PP = 8448, PV = 8320, LEAD = 112, DM = 1024, MT = NB * PP, SEQ = 8192;
constexpr int LDH = 5376, NIN = 6144;
constexpr int HQ_A = 0, HK_A = 512, HG_A = 1024, HCQ_B = 1536, HCKV_B = 1792, HG_B = 1920, HQ_C = 2432, HK_C = 2944, HV_C = 3072,
              HIQ_C = 3200, HG_C = 3712, HQ_D = 4224, HK_D = 4736, HG_D = 4864;
constexpr int D_IN = 6128;
constexpr float LOG2E = 1.4426950408889634f;
constexpr float NEGL = -1e30f;
constexpr float ALPHA = 1.681792830507429f;
constexpr int LDS_JOB = 147456;
constexpr int LDS_BYTES = LDS_JOB + 64;
constexpr int GEMM_STAGE = 55296;
constexpr int NTHREADS = 512;
#define REP_P1 1
#define REP_P2 1
#define REP_P3 1
#define SC_FOX 1.0f
#define SC_MLA 1.0f
#define SC_SWA 1.0f
#define SC_DSA 1.0f

struct Params {
  const float *x, *meta, *ln0_g, *ln0_b, *rel_bias, *w_in, *b_f, *gq, *gkv, *w_uq, *w_ukv, *sinks, *w_out, *ln_g, *ln_b;
  float* out;
  u16 *Wt_in, *Wt_out, *Wt_uq, *Wt_ukv;
  u16 *H, *Xb, *Mix, *VtA, *VtD, *VtB, *Qm, *Km, *Kpe, *IK, *IDX;
  float *R, *LOGF, *CUM, *IW, *ROPE;
  unsigned* ctr;
  unsigned* bar;
};

DI unsigned pk2(float a, float b) { f32x2 v = {a, b}; return __builtin_bit_cast(unsigned, __builtin_convertvector(v, bf2_t)); }
DI float bf_lo(unsigned u) { return __uint_as_float(u << 16); }
DI float bf_hi(unsigned u) { return __uint_as_float(u & 0xffff0000u); }
DI int opaque_tid() { int t = threadIdx.x; asm volatile("" : "+v"(t)); return t; }
DI int crow(int i, int h) { return (i & 3) + 8 * (i >> 2) + 4 * h; }
template <int CTRL> DI float dpp_mov(float v) { return __int_as_float(__builtin_amdgcn_mov_dpp(__float_as_int(v), CTRL, 0xF, 0xF, true)); }
DI float wsum(float v) {
  v += dpp_mov<0xB1>(v); v += dpp_mov<0x4E>(v); v += dpp_mov<0x141>(v); v += dpp_mov<0x140>(v);
  u32x2 r = __builtin_amdgcn_permlane16_swap(__float_as_uint(v), __float_as_uint(v), false, false);
  v = __uint_as_float(r[0]) + __uint_as_float(r[1]);
  r = __builtin_amdgcn_permlane32_swap(__float_as_uint(v), __float_as_uint(v), false, false);
  return __uint_as_float(r[0]) + __uint_as_float(r[1]);
}
DI float wmax(float v) {
  v = fmaxf(v, dpp_mov<0xB1>(v)); v = fmaxf(v, dpp_mov<0x4E>(v)); v = fmaxf(v, dpp_mov<0x141>(v)); v = fmaxf(v, dpp_mov<0x140>(v));
  u32x2 r = __builtin_amdgcn_permlane16_swap(__float_as_uint(v), __float_as_uint(v), false, false);
  v = fmaxf(__uint_as_float(r[0]), __uint_as_float(r[1]));
  r = __builtin_amdgcn_permlane32_swap(__float_as_uint(v), __float_as_uint(v), false, false);
  return fmaxf(__uint_as_float(r[0]), __uint_as_float(r[1]));
}
template <int CTRL> DI int dpp_movi(int v) { return __builtin_amdgcn_mov_dpp(v, CTRL, 0xF, 0xF, true); }
template <bool UP> DI int wscan(int v, int lane, int& total) {
  int acc = v, tot = v, o;
  o = dpp_movi<0xB1>(tot);  if (((lane & 1) != 0) == UP) acc += o;  tot += o;
  o = dpp_movi<0x4E>(tot);  if (((lane & 2) != 0) == UP) acc += o;  tot += o;
  o = dpp_movi<0x141>(tot); if (((lane & 4) != 0) == UP) acc += o;  tot += o;
  o = dpp_movi<0x140>(tot); if (((lane & 8) != 0) == UP) acc += o;  tot += o;
  u32x2 r = __builtin_amdgcn_permlane16_swap((unsigned)tot, (unsigned)tot, false, false);
  o = (int)((lane & 16) ? r[0] : r[1]); if (((lane & 16) != 0) == UP) acc += o; tot += o;
  r = __builtin_amdgcn_permlane32_swap((unsigned)tot, (unsigned)tot, false, false);
  o = (int)((lane & 32) ? r[0] : r[1]); if (((lane & 32) != 0) == UP) acc += o; tot += o;
  total = tot;
  return acc;
}
DI int wsumi(int v) { for (int o = 32; o > 0; o >>= 1) v += __shfl_xor(v, o); return v; }
DI float silu(float g) { return g / (1.f + __expf(-g)); }
DI float dot2(unsigned a, unsigned b, float c) { return __builtin_amdgcn_fdot2_f32_bf16(__builtin_bit_cast(bf2_t, a), __builtin_bit_cast(bf2_t, b), c, false); }
template <int CTRL> DI float dpp_add(float v) { return v + __int_as_float(__builtin_amdgcn_mov_dpp(__float_as_int(v), CTRL, 0xF, 0xF, true)); }
DI int t5_bucket(int n) {
  if (n < 16) return n;
  int lg = 16 + (int)(logf((float)n / 16.f) / logf(8.f) * 16.f);
  return lg < 31 ? lg : 31;
}

DI int next_job(unsigned* ctr, char* lds, int& pending, int njobs, int& par) {
  int* sj = (int*)(lds + LDS_JOB);
  if (threadIdx.x == 0) sj[par] = pending;
  __syncthreads();
  const int j = sj[par];
  par ^= 1;
  if (threadIdx.x == 0 && j < njobs) pending = (int)atomicAdd(ctr, 1u);
  return j;
}

template <bool SWAP, class Epi>
DI void gemm_tile(const u16* __restrict__ A, int lda, const u16* __restrict__ Bw, int ldb, int K, char* lds, Epi epi) {
  const int tid = opaque_tid(), lane = tid & 63, w = tid >> 6, r = lane & 31, h = lane >> 5;
  const int wm = w & 3, wn = w >> 2;
  f32x16 acc[2][2];
#pragma unroll
  for (int a = 0; a < 2; ++a)
#pragma unroll
    for (int b = 0; b < 2; ++b)
#pragma unroll
      for (int i = 0; i < 16; ++i) acc[a][b][i] = 0.f;
  const int lrow = tid >> 3, lkc = tid & 7;
  u32x4 ra0[4], rb0[2], ra1[4], rb1[2];
  const u16* ap = A + (size_t)lrow * lda + lkc * 8;
  const u16* bp = Bw + (size_t)lrow * ldb + lkc * 8;
  const int nk = K >> 6;
  auto gload = [&](int kt, u32x4* ra, u32x4* rb) {
#pragma unroll
    for (int j = 0; j < 4; ++j) ra[j] = *(const u32x4*)(ap + (size_t)(64 * j) * lda + kt * 64);
#pragma unroll
    for (int j = 0; j < 2; ++j) rb[j] = *(const u32x4*)(bp + (size_t)(64 * j) * ldb + kt * 64);
  };
  auto lstore = [&](int st, const u32x4* ra, const u32x4* rb) {
    char* base = lds + st * GEMM_STAGE;
#pragma unroll
    for (int j = 0; j < 4; ++j) *(u32x4*)(base + ((lrow + 64 * j) * 72 + lkc * 8) * 2) = ra[j];
#pragma unroll
    for (int j = 0; j < 2; ++j) *(u32x4*)(base + 36864 + ((lrow + 64 * j) * 72 + lkc * 8) * 2) = rb[j];
  };
  auto compute = [&](int st) {
    const char* as = lds + st * GEMM_STAGE;
    const char* bs = as + 36864;
#pragma unroll
    for (int ks = 0; ks < 4; ++ks) {
      bf16x8 af[2], bfr[2];
#pragma unroll
      for (int mi = 0; mi < 2; ++mi) af[mi] = *(const bf16x8*)(as + ((wm * 64 + mi * 32 + r) * 72 + ks * 16 + 8 * h) * 2);
#pragma unroll
      for (int ni = 0; ni < 2; ++ni) bfr[ni] = *(const bf16x8*)(bs + ((wn * 64 + ni * 32 + r) * 72 + ks * 16 + 8 * h) * 2);
#pragma unroll
      for (int mi = 0; mi < 2; ++mi)
#pragma unroll
        for (int ni = 0; ni < 2; ++ni) {
          if (SWAP) acc[mi][ni] = MFMA32(bfr[ni], af[mi], acc[mi][ni]);
          else acc[mi][ni] = MFMA32(af[mi], bfr[ni], acc[mi][ni]);
        }
    }
  };
  gload(0, ra0, rb0);
  lstore(0, ra0, rb0);
  gload(1, ra1, rb1);
  __syncthreads();
  for (int kt = 0; kt < nk; kt += 2) {
    if (kt + 2 < nk) gload(kt + 2, ra0, rb0);
    compute(0);
    lstore(1, ra1, rb1);
    __syncthreads();
    if (kt + 3 < nk) gload(kt + 3, ra1, rb1);
    compute(1);
    if (kt + 2 < nk) lstore(0, ra0, rb0);
    __syncthreads();
  }
#pragma unroll
  for (int mi = 0; mi < 2; ++mi)
#pragma unroll
    for (int ni = 0; ni < 2; ++ni) epi(mi, ni, acc[mi][ni]);
}

DI void store_rowmajor(u16* dst, const f32x16& a, int h, float sc) {
#pragma unroll
  for (int kp = 0; kp < 2; ++kp) {
    const int g = 2 * kp;
    unsigned ax = pk2(a[4 * g] * sc, a[4 * g + 1] * sc), ay = pk2(a[4 * g + 2] * sc, a[4 * g + 3] * sc);
    unsigned bx = pk2(a[4 * g + 4] * sc, a[4 * g + 5] * sc), by = pk2(a[4 * g + 6] * sc, a[4 * g + 7] * sc);
    const u32x2 rx = __builtin_amdgcn_permlane32_swap(ax, bx, false, false);
    const u32x2 ry = __builtin_amdgcn_permlane32_swap(ay, by, false, false);
    const u32x4 v = {rx[0], ry[0], rx[1], ry[1]};
    *(u32x4*)(dst + 8 * (g + h)) = v;
  }
}
DI void store_rope(u16* dst, const f32x16& a, int h, float sc, const float* rp) {
#pragma unroll
  for (int g = 0; g < 2; ++g) {
    f32x4 cs = *(const f32x4*)(rp + 8 * g + 4 * h);
    f32x4 sn = *(const f32x4*)(rp + 16 + 8 * g + 4 * h);
    float o1[4], o2[4];
#pragma unroll
    for (int e = 0; e < 4; ++e) {
      float x1 = a[4 * g + e] * sc, x2 = a[8 + 4 * g + e] * sc;
      o1[e] = x1 * cs[e] - x2 * sn[e];
      o2[e] = x1 * sn[e] + x2 * cs[e];
    }
    u32x2 v1 = {pk2(o1[0], o1[1]), pk2(o1[2], o1[3])};
    u32x2 v2 = {pk2(o2[0], o2[1]), pk2(o2[2], o2[3])};
    *(u32x2*)(dst + 8 * g + 4 * h) = v1;
    *(u32x2*)(dst + 16 + 8 * g + 4 * h) = v2;
  }
}
DI void store_transposed(u16* dst, const f32x16& a, int h, const float* rs  ) {
#pragma unroll
  for (int g = 0; g < 4; ++g) {
    float s0 = 1.f, s1 = 1.f, s2 = 1.f, s3 = 1.f;
    if (rs) { f32x4 sv = *(const f32x4*)(rs + 8 * g + 4 * h); s0 = sv[0]; s1 = sv[1]; s2 = sv[2]; s3 = sv[3]; }
    u32x2 v = {pk2(a[4 * g] * s0, a[4 * g + 1] * s1), pk2(a[4 * g + 2] * s2, a[4 * g + 3] * s3)};
    *(u32x2*)(dst + 8 * g + 4 * h) = v;
  }
}

DI void inproj_tile(const Params& p, int l, int mt, int nt, char* lds) {
  const int tid = opaque_tid(), lane = tid & 63, w = tid >> 6, r = lane & 31, h = lane >> 5;
  const int wm = w & 3, wn = w >> 2;
  const int m0 = mt * 256;
  const u16* A = p.Xb + (size_t)m0 * DM;
  const u16* Bw = p.Wt_in + (size_t)nt * 128 * DM;
  if (nt < 42) {
    float ssq = 0.f;
    gemm_tile<true>(A, DM, Bw, DM, DM, lds, [&](int mi, int ni, const f32x16& a) {
      const int tok = m0 + wm * 64 + mi * 32 + r;
      store_rowmajor(p.H + (size_t)tok * LDH + nt * 128 + wn * 64 + ni * 32, a, h, 1.f);
      if (nt >= 4 && nt < 8) {
        if (ni == 0) ssq = 0.f;
#pragma unroll
        for (int i = 0; i < 16; ++i) ssq += a[i] * a[i];
        if (ni == 1) {
          float tot = ssq + __shfl_xor(ssq, 32);
          tot = wmax(tot);
          if (lane == 0) atomicMax(p.ctr + 64 + l * 16 + (m0 / PP) * 8 + (nt - 4) * 2 + wn, __float_as_uint(sqrtf(tot) * 1.01f));
        }
      }
    });
  } else if (nt == 42) {
    gemm_tile<true>(A, DM, Bw, DM, DM, lds, [&](int mi, int ni, const f32x16& a) {
      const int tok = m0 + wm * 64 + mi * 32 + r;
      const int b = tok / PP, t = tok - b * PP;
      const int sub = wn * 2 + ni;
      if (sub == 0) {
        store_rope(p.Kpe + (size_t)tok * 32, a, h, 1.f, p.ROPE + (size_t)t * 32);
      } else if (sub == 1) {
        store_rowmajor(p.IK + (size_t)tok * 64, a, h, 1.f);
      } else if (sub == 2) {
        store_rowmajor(p.IK + (size_t)tok * 64 + 32, a, h, 1.f);
      } else {
#pragma unroll
        for (int e = 0; e < 4; ++e) {
          const int hd = e + 4 * h;
          float xv = a[e] + p.b_f[l * 8 + hd];
          float lf = fminf(xv, 0.f) - log1pf(expf(-fabsf(xv)));
          p.LOGF[(size_t)(b * 8 + hd) * PP + t] = lf;
          p.IW[(size_t)tok * 8 + hd] = a[4 + e];
        }
      }
    });
  } else {
    u16* vt; int nv, c0;
    if (nt < 47) { vt = p.VtA; nv = 512; c0 = (nt - 43) * 128; } else { vt = p.VtD; nv = 128; c0 = 0; }
    gemm_tile<false>(A, DM, Bw, DM, DM, lds, [&](int mi, int ni, const f32x16& a) {
      const int b = m0 / PP, t0 = m0 - b * PP + wm * 64 + mi * 32;
      const int col = c0 + wn * 64 + ni * 32 + r;
      store_transposed(vt + ((size_t)b * nv + col) * PP + t0, a, h, nullptr);
    });
  }
}

DI void upproj_tile(const Params& p, int mt, int nt14, char* lds) {
  const int tid = opaque_tid(), lane = tid & 63, w = tid >> 6, r = lane & 31, h = lane >> 5;
  const int wm = w & 3, wn = w >> 2;
  const int m0 = mt * 256;
  float* rs = (float*)(lds + 2 * GEMM_STAGE);
  const bool isq = nt14 < 6;
  {
    const int row = tid >> 1, half = tid & 1;
    const int kw = isq ? 128 : 64;
    const u16* src = p.H + (size_t)(m0 + row) * LDH + (isq ? HCQ_B : HCKV_B) + half * kw;
    float ss = 0.f;
    u32x4 rv[16];
#pragma unroll
    for (int c = 0; c < 8; ++c) rv[c] = *(const u32x4*)(src + c * 8);
    if (isq) {
#pragma unroll
      for (int c = 8; c < 16; ++c) rv[c] = *(const u32x4*)(src + c * 8);
    } else {
#pragma unroll
      for (int c = 8; c < 16; ++c) { rv[c][0] = 0u; rv[c][1] = 0u; rv[c][2] = 0u; rv[c][3] = 0u; }
    }
#pragma unroll
    for (int c = 0; c < 16; ++c)
#pragma unroll
      for (int e = 0; e < 4; ++e) { float a = bf_lo(rv[c][e]), b2 = bf_hi(rv[c][e]); ss += a * a + b2 * b2; }
    ss += __shfl_xor(ss, 1);
    if (half == 0) rs[row] = rsqrtf(ss / (isq ? 256.f : 128.f) + 1e-6f);
  }
  __syncthreads();
  if (isq) {
    const int nt = nt14;
    gemm_tile<true>(p.H + (size_t)m0 * LDH + HCQ_B, LDH, p.Wt_uq + (size_t)nt * 128 * 256, 256, 256, lds, [&](int mi, int ni, const f32x16& a) {
      const int lr = wm * 64 + mi * 32 + r;
      const int tok = m0 + lr;
      const int t = tok % PP;
      const int j32 = nt * 4 + wn * 2 + ni;
      const float sc = rs[lr];
      u16* dst = p.Qm + (size_t)tok * 768 + j32 * 32;
      if (j32 % 3 == 2) store_rope(dst, a, h, sc, p.ROPE + (size_t)t * 32);
      else store_rowmajor(dst, a, h, sc);
    });
  } else {
    const int nt = nt14 - 6;
    const u16* A = p.H + (size_t)m0 * LDH + HCKV_B;
    const u16* Bw = p.Wt_ukv + (size_t)nt * 128 * 128;
    if (nt < 4) {
      gemm_tile<true>(A, LDH, Bw, 128, 128, lds, [&](int mi, int ni, const f32x16& a) {
        const int lr = wm * 64 + mi * 32 + r;
        store_rowmajor(p.Km + (size_t)(m0 + lr) * 512 + nt * 128 + wn * 64 + ni * 32, a, h, rs[lr]);
      });
    } else {
      gemm_tile<false>(A, LDH, Bw, 128, 128, lds, [&](int mi, int ni, const f32x16& a) {
        const int b = m0 / PP, t0 = m0 - b * PP + wm * 64 + mi * 32;
        const int col = (nt - 4) * 128 + wn * 64 + ni * 32 + r;
        store_transposed(p.VtB + ((size_t)b * 512 + col) * PP + t0, a, h, rs + wm * 64 + mi * 32);
      });
    }
  }
}

DI void cumsum_job(const Params& p, int j, char* lds) {
  const int tid = opaque_tid(), lane = tid & 63, w = tid >> 6;
  const float* src = p.LOGF + (size_t)j * PP;
  float* dst = p.CUM + (size_t)j * PP;
  float* wt = (float*)lds;
  float v[17];
#pragma unroll
  for (int rr = 0; rr < 17; ++rr) {
    const int o = rr * 64 + lane, i = w * 1056 + o;
    v[rr] = (o < 1056 && i >= LEAD) ? src[i] : 0.f;
  }
  float carry = 0.f;
#pragma unroll
  for (int rr = 0; rr < 17; ++rr) {
    float inc = v[rr];
    for (int o = 1; o < 64; o <<= 1) { float x = __shfl_up(inc, o); if (lane >= o) inc += x; }
    v[rr] = inc + carry;
    carry += __shfl(inc, 63);
  }
  if (lane == 0) wt[w] = carry;
  __syncthreads();
  float base = 0.f;
  for (int k = 0; k < w; ++k) base += wt[k];
#pragma unroll
  for (int rr = 0; rr < 17; ++rr) {
    const int o = rr * 64 + lane;
    if (o < 1056) dst[w * 1056 + o] = v[rr] + base;
  }
}

DI void topk_job(const Params& p, int b, int t0, char* lds) {
  const int tid = opaque_tid(), lane = tid & 63, w = tid >> 6, r = lane & 31, h = lane >> 5;
  const int cmax = (t0 + 3) >> 6;
  unsigned sc[17][4];
  {
    const u16* iqp = p.H + (size_t)(b * PP + t0 + (r >> 3)) * LDH + HIQ_C + (r & 7) * 64 + 8 * h;
    bf16x8 af[4];
#pragma unroll
    for (int ks = 0; ks < 4; ++ks) af[ks] = *(const bf16x8*)(iqp + ks * 16);
    f32x4 iw[4];
#pragma unroll
    for (int qi = 0; qi < 4; ++qi) iw[qi] = *(const f32x4*)(p.IW + (size_t)(b * PP + t0 + qi) * 8 + 4 * h);
    char* wb = lds + 16384 + w * 9216;
    const int lrow = lane >> 3, lpc = lane & 7;
    const u16* ikb = p.IK + ((size_t)(b * PP) + lrow) * 64 + lpc * 8;
    u32x4 st[8];
    if (1 + w <= cmax) {
      const u16* kp = ikb + (size_t)(1 + w) * 64 * 64;
#pragma unroll
      for (int j = 0; j < 8; ++j) st[j] = *(const u32x4*)(kp + (size_t)j * 8 * 64);
#pragma unroll
      for (int j = 0; j < 8; ++j) *(u32x4*)(wb + (lrow + 8 * j) * 144 + lpc * 16) = st[j];
    }
#pragma unroll
    for (int i = 0; i < 17; ++i) {
      const int c = 1 + w + 8 * i;
      if (c <= cmax) {
        const bool more = c + 8 <= cmax;
        if (more) {
          const u16* kp = ikb + (size_t)(c + 8) * 64 * 64;
#pragma unroll
          for (int j = 0; j < 8; ++j) st[j] = *(const u32x4*)(kp + (size_t)j * 8 * 64);
        }
        bf16x8 b0[4], b1[4];
#pragma unroll
        for (int ks = 0; ks < 4; ++ks) {
          b0[ks] = *(const bf16x8*)(wb + r * 144 + ks * 32 + h * 16);
          b1[ks] = *(const bf16x8*)(wb + (32 + r) * 144 + ks * 32 + h * 16);
        }
        __builtin_amdgcn_sched_barrier(0);
        f32x16 a0, a1;
#pragma unroll
        for (int e = 0; e < 16; ++e) { a0[e] = 0.f; a1[e] = 0.f; }
#pragma unroll
        for (int ks = 0; ks < 4; ++ks) { a0 = MFMA32(af[ks], b0[ks], a0); a1 = MFMA32(af[ks], b1[ks], a1); }
        const int key = c * 64 + lane;
#pragma unroll
        for (int qi = 0; qi < 4; ++qi) {
          f32x2 pp2 = {0.f, 0.f};
#pragma unroll
          for (int e = 0; e < 4; ++e) {
            const f32x2 rl = {fmaxf(a0[4 * qi + e], 0.f), fmaxf(a1[4 * qi + e], 0.f)};
            const f32x2 wv = {iw[qi][e], iw[qi][e]};
            pp2 += rl * wv;
          }
          const float p0 = pp2[0], p1 = pp2[1];
          const u32x2 sw = __builtin_amdgcn_permlane32_swap(__float_as_uint(p0), __float_as_uint(p1), false, false);
          float mine = __uint_as_float(sw[0]) + __uint_as_float(sw[1]);
          mine += 0.0f;
          unsigned u = __float_as_uint(mine);
          u = (u & 0x80000000u) ? ~u : (u | 0x80000000u);
          if (key > t0 + qi || key < LEAD) u = 0u;
          sc[i][qi] = u;
        }
        if (more) {
#pragma unroll
          for (int j = 0; j < 8; ++j) *(u32x4*)(wb + (lrow + 8 * j) * 144 + lpc * 16) = st[j];
        }
      } else {
#pragma unroll
        for (int qi = 0; qi < 4; ++qi) sc[i][qi] = 0u;
      }
    }
  }
  int* ng = (int*)(lds + 256);
  unsigned long long* mg = (unsigned long long*)(lds + 1024);
  unsigned long long* me = mg + 4 * 132;
  int* bg = (int*)(me + 4 * 132);
  int* be = bg + 4 * 132;
  unsigned T[4];
  {
    unsigned* hist = (unsigned*)(lds + 16384);
    int* sel = (int*)(lds + 512);
    unsigned pref[4] = {0u, 0u, 0u, 0u};
    int chi[4] = {0, 0, 0, 0};
    bool few[4] = {false, false, false, false};
    __syncthreads();
    bool small = false;
    int nb[4] = {0, 0, 0, 0};
#pragma unroll
    for (int pass = 0; pass < 3; ++pass) {
      if (pass == 2) {
        small = true;
#pragma unroll
        for (int q = 0; q < 4; ++q) small = small && (few[q] || nb[q] <= 64);
        if (small) break;
      }
      {
        const u32x4 z = {0u, 0u, 0u, 0u};
#pragma unroll
        for (int j = 0; j < 8; ++j) ((u32x4*)hist)[tid + 512 * j] = z;
      }
      __syncthreads();
#pragma unroll
      for (int i = 0; i < 17; ++i) {
#pragma unroll
        for (int q = 0; q < 4; ++q) {
          const unsigned u = sc[i][q];
          bool part; unsigned bin;
          if (pass == 0) { part = (u != 0u); bin = (u >> 22) + (lane & 3) * 1024; }
          else if (pass == 1) { part = (u != 0u) && ((u >> 22) == pref[q]) && !few[q]; bin = ((u >> 12) & 1023u) + (lane & 3) * 1024; }
          else { part = (u != 0u) && ((u >> 12) == pref[q]) && !few[q]; bin = u & 4095u; }
          if (part) atomicAdd(hist + q * 4096 + bin, 1u);
        }
      }
      __syncthreads();
      if (w < 4) {
        const int q = w;
        const unsigned* hq = hist + q * 4096;
        const int need = 256 - chi[q];
        int G = 0;
        if (pass < 2) {
#pragma unroll
          for (int rep = 0; rep < 4; ++rep)
#pragma unroll
            for (int j = 0; j < 16; ++j) G += (int)hq[rep * 1024 + 16 * lane + ((j + lane) & 15)];
        } else {
#pragma unroll 8
          for (int j = 0; j < 64; ++j) G += (int)hq[64 * lane + ((j + lane) & 63)];
        }
        int S = G;
        { int tt; S = wscan<false>(S, lane, tt); }
        const unsigned long long mk = __ballot(S >= need);
        int B = 0, cg2 = 0, fw = 0, nbin = 0;
        if (mk == 0ull) {
          fw = 1;
        } else {
          const int ks = 63 - __clzll(mk);
          const int above = (ks < 63) ? __builtin_amdgcn_readlane(S, ks + 1) : 0;
          int hh;
          if (pass < 2) {
            hh = 0;
            if (lane < 16) hh = (int)(hq[16 * ks + lane] + hq[1024 + 16 * ks + lane] + hq[2048 + 16 * ks + lane] + hq[3072 + 16 * ks + lane]);
          } else {
            hh = (int)hq[64 * ks + lane];
          }
          int s2 = hh;
          { int tt; s2 = wscan<false>(s2, lane, tt); }
          const unsigned long long m2 = __ballot(above + s2 >= need);
          const int Ls = 63 - __clzll(m2);
          B = (pass < 2 ? 16 : 64) * ks + Ls;
          nbin = __builtin_amdgcn_readlane(hh, Ls);
          cg2 = above + __builtin_amdgcn_readlane(s2, Ls) - nbin;
        }
        if (lane == 0) { sel[q * 4 + 0] = B; sel[q * 4 + 1] = chi[q] + cg2; sel[q * 4 + 2] = fw; sel[q * 4 + 3] = nbin; }
      }
      __syncthreads();
#pragma unroll
      for (int q = 0; q < 4; ++q) {
        if (!few[q]) {
          pref[q] = (pref[q] << (pass < 2 ? 10 : 12)) | (unsigned)sel[q * 4 + 0];
          chi[q] = sel[q * 4 + 1];
          nb[q] = sel[q * 4 + 3];
          if (pass == 0) few[q] = sel[q * 4 + 2] != 0;
        }
      }
    }
    if (small) {
      unsigned* lst = hist;
      int* lcnt = sel + 16;
      if (tid < 4) lcnt[tid] = 0;
      __syncthreads();
#pragma unroll
      for (int i = 0; i < 17; ++i)
#pragma unroll
        for (int q = 0; q < 4; ++q) {
          const unsigned u = sc[i][q];
          if (!few[q] && u != 0u && (u >> 12) == pref[q]) { const int pos = atomicAdd(lcnt + q, 1); lst[q * 64 + pos] = u; }
        }
      __syncthreads();
      if (w < 4) {
        const int q = w, n = lcnt[q], need = 256 - chi[q];
        const unsigned e = lane < n ? lst[q * 64 + lane] : 0u;
        int rank = 0;
        for (int k = 0; k < n; ++k) rank += (lst[q * 64 + k] > e) ? 1 : 0;
        unsigned cand = (lane < n && rank <= need - 1) ? e : 0xFFFFFFFFu;
        for (int o = 32; o > 0; o >>= 1) { const unsigned x = (unsigned)__shfl_xor((int)cand, o); cand = x < cand ? x : cand; }
        if (lane == 0) sel[q * 4 + 0] = (int)cand;
      }
      __syncthreads();
#pragma unroll
      for (int q = 0; q < 4; ++q) T[q] = few[q] ? 0u : (unsigned)sel[q * 4 + 0];
    } else {
#pragma unroll
      for (int q = 0; q < 4; ++q) T[q] = few[q] ? 0u : pref[q];
    }
  }
  unsigned* cntb = (unsigned*)mg;
  unsigned* baseb = (unsigned*)bg;
#pragma unroll
  for (int i = 0; i < 17; ++i) {
    const int c = 1 + w + 8 * i;
    if (c <= cmax) {
      unsigned mine = 0u;
#pragma unroll
      for (int q = 0; q < 4; ++q) {
        const unsigned pk = (unsigned)__popcll(__ballot(sc[i][q] > T[q])) | ((unsigned)__popcll(__ballot(sc[i][q] == T[q])) << 16);
        mine = (lane == q) ? pk : mine;
      }
      if (lane < 4) cntb[lane * 132 + c] = mine;
    }
  }
  __syncthreads();
  if (w < 4) {
    const int q = w;
    int cg_ = 0, ce_ = 0;
    for (int base = 0; base <= cmax; base += 64) {
      const int c = base + lane;
      const bool in = (c >= 1) && (c <= cmax);
      const unsigned cv = in ? cntb[q * 132 + c] : 0u;
      const int v1 = (int)(cv & 0xffffu), v2 = (int)(cv >> 16);
      int t1, t2;
      const int i1 = wscan<true>(v1, lane, t1), i2 = wscan<true>(v2, lane, t2);
      if (in) baseb[q * 132 + c] = (unsigned)(cg_ + i1 - v1) | ((unsigned)(ce_ + i2 - v2) << 16);
      cg_ += t1;
      ce_ += t2;
    }
    if (lane == 0) ng[q] = cg_;
  }
  __syncthreads();
  const unsigned long long lt = (1ull << lane) - 1ull;
#pragma unroll
  for (int i = 0; i < 17; ++i) {
    const int c = 1 + w + 8 * i;
    if (c <= cmax) {
      const int key = c * 64 + lane;
#pragma unroll
      for (int q = 0; q < 4; ++q) {
        u16* out = p.IDX + (size_t)(b * PP + t0 + q) * 256;
        const bool gt = sc[i][q] > T[q];
        const bool eq = (sc[i][q] == T[q]) && (T[q] != 0u);
        const unsigned long long m1 = __ballot(gt), m2 = __ballot(eq);
        if ((m1 | m2) != 0ull) {
          const unsigned bb = baseb[q * 132 + c];
          if (gt) out[(int)(bb & 0xffffu) + __popcll(m1 & lt)] = (u16)key;
          if (eq) { const int pos = ng[q] + (int)(bb >> 16) + __popcll(m2 & lt); if (pos < 256) out[pos] = (u16)key; }
        }
      }
    }
  }
#pragma unroll
  for (int q = 0; q < 4; ++q) {
    if (T[q] == 0u) {
      u16* out = p.IDX + (size_t)(b * PP + t0 + q) * 256;
      if (tid < 256 && tid >= ng[q]) out[tid] = (u16)0xFFFF;
    }
  }
}

constexpr int AT_STAGE = 23040;
template <int DK, int MODE>
DI void attn_unit(const Params& p, int l, int b, int head, int qu, char* lds) {
  const int tid = opaque_tid(), lane = tid & 63, w = tid >> 6, r = lane & 31, h = lane >> 5;
  constexpr int KS = DK / 16, KST = DK + 8;
  const int q0 = qu * 256, qw0 = q0 + w * 32, qw = qw0 + r;
  const size_t tokq = (size_t)b * PP + qw;
  const u16 *qptr, *kptr, *vtptr, *gptr;
  int ldk;
  if (MODE == 0) {
    qptr = p.H + tokq * LDH + HQ_A + head * 64; kptr = p.H + (size_t)b * PP * LDH + HK_A + head * 64; ldk = LDH;
    vtptr = p.VtA + ((size_t)b * 512 + head * 64) * PP; gptr = p.H + tokq * LDH + HG_A + head * 64;
  } else if (MODE == 1) {
    qptr = p.Qm + tokq * 768 + head * 96; kptr = p.Km + (size_t)b * PP * 512 + head * 64; ldk = 512;
    vtptr = p.VtB + ((size_t)b * 512 + head * 64) * PP; gptr = p.H + tokq * LDH + HG_B + head * 64;
  } else {
    qptr = p.H + tokq * LDH + HQ_D + head * 64; kptr = p.H + (size_t)b * PP * LDH + HK_D + (head >> 2) * 64; ldk = LDH;
    vtptr = p.VtD + ((size_t)b * 128 + (head >> 2) * 64) * PP; gptr = p.H + tokq * LDH + HG_D + head * 64;
  }
  const float* cum = p.CUM + (size_t)(b * 8 + head) * PP;
  float* btab = (float*)(lds + 2 * AT_STAGE);
  u32x2 gpre[2][4];
#pragma unroll
  for (int d = 0; d < 2; ++d)
#pragma unroll
    for (int g = 0; g < 4; ++g) gpre[d][g] = *(const u32x2*)(gptr + d * 32 + 8 * g + 4 * h);
  bf16x8 qf[KS];
#pragma unroll
  for (int ks = 0; ks < KS; ++ks) qf[ks] = *(const bf16x8*)(qptr + ks * 16 + 8 * h);
  float cref = 0.f;
  if (MODE == 0) cref = cum[q0];
  if (MODE == 2) { if (tid < 128) btab[tid] = p.rel_bias[t5_bucket(tid) * 16 + 8 + head] * LOG2E; }
  const float sc2 = (MODE == 1 ? 0.10206207261596577f : 0.125f) * LOG2E;
  const int kt_hi = qu * 4 + 3;
  int kt_lo = 1;
  if (MODE == 2) { kt_lo = qu * 4 - 2; if (kt_lo < 1) kt_lo = 1; }
  u32x4 rk, rk2, rv;
  float re = 0.f;
  const int srow = tid >> 3, sc8 = tid & 7;
  auto gload = [&](int kt) {
    const int k0 = kt * 64;
    rk = *(const u32x4*)(kptr + (size_t)(k0 + srow) * ldk + sc8 * 8);
    if (MODE == 1) { if (tid < 256) rk2 = *(const u32x4*)(p.Kpe + ((size_t)b * PP + k0 + (tid >> 2)) * 32 + (tid & 3) * 8); }
    rv = *(const u32x4*)(vtptr + (size_t)srow * PP + k0 + sc8 * 8);
    if (MODE == 0) { if (tid < 64) re = (cum[k0 + tid] - cref) * LOG2E; }
  };
  auto lstore = [&](int st) {
    char* base = lds + st * AT_STAGE;
    *(u32x4*)(base + (srow * KST + sc8 * 8) * 2) = rk;
    if (MODE == 1) { if (tid < 256) *(u32x4*)(base + ((tid >> 2) * KST + 64 + (tid & 3) * 8) * 2) = rk2; }
    char* vb = base + 64 * KST * 2;
    u32x2 lo = {rv[0], rv[1]}, hi = {rv[2], rv[3]};
    *(u32x2*)(vb + (srow * 68 + sc8 * 8) * 2) = lo;
    *(u32x2*)(vb + (srow * 68 + sc8 * 8 + 4) * 2) = hi;
    if (MODE == 0) { if (tid < 64) *(float*)(vb + 64 * 68 * 2 + tid * 4) = re; }
  };
  f32x16 o[2];
#pragma unroll
  for (int d = 0; d < 2; ++d)
#pragma unroll
    for (int i = 0; i < 16; ++i) o[d][i] = 0.f;
  float m = NEGL, lsum = 0.f;
  float qn = 0.f, kmx = 0.f;
  int* stopf = (int*)(lds + 2 * AT_STAGE + 1024);
  if (MODE == 0) {
#pragma unroll
    for (int ks = 0; ks < KS; ++ks) {
      const u32x4 qq = __builtin_bit_cast(u32x4, qf[ks]);
#pragma unroll
      for (int e = 0; e < 4; ++e) { const float a = bf_lo(qq[e]), b2 = bf_hi(qq[e]); qn += a * a + b2 * b2; }
    }
    qn += __shfl_xor(qn, 32);
    qn = sqrtf(qn) * 1.01f;
    kmx = __uint_as_float(p.ctr[64 + l * 16 + b * 8 + head]);
  }
  gload(kt_hi); lstore(0);
  __syncthreads();
  for (int kt = kt_hi; kt >= kt_lo; --kt) {
    const bool more = kt > kt_lo;
    if (more) gload(kt - 1);
    float cnext = 0.f;
    if (MODE == 0) { if (more) cnext = cum[(kt - 1) * 64 + 63]; }
    const int st = (kt_hi - kt) & 1;
    const int k0 = kt * 64;
    bool active = k0 <= qw0 + 31;
    if (MODE == 2) active = active && (k0 + 63 >= qw0 - 127);
    if (active) {
      const char* kb = lds + st * AT_STAGE;
      const char* vb = kb + 64 * KST * 2;
      f32x16 s[2];
      bf16x8 kf[2][KS];
#pragma unroll
      for (int kr = 0; kr < 2; ++kr)
#pragma unroll
        for (int ks = 0; ks < KS; ++ks) kf[kr][ks] = *(const bf16x8*)(kb + ((kr * 32 + r) * KST + ks * 16 + 8 * h) * 2);
      __builtin_amdgcn_sched_barrier(0);
#pragma unroll
      for (int kr = 0; kr < 2; ++kr) {
#pragma unroll
        for (int i = 0; i < 16; ++i) s[kr][i] = 0.f;
#pragma unroll
        for (int ks = 0; ks < KS; ++ks) s[kr] = MFMA32(kf[kr][ks], qf[ks], s[kr]);
      }
      u32x4 vfr[2][2][2];
#pragma unroll
      for (int kr = 0; kr < 2; ++kr)
#pragma unroll
        for (int s2 = 0; s2 < 2; ++s2)
#pragma unroll
          for (int d = 0; d < 2; ++d) {
            const char* va = vb + ((d * 32 + r) * 68 + kr * 32 + s2 * 16 + 4 * h) * 2;
            const u32x2 lo = *(const u32x2*)va;
            const u32x2 hi = *(const u32x2*)(va + 16);
            vfr[kr][s2][d] = (u32x4){lo[0], lo[1], hi[0], hi[1]};
          }
      __builtin_amdgcn_sched_barrier(0);
      const bool need_mask = (MODE == 2) || (k0 + 63 > qw0) || (k0 < LEAD);
      const bool rawpath = (MODE == 1) && !need_mask;
      float tmax = NEGL;
      const f32x2 sc2v = {sc2, sc2};
      if (rawpath) {
#pragma unroll
        for (int kr = 0; kr < 2; ++kr)
#pragma unroll
          for (int i = 0; i < 16; ++i) tmax = fmaxf(tmax, s[kr][i]);
        tmax *= sc2;
      } else {
#pragma unroll
        for (int kr = 0; kr < 2; ++kr) {
#pragma unroll
          for (int g = 0; g < 4; ++g) {
            f32x4 ev = {0.f, 0.f, 0.f, 0.f};
            if (MODE == 0) ev = *(const f32x4*)(vb + 64 * 68 * 2 + (kr * 32 + 8 * g + 4 * h) * 4);
#pragma unroll
            for (int e2 = 0; e2 < 2; ++e2) {
              const int i = 4 * g + 2 * e2;
              f32x2 v2 = {s[kr][i], s[kr][i + 1]};
              if (MODE == 0) { const f32x2 e2v = {ev[2 * e2], ev[2 * e2 + 1]}; v2 = v2 * sc2v - e2v; }
              else v2 = v2 * sc2v;
#pragma unroll
              for (int e1 = 0; e1 < 2; ++e1) {
                const int key = k0 + kr * 32 + 8 * g + 4 * h + 2 * e2 + e1;
                float v = v2[e1];
                if (MODE == 2) v += btab[(qw - key) & 127];
                if (need_mask) {
                  bool ok = (key <= qw) && (key >= LEAD);
                  if (MODE == 2) ok = ok && (qw - key < 128);
                  v = ok ? v : NEGL;
                }
                s[kr][i + e1] = v;
                tmax = fmaxf(tmax, v);
              }
            }
          }
        }
      }
      tmax = fmaxf(tmax, __shfl_xor(tmax, 32));
      const float mn = fmaxf(m, tmax);
      const float alpha = __builtin_amdgcn_exp2f(m - mn);
      const bool resc = __any(m != mn);
      m = mn;
      f32x2 ps2 = {0.f, 0.f};
      const f32x2 mnv = {mn, mn};
      const f32x2 scx = rawpath ? sc2v : (f32x2){1.f, 1.f};
#pragma unroll
      for (int kr = 0; kr < 2; ++kr)
#pragma unroll
        for (int i = 0; i < 16; i += 2) {
          f32x2 v2 = {s[kr][i], s[kr][i + 1]};
          v2 = v2 * scx - mnv;
          f32x2 p2 = {__builtin_amdgcn_exp2f(v2[0]), __builtin_amdgcn_exp2f(v2[1])};
          s[kr][i] = p2[0]; s[kr][i + 1] = p2[1];
          ps2 += p2;
        }
      const float ps = ps2[0] + ps2[1];
      lsum = lsum * alpha + ps;
      if (resc)
#pragma unroll
      for (int d = 0; d < 2; ++d)
#pragma unroll
        for (int i = 0; i < 16; ++i) o[d][i] *= alpha;
#pragma unroll
      for (int kr = 0; kr < 2; ++kr) {
#pragma unroll
        for (int s2 = 0; s2 < 2; ++s2) {
          u32x4 pp = {pk2(s[kr][8 * s2], s[kr][8 * s2 + 1]), pk2(s[kr][8 * s2 + 2], s[kr][8 * s2 + 3]),
                      pk2(s[kr][8 * s2 + 4], s[kr][8 * s2 + 5]), pk2(s[kr][8 * s2 + 6], s[kr][8 * s2 + 7])};
          bf16x8 pf = __builtin_bit_cast(bf16x8, pp);
#pragma unroll
          for (int d = 0; d < 2; ++d) o[d] = MFMA32(__builtin_bit_cast(bf16x8, vfr[kr][s2][d]), pf, o[d]);
        }
      }
    }
    if (more) lstore(st ^ 1);
    if (MODE == 0) {
      if (more) {
        const float enext = (cnext - cref) * LOG2E;
        const bool okl = (qn * kmx * sc2 - enext) <= (m - 40.f);
        const bool okw = __all(okl);
        if (lane == 0) stopf[(kt & 1) * 8 + w] = okw ? 1 : 0;
      }
    }
    __syncthreads();
    if (MODE == 0) {
      if (more) {
        const int* sf = stopf + (kt & 1) * 8;
        if (sf[0] & sf[1] & sf[2] & sf[3] & sf[4] & sf[5] & sf[6] & sf[7]) break;
      }
    }
  }
  lsum += __shfl_xor(lsum, 32);
  float f;
  if (MODE == 2) {
    const float s2 = p.sinks[l * 8 + head] * LOG2E;
    const float mf = fmaxf(m, s2);
    const float em = __builtin_amdgcn_exp2f(m - mf);
    f = em / (lsum * em + __builtin_amdgcn_exp2f(s2 - mf));
  } else {
    f = lsum > 0.f ? 1.f / lsum : 0.f;
  }
  f *= (MODE == 0 ? SC_FOX : (MODE == 1 ? SC_MLA : SC_SWA));
  u16* mp = p.Mix + tokq * 2048 + (MODE == 0 ? 0 : (MODE == 1 ? 512 : 1536)) + head * 64;
#pragma unroll
  for (int d = 0; d < 2; ++d)
#pragma unroll
    for (int g = 0; g < 4; ++g) {
      const int dd = d * 32 + 8 * g + 4 * h;
      const u32x2 gv = gpre[d][g];
      float g0 = silu(bf_lo(gv[0])), g1 = silu(bf_hi(gv[0])), g2 = silu(bf_lo(gv[1])), g3 = silu(bf_hi(gv[1]));
      u32x2 ov = {pk2(o[d][4 * g] * f * g0, o[d][4 * g + 1] * f * g1), pk2(o[d][4 * g + 2] * f * g2, o[d][4 * g + 3] * f * g3)};
      *(u32x2*)(mp + dd) = ov;
    }
}

DI void dsa_job(const Params& p, int b, int tq0, char* lds) {
  const int tid = opaque_tid(), lane = tid & 63, w = tid >> 6;
  float* biasC = (float*)(lds + 143360);
  int* btab = (int*)(lds + 143360 + 1024);
  char* wl = lds + w * 17920;
  float* Pl = (float*)wl;
  int* kid = (int*)(wl + 8192);
  const int tq = tq0 + w;
  const size_t tok = (size_t)b * PP + tq;
  const u16* Hb = p.H + (size_t)b * PP * LDH;
  int kk[4], ku[4];
  {
    u32x2 iv = *(const u32x2*)(p.IDX + tok * 256 + 4 * lane);
    kk[0] = iv[0] & 0xffff; kk[1] = iv[0] >> 16; kk[2] = iv[1] & 0xffff; kk[3] = iv[1] >> 16;
#pragma unroll
    for (int j = 0; j < 4; ++j) ku[j] = (kk[j] == 0xFFFF) ? LEAD : kk[j];
    u32x4 kv4 = {(unsigned)ku[0], (unsigned)ku[1], (unsigned)ku[2], (unsigned)ku[3]};
    ((u32x4*)kid)[lane] = kv4;
  }
  u32x4 gvp[4];
#pragma unroll
  for (int hh = 0; hh < 4; ++hh) gvp[hh] = *(const u32x4*)(p.H + tok * LDH + HG_C + (((lane >> 3) & 1) * 4 + hh) * 64 + (lane & 7) * 8);
  __builtin_amdgcn_wave_barrier();
  const int ksub = lane >> 4, g = (lane >> 3) & 1, dc = lane & 7;
  {
    const int r = lane & 31, h = lane >> 5, pc = lane & 15;
    char* kst = wl + 9216;
    bf16x8 qb[8];
#pragma unroll
    for (int ks = 0; ks < 8; ++ks) {
      u32x4 v = {0u, 0u, 0u, 0u};
      if (r < 8 && (ks >> 2) == (r >> 2)) v = *(const u32x4*)(p.H + tok * LDH + HQ_C + r * 64 + (ks & 3) * 16 + 8 * h);
      qb[ks] = __builtin_bit_cast(bf16x8, v);
    }
    const u16* kbase = Hb + HK_C + pc * 8;
    u32x4 st0[8], st1[8];
#pragma unroll
    for (int s2 = 0; s2 < 8; ++s2) st0[s2] = *(const u32x4*)(kbase + (size_t)kid[4 * s2 + ksub] * LDH);
#pragma unroll
    for (int s2 = 0; s2 < 8; ++s2) st1[s2] = *(const u32x4*)(kbase + (size_t)kid[32 + 4 * s2 + ksub] * LDH);
    auto chunk = [&](int c, u32x4* stc) {
#pragma unroll
      for (int s2 = 0; s2 < 8; ++s2) *(u32x4*)(kst + (4 * s2 + ksub) * 272 + pc * 16) = stc[s2];
      if (c + 2 < 8) {
#pragma unroll
        for (int s2 = 0; s2 < 8; ++s2) stc[s2] = *(const u32x4*)(kbase + (size_t)kid[32 * (c + 2) + 4 * s2 + ksub] * LDH);
      }
      bf16x8 af[8];
#pragma unroll
      for (int ks = 0; ks < 8; ++ks) af[ks] = *(const bf16x8*)(kst + r * 272 + ks * 32 + 16 * h);
      __builtin_amdgcn_sched_barrier(0);
      f32x16 acc0, acc1;
#pragma unroll
      for (int i = 0; i < 16; ++i) { acc0[i] = 0.f; acc1[i] = 0.f; }
#pragma unroll
      for (int ks = 0; ks < 8; ks += 2) { acc0 = MFMA32(af[ks], qb[ks], acc0); acc1 = MFMA32(af[ks + 1], qb[ks + 1], acc1); }
      if (r < 8) {
#pragma unroll
        for (int i = 0; i < 16; ++i) Pl[(32 * c + crow(i, h)) * 8 + r] = acc0[i] + acc1[i];
      }
    };
#pragma unroll 1
    for (int c = 0; c < 8; c += 2) { chunk(c, st0); chunk(c + 1, st1); }
  }
  __builtin_amdgcn_wave_barrier();
  float lg[4][8];
#pragma unroll
  for (int j = 0; j < 4; ++j) {
    const f32x4 v0 = *(const f32x4*)(Pl + (4 * lane + j) * 8), v1 = *(const f32x4*)(Pl + (4 * lane + j) * 8 + 4);
#pragma unroll
    for (int e = 0; e < 4; ++e) { lg[j][e] = v0[e]; lg[j][4 + e] = v1[e]; }
  }
  int bk[4];
#pragma unroll
  for (int j = 0; j < 4; ++j) { int dist = tq - ku[j]; bk[j] = (dist < 128) ? btab[dist & 127] : 31; }
#pragma unroll
  for (int hd = 0; hd < 8; ++hd) {
    float mx = NEGL;
#pragma unroll
    for (int j = 0; j < 4; ++j) {
      float v = lg[j][hd] * 0.125f + biasC[bk[j] * 8 + hd];
      v = (kk[j] == 0xFFFF) ? NEGL : v;
      lg[j][hd] = v;
      mx = fmaxf(mx, v);
    }
    mx = wmax(mx);
    float sm = 0.f;
#pragma unroll
    for (int j = 0; j < 4; ++j) { float e = __expf(lg[j][hd] - mx); lg[j][hd] = e; sm += e; }
    sm = wsum(sm);
    const float inv = 1.f / sm;
#pragma unroll
    for (int j = 0; j < 4; ++j) lg[j][hd] *= inv;
  }
#pragma unroll
  for (int j = 0; j < 4; ++j) {
    f32x4 v0 = {lg[j][0], lg[j][1], lg[j][2], lg[j][3]}, v1 = {lg[j][4], lg[j][5], lg[j][6], lg[j][7]};
    *(f32x4*)(Pl + (4 * lane + j) * 8) = v0;
    *(f32x4*)(Pl + (4 * lane + j) * 8 + 4) = v1;
  }
  __builtin_amdgcn_wave_barrier();
  const u16* vb = Hb + HV_C + g * 64 + dc * 8;
  f32x2 acc2[4][4];
#pragma unroll
  for (int hh = 0; hh < 4; ++hh)
#pragma unroll
    for (int e = 0; e < 4; ++e) { acc2[hh][e][0] = 0.f; acc2[hh][e][1] = 0.f; }
  u32x4 vA[16], vB[16];
  auto pv_load = [&](int grp, u32x4* dst) {
#pragma unroll
    for (int s = 0; s < 16; ++s) dst[s] = *(const u32x4*)(vb + (size_t)kid[4 * (grp * 16 + s) + ksub] * LDH);
  };
  auto pv_fma = [&](int grp, const u32x4* src) {
#pragma unroll
    for (int s = 0; s < 16; ++s) {
      const int slot = 4 * (grp * 16 + s) + ksub;
      const f32x4 pp = *(const f32x4*)(Pl + slot * 8 + g * 4);
      const u32x4 vv = src[s];
#pragma unroll
      for (int hh = 0; hh < 4; ++hh) {
        const f32x2 ph = {pp[hh], pp[hh]};
#pragma unroll
        for (int e = 0; e < 4; ++e) {
          const f32x2 vf2 = {bf_lo(vv[e]), bf_hi(vv[e])};
          acc2[hh][e] += ph * vf2;
        }
      }
    }
  };
  pv_load(0, vA);
  pv_load(1, vB);
  pv_fma(0, vA);
  pv_load(2, vA);
  pv_fma(1, vB);
  pv_load(3, vB);
  pv_fma(2, vA);
  pv_fma(3, vB);
  float acc[4][8];
#pragma unroll
  for (int hh = 0; hh < 4; ++hh)
#pragma unroll
    for (int e = 0; e < 8; ++e) { float v = acc2[hh][e >> 1][e & 1]; v += __shfl_xor(v, 16); v += __shfl_xor(v, 32); acc[hh][e] = v; }
  if (ksub == 0) {
#pragma unroll
    for (int hh = 0; hh < 4; ++hh) {
      const int hd = g * 4 + hh;
      const u32x4 gv = gvp[hh];
      u32x4 ov;
#pragma unroll
      for (int e = 0; e < 4; ++e) ov[e] = pk2(acc[hh][2 * e] * SC_DSA * silu(bf_lo(gv[e])), acc[hh][2 * e + 1] * SC_DSA * silu(bf_hi(gv[e])));
      *(u32x4*)(p.Mix + tok * 2048 + 1024 + hd * 64 + dc * 8) = ov;
    }
  }
}

DI void outproj_tile(const Params& p, int mt, int nt, char* lds) {
  const int tid = opaque_tid(), lane = tid & 63, w = tid >> 6, r = lane & 31, h = lane >> 5;
  const int wm = w & 3, wn = w >> 2;
  const int m0 = mt * 256;
  gemm_tile<true>(p.Mix + (size_t)m0 * 2048, 2048, p.Wt_out + (size_t)nt * 128 * 2048, 2048, 2048, lds, [&](int mi, int ni, const f32x16& a) {
    const int tok = m0 + wm * 64 + mi * 32 + r;
    float* rp = p.R + (size_t)tok * DM + nt * 128 + wn * 64 + ni * 32;
#pragma unroll
    for (int g = 0; g < 4; ++g) {
      f32x4 v = *(const f32x4*)(rp + 8 * g + 4 * h);
#pragma unroll
      for (int e = 0; e < 4; ++e) v[e] = ALPHA * v[e] + a[4 * g + e];
      *(f32x4*)(rp + 8 * g + 4 * h) = v;
    }
  });
}

DI void ln_rows(const Params& p, int l) {
  const int tid = opaque_tid(), lane = tid & 63, w = tid >> 6;
  const float* gg = l < 0 ? p.ln0_g : p.ln_g + l * DM;
  const float* bb = l < 0 ? p.ln0_b : p.ln_b + l * DM;
  const int stride = gridDim.x * 8;
  auto loadrow = [&](int row, f32x4* dst) {
    if (l < 0) {
      const int b = row / PP, t = row - b * PP;
      const float* src = nullptr;
      if (t >= 128 && t < PV) src = p.x + ((size_t)b * SEQ + (t - 128)) * DM;
      else if (t >= LEAD && t < 128) src = p.meta + (size_t)(t - LEAD) * DM;
#pragma unroll
      for (int j = 0; j < 4; ++j) {
        if (src) dst[j] = *(const f32x4*)(src + lane * 4 + 256 * j);
        else { dst[j][0] = 0.f; dst[j][1] = 0.f; dst[j][2] = 0.f; dst[j][3] = 0.f; }
      }
    } else {
#pragma unroll
      for (int j = 0; j < 4; ++j) dst[j] = *(const f32x4*)(p.R + (size_t)row * DM + lane * 4 + 256 * j);
    }
  };
  f32x4 v[4], vn[4];
  int row = blockIdx.x * 8 + w;
  if (row < MT) loadrow(row, v);
  for (; row < MT; row += stride) {
    const int b = row / PP, t = row - b * PP;
    if (row + stride < MT) loadrow(row + stride, vn);
    float s = 0.f;
#pragma unroll
    for (int j = 0; j < 4; ++j) s += v[j][0] + v[j][1] + v[j][2] + v[j][3];
    const float mu = wsum(s) * (1.f / DM);
    float q = 0.f;
#pragma unroll
    for (int j = 0; j < 4; ++j)
#pragma unroll
      for (int e = 0; e < 4; ++e) { float d = v[j][e] - mu; q += d * d; }
    const float rstd = rsqrtf(wsum(q) * (1.f / DM) + 1e-5f);
#pragma unroll
    for (int j = 0; j < 4; ++j) {
      const int c = lane * 4 + 256 * j;
      f32x4 g4 = *(const f32x4*)(gg + c), b4 = *(const f32x4*)(bb + c);
      f32x4 y;
#pragma unroll
      for (int e = 0; e < 4; ++e) y[e] = (v[j][e] - mu) * rstd * g4[e] + b4[e];
      if (l == 3) {
        if (t >= 128 && t < PV) *(f32x4*)(p.out + ((size_t)b * SEQ + (t - 128)) * DM + c) = y;
      } else {
        *(f32x4*)(p.R + (size_t)row * DM + c) = y;
        u32x2 yb = {pk2(y[0], y[1]), pk2(y[2], y[3])};
        *(u32x2*)(p.Xb + (size_t)row * DM + c) = yb;
      }
    }
#pragma unroll
    for (int j = 0; j < 4; ++j) v[j] = vn[j];
  }
}

DI int map_in(int n) {
  if (n < 512) return n;
  if (n < 1024) return n;
  if (n < 1536) return 1544 + (n - 1024);
  if (n < 1792) return 2056 + (n - 1536);
  if (n < 1920) return 2312 + (n - 1792);
  if (n < 2432) return 2472 + (n - 1920);
  if (n < 2944) return 2984 + (n - 2432);
  if (n < 3072) return 3496 + (n - 2944);
  if (n < 3200) return 3624 + (n - 3072);
  if (n < 3712) return 3752 + (n - 3200);
  if (n < 4224) return 4336 + (n - 3712);
  if (n < 4736) return 4848 + (n - 4224);
  if (n < 4864) return 5360 + (n - 4736);
  if (n < 5376) return 5616 + (n - 4864);
  if (n < 5408) return 2440 + (n - 5376);
  if (n < 5472) return 4264 + (n - 5408);
  if (n < 5480) return 1536 + (n - 5472);
  if (n < 5488) return 4328 + (n - 5480);
  if (n < 5504) return -1;
  if (n < 6016) return 1024 + (n - 5504);
  return 5488 + (n - 6016);
}
DI void conv_weights(const Params& p, int l, char* lds) {
  const int tid = opaque_tid();
  float* tile = (float*)lds;
  struct TD { u16* dst; int K, k0, n0; };
  const int nn_l = tid & 63;
  auto loadtile = [&](int tI, float* rv, TD& d) {
    const float* src; const float* ksc = nullptr; int ldsrc, kind, kt, ntile;
    if (tI < 1536) { kind = 0; kt = tI / 96; ntile = tI % 96; src = p.w_in + (size_t)l * DM * D_IN; ldsrc = D_IN; d.K = DM; d.dst = p.Wt_in; }
    else if (tI < 2048) { int u = tI - 1536; kind = 1; kt = u / 16; ntile = u % 16; src = p.w_out + (size_t)l * 2048 * DM; ldsrc = DM; d.K = 2048; d.dst = p.Wt_out; }
    else if (tI < 2096) { int u = tI - 2048; kind = 2; kt = u / 12; ntile = u % 12; src = p.w_uq + (size_t)l * 256 * 768; ldsrc = 768; d.K = 256; d.dst = p.Wt_uq; ksc = p.gq + l * 256; }
    else { int u = tI - 2096; kind = 3; kt = u / 16; ntile = u % 16; src = p.w_ukv + (size_t)l * 128 * 1024; ldsrc = 1024; d.K = 128; d.dst = p.Wt_ukv; ksc = p.gkv + l * 128; }
    d.k0 = kt * 64; d.n0 = ntile * 64;
    const int n = d.n0 + nn_l;
    int sc;
    if (kind == 0) sc = map_in(n);
    else if (kind == 3) sc = (n < 512) ? ((n >> 6) * 128 + (n & 63)) : (((n - 512) >> 6) * 128 + 64 + (n & 63));
    else sc = n;
#pragma unroll
    for (int j = 0; j < 8; ++j) {
      const int kk = (tid >> 6) + 8 * j;
      float v = 0.f;
      if (sc >= 0) v = src[(size_t)(d.k0 + kk) * ldsrc + sc];
      if (ksc) v *= ksc[d.k0 + kk];
      rv[j] = v;
    }
  };
  float rv[8], rn[8];
  TD dc, dn;
  int tI = blockIdx.x;
  if (tI < 2128) loadtile(tI, rv, dc);
  for (; tI < 2128; tI += gridDim.x) {
    const int tN = tI + gridDim.x;
    if (tN < 2128) loadtile(tN, rn, dn);
#pragma unroll
    for (int j = 0; j < 8; ++j) tile[nn_l * 65 + (tid >> 6) + 8 * j] = rv[j];
    __syncthreads();
    {
      const int nn = tid >> 3, kc = (tid & 7) * 8;
      const float* tp = tile + nn * 65 + kc;
      u32x4 ov = {pk2(tp[0], tp[1]), pk2(tp[2], tp[3]), pk2(tp[4], tp[5]), pk2(tp[6], tp[7])};
      *(u32x4*)(dc.dst + (size_t)(dc.n0 + nn) * dc.K + dc.k0 + kc) = ov;
    }
    __syncthreads();
#pragma unroll
    for (int j = 0; j < 8; ++j) rv[j] = rn[j];
    dc = dn;
  }
}
DI void rope_table(const Params& p) {
  const int gt = blockIdx.x * NTHREADS + threadIdx.x;
  for (int i = gt; i < PP * 16; i += gridDim.x * NTHREADS) {
    const int t = i >> 4, c = i & 15;
    const float freq = powf(10000.f, -(float)c / 16.f);
    const float ang = (float)(t - LEAD) * freq;
    float sn, cs;
    sincosf(ang, &sn, &cs);
    p.ROPE[(size_t)t * 32 + c] = cs;
    p.ROPE[(size_t)t * 32 + 16 + c] = sn;
  }
}


#define XB_TMO      128
#define XB_XCNT(j)  (256  + 64 * (j))
#define XB_XSUB(j)  (1280 + 64 * (j))
#define XB_XGEN(j)  (2304 + 64 * (j))
#define XB_TOP      3328
#define XB_TOPGEN   3392
#define XCD_BAR_WORDS 3456
#define XB_SPIN_CAP (1u << 18)
DI unsigned xb_ld(unsigned* p) { return __hip_atomic_load(p, __ATOMIC_RELAXED, __HIP_MEMORY_SCOPE_AGENT); }
DI unsigned xb_add(unsigned* p, unsigned v) { return __hip_atomic_fetch_add(p, v, __ATOMIC_RELAXED, __HIP_MEMORY_SCOPE_AGENT); }
DI unsigned xb_xcc_id() { return (unsigned)__builtin_amdgcn_s_getreg((3 << 11) | 20) & 0xFu; }
#define XB_SPIN(cond, bar) do { unsigned _sp = 0; while (cond) { __builtin_amdgcn_s_sleep(1); \
    if ((++_sp & 255u) == 0u) { if (xb_ld(&(bar)[XB_TMO])) break; if (_sp > XB_SPIN_CAP) { atomicAdd(&(bar)[XB_TMO], 1u); break; } } } } while (0)
struct XcdBarrier { unsigned* bar; unsigned x; volatile unsigned* st; };
DI XcdBarrier xcd_barrier_post(unsigned* bar, volatile unsigned* st) {
  XcdBarrier b; b.bar = bar; b.x = xb_xcc_id(); b.st = st;
  if (threadIdx.x == 0) (void)xb_add(&bar[XB_XCNT(b.x)], 1u);
  return b;
}
DI void xcd_barrier_complete(unsigned* bar, unsigned x, unsigned& nloc, unsigned& nx) {
  const unsigned G = gridDim.x * gridDim.y * gridDim.z;
  unsigned sum, cnt, mine, sp = 0u;
  for (;;) {
    sum = 0u; cnt = 0u; mine = 0u;
#pragma unroll
    for (unsigned j = 0; j < 16; ++j) { const unsigned c = xb_ld(&bar[XB_XCNT(j)]); sum += c; cnt += (c > 0u) ? 1u : 0u; mine = (j == x) ? c : mine; }
    if (sum == G) break;
    __builtin_amdgcn_s_sleep(1);
    if ((++sp & 255u) == 0u) { if (xb_ld(&bar[XB_TMO])) break; if (sp > XB_SPIN_CAP) { atomicAdd(&bar[XB_TMO], 1u); break; } }
  }
  nloc = mine > 0u ? mine : 1u; nx = cnt > 0u ? cnt : 1u;
}
DI void xcd_barrier(const XcdBarrier& b) {
  asm volatile("s_waitcnt vmcnt(0)" ::: "memory");
  __syncthreads();
  if (threadIdx.x == 0) {
    unsigned* bar = b.bar;
    __builtin_amdgcn_s_waitcnt(0);
    unsigned nloc = b.st[0], nx = b.st[1];
    if (nloc == 0u) { xcd_barrier_complete(bar, b.x, nloc, nx); b.st[0] = nloc; b.st[1] = nx; }
    const unsigned old = xb_add(&bar[XB_XSUB(b.x)], 1u);
    const unsigned gen = old / nloc;
    if (old + 1u == (gen + 1u) * nloc) {
      __builtin_amdgcn_fence(__ATOMIC_RELEASE, "agent");
      asm volatile("s_waitcnt vmcnt(0)" ::: "memory");
      const unsigned og = xb_add(&bar[XB_TOP], 1u);
      const unsigned tg = og / nx;
      if (og + 1u == (tg + 1u) * nx) xb_add(&bar[XB_TOPGEN], 1u);
      else XB_SPIN(xb_ld(&bar[XB_TOPGEN]) == tg, bar);
      __builtin_amdgcn_fence(__ATOMIC_ACQUIRE, "agent");
      xb_add(&bar[XB_XGEN(b.x)], 1u);
      asm volatile("s_waitcnt vmcnt(0)" ::: "memory");
    } else {
      XB_SPIN(xb_ld(&bar[XB_XGEN(b.x)]) == gen, bar);
      __builtin_amdgcn_fence(__ATOMIC_ACQUIRE, "agent");
      asm volatile("s_waitcnt vmcnt(0)" ::: "memory");
    }
  }
  __syncthreads();
}

__global__ void __launch_bounds__(NTHREADS) mega(Params p) {
  extern __shared__ __attribute__((aligned(16))) char lds[];
  cg::grid_group grid = cg::this_grid();
  ln_rows(p, -1);
  conv_weights(p, 0, lds);
  rope_table(p);
  if (blockIdx.x == 0) {
    if (threadIdx.x < 256) p.ctr[threadIdx.x] = 0u;
    for (int i = threadIdx.x; i < XCD_BAR_WORDS; i += NTHREADS) p.bar[i] = 0u;
  }
  volatile unsigned* xst = (volatile unsigned*)(lds + LDS_JOB + 16);
  if (threadIdx.x == 0) { xst[0] = 0u; xst[1] = 0u; }
  grid.sync();
  const XcdBarrier xb = xcd_barrier_post(p.bar, xst);
  for (int l = 0; l < 4; ++l) {
    for (int rep = 0; rep < REP_P1; ++rep) {
      for (int j = blockIdx.x; j < 66 * 48; j += gridDim.x) inproj_tile(p, l, j / 48, j % 48, lds);
      xcd_barrier(xb);
    }
    for (int rep = 0; rep < REP_P2; ++rep) {
      constexpr int NTK = 2 * 2052, NUP = 66 * 14, NJ = NTK + NUP + 16;
      int pending = 0, par = 0;
      if (threadIdx.x == 0) pending = (int)atomicAdd(p.ctr + l * 2 + 8 * rep, 1u);
      for (;;) {
        const int j = next_job(p.ctr + l * 2 + 8 * rep, lds, pending, NJ, par);
        if (j >= NJ) break;
        if (j < 16) {
          cumsum_job(p, j, lds);
        } else if (j < 16 + NTK) {
          const int jj = j - 16;
          const int b = jj & 1, q = 2051 - (jj >> 1);
          topk_job(p, b, LEAD + 4 * q, lds);
        } else {
          const int u = j - 16 - NTK;
          upproj_tile(p, u / 14, u % 14, lds);
        }
      }
      xcd_barrier(xb);
    }
    for (int rep = 0; rep < REP_P3; ++rep) {
      constexpr int ND = 1056, NS = 528, NC = 2 * 1026, NJ = ND + NS + NC;
      {
        float* biasC = (float*)(lds + 143360);
        int* btab = (int*)(lds + 143360 + 1024);
        if (threadIdx.x < 256) biasC[threadIdx.x] = p.rel_bias[(threadIdx.x >> 3) * 16 + (threadIdx.x & 7)];
        if (threadIdx.x < 128) btab[threadIdx.x] = t5_bucket(threadIdx.x);
      }
      int pending = 0, par = 0;
      if (threadIdx.x == 0) pending = (int)atomicAdd(p.ctr + l * 2 + 1 + 8 * rep, 1u);
      for (;;) {
        const int j = next_job(p.ctr + l * 2 + 1 + 8 * rep, lds, pending, NJ, par);
        if (j >= NJ) break;
        if (j < ND) {
          const int qu = 32 - (j >> 5), rem = j & 31, kind = rem >> 4, b = (rem >> 3) & 1, head = rem & 7;
          if (kind == 0) attn_unit<64, 0>(p, l, b, head, qu, lds);
          else attn_unit<96, 1>(p, l, b, head, qu, lds);
        } else if (j < ND + NS) {
          const int u = j - ND;
          attn_unit<64, 2>(p, l, (u >> 3) & 1, u & 7, u >> 4, lds);
        } else {
          const int u = j - ND - NS;
          dsa_job(p, u & 1, LEAD + 8 * (u >> 1), lds);
        }
      }
      xcd_barrier(xb);
    }
    for (int j = blockIdx.x; j < 66 * 8; j += gridDim.x) {
      const int x = j & 7, a = j >> 3;
      outproj_tile(p, 2 * (a >> 1) + (x >> 2), 2 * (x & 3) + (a & 1), lds);
    }
    xcd_barrier(xb);
    ln_rows(p, l);
    if (l < 3) { conv_weights(p, l + 1, lds); xcd_barrier(xb); }
  }
}

extern "C" void kernel_launch(void* const* d_in, const int* in_sizes, int n_in, void* d_out, int out_size, void* d_ws, size_t ws_size,
                              hipStream_t stream) {
  static int grid = 0;
  if (grid == 0) {
    int dev = 0, cus = 0, per_cu = 0;
    hipGetDevice(&dev);
    hipDeviceGetAttribute(&cus, hipDeviceAttributeMultiprocessorCount, dev);
    if (hipFuncSetAttribute((const void*)mega, hipFuncAttributeMaxDynamicSharedMemorySize, LDS_BYTES) != hipSuccess) { fprintf(stderr, "hipFuncSetAttribute failed\n"); grid = -1; return; }
    hipOccupancyMaxActiveBlocksPerMultiprocessor(&per_cu, (const void*)mega, NTHREADS, LDS_BYTES);
    if (per_cu < 1) { fprintf(stderr, "occupancy query: %d\n", per_cu); grid = -1; return; }
    grid = cus * per_cu;
  }
  if (grid < 0) return;
  size_t off = 0;
  auto take = [&](size_t bytes) { size_t o = off; off += (bytes + 255) & ~(size_t)255; return (char*)d_ws + o; };
  Params p{};
  p.x = (const float*)d_in[0]; p.meta = (const float*)d_in[1]; p.ln0_g = (const float*)d_in[2]; p.ln0_b = (const float*)d_in[3];
  p.rel_bias = (const float*)d_in[4]; p.w_in = (const float*)d_in[5]; p.b_f = (const float*)d_in[6]; p.gq = (const float*)d_in[7];
  p.gkv = (const float*)d_in[8]; p.w_uq = (const float*)d_in[9]; p.w_ukv = (const float*)d_in[10]; p.sinks = (const float*)d_in[11];
  p.w_out = (const float*)d_in[12]; p.ln_g = (const float*)d_in[13]; p.ln_b = (const float*)d_in[14];
  p.out = (float*)d_out;
  p.ctr = (unsigned*)take(1024);
  p.bar = (unsigned*)take(XCD_BAR_WORDS * 4);
  p.Wt_in = (u16*)take((size_t)NIN * DM * 2);
  p.Wt_out = (u16*)take((size_t)DM * 2048 * 2);
  p.Wt_uq = (u16*)take((size_t)768 * 256 * 2);
  p.Wt_ukv = (u16*)take((size_t)1024 * 128 * 2);
  p.H = (u16*)take((size_t)MT * LDH * 2);
  p.Mix = (u16*)take((size_t)MT * 2048 * 2);
  p.Xb = p.Mix;
  p.VtA = (u16*)take((size_t)NB * 512 * PP * 2);
  p.VtD = (u16*)take((size_t)NB * 128 * PP * 2);
  p.R = (float*)take((size_t)MT * DM * 4);
  p.IDX = (u16*)take((size_t)MT * 256 * 2);
  p.IK = (u16*)take((size_t)MT * 64 * 2);
  p.Kpe = (u16*)take((size_t)MT * 32 * 2);
  p.IW = (float*)take((size_t)MT * 8 * 4);
  p.LOGF = (float*)take((size_t)NB * 8 * PP * 4);
  p.CUM = (float*)take((size_t)NB * 8 * PP * 4);
  p.ROPE = (float*)take((size_t)PP * 32 * 4);
  if (off > ws_size) { fprintf(stderr, "workspace too small: need %zu have %zu\n", off, ws_size); return; }
  {
    char* ob = (char*)d_out;
    p.Qm = (u16*)ob; ob += (size_t)MT * 768 * 2;
    p.Km = (u16*)ob; ob += (size_t)MT * 512 * 2;
    p.VtB = (u16*)ob; ob += (size_t)NB * 512 * PP * 2;
    if ((size_t)(ob - (char*)d_out) > (size_t)out_size * 4) { fprintf(stderr, "d_out too small for scratch\n"); return; }
  }
  hipMemsetAsync(p.ctr, 0, 1024 + XCD_BAR_WORDS * 4, stream);
  void* args[] = {&p};
  hipError_t e = hipLaunchCooperativeKernel((const void*)mega, dim3(grid), dim3(NTHREADS), args, LDS_BYTES, stream);
  if (e != hipSuccess) fprintf(stderr, "cooperative launch failed: %s (grid %d)\n", hipGetErrorString(e), grid);
}
```

```cpp
#include <hip/hip_runtime.h>
#include <hip/hip_cooperative_groups.h>
#include <cstdio>
namespace cg = cooperative_groups;

#define DI __device__ __forceinline__
typedef __attribute__((ext_vector_type(8))) short bf16x8;
typedef __attribute__((ext_vector_type(16))) float f32x16;
typedef __attribute__((ext_vector_type(4))) float f32x4;
typedef __attribute__((ext_vector_type(2))) float f32x2;
typedef __attribute__((ext_vector_type(2))) __bf16 bf2_t;
typedef __attribute__((ext_vector_type(4))) unsigned u32x4;
typedef __attribute__((ext_vector_type(2))) unsigned u32x2;
typedef unsigned short u16;
#define MFMA32(a, b, c) __builtin_amdgcn_mfma_f32_32x32x16_bf16((a), (b), (c), 0, 0, 0)

constexpr int NB = 2, PP = 8448, PV = 8320, LEAD = 112, DM = 1024, MT = NB * PP, SEQ = 8192;
constexpr int LDH = 5376, NIN = 6144;
constexpr int HQ_A = 0, HK_A = 512, HG_A = 1024, HCQ_B = 1536, HCKV_B = 1792, HG_B = 1920, HQ_C = 2432, HK_C = 2944, HV_C = 3072,
              HIQ_C = 3200, HG_C = 3712, HQ_D = 4224, HK_D = 4736, HG_D = 4864;
constexpr int D_IN = 6128;
constexpr float LOG2E = 1.4426950408889634f;
constexpr float NEGL = -1e30f;
constexpr float ALPHA = 1.681792830507429f;
constexpr int LDS_JOB = 147456;
constexpr int LDS_BYTES = LDS_JOB + 64;
constexpr int GEMM_STAGE = 55296;
constexpr int NTHREADS = 512;
#define REP_P1 1
#define REP_P2 1
#define REP_P3 1
#define SC_FOX 1.0f
#define SC_MLA 1.0f
#define SC_SWA 1.0f
#define SC_DSA 1.0f

struct Params {
  const float *x, *meta, *ln0_g, *ln0_b, *rel_bias, *w_in, *b_f, *gq, *gkv, *w_uq, *w_ukv, *sinks, *w_out, *ln_g, *ln_b;
  float* out;
  u16 *Wt_in, *Wt_out, *Wt_uq, *Wt_ukv;
  u16 *H, *Xb, *Mix, *VtA, *VtD, *VtB, *Qm, *Km, *Kpe, *IK, *IDX;
  float *R, *LOGF, *CUM, *IW, *ROPE;
  unsigned* ctr;
  unsigned* bar;
};

DI unsigned pk2(float a, float b) { f32x2 v = {a, b}; return __builtin_bit_cast(unsigned, __builtin_convertvector(v, bf2_t)); }
DI float bf_lo(unsigned u) { return __uint_as_float(u << 16); }
DI float bf_hi(unsigned u) { return __uint_as_float(u & 0xffff0000u); }
DI int opaque_tid() { int t = threadIdx.x; asm volatile("" : "+v"(t)); return t; }
DI int crow(int i, int h) { return (i & 3) + 8 * (i >> 2) + 4 * h; }
template <int CTRL> DI float dpp_mov(float v) { return __int_as_float(__builtin_amdgcn_mov_dpp(__float_as_int(v), CTRL, 0xF, 0xF, true)); }
DI float wsum(float v) {
  v += dpp_mov<0xB1>(v); v += dpp_mov<0x4E>(v); v += dpp_mov<0x141>(v); v += dpp_mov<0x140>(v);
  u32x2 r = __builtin_amdgcn_permlane16_swap(__float_as_uint(v), __float_as_uint(v), false, false);
  v = __uint_as_float(r[0]) + __uint_as_float(r[1]);
  r = __builtin_amdgcn_permlane32_swap(__float_as_uint(v), __float_as_uint(v), false, false);
  return __uint_as_float(r[0]) + __uint_as_float(r[1]);
}
DI float wmax(float v) {
  v = fmaxf(v, dpp_mov<0xB1>(v)); v = fmaxf(v, dpp_mov<0x4E>(v)); v = fmaxf(v, dpp_mov<0x141>(v)); v = fmaxf(v, dpp_mov<0x140>(v));
  u32x2 r = __builtin_amdgcn_permlane16_swap(__float_as_uint(v), __float_as_uint(v), false, false);
  v = fmaxf(__uint_as_float(r[0]), __uint_as_float(r[1]));
  r = __builtin_amdgcn_permlane32_swap(__float_as_uint(v), __float_as_uint(v), false, false);
  return fmaxf(__uint_as_float(r[0]), __uint_as_float(r[1]));
}
template <int CTRL> DI int dpp_movi(int v) { return __builtin_amdgcn_mov_dpp(v, CTRL, 0xF, 0xF, true); }
template <bool UP> DI int wscan(int v, int lane, int& total) {
  int acc = v, tot = v, o;
  o = dpp_movi<0xB1>(tot);  if (((lane & 1) != 0) == UP) acc += o;  tot += o;
  o = dpp_movi<0x4E>(tot);  if (((lane & 2) != 0) == UP) acc += o;  tot += o;
  o = dpp_movi<0x141>(tot); if (((lane & 4) != 0) == UP) acc += o;  tot += o;
  o = dpp_movi<0x140>(tot); if (((lane & 8) != 0) == UP) acc += o;  tot += o;
  u32x2 r = __builtin_amdgcn_permlane16_swap((unsigned)tot, (unsigned)tot, false, false);
  o = (int)((lane & 16) ? r[0] : r[1]); if (((lane & 16) != 0) == UP) acc += o; tot += o;
  r = __builtin_amdgcn_permlane32_swap((unsigned)tot, (unsigned)tot, false, false);
  o = (int)((lane & 32) ? r[0] : r[1]); if (((lane & 32) != 0) == UP) acc += o; tot += o;
  total = tot;
  return acc;
}
DI float xor32_max(float v) { const u32x2 r = __builtin_amdgcn_permlane32_swap(__float_as_uint(v), __float_as_uint(v), false, false); return fmaxf(__uint_as_float(r[0]), __uint_as_float(r[1])); }
DI float xor32_sum(float v) { const u32x2 r = __builtin_amdgcn_permlane32_swap(__float_as_uint(v), __float_as_uint(v), false, false); return __uint_as_float(r[0]) + __uint_as_float(r[1]); }
DI unsigned wminu(unsigned v) {
  unsigned o;
  o = (unsigned)dpp_movi<0xB1>((int)v); v = o < v ? o : v;
  o = (unsigned)dpp_movi<0x4E>((int)v); v = o < v ? o : v;
  o = (unsigned)dpp_movi<0x141>((int)v); v = o < v ? o : v;
  o = (unsigned)dpp_movi<0x140>((int)v); v = o < v ? o : v;
  u32x2 r = __builtin_amdgcn_permlane16_swap(v, v, false, false); v = r[0] < r[1] ? r[0] : r[1];
  r = __builtin_amdgcn_permlane32_swap(v, v, false, false); return r[0] < r[1] ? r[0] : r[1];
}
DI int wsumi(int v) { for (int o = 32; o > 0; o >>= 1) v += __shfl_xor(v, o); return v; }
DI float silu(float g) { return g / (1.f + __expf(-g)); }
DI float dot2(unsigned a, unsigned b, float c) { return __builtin_amdgcn_fdot2_f32_bf16(__builtin_bit_cast(bf2_t, a), __builtin_bit_cast(bf2_t, b), c, false); }
template <int CTRL> DI float dpp_add(float v) { return v + __int_as_float(__builtin_amdgcn_mov_dpp(__float_as_int(v), CTRL, 0xF, 0xF, true)); }
DI int t5_bucket(int n) {
  if (n < 16) return n;
  int lg = 16 + (int)(logf((float)n / 16.f) / logf(8.f) * 16.f);
  return lg < 31 ? lg : 31;
}

DI int next_job(unsigned* ctr, char* lds, int& pending, int njobs, int& par) {
  int* sj = (int*)(lds + LDS_JOB);
  if (threadIdx.x == 0) sj[par] = pending;
  __syncthreads();
  const int j = sj[par];
  par ^= 1;
  if (threadIdx.x == 0 && j < njobs) pending = (int)atomicAdd(ctr, 1u);
  return j;
}

template <bool SWAP, class Epi>
DI void gemm_tile(const u16* __restrict__ A, int lda, const u16* __restrict__ Bw, int ldb, int K, char* lds, Epi epi) {
  const int tid = opaque_tid(), lane = tid & 63, w = tid >> 6, r = lane & 31, h = lane >> 5;
  const int wm = w & 3, wn = w >> 2;
  f32x16 acc[2][2];
#pragma unroll
  for (int a = 0; a < 2; ++a)
#pragma unroll
    for (int b = 0; b < 2; ++b)
#pragma unroll
      for (int i = 0; i < 16; ++i) acc[a][b][i] = 0.f;
  const int lrow = tid >> 3, lkc = tid & 7;
  u32x4 ra0[4], rb0[2], ra1[4], rb1[2];
  const u16* ap = A + (size_t)lrow * lda + lkc * 8;
  const u16* bp = Bw + (size_t)lrow * ldb + lkc * 8;
  const int nk = K >> 6;
  auto gload = [&](int kt, u32x4* ra, u32x4* rb) {
#pragma unroll
    for (int j = 0; j < 4; ++j) ra[j] = *(const u32x4*)(ap + (size_t)(64 * j) * lda + kt * 64);
#pragma unroll
    for (int j = 0; j < 2; ++j) rb[j] = *(const u32x4*)(bp + (size_t)(64 * j) * ldb + kt * 64);
  };
  auto lstore = [&](int st, const u32x4* ra, const u32x4* rb) {
    char* base = lds + st * GEMM_STAGE;
#pragma unroll
    for (int j = 0; j < 4; ++j) *(u32x4*)(base + ((lrow + 64 * j) * 72 + lkc * 8) * 2) = ra[j];
#pragma unroll
    for (int j = 0; j < 2; ++j) *(u32x4*)(base + 36864 + ((lrow + 64 * j) * 72 + lkc * 8) * 2) = rb[j];
  };
  auto compute = [&](int st) {
    const char* as = lds + st * GEMM_STAGE;
    const char* bs = as + 36864;
#pragma unroll
    for (int ks = 0; ks < 4; ++ks) {
      bf16x8 af[2], bfr[2];
#pragma unroll
      for (int mi = 0; mi < 2; ++mi) af[mi] = *(const bf16x8*)(as + ((wm * 64 + mi * 32 + r) * 72 + ks * 16 + 8 * h) * 2);
#pragma unroll
      for (int ni = 0; ni < 2; ++ni) bfr[ni] = *(const bf16x8*)(bs + ((wn * 64 + ni * 32 + r) * 72 + ks * 16 + 8 * h) * 2);
#pragma unroll
      for (int mi = 0; mi < 2; ++mi)
#pragma unroll
        for (int ni = 0; ni < 2; ++ni) {
          if (SWAP) acc[mi][ni] = MFMA32(bfr[ni], af[mi], acc[mi][ni]);
          else acc[mi][ni] = MFMA32(af[mi], bfr[ni], acc[mi][ni]);
        }
    }
  };
  gload(0, ra0, rb0);
  lstore(0, ra0, rb0);
  gload(1, ra1, rb1);
  __syncthreads();
  for (int kt = 0; kt < nk; kt += 2) {
    if (kt + 2 < nk) gload(kt + 2, ra0, rb0);
    compute(0);
    lstore(1, ra1, rb1);
    __syncthreads();
    if (kt + 3 < nk) gload(kt + 3, ra1, rb1);
    compute(1);
    if (kt + 2 < nk) lstore(0, ra0, rb0);
    __syncthreads();
  }
#pragma unroll
  for (int mi = 0; mi < 2; ++mi)
#pragma unroll
    for (int ni = 0; ni < 2; ++ni) epi(mi, ni, acc[mi][ni]);
}

DI void store_rowmajor(u16* dst, const f32x16& a, int h, float sc) {
#pragma unroll
  for (int kp = 0; kp < 2; ++kp) {
    const int g = 2 * kp;
    unsigned ax = pk2(a[4 * g] * sc, a[4 * g + 1] * sc), ay = pk2(a[4 * g + 2] * sc, a[4 * g + 3] * sc);
    unsigned bx = pk2(a[4 * g + 4] * sc, a[4 * g + 5] * sc), by = pk2(a[4 * g + 6] * sc, a[4 * g + 7] * sc);
    const u32x2 rx = __builtin_amdgcn_permlane32_swap(ax, bx, false, false);
    const u32x2 ry = __builtin_amdgcn_permlane32_swap(ay, by, false, false);
    const u32x4 v = {rx[0], ry[0], rx[1], ry[1]};
    *(u32x4*)(dst + 8 * (g + h)) = v;
  }
}
DI void store_rope(u16* dst, const f32x16& a, int h, float sc, const float* rp) {
#pragma unroll
  for (int g = 0; g < 2; ++g) {
    f32x4 cs = *(const f32x4*)(rp + 8 * g + 4 * h);
    f32x4 sn = *(const f32x4*)(rp + 16 + 8 * g + 4 * h);
    float o1[4], o2[4];
#pragma unroll
    for (int e = 0; e < 4; ++e) {
      float x1 = a[4 * g + e] * sc, x2 = a[8 + 4 * g + e] * sc;
      o1[e] = x1 * cs[e] - x2 * sn[e];
      o2[e] = x1 * sn[e] + x2 * cs[e];
    }
    u32x2 v1 = {pk2(o1[0], o1[1]), pk2(o1[2], o1[3])};
    u32x2 v2 = {pk2(o2[0], o2[1]), pk2(o2[2], o2[3])};
    *(u32x2*)(dst + 8 * g + 4 * h) = v1;
    *(u32x2*)(dst + 16 + 8 * g + 4 * h) = v2;
  }
}
DI void store_transposed(u16* dst, const f32x16& a, int h, const float* rs  ) {
#pragma unroll
  for (int g = 0; g < 4; ++g) {
    float s0 = 1.f, s1 = 1.f, s2 = 1.f, s3 = 1.f;
    if (rs) { f32x4 sv = *(const f32x4*)(rs + 8 * g + 4 * h); s0 = sv[0]; s1 = sv[1]; s2 = sv[2]; s3 = sv[3]; }
    u32x2 v = {pk2(a[4 * g] * s0, a[4 * g + 1] * s1), pk2(a[4 * g + 2] * s2, a[4 * g + 3] * s3)};
    *(u32x2*)(dst + 8 * g + 4 * h) = v;
  }
}

DI void inproj_tile(const Params& p, int l, int mt, int nt, char* lds) {
  const int tid = opaque_tid(), lane = tid & 63, w = tid >> 6, r = lane & 31, h = lane >> 5;
  const int wm = w & 3, wn = w >> 2;
  const int m0 = mt * 256;
  const u16* A = p.Xb + (size_t)m0 * DM;
  const u16* Bw = p.Wt_in + (size_t)nt * 128 * DM;
  if (nt < 42) {
    float ssq = 0.f;
    gemm_tile<true>(A, DM, Bw, DM, DM, lds, [&](int mi, int ni, const f32x16& a) {
      const int tok = m0 + wm * 64 + mi * 32 + r;
      store_rowmajor(p.H + (size_t)tok * LDH + nt * 128 + wn * 64 + ni * 32, a, h, 1.f);
      if (nt >= 4 && nt < 8) {
        if (ni == 0) ssq = 0.f;
#pragma unroll
        for (int i = 0; i < 16; ++i) ssq += a[i] * a[i];
        if (ni == 1) {
          float tot = ssq + __shfl_xor(ssq, 32);
          tot = wmax(tot);
          if (lane == 0) atomicMax(p.ctr + 64 + l * 16 + (m0 / PP) * 8 + (nt - 4) * 2 + wn, __float_as_uint(sqrtf(tot) * 1.01f));
        }
      }
    });
  } else if (nt == 42) {
    gemm_tile<true>(A, DM, Bw, DM, DM, lds, [&](int mi, int ni, const f32x16& a) {
      const int tok = m0 + wm * 64 + mi * 32 + r;
      const int b = tok / PP, t = tok - b * PP;
      const int sub = wn * 2 + ni;
      if (sub == 0) {
        store_rope(p.Kpe + (size_t)tok * 32, a, h, 1.f, p.ROPE + (size_t)t * 32);
      } else if (sub == 1) {
        store_rowmajor(p.IK + (size_t)tok * 64, a, h, 1.f);
      } else if (sub == 2) {
        store_rowmajor(p.IK + (size_t)tok * 64 + 32, a, h, 1.f);
      } else {
#pragma unroll
        for (int e = 0; e < 4; ++e) {
          const int hd = e + 4 * h;
          float xv = a[e] + p.b_f[l * 8 + hd];
          float lf = fminf(xv, 0.f) - log1pf(expf(-fabsf(xv)));
          p.LOGF[(size_t)(b * 8 + hd) * PP + t] = lf;
          p.IW[(size_t)tok * 8 + hd] = a[4 + e];
        }
      }
    });
  } else {
    u16* vt; int nv, c0;
    if (nt < 47) { vt = p.VtA; nv = 512; c0 = (nt - 43) * 128; } else { vt = p.VtD; nv = 128; c0 = 0; }
    gemm_tile<false>(A, DM, Bw, DM, DM, lds, [&](int mi, int ni, const f32x16& a) {
      const int b = m0 / PP, t0 = m0 - b * PP + wm * 64 + mi * 32;
      const int col = c0 + wn * 64 + ni * 32 + r;
      store_transposed(vt + ((size_t)b * nv + col) * PP + t0, a, h, nullptr);
    });
  }
}

DI void upproj_tile(const Params& p, int mt, int nt14, char* lds) {
  const int tid = opaque_tid(), lane = tid & 63, w = tid >> 6, r = lane & 31, h = lane >> 5;
  const int wm = w & 3, wn = w >> 2;
  const int m0 = mt * 256;
  float* rs = (float*)(lds + 2 * GEMM_STAGE);
  const bool isq = nt14 < 6;
  {
    const int row = tid >> 1, half = tid & 1;
    const int kw = isq ? 128 : 64;
    const u16* src = p.H + (size_t)(m0 + row) * LDH + (isq ? HCQ_B : HCKV_B) + half * kw;
    float ss = 0.f;
    u32x4 rv[16];
#pragma unroll
    for (int c = 0; c < 8; ++c) rv[c] = *(const u32x4*)(src + c * 8);
    if (isq) {
#pragma unroll
      for (int c = 8; c < 16; ++c) rv[c] = *(const u32x4*)(src + c * 8);
    } else {
#pragma unroll
      for (int c = 8; c < 16; ++c) { rv[c][0] = 0u; rv[c][1] = 0u; rv[c][2] = 0u; rv[c][3] = 0u; }
    }
#pragma unroll
    for (int c = 0; c < 16; ++c)
#pragma unroll
      for (int e = 0; e < 4; ++e) { float a = bf_lo(rv[c][e]), b2 = bf_hi(rv[c][e]); ss += a * a + b2 * b2; }
    ss += __shfl_xor(ss, 1);
    if (half == 0) rs[row] = rsqrtf(ss / (isq ? 256.f : 128.f) + 1e-6f);
  }
  __syncthreads();
  if (isq) {
    const int nt = nt14;
    gemm_tile<true>(p.H + (size_t)m0 * LDH + HCQ_B, LDH, p.Wt_uq + (size_t)nt * 128 * 256, 256, 256, lds, [&](int mi, int ni, const f32x16& a) {
      const int lr = wm * 64 + mi * 32 + r;
      const int tok = m0 + lr;
      const int t = tok % PP;
      const int j32 = nt * 4 + wn * 2 + ni;
      const float sc = rs[lr];
      u16* dst = p.Qm + (size_t)tok * 768 + j32 * 32;
      if (j32 % 3 == 2) store_rope(dst, a, h, sc, p.ROPE + (size_t)t * 32);
      else store_rowmajor(dst, a, h, sc);
    });
  } else {
    const int nt = nt14 - 6;
    const u16* A = p.H + (size_t)m0 * LDH + HCKV_B;
    const u16* Bw = p.Wt_ukv + (size_t)nt * 128 * 128;
    if (nt < 4) {
      gemm_tile<true>(A, LDH, Bw, 128, 128, lds, [&](int mi, int ni, const f32x16& a) {
        const int lr = wm * 64 + mi * 32 + r;
        store_rowmajor(p.Km + (size_t)(m0 + lr) * 512 + nt * 128 + wn * 64 + ni * 32, a, h, rs[lr]);
      });
    } else {
      gemm_tile<false>(A, LDH, Bw, 128, 128, lds, [&](int mi, int ni, const f32x16& a) {
        const int b = m0 / PP, t0 = m0 - b * PP + wm * 64 + mi * 32;
        const int col = (nt - 4) * 128 + wn * 64 + ni * 32 + r;
        store_transposed(p.VtB + ((size_t)b * 512 + col) * PP + t0, a, h, rs + wm * 64 + mi * 32);
      });
    }
  }
}

DI void cumsum_job(const Params& p, int j, char* lds) {
  const int tid = opaque_tid(), lane = tid & 63, w = tid >> 6;
  const float* src = p.LOGF + (size_t)j * PP;
  float* dst = p.CUM + (size_t)j * PP;
  float* wt = (float*)lds;
  float v[17];
#pragma unroll
  for (int rr = 0; rr < 17; ++rr) {
    const int o = rr * 64 + lane, i = w * 1056 + o;
    v[rr] = (o < 1056 && i >= LEAD) ? src[i] : 0.f;
  }
  float carry = 0.f;
#pragma unroll
  for (int rr = 0; rr < 17; ++rr) {
    float inc = v[rr];
    for (int o = 1; o < 64; o <<= 1) { float x = __shfl_up(inc, o); if (lane >= o) inc += x; }
    v[rr] = inc + carry;
    carry += __shfl(inc, 63);
  }
  if (lane == 0) wt[w] = carry;
  __syncthreads();
  float base = 0.f;
  for (int k = 0; k < w; ++k) base += wt[k];
#pragma unroll
  for (int rr = 0; rr < 17; ++rr) {
    const int o = rr * 64 + lane;
    if (o < 1056) dst[w * 1056 + o] = v[rr] + base;
  }
}

DI void topk_job(const Params& p, int b, int t0, char* lds) {
  const int tid = opaque_tid(), lane = tid & 63, w = tid >> 6, r = lane & 31, h = lane >> 5;
  const int cmax = (t0 + 3) >> 6;
  unsigned sc[17][4];
  {
    const u16* iqp = p.H + (size_t)(b * PP + t0 + (r >> 3)) * LDH + HIQ_C + (r & 7) * 64 + 8 * h;
    bf16x8 af[4];
#pragma unroll
    for (int ks = 0; ks < 4; ++ks) af[ks] = *(const bf16x8*)(iqp + ks * 16);
    f32x4 iw[4];
#pragma unroll
    for (int qi = 0; qi < 4; ++qi) iw[qi] = *(const f32x4*)(p.IW + (size_t)(b * PP + t0 + qi) * 8 + 4 * h);
    char* wb = lds + 16384 + w * 9216;
    const int lrow = lane >> 3, lpc = lane & 7;
    const u16* ikb = p.IK + ((size_t)(b * PP) + lrow) * 64 + lpc * 8;
    u32x4 st[8];
    if (1 + w <= cmax) {
      const u16* kp = ikb + (size_t)(1 + w) * 64 * 64;
#pragma unroll
      for (int j = 0; j < 8; ++j) st[j] = *(const u32x4*)(kp + (size_t)j * 8 * 64);
#pragma unroll
      for (int j = 0; j < 8; ++j) *(u32x4*)(wb + (lrow + 8 * j) * 144 + lpc * 16) = st[j];
    }
#pragma unroll
    for (int i = 0; i < 17; ++i) {
      const int c = 1 + w + 8 * i;
      if (c <= cmax) {
        const bool more = c + 8 <= cmax;
        if (more) {
          const u16* kp = ikb + (size_t)(c + 8) * 64 * 64;
#pragma unroll
          for (int j = 0; j < 8; ++j) st[j] = *(const u32x4*)(kp + (size_t)j * 8 * 64);
        }
        bf16x8 b0[4], b1[4];
#pragma unroll
        for (int ks = 0; ks < 4; ++ks) {
          b0[ks] = *(const bf16x8*)(wb + r * 144 + ks * 32 + h * 16);
          b1[ks] = *(const bf16x8*)(wb + (32 + r) * 144 + ks * 32 + h * 16);
        }
        __builtin_amdgcn_sched_barrier(0);
        f32x16 a0, a1;
#pragma unroll
        for (int e = 0; e < 16; ++e) { a0[e] = 0.f; a1[e] = 0.f; }
#pragma unroll
        for (int ks = 0; ks < 4; ++ks) { a0 = MFMA32(af[ks], b0[ks], a0); a1 = MFMA32(af[ks], b1[ks], a1); }
        const int key = c * 64 + lane;
#pragma unroll
        for (int qi = 0; qi < 4; ++qi) {
          f32x2 pp2 = {0.f, 0.f};
#pragma unroll
          for (int e = 0; e < 4; ++e) {
            const f32x2 rl = {fmaxf(a0[4 * qi + e], 0.f), fmaxf(a1[4 * qi + e], 0.f)};
            const f32x2 wv = {iw[qi][e], iw[qi][e]};
            pp2 += rl * wv;
          }
          const float p0 = pp2[0], p1 = pp2[1];
          const u32x2 sw = __builtin_amdgcn_permlane32_swap(__float_as_uint(p0), __float_as_uint(p1), false, false);
          float mine = __uint_as_float(sw[0]) + __uint_as_float(sw[1]);
          mine += 0.0f;
          unsigned u = __float_as_uint(mine);
          u = (u & 0x80000000u) ? ~u : (u | 0x80000000u);
          if (key > t0 + qi || key < LEAD) u = 0u;
          sc[i][qi] = u;
        }
        if (more) {
#pragma unroll
          for (int j = 0; j < 8; ++j) *(u32x4*)(wb + (lrow + 8 * j) * 144 + lpc * 16) = st[j];
        }
      } else {
#pragma unroll
        for (int qi = 0; qi < 4; ++qi) sc[i][qi] = 0u;
      }
    }
  }
  int* ng = (int*)(lds + 256);
  unsigned long long* mg = (unsigned long long*)(lds + 1024);
  unsigned long long* me = mg + 4 * 132;
  int* bg = (int*)(me + 4 * 132);
  int* be = bg + 4 * 132;
  unsigned T[4];
  {
    unsigned* hist = (unsigned*)(lds + 16384);
    int* sel = (int*)(lds + 512);
    unsigned pref[4] = {0u, 0u, 0u, 0u};
    int chi[4] = {0, 0, 0, 0};
    bool few[4] = {false, false, false, false};
    __syncthreads();
    bool small = false;
    int nb[4] = {0, 0, 0, 0};
#pragma unroll
    for (int pass = 0; pass < 3; ++pass) {
      if (pass == 2) {
        small = true;
#pragma unroll
        for (int q = 0; q < 4; ++q) small = small && (few[q] || nb[q] <= 64);
        if (small) break;
      }
      {
        const u32x4 z = {0u, 0u, 0u, 0u};
#pragma unroll
        for (int j = 0; j < 8; ++j) ((u32x4*)hist)[tid + 512 * j] = z;
      }
      __syncthreads();
#pragma unroll
      for (int i = 0; i < 17; ++i) {
#pragma unroll
        for (int q = 0; q < 4; ++q) {
          const unsigned u = sc[i][q];
          bool part; unsigned bin;
          if (pass == 0) { part = (u != 0u); bin = (u >> 22) + (lane & 3) * 1024; }
          else if (pass == 1) { part = (u != 0u) && ((u >> 22) == pref[q]) && !few[q]; bin = ((u >> 12) & 1023u) + (lane & 3) * 1024; }
          else { part = (u != 0u) && ((u >> 12) == pref[q]) && !few[q]; bin = u & 4095u; }
          if (part) atomicAdd(hist + q * 4096 + bin, 1u);
        }
      }
      __syncthreads();
      if (w < 4) {
        const int q = w;
        const unsigned* hq = hist + q * 4096;
        const int need = 256 - chi[q];
        int G = 0;
        if (pass < 2) {
#pragma unroll
          for (int rep = 0; rep < 4; ++rep)
#pragma unroll
            for (int j = 0; j < 16; ++j) G += (int)hq[rep * 1024 + 16 * lane + ((j + lane) & 15)];
        } else {
#pragma unroll 8
          for (int j = 0; j < 64; ++j) G += (int)hq[64 * lane + ((j + lane) & 63)];
        }
        int S = G;
        { int tt; S = wscan<false>(S, lane, tt); }
        const unsigned long long mk = __ballot(S >= need);
        int B = 0, cg2 = 0, fw = 0, nbin = 0;
        if (mk == 0ull) {
          fw = 1;
        } else {
          const int ks = 63 - __clzll(mk);
          const int above = (ks < 63) ? __builtin_amdgcn_readlane(S, ks + 1) : 0;
          int hh;
          if (pass < 2) {
            hh = 0;
            if (lane < 16) hh = (int)(hq[16 * ks + lane] + hq[1024 + 16 * ks + lane] + hq[2048 + 16 * ks + lane] + hq[3072 + 16 * ks + lane]);
          } else {
            hh = (int)hq[64 * ks + lane];
          }
          int s2 = hh;
          { int tt; s2 = wscan<false>(s2, lane, tt); }
          const unsigned long long m2 = __ballot(above + s2 >= need);
          const int Ls = 63 - __clzll(m2);
          B = (pass < 2 ? 16 : 64) * ks + Ls;
          nbin = __builtin_amdgcn_readlane(hh, Ls);
          cg2 = above + __builtin_amdgcn_readlane(s2, Ls) - nbin;
        }
        if (lane == 0) { sel[q * 4 + 0] = B; sel[q * 4 + 1] = chi[q] + cg2; sel[q * 4 + 2] = fw; sel[q * 4 + 3] = nbin; }
      }
      __syncthreads();
#pragma unroll
      for (int q = 0; q < 4; ++q) {
        if (!few[q]) {
          pref[q] = (pref[q] << (pass < 2 ? 10 : 12)) | (unsigned)sel[q * 4 + 0];
          chi[q] = sel[q * 4 + 1];
          nb[q] = sel[q * 4 + 3];
          if (pass == 0) few[q] = sel[q * 4 + 2] != 0;
        }
      }
    }
    if (small) {
      unsigned* lst = hist;
      int* lcnt = sel + 16;
      if (tid < 4) lcnt[tid] = 0;
      __syncthreads();
#pragma unroll
      for (int i = 0; i < 17; ++i)
#pragma unroll
        for (int q = 0; q < 4; ++q) {
          const unsigned u = sc[i][q];
          if (!few[q] && u != 0u && (u >> 12) == pref[q]) { const int pos = atomicAdd(lcnt + q, 1); lst[q * 64 + pos] = u; }
        }
      __syncthreads();
      if (w < 4) {
        const int q = w, n = lcnt[q], need = 256 - chi[q];
        const unsigned e = lane < n ? lst[q * 64 + lane] : 0u;
        int rank = 0;
        for (int k = 0; k < n; ++k) rank += (lst[q * 64 + k] > e) ? 1 : 0;
        unsigned cand = (lane < n && rank <= need - 1) ? e : 0xFFFFFFFFu;
        cand = wminu(cand);
        if (lane == 0) sel[q * 4 + 0] = (int)cand;
      }
      __syncthreads();
#pragma unroll
      for (int q = 0; q < 4; ++q) T[q] = few[q] ? 0u : (unsigned)sel[q * 4 + 0];
    } else {
#pragma unroll
      for (int q = 0; q < 4; ++q) T[q] = few[q] ? 0u : pref[q];
    }
  }
  unsigned* cntb = (unsigned*)mg;
  unsigned* baseb = (unsigned*)bg;
#pragma unroll
  for (int i = 0; i < 17; ++i) {
    const int c = 1 + w + 8 * i;
    if (c <= cmax) {
      unsigned mine = 0u;
#pragma unroll
      for (int q = 0; q < 4; ++q) {
        const unsigned pk = (unsigned)__popcll(__ballot(sc[i][q] > T[q])) | ((unsigned)__popcll(__ballot(sc[i][q] == T[q])) << 16);
        mine = (lane == q) ? pk : mine;
      }
      if (lane < 4) cntb[lane * 132 + c] = mine;
    }
  }
  __syncthreads();
  if (w < 4) {
    const int q = w;
    int cg_ = 0, ce_ = 0;
    for (int base = 0; base <= cmax; base += 64) {
      const int c = base + lane;
      const bool in = (c >= 1) && (c <= cmax);
      const unsigned cv = in ? cntb[q * 132 + c] : 0u;
      const int v1 = (int)(cv & 0xffffu), v2 = (int)(cv >> 16);
      int t1, t2;
      const int i1 = wscan<true>(v1, lane, t1), i2 = wscan<true>(v2, lane, t2);
      if (in) baseb[q * 132 + c] = (unsigned)(cg_ + i1 - v1) | ((unsigned)(ce_ + i2 - v2) << 16);
      cg_ += t1;
      ce_ += t2;
    }
    if (lane == 0) ng[q] = cg_;
  }
  __syncthreads();
  const unsigned long long lt = (1ull << lane) - 1ull;
#pragma unroll
  for (int i = 0; i < 17; ++i) {
    const int c = 1 + w + 8 * i;
    if (c <= cmax) {
      const int key = c * 64 + lane;
#pragma unroll
      for (int q = 0; q < 4; ++q) {
        u16* out = p.IDX + (size_t)(b * PP + t0 + q) * 256;
        const bool gt = sc[i][q] > T[q];
        const bool eq = (sc[i][q] == T[q]) && (T[q] != 0u);
        const unsigned long long m1 = __ballot(gt), m2 = __ballot(eq);
        if ((m1 | m2) != 0ull) {
          const unsigned bb = baseb[q * 132 + c];
          if (gt) out[(int)(bb & 0xffffu) + __popcll(m1 & lt)] = (u16)key;
          if (eq) { const int pos = ng[q] + (int)(bb >> 16) + __popcll(m2 & lt); if (pos < 256) out[pos] = (u16)key; }
        }
      }
    }
  }
#pragma unroll
  for (int q = 0; q < 4; ++q) {
    if (T[q] == 0u) {
      u16* out = p.IDX + (size_t)(b * PP + t0 + q) * 256;
      if (tid < 256 && tid >= ng[q]) out[tid] = (u16)0xFFFF;
    }
  }
}

constexpr int AT_STAGE = 23040;
template <int DK, int MODE>
DI void attn_unit(const Params& p, int l, int b, int head, int qu, char* lds) {
  const int tid = opaque_tid(), lane = tid & 63, w = tid >> 6, r = lane & 31, h = lane >> 5;
  constexpr int KS = DK / 16, KST = DK + 8;
  const int q0 = qu * 256, qw0 = q0 + w * 32, qw = qw0 + r;
  const size_t tokq = (size_t)b * PP + qw;
  const u16 *qptr, *kptr, *vtptr, *gptr;
  int ldk;
  if (MODE == 0) {
    qptr = p.H + tokq * LDH + HQ_A + head * 64; kptr = p.H + (size_t)b * PP * LDH + HK_A + head * 64; ldk = LDH;
    vtptr = p.VtA + ((size_t)b * 512 + head * 64) * PP; gptr = p.H + tokq * LDH + HG_A + head * 64;
  } else if (MODE == 1) {
    qptr = p.Qm + tokq * 768 + head * 96; kptr = p.Km + (size_t)b * PP * 512 + head * 64; ldk = 512;
    vtptr = p.VtB + ((size_t)b * 512 + head * 64) * PP; gptr = p.H + tokq * LDH + HG_B + head * 64;
  } else {
    qptr = p.H + tokq * LDH + HQ_D + head * 64; kptr = p.H + (size_t)b * PP * LDH + HK_D + (head >> 2) * 64; ldk = LDH;
    vtptr = p.VtD + ((size_t)b * 128 + (head >> 2) * 64) * PP; gptr = p.H + tokq * LDH + HG_D + head * 64;
  }
  const float* cum = p.CUM + (size_t)(b * 8 + head) * PP;
  float* btab = (float*)(lds + 2 * AT_STAGE);
  u32x2 gpre[2][4];
#pragma unroll
  for (int d = 0; d < 2; ++d)
#pragma unroll
    for (int g = 0; g < 4; ++g) gpre[d][g] = *(const u32x2*)(gptr + d * 32 + 8 * g + 4 * h);
  bf16x8 qf[KS];
#pragma unroll
  for (int ks = 0; ks < KS; ++ks) qf[ks] = *(const bf16x8*)(qptr + ks * 16 + 8 * h);
  float cref = 0.f;
  if (MODE == 0) cref = cum[q0];
  if (MODE == 2) { if (tid < 128) btab[tid] = p.rel_bias[t5_bucket(tid) * 16 + 8 + head] * LOG2E; }
  const float sc2 = (MODE == 1 ? 0.10206207261596577f : 0.125f) * LOG2E;
  const int kt_hi = qu * 4 + 3;
  int kt_lo = 1;
  if (MODE == 2) { kt_lo = qu * 4 - 2; if (kt_lo < 1) kt_lo = 1; }
  u32x4 rk, rk2, rv;
  float re = 0.f;
  const int srow = tid >> 3, sc8 = tid & 7;
  auto gload = [&](int kt) {
    const int k0 = kt * 64;
    rk = *(const u32x4*)(kptr + (size_t)(k0 + srow) * ldk + sc8 * 8);
    if (MODE == 1) { if (tid < 256) rk2 = *(const u32x4*)(p.Kpe + ((size_t)b * PP + k0 + (tid >> 2)) * 32 + (tid & 3) * 8); }
    rv = *(const u32x4*)(vtptr + (size_t)srow * PP + k0 + sc8 * 8);
    if (MODE == 0) { if (tid < 64) re = (cum[k0 + tid] - cref) * LOG2E; }
  };
  auto lstore = [&](int st) {
    char* base = lds + st * AT_STAGE;
    *(u32x4*)(base + (srow * KST + sc8 * 8) * 2) = rk;
    if (MODE == 1) { if (tid < 256) *(u32x4*)(base + ((tid >> 2) * KST + 64 + (tid & 3) * 8) * 2) = rk2; }
    char* vb = base + 64 * KST * 2;
    u32x2 lo = {rv[0], rv[1]}, hi = {rv[2], rv[3]};
    *(u32x2*)(vb + (srow * 68 + sc8 * 8) * 2) = lo;
    *(u32x2*)(vb + (srow * 68 + sc8 * 8 + 4) * 2) = hi;
    if (MODE == 0) { if (tid < 64) *(float*)(vb + 64 * 68 * 2 + tid * 4) = re; }
  };
  f32x16 o[2];
#pragma unroll
  for (int d = 0; d < 2; ++d)
#pragma unroll
    for (int i = 0; i < 16; ++i) o[d][i] = 0.f;
  float m = NEGL, lsum = 0.f;
  float qn = 0.f, kmx = 0.f;
  int* stopf = (int*)(lds + 2 * AT_STAGE + 1024);
  if (MODE == 0) {
#pragma unroll
    for (int ks = 0; ks < KS; ++ks) {
      const u32x4 qq = __builtin_bit_cast(u32x4, qf[ks]);
#pragma unroll
      for (int e = 0; e < 4; ++e) { const float a = bf_lo(qq[e]), b2 = bf_hi(qq[e]); qn += a * a + b2 * b2; }
    }
    qn = xor32_sum(qn);
    qn = sqrtf(qn) * 1.01f;
    kmx = __uint_as_float(p.ctr[64 + l * 16 + b * 8 + head]);
  }
  gload(kt_hi); lstore(0);
  __syncthreads();
  for (int kt = kt_hi; kt >= kt_lo; --kt) {
    const bool more = kt > kt_lo;
    if (more) gload(kt - 1);
    float cnext = 0.f;
    if (MODE == 0) { if (more) cnext = cum[(kt - 1) * 64 + 63]; }
    const int st = (kt_hi - kt) & 1;
    const int k0 = kt * 64;
    bool active = k0 <= qw0 + 31;
    if (MODE == 2) active = active && (k0 + 63 >= qw0 - 127);
    if (active) {
      const char* kb = lds + st * AT_STAGE;
      const char* vb = kb + 64 * KST * 2;
      f32x16 s[2];
      bf16x8 kf[2][KS];
#pragma unroll
      for (int kr = 0; kr < 2; ++kr)
#pragma unroll
        for (int ks = 0; ks < KS; ++ks) kf[kr][ks] = *(const bf16x8*)(kb + ((kr * 32 + r) * KST + ks * 16 + 8 * h) * 2);
      __builtin_amdgcn_sched_barrier(0);
#pragma unroll
      for (int kr = 0; kr < 2; ++kr) {
#pragma unroll
        for (int i = 0; i < 16; ++i) s[kr][i] = 0.f;
#pragma unroll
        for (int ks = 0; ks < KS; ++ks) s[kr] = MFMA32(kf[kr][ks], qf[ks], s[kr]);
      }
      u32x4 vfr[2][2][2];
#pragma unroll
      for (int kr = 0; kr < 2; ++kr)
#pragma unroll
        for (int s2 = 0; s2 < 2; ++s2)
#pragma unroll
          for (int d = 0; d < 2; ++d) {
            const char* va = vb + ((d * 32 + r) * 68 + kr * 32 + s2 * 16 + 4 * h) * 2;
            const u32x2 lo = *(const u32x2*)va;
            const u32x2 hi = *(const u32x2*)(va + 16);
            vfr[kr][s2][d] = (u32x4){lo[0], lo[1], hi[0], hi[1]};
          }
      __builtin_amdgcn_sched_barrier(0);
      const bool need_mask = (MODE == 2) || (k0 + 63 > qw0) || (k0 < LEAD);
      const bool rawpath = (MODE == 1) && !need_mask;
      float tmax = NEGL;
      const f32x2 sc2v = {sc2, sc2};
      if (rawpath) {
#pragma unroll
        for (int kr = 0; kr < 2; ++kr)
#pragma unroll
          for (int i = 0; i < 16; ++i) tmax = fmaxf(tmax, s[kr][i]);
        tmax *= sc2;
      } else {
#pragma unroll
        for (int kr = 0; kr < 2; ++kr) {
#pragma unroll
          for (int g = 0; g < 4; ++g) {
            f32x4 ev = {0.f, 0.f, 0.f, 0.f};
            if (MODE == 0) ev = *(const f32x4*)(vb + 64 * 68 * 2 + (kr * 32 + 8 * g + 4 * h) * 4);
#pragma unroll
            for (int e2 = 0; e2 < 2; ++e2) {
              const int i = 4 * g + 2 * e2;
              f32x2 v2 = {s[kr][i], s[kr][i + 1]};
              if (MODE == 0) { const f32x2 e2v = {ev[2 * e2], ev[2 * e2 + 1]}; v2 = v2 * sc2v - e2v; }
              else v2 = v2 * sc2v;
#pragma unroll
              for (int e1 = 0; e1 < 2; ++e1) {
                const int key = k0 + kr * 32 + 8 * g + 4 * h + 2 * e2 + e1;
                float v = v2[e1];
                if (MODE == 2) v += btab[(qw - key) & 127];
                if (need_mask) {
                  bool ok = (key <= qw) && (key >= LEAD);
                  if (MODE == 2) ok = ok && (qw - key < 128);
                  v = ok ? v : NEGL;
                }
                s[kr][i + e1] = v;
                tmax = fmaxf(tmax, v);
              }
            }
          }
        }
      }
      tmax = xor32_max(tmax);
      const float mn = fmaxf(m, tmax);
      const float alpha = __builtin_amdgcn_exp2f(m - mn);
      const bool resc = __any(m != mn);
      m = mn;
      f32x2 ps2 = {0.f, 0.f};
      const f32x2 mnv = {mn, mn};
      const f32x2 scx = rawpath ? sc2v : (f32x2){1.f, 1.f};
#pragma unroll
      for (int kr = 0; kr < 2; ++kr)
#pragma unroll
        for (int i = 0; i < 16; i += 2) {
          f32x2 v2 = {s[kr][i], s[kr][i + 1]};
          v2 = v2 * scx - mnv;
          f32x2 p2 = {__builtin_amdgcn_exp2f(v2[0]), __builtin_amdgcn_exp2f(v2[1])};
          s[kr][i] = p2[0]; s[kr][i + 1] = p2[1];
          ps2 += p2;
        }
      const float ps = ps2[0] + ps2[1];
      lsum = lsum * alpha + ps;
      if (resc)
#pragma unroll
      for (int d = 0; d < 2; ++d)
#pragma unroll
        for (int i = 0; i < 16; ++i) o[d][i] *= alpha;
#pragma unroll
      for (int kr = 0; kr < 2; ++kr) {
#pragma unroll
        for (int s2 = 0; s2 < 2; ++s2) {
          u32x4 pp = {pk2(s[kr][8 * s2], s[kr][8 * s2 + 1]), pk2(s[kr][8 * s2 + 2], s[kr][8 * s2 + 3]),
                      pk2(s[kr][8 * s2 + 4], s[kr][8 * s2 + 5]), pk2(s[kr][8 * s2 + 6], s[kr][8 * s2 + 7])};
          bf16x8 pf = __builtin_bit_cast(bf16x8, pp);
#pragma unroll
          for (int d = 0; d < 2; ++d) o[d] = MFMA32(__builtin_bit_cast(bf16x8, vfr[kr][s2][d]), pf, o[d]);
        }
      }
    }
    if (more) lstore(st ^ 1);
    if (MODE == 0) {
      if (more) {
        const float enext = (cnext - cref) * LOG2E;
        const bool okl = (qn * kmx * sc2 - enext) <= (m - 40.f);
        const bool okw = __all(okl);
        if (lane == 0) stopf[(kt & 1) * 8 + w] = okw ? 1 : 0;
      }
    }
    __syncthreads();
    if (MODE == 0) {
      if (more) {
        const int* sf = stopf + (kt & 1) * 8;
        if (sf[0] & sf[1] & sf[2] & sf[3] & sf[4] & sf[5] & sf[6] & sf[7]) break;
      }
    }
  }
  lsum = xor32_sum(lsum);
  float f;
  if (MODE == 2) {
    const float s2 = p.sinks[l * 8 + head] * LOG2E;
    const float mf = fmaxf(m, s2);
    const float em = __builtin_amdgcn_exp2f(m - mf);
    f = em / (lsum * em + __builtin_amdgcn_exp2f(s2 - mf));
  } else {
    f = lsum > 0.f ? 1.f / lsum : 0.f;
  }
  f *= (MODE == 0 ? SC_FOX : (MODE == 1 ? SC_MLA : SC_SWA));
  u16* mp = p.Mix + tokq * 2048 + (MODE == 0 ? 0 : (MODE == 1 ? 512 : 1536)) + head * 64;
#pragma unroll
  for (int d = 0; d < 2; ++d)
#pragma unroll
    for (int g = 0; g < 4; ++g) {
      const int dd = d * 32 + 8 * g + 4 * h;
      const u32x2 gv = gpre[d][g];
      float g0 = silu(bf_lo(gv[0])), g1 = silu(bf_hi(gv[0])), g2 = silu(bf_lo(gv[1])), g3 = silu(bf_hi(gv[1]));
      u32x2 ov = {pk2(o[d][4 * g] * f * g0, o[d][4 * g + 1] * f * g1), pk2(o[d][4 * g + 2] * f * g2, o[d][4 * g + 3] * f * g3)};
      *(u32x2*)(mp + dd) = ov;
    }
}

DI void dsa_job(const Params& p, int b, int tq0, char* lds) {
  const int tid = opaque_tid(), lane = tid & 63, w = tid >> 6;
  float* biasC = (float*)(lds + 143360);
  int* btab = (int*)(lds + 143360 + 1024);
  char* wl = lds + w * 17920;
  float* Pl = (float*)wl;
  int* kid = (int*)(wl + 8192);
  const int tq = tq0 + w;
  const size_t tok = (size_t)b * PP + tq;
  const u16* Hb = p.H + (size_t)b * PP * LDH;
  int kk[4], ku[4];
  {
    u32x2 iv = *(const u32x2*)(p.IDX + tok * 256 + 4 * lane);
    kk[0] = iv[0] & 0xffff; kk[1] = iv[0] >> 16; kk[2] = iv[1] & 0xffff; kk[3] = iv[1] >> 16;
#pragma unroll
    for (int j = 0; j < 4; ++j) ku[j] = (kk[j] == 0xFFFF) ? LEAD : kk[j];
    u32x4 kv4 = {(unsigned)ku[0], (unsigned)ku[1], (unsigned)ku[2], (unsigned)ku[3]};
    ((u32x4*)kid)[lane] = kv4;
  }
  u32x4 gvp[4];
#pragma unroll
  for (int hh = 0; hh < 4; ++hh) gvp[hh] = *(const u32x4*)(p.H + tok * LDH + HG_C + (((lane >> 3) & 1) * 4 + hh) * 64 + (lane & 7) * 8);
  __builtin_amdgcn_wave_barrier();
  const int ksub = lane >> 4, g = (lane >> 3) & 1, dc = lane & 7;
  {
    const int r = lane & 31, h = lane >> 5, pc = lane & 15;
    char* kst = wl + 9216;
    bf16x8 qb[8];
#pragma unroll
    for (int ks = 0; ks < 8; ++ks) {
      u32x4 v = {0u, 0u, 0u, 0u};
      if (r < 8 && (ks >> 2) == (r >> 2)) v = *(const u32x4*)(p.H + tok * LDH + HQ_C + r * 64 + (ks & 3) * 16 + 8 * h);
      qb[ks] = __builtin_bit_cast(bf16x8, v);
    }
    const u16* kbase = Hb + HK_C + pc * 8;
    u32x4 st0[8], st1[8];
#pragma unroll
    for (int s2 = 0; s2 < 8; ++s2) st0[s2] = *(const u32x4*)(kbase + (size_t)kid[4 * s2 + ksub] * LDH);
#pragma unroll
    for (int s2 = 0; s2 < 8; ++s2) st1[s2] = *(const u32x4*)(kbase + (size_t)kid[32 + 4 * s2 + ksub] * LDH);
    auto chunk = [&](int c, u32x4* stc) {
#pragma unroll
      for (int s2 = 0; s2 < 8; ++s2) *(u32x4*)(kst + (4 * s2 + ksub) * 272 + pc * 16) = stc[s2];
      if (c + 2 < 8) {
#pragma unroll
        for (int s2 = 0; s2 < 8; ++s2) stc[s2] = *(const u32x4*)(kbase + (size_t)kid[32 * (c + 2) + 4 * s2 + ksub] * LDH);
      }
      bf16x8 af[8];
#pragma unroll
      for (int ks = 0; ks < 8; ++ks) af[ks] = *(const bf16x8*)(kst + r * 272 + ks * 32 + 16 * h);
      __builtin_amdgcn_sched_barrier(0);
      f32x16 acc0, acc1;
#pragma unroll
      for (int i = 0; i < 16; ++i) { acc0[i] = 0.f; acc1[i] = 0.f; }
#pragma unroll
      for (int ks = 0; ks < 8; ks += 2) { acc0 = MFMA32(af[ks], qb[ks], acc0); acc1 = MFMA32(af[ks + 1], qb[ks + 1], acc1); }
      if (r < 8) {
#pragma unroll
        for (int i = 0; i < 16; ++i) Pl[(32 * c + crow(i, h)) * 8 + r] = acc0[i] + acc1[i];
      }
    };
#pragma unroll 1
    for (int c = 0; c < 8; c += 2) { chunk(c, st0); chunk(c + 1, st1); }
  }
  __builtin_amdgcn_wave_barrier();
  float lg[4][8];
#pragma unroll
  for (int j = 0; j < 4; ++j) {
    const f32x4 v0 = *(const f32x4*)(Pl + (4 * lane + j) * 8), v1 = *(const f32x4*)(Pl + (4 * lane + j) * 8 + 4);
#pragma unroll
    for (int e = 0; e < 4; ++e) { lg[j][e] = v0[e]; lg[j][4 + e] = v1[e]; }
  }
  int bk[4];
#pragma unroll
  for (int j = 0; j < 4; ++j) { int dist = tq - ku[j]; bk[j] = (dist < 128) ? btab[dist & 127] : 31; }
#pragma unroll
  for (int hd = 0; hd < 8; ++hd) {
    float mx = NEGL;
#pragma unroll
    for (int j = 0; j < 4; ++j) {
      float v = lg[j][hd] * 0.125f + biasC[bk[j] * 8 + hd];
      v = (kk[j] == 0xFFFF) ? NEGL : v;
      lg[j][hd] = v;
      mx = fmaxf(mx, v);
    }
    mx = wmax(mx);
    float sm = 0.f;
#pragma unroll
    for (int j = 0; j < 4; ++j) { float e = __expf(lg[j][hd] - mx); lg[j][hd] = e; sm += e; }
    sm = wsum(sm);
    const float inv = 1.f / sm;
#pragma unroll
    for (int j = 0; j < 4; ++j) lg[j][hd] *= inv;
  }
#pragma unroll
  for (int j = 0; j < 4; ++j) {
    f32x4 v0 = {lg[j][0], lg[j][1], lg[j][2], lg[j][3]}, v1 = {lg[j][4], lg[j][5], lg[j][6], lg[j][7]};
    *(f32x4*)(Pl + (4 * lane + j) * 8) = v0;
    *(f32x4*)(Pl + (4 * lane + j) * 8 + 4) = v1;
  }
  __builtin_amdgcn_wave_barrier();
  const u16* vb = Hb + HV_C + g * 64 + dc * 8;
  f32x2 acc2[4][4];
#pragma unroll
  for (int hh = 0; hh < 4; ++hh)
#pragma unroll
    for (int e = 0; e < 4; ++e) { acc2[hh][e][0] = 0.f; acc2[hh][e][1] = 0.f; }
  u32x4 vA[16], vB[16];
  auto pv_load = [&](int grp, u32x4* dst) {
#pragma unroll
    for (int s = 0; s < 16; ++s) dst[s] = *(const u32x4*)(vb + (size_t)kid[4 * (grp * 16 + s) + ksub] * LDH);
  };
  auto pv_fma = [&](int grp, const u32x4* src) {
#pragma unroll
    for (int s = 0; s < 16; ++s) {
      const int slot = 4 * (grp * 16 + s) + ksub;
      const f32x4 pp = *(const f32x4*)(Pl + slot * 8 + g * 4);
      const u32x4 vv = src[s];
#pragma unroll
      for (int hh = 0; hh < 4; ++hh) {
        const f32x2 ph = {pp[hh], pp[hh]};
#pragma unroll
        for (int e = 0; e < 4; ++e) {
          const f32x2 vf2 = {bf_lo(vv[e]), bf_hi(vv[e])};
          acc2[hh][e] += ph * vf2;
        }
      }
    }
  };
  pv_load(0, vA);
  pv_load(1, vB);
  pv_fma(0, vA);
  pv_load(2, vA);
  pv_fma(1, vB);
  pv_load(3, vB);
  pv_fma(2, vA);
  pv_fma(3, vB);
  float acc[4][8];
#pragma unroll
  for (int hh = 0; hh < 4; ++hh)
#pragma unroll
    for (int e = 0; e < 8; ++e) { float v = acc2[hh][e >> 1][e & 1]; v += __shfl_xor(v, 16); v += __shfl_xor(v, 32); acc[hh][e] = v; }
  if (ksub == 0) {
#pragma unroll
    for (int hh = 0; hh < 4; ++hh) {
      const int hd = g * 4 + hh;
      const u32x4 gv = gvp[hh];
      u32x4 ov;
#pragma unroll
      for (int e = 0; e < 4; ++e) ov[e] = pk2(acc[hh][2 * e] * SC_DSA * silu(bf_lo(gv[e])), acc[hh][2 * e + 1] * SC_DSA * silu(bf_hi(gv[e])));
      *(u32x4*)(p.Mix + tok * 2048 + 1024 + hd * 64 + dc * 8) = ov;
    }
  }
}

DI void outproj_tile(const Params& p, int mt, int nt, char* lds) {
  const int tid = opaque_tid(), lane = tid & 63, w = tid >> 6, r = lane & 31, h = lane >> 5;
  const int wm = w & 3, wn = w >> 2;
  const int m0 = mt * 256;
  gemm_tile<true>(p.Mix + (size_t)m0 * 2048, 2048, p.Wt_out + (size_t)nt * 128 * 2048, 2048, 2048, lds, [&](int mi, int ni, const f32x16& a) {
    const int tok = m0 + wm * 64 + mi * 32 + r;
    float* rp = p.R + (size_t)tok * DM + nt * 128 + wn * 64 + ni * 32;
#pragma unroll
    for (int g = 0; g < 4; ++g) {
      f32x4 v = *(const f32x4*)(rp + 8 * g + 4 * h);
#pragma unroll
      for (int e = 0; e < 4; ++e) v[e] = ALPHA * v[e] + a[4 * g + e];
      *(f32x4*)(rp + 8 * g + 4 * h) = v;
    }
  });
}

DI void ln_rows(const Params& p, int l) {
  const int tid = opaque_tid(), lane = tid & 63, w = tid >> 6;
  const float* gg = l < 0 ? p.ln0_g : p.ln_g + l * DM;
  const float* bb = l < 0 ? p.ln0_b : p.ln_b + l * DM;
  const int stride = gridDim.x * 8;
  auto loadrow = [&](int row, f32x4* dst) {
    if (l < 0) {
      const int b = row / PP, t = row - b * PP;
      const float* src = nullptr;
      if (t >= 128 && t < PV) src = p.x + ((size_t)b * SEQ + (t - 128)) * DM;
      else if (t >= LEAD && t < 128) src = p.meta + (size_t)(t - LEAD) * DM;
#pragma unroll
      for (int j = 0; j < 4; ++j) {
        if (src) dst[j] = *(const f32x4*)(src + lane * 4 + 256 * j);
        else { dst[j][0] = 0.f; dst[j][1] = 0.f; dst[j][2] = 0.f; dst[j][3] = 0.f; }
      }
    } else {
#pragma unroll
      for (int j = 0; j < 4; ++j) dst[j] = *(const f32x4*)(p.R + (size_t)row * DM + lane * 4 + 256 * j);
    }
  };
  f32x4 v[4], vn[4];
  int row = blockIdx.x * 8 + w;
  if (row < MT) loadrow(row, v);
  for (; row < MT; row += stride) {
    const int b = row / PP, t = row - b * PP;
    if (row + stride < MT) loadrow(row + stride, vn);
    float s = 0.f;
#pragma unroll
    for (int j = 0; j < 4; ++j) s += v[j][0] + v[j][1] + v[j][2] + v[j][3];
    const float mu = wsum(s) * (1.f / DM);
    float q = 0.f;
#pragma unroll
    for (int j = 0; j < 4; ++j)
#pragma unroll
      for (int e = 0; e < 4; ++e) { float d = v[j][e] - mu; q += d * d; }
    const float rstd = rsqrtf(wsum(q) * (1.f / DM) + 1e-5f);
#pragma unroll
    for (int j = 0; j < 4; ++j) {
      const int c = lane * 4 + 256 * j;
      f32x4 g4 = *(const f32x4*)(gg + c), b4 = *(const f32x4*)(bb + c);
      f32x4 y;
#pragma unroll
      for (int e = 0; e < 4; ++e) y[e] = (v[j][e] - mu) * rstd * g4[e] + b4[e];
      if (l == 3) {
        if (t >= 128 && t < PV) *(f32x4*)(p.out + ((size_t)b * SEQ + (t - 128)) * DM + c) = y;
      } else {
        *(f32x4*)(p.R + (size_t)row * DM + c) = y;
        u32x2 yb = {pk2(y[0], y[1]), pk2(y[2], y[3])};
        *(u32x2*)(p.Xb + (size_t)row * DM + c) = yb;
      }
    }
#pragma unroll
    for (int j = 0; j < 4; ++j) v[j] = vn[j];
  }
}

DI int map_in(int n) {
  if (n < 512) return n;
  if (n < 1024) return n;
  if (n < 1536) return 1544 + (n - 1024);
  if (n < 1792) return 2056 + (n - 1536);
  if (n < 1920) return 2312 + (n - 1792);
  if (n < 2432) return 2472 + (n - 1920);
  if (n < 2944) return 2984 + (n - 2432);
  if (n < 3072) return 3496 + (n - 2944);
  if (n < 3200) return 3624 + (n - 3072);
  if (n < 3712) return 3752 + (n - 3200);
  if (n < 4224) return 4336 + (n - 3712);
  if (n < 4736) return 4848 + (n - 4224);
  if (n < 4864) return 5360 + (n - 4736);
  if (n < 5376) return 5616 + (n - 4864);
  if (n < 5408) return 2440 + (n - 5376);
  if (n < 5472) return 4264 + (n - 5408);
  if (n < 5480) return 1536 + (n - 5472);
  if (n < 5488) return 4328 + (n - 5480);
  if (n < 5504) return -1;
  if (n < 6016) return 1024 + (n - 5504);
  return 5488 + (n - 6016);
}
DI void conv_weights(const Params& p, int l, char* lds) {
  const int tid = opaque_tid();
  float* tile = (float*)lds;
  struct TD { u16* dst; int K, k0, n0; };
  const int nn_l = tid & 63;
  auto loadtile = [&](int tI, float* rv, TD& d) {
    const float* src; const float* ksc = nullptr; int ldsrc, kind, kt, ntile;
    if (tI < 1536) { kind = 0; kt = tI / 96; ntile = tI % 96; src = p.w_in + (size_t)l * DM * D_IN; ldsrc = D_IN; d.K = DM; d.dst = p.Wt_in; }
    else if (tI < 2048) { int u = tI - 1536; kind = 1; kt = u / 16; ntile = u % 16; src = p.w_out + (size_t)l * 2048 * DM; ldsrc = DM; d.K = 2048; d.dst = p.Wt_out; }
    else if (tI < 2096) { int u = tI - 2048; kind = 2; kt = u / 12; ntile = u % 12; src = p.w_uq + (size_t)l * 256 * 768; ldsrc = 768; d.K = 256; d.dst = p.Wt_uq; ksc = p.gq + l * 256; }
    else { int u = tI - 2096; kind = 3; kt = u / 16; ntile = u % 16; src = p.w_ukv + (size_t)l * 128 * 1024; ldsrc = 1024; d.K = 128; d.dst = p.Wt_ukv; ksc = p.gkv + l * 128; }
    d.k0 = kt * 64; d.n0 = ntile * 64;
    const int n = d.n0 + nn_l;
    int sc;
    if (kind == 0) sc = map_in(n);
    else if (kind == 3) sc = (n < 512) ? ((n >> 6) * 128 + (n & 63)) : (((n - 512) >> 6) * 128 + 64 + (n & 63));
    else sc = n;
#pragma unroll
    for (int j = 0; j < 8; ++j) {
      const int kk = (tid >> 6) + 8 * j;
      float v = 0.f;
      if (sc >= 0) v = src[(size_t)(d.k0 + kk) * ldsrc + sc];
      if (ksc) v *= ksc[d.k0 + kk];
      rv[j] = v;
    }
  };
  float rv[8], rn[8];
  TD dc, dn;
  int tI = blockIdx.x;
  if (tI < 2128) loadtile(tI, rv, dc);
  for (; tI < 2128; tI += gridDim.x) {
    const int tN = tI + gridDim.x;
    if (tN < 2128) loadtile(tN, rn, dn);
#pragma unroll
    for (int j = 0; j < 8; ++j) tile[nn_l * 65 + (tid >> 6) + 8 * j] = rv[j];
    __syncthreads();
    {
      const int nn = tid >> 3, kc = (tid & 7) * 8;
      const float* tp = tile + nn * 65 + kc;
      u32x4 ov = {pk2(tp[0], tp[1]), pk2(tp[2], tp[3]), pk2(tp[4], tp[5]), pk2(tp[6], tp[7])};
      *(u32x4*)(dc.dst + (size_t)(dc.n0 + nn) * dc.K + dc.k0 + kc) = ov;
    }
    __syncthreads();
#pragma unroll
    for (int j = 0; j < 8; ++j) rv[j] = rn[j];
    dc = dn;
  }
}
DI void rope_table(const Params& p) {
  const int gt = blockIdx.x * NTHREADS + threadIdx.x;
  for (int i = gt; i < PP * 16; i += gridDim.x * NTHREADS) {
    const int t = i >> 4, c = i & 15;
    const float freq = powf(10000.f, -(float)c / 16.f);
    const float ang = (float)(t - LEAD) * freq;
    float sn, cs;
    sincosf(ang, &sn, &cs);
    p.ROPE[(size_t)t * 32 + c] = cs;
    p.ROPE[(size_t)t * 32 + 16 + c] = sn;
  }
}


#define XB_TMO      128
#define XB_XCNT(j)  (256  + 64 * (j))
#define XB_XSUB(j)  (1280 + 64 * (j))
#define XB_XGEN(j)  (2304 + 64 * (j))
#define XB_TOP      3328
#define XB_TOPGEN   3392
#define XCD_BAR_WORDS 3456
#define XB_SPIN_CAP (1u << 18)
DI unsigned xb_ld(unsigned* p) { return __hip_atomic_load(p, __ATOMIC_RELAXED, __HIP_MEMORY_SCOPE_AGENT); }
DI unsigned xb_add(unsigned* p, unsigned v) { return __hip_atomic_fetch_add(p, v, __ATOMIC_RELAXED, __HIP_MEMORY_SCOPE_AGENT); }
DI unsigned xb_xcc_id() { return (unsigned)__builtin_amdgcn_s_getreg((3 << 11) | 20) & 0xFu; }
#define XB_SPIN(cond, bar) do { unsigned _sp = 0; while (cond) { __builtin_amdgcn_s_sleep(1); \
    if ((++_sp & 255u) == 0u) { if (xb_ld(&(bar)[XB_TMO])) break; if (_sp > XB_SPIN_CAP) { atomicAdd(&(bar)[XB_TMO], 1u); break; } } } } while (0)
struct XcdBarrier { unsigned* bar; unsigned x; volatile unsigned* st; };
DI XcdBarrier xcd_barrier_post(unsigned* bar, volatile unsigned* st) {
  XcdBarrier b; b.bar = bar; b.x = xb_xcc_id(); b.st = st;
  if (threadIdx.x == 0) (void)xb_add(&bar[XB_XCNT(b.x)], 1u);
  return b;
}
DI void xcd_barrier_complete(unsigned* bar, unsigned x, unsigned& nloc, unsigned& nx) {
  const unsigned G = gridDim.x * gridDim.y * gridDim.z;
  unsigned sum, cnt, mine, sp = 0u;
  for (;;) {
    sum = 0u; cnt = 0u; mine = 0u;
#pragma unroll
    for (unsigned j = 0; j < 16; ++j) { const unsigned c = xb_ld(&bar[XB_XCNT(j)]); sum += c; cnt += (c > 0u) ? 1u : 0u; mine = (j == x) ? c : mine; }
    if (sum == G) break;
    __builtin_amdgcn_s_sleep(1);
    if ((++sp & 255u) == 0u) { if (xb_ld(&bar[XB_TMO])) break; if (sp > XB_SPIN_CAP) { atomicAdd(&bar[XB_TMO], 1u); break; } }
  }
  nloc = mine > 0u ? mine : 1u; nx = cnt > 0u ? cnt : 1u;
}
DI void xcd_barrier(const XcdBarrier& b) {
  asm volatile("s_waitcnt vmcnt(0)" ::: "memory");
  __syncthreads();
  if (threadIdx.x == 0) {
    unsigned* bar = b.bar;
    __builtin_amdgcn_s_waitcnt(0);
    unsigned nloc = b.st[0], nx = b.st[1];
    if (nloc == 0u) { xcd_barrier_complete(bar, b.x, nloc, nx); b.st[0] = nloc; b.st[1] = nx; }
    const unsigned old = xb_add(&bar[XB_XSUB(b.x)], 1u);
    const unsigned gen = old / nloc;
    if (old + 1u == (gen + 1u) * nloc) {
      __builtin_amdgcn_fence(__ATOMIC_RELEASE, "agent");
      asm volatile("s_waitcnt vmcnt(0)" ::: "memory");
      const unsigned og = xb_add(&bar[XB_TOP], 1u);
      const unsigned tg = og / nx;
      if (og + 1u == (tg + 1u) * nx) xb_add(&bar[XB_TOPGEN], 1u);
      else XB_SPIN(xb_ld(&bar[XB_TOPGEN]) == tg, bar);
      __builtin_amdgcn_fence(__ATOMIC_ACQUIRE, "agent");
      xb_add(&bar[XB_XGEN(b.x)], 1u);
      asm volatile("s_waitcnt vmcnt(0)" ::: "memory");
    } else {
      XB_SPIN(xb_ld(&bar[XB_XGEN(b.x)]) == gen, bar);
      __builtin_amdgcn_fence(__ATOMIC_ACQUIRE, "agent");
      asm volatile("s_waitcnt vmcnt(0)" ::: "memory");
    }
  }
  __syncthreads();
}

__global__ void __launch_bounds__(NTHREADS) mega(Params p) {
  extern __shared__ __attribute__((aligned(16))) char lds[];
  cg::grid_group grid = cg::this_grid();
  ln_rows(p, -1);
  conv_weights(p, 0, lds);
  rope_table(p);
  if (blockIdx.x == 0) {
    if (threadIdx.x < 256) p.ctr[threadIdx.x] = 0u;
    for (int i = threadIdx.x; i < XCD_BAR_WORDS; i += NTHREADS) p.bar[i] = 0u;
  }
  volatile unsigned* xst = (volatile unsigned*)(lds + LDS_JOB + 16);
  if (threadIdx.x == 0) { xst[0] = 0u; xst[1] = 0u; }
  grid.sync();
  const XcdBarrier xb = xcd_barrier_post(p.bar, xst);
  for (int l = 0; l < 4; ++l) {
    for (int rep = 0; rep < REP_P1; ++rep) {
      for (int j = blockIdx.x; j < 66 * 48; j += gridDim.x) inproj_tile(p, l, j / 48, j % 48, lds);
      xcd_barrier(xb);
    }
    for (int rep = 0; rep < REP_P2; ++rep) {
      constexpr int NTK = 2 * 2052, NUP = 66 * 14, NJ = NTK + NUP + 16;
      int pending = 0, par = 0;
      if (threadIdx.x == 0) pending = (int)atomicAdd(p.ctr + l * 2 + 8 * rep, 1u);
      for (;;) {
        const int j = next_job(p.ctr + l * 2 + 8 * rep, lds, pending, NJ, par);
        if (j >= NJ) break;
        if (j < 16) {
          cumsum_job(p, j, lds);
        } else if (j < 16 + NTK) {
          const int jj = j - 16;
          const int b = jj & 1, q = 2051 - (jj >> 1);
          topk_job(p, b, LEAD + 4 * q, lds);
        } else {
          const int u = j - 16 - NTK;
          upproj_tile(p, u / 14, u % 14, lds);
        }
      }
      xcd_barrier(xb);
    }
    for (int rep = 0; rep < REP_P3; ++rep) {
      constexpr int ND = 1056, NS = 528, NC = 2 * 1026, NJ = ND + NS + NC;
      {
        float* biasC = (float*)(lds + 143360);
        int* btab = (int*)(lds + 143360 + 1024);
        if (threadIdx.x < 256) biasC[threadIdx.x] = p.rel_bias[(threadIdx.x >> 3) * 16 + (threadIdx.x & 7)];
        if (threadIdx.x < 128) btab[threadIdx.x] = t5_bucket(threadIdx.x);
      }
      int pending = 0, par = 0;
      if (threadIdx.x == 0) pending = (int)atomicAdd(p.ctr + l * 2 + 1 + 8 * rep, 1u);
      for (;;) {
        const int j = next_job(p.ctr + l * 2 + 1 + 8 * rep, lds, pending, NJ, par);
        if (j >= NJ) break;
        if (j < ND) {
          const int qu = 32 - (j >> 5), rem = j & 31, kind = rem >> 4, b = (rem >> 3) & 1, head = rem & 7;
          if (kind == 0) attn_unit<64, 0>(p, l, b, head, qu, lds);
          else attn_unit<96, 1>(p, l, b, head, qu, lds);
        } else if (j < ND + NS) {
          const int u = j - ND;
          attn_unit<64, 2>(p, l, (u >> 3) & 1, u & 7, u >> 4, lds);
        } else {
          const int u = j - ND - NS;
          dsa_job(p, u & 1, LEAD + 8 * (u >> 1), lds);
        }
      }
      xcd_barrier(xb);
    }
    for (int j = blockIdx.x; j < 66 * 8; j += gridDim.x) {
      const int x = j & 7, a = j >> 3;
      outproj_tile(p, 2 * (a >> 1) + (x >> 2), 2 * (x & 3) + (a & 1), lds);
    }
    xcd_barrier(xb);
    ln_rows(p, l);
    if (l < 3) { conv_weights(p, l + 1, lds); xcd_barrier(xb); }
  }
}

extern "C" void kernel_launch(void* const* d_in, const int* in_sizes, int n_in, void* d_out, int out_size, void* d_ws, size_t ws_size,
                              hipStream_t stream) {
  static int grid = 0;
  if (grid == 0) {
    int dev = 0, cus = 0, per_cu = 0;
    hipGetDevice(&dev);
    hipDeviceGetAttribute(&cus, hipDeviceAttributeMultiprocessorCount, dev);
    if (hipFuncSetAttribute((const void*)mega, hipFuncAttributeMaxDynamicSharedMemorySize, LDS_BYTES) != hipSuccess) { fprintf(stderr, "hipFuncSetAttribute failed\n"); grid = -1; return; }
    hipOccupancyMaxActiveBlocksPerMultiprocessor(&per_cu, (const void*)mega, NTHREADS, LDS_BYTES);
    if (per_cu < 1) { fprintf(stderr, "occupancy query: %d\n", per_cu); grid = -1; return; }
    grid = cus * per_cu;
  }
  if (grid < 0) return;
  size_t off = 0;
  auto take = [&](size_t bytes) { size_t o = off; off += (bytes + 255) & ~(size_t)255; return (char*)d_ws + o; };
  Params p{};
  p.x = (const float*)d_in[0]; p.meta = (const float*)d_in[1]; p.ln0_g = (const float*)d_in[2]; p.ln0_b = (const float*)d_in[3];
  p.rel_bias = (const float*)d_in[4]; p.w_in = (const float*)d_in[5]; p.b_f = (const float*)d_in[6]; p.gq = (const float*)d_in[7];
  p.gkv = (const float*)d_in[8]; p.w_uq = (const float*)d_in[9]; p.w_ukv = (const float*)d_in[10]; p.sinks = (const float*)d_in[11];
  p.w_out = (const float*)d_in[12]; p.ln_g = (const float*)d_in[13]; p.ln_b = (const float*)d_in[14];
  p.out = (float*)d_out;
  p.ctr = (unsigned*)take(1024);
  p.bar = (unsigned*)take(XCD_BAR_WORDS * 4);
  p.Wt_in = (u16*)take((size_t)NIN * DM * 2);
  p.Wt_out = (u16*)take((size_t)DM * 2048 * 2);
  p.Wt_uq = (u16*)take((size_t)768 * 256 * 2);
  p.Wt_ukv = (u16*)take((size_t)1024 * 128 * 2);
  p.H = (u16*)take((size_t)MT * LDH * 2);
  p.Mix = (u16*)take((size_t)MT * 2048 * 2);
  p.Xb = p.Mix;
  p.VtA = (u16*)take((size_t)NB * 512 * PP * 2);
  p.VtD = (u16*)take((size_t)NB * 128 * PP * 2);
  p.R = (float*)take((size_t)MT * DM * 4);
  p.IDX = (u16*)take((size_t)MT * 256 * 2);
  p.IK = (u16*)take((size_t)MT * 64 * 2);
  p.Kpe = (u16*)take((size_t)MT * 32 * 2);
  p.IW = (float*)take((size_t)MT * 8 * 4);
  p.LOGF = (float*)take((size_t)NB * 8 * PP * 4);
  p.CUM = (float*)take((size_t)NB * 8 * PP * 4);
  p.ROPE = (float*)take((size_t)PP * 32 * 4);
  if (off > ws_size) { fprintf(stderr, "workspace too small: need %zu have %zu\n", off, ws_size); return; }
  {
    char* ob = (char*)d_out;
    p.Qm = (u16*)ob; ob += (size_t)MT * 768 * 2;
    p.Km = (u16*)ob; ob += (size_t)MT * 512 * 2;
    p.VtB = (u16*)ob; ob += (size_t)NB * 512 * PP * 2;
    if ((size_t)(ob - (char*)d_out) > (size_t)out_size * 4) { fprintf(stderr, "d_out too small for scratch\n"); return; }
  }
  hipMemsetAsync(p.ctr, 0, 1024 + XCD_BAR_WORDS * 4, stream);
  void* args[] = {&p};
  hipError_t e = hipLaunchCooperativeKernel((const void*)mega, dim3(grid), dim3(NTHREADS), args, LDS_BYTES, stream);
  if (e != hipSuccess) fprintf(stderr, "cooperative launch failed: %s (grid %d)\n", hipGetErrorString(e), grid);
}
```

```cpp
#include <hip/hip_runtime.h>
#include <hip/hip_cooperative_groups.h>
#include <cstdio>
namespace cg = cooperative_groups;

#define DI __device__ __forceinline__
typedef __attribute__((ext_vector_type(8))) short bf16x8;
typedef __attribute__((ext_vector_type(16))) float f32x16;
typedef __attribute__((ext_vector_type(4))) float f32x4;
typedef __attribute__((ext_vector_type(2))) float f32x2;
typedef __attribute__((ext_vector_type(2))) __bf16 bf2_t;
typedef __attribute__((ext_vector_type(4))) unsigned u32x4;
typedef __attribute__((ext_vector_type(2))) unsigned u32x2;
typedef unsigned short u16;
#define MFMA32(a, b, c) __builtin_amdgcn_mfma_f32_32x32x16_bf16((a), (b), (c), 0, 0, 0)

constexpr int NB = 2, PP = 8448, PV = 8320, LEAD = 112, DM = 1024, MT = NB * PP, SEQ = 8192;
constexpr int LDH = 5376, NIN = 6144;
constexpr int HQ_A = 0, HK_A = 512, HG_A = 1024, HCQ_B = 1536, HCKV_B = 1792, HG_B = 1920, HQ_C = 2432, HK_C = 2944, HV_C = 3072,
              HIQ_C = 3200, HG_C = 3712, HQ_D = 4224, HK_D = 4736, HG_D = 4864;
constexpr int D_IN = 6128;
constexpr float LOG2E = 1.4426950408889634f;
constexpr float NEGL = -1e30f;
constexpr float ALPHA = 1.681792830507429f;
constexpr int LDS_JOB = 147456;
constexpr int LDS_BYTES = LDS_JOB + 64;
constexpr int GEMM_STAGE = 55296;
constexpr int NTHREADS = 512;
#define REP_P1 1
#define REP_P2 1
#define REP_P3 1
#define SC_FOX 1.0f
#define SC_MLA 1.0f
#define SC_SWA 1.0f
#define SC_DSA 1.0f

struct Params {
  const float *x, *meta, *ln0_g, *ln0_b, *rel_bias, *w_in, *b_f, *gq, *gkv, *w_uq, *w_ukv, *sinks, *w_out, *ln_g, *ln_b;
  float* out;
  u16 *Wt_in, *Wt_out, *Wt_uq, *Wt_ukv;
  u16 *H, *Xb, *Mix, *VtA, *VtD, *VtB, *Qm, *Km, *Kpe, *IK, *IDX;
  float *R, *LOGF, *CUM, *IW, *ROPE, *Y1;
  unsigned* ctr;
  unsigned* bar;
};

DI unsigned pk2(float a, float b) { f32x2 v = {a, b}; return __builtin_bit_cast(unsigned, __builtin_convertvector(v, bf2_t)); }
DI float bf_lo(unsigned u) { return __uint_as_float(u << 16); }
DI float bf_hi(unsigned u) { return __uint_as_float(u & 0xffff0000u); }
DI int opaque_tid() { int t = threadIdx.x; asm volatile("" : "+v"(t)); return t; }
DI int crow(int i, int h) { return (i & 3) + 8 * (i >> 2) + 4 * h; }
template <int CTRL> DI float dpp_mov(float v) { return __int_as_float(__builtin_amdgcn_mov_dpp(__float_as_int(v), CTRL, 0xF, 0xF, true)); }
DI float wsum(float v) {
  v += dpp_mov<0xB1>(v); v += dpp_mov<0x4E>(v); v += dpp_mov<0x141>(v); v += dpp_mov<0x140>(v);
  u32x2 r = __builtin_amdgcn_permlane16_swap(__float_as_uint(v), __float_as_uint(v), false, false);
  v = __uint_as_float(r[0]) + __uint_as_float(r[1]);
  r = __builtin_amdgcn_permlane32_swap(__float_as_uint(v), __float_as_uint(v), false, false);
  return __uint_as_float(r[0]) + __uint_as_float(r[1]);
}
DI float wmax(float v) {
  v = fmaxf(v, dpp_mov<0xB1>(v)); v = fmaxf(v, dpp_mov<0x4E>(v)); v = fmaxf(v, dpp_mov<0x141>(v)); v = fmaxf(v, dpp_mov<0x140>(v));
  u32x2 r = __builtin_amdgcn_permlane16_swap(__float_as_uint(v), __float_as_uint(v), false, false);
  v = fmaxf(__uint_as_float(r[0]), __uint_as_float(r[1]));
  r = __builtin_amdgcn_permlane32_swap(__float_as_uint(v), __float_as_uint(v), false, false);
  return fmaxf(__uint_as_float(r[0]), __uint_as_float(r[1]));
}
template <int CTRL> DI int dpp_movi(int v) { return __builtin_amdgcn_mov_dpp(v, CTRL, 0xF, 0xF, true); }
template <bool UP> DI int wscan(int v, int lane, int& total) {
  int acc = v, tot = v, o;
  o = dpp_movi<0xB1>(tot);  if (((lane & 1) != 0) == UP) acc += o;  tot += o;
  o = dpp_movi<0x4E>(tot);  if (((lane & 2) != 0) == UP) acc += o;  tot += o;
  o = dpp_movi<0x141>(tot); if (((lane & 4) != 0) == UP) acc += o;  tot += o;
  o = dpp_movi<0x140>(tot); if (((lane & 8) != 0) == UP) acc += o;  tot += o;
  u32x2 r = __builtin_amdgcn_permlane16_swap((unsigned)tot, (unsigned)tot, false, false);
  o = (int)((lane & 16) ? r[0] : r[1]); if (((lane & 16) != 0) == UP) acc += o; tot += o;
  r = __builtin_amdgcn_permlane32_swap((unsigned)tot, (unsigned)tot, false, false);
  o = (int)((lane & 32) ? r[0] : r[1]); if (((lane & 32) != 0) == UP) acc += o; tot += o;
  total = tot;
  return acc;
}
DI float xor32_max(float v) { const u32x2 r = __builtin_amdgcn_permlane32_swap(__float_as_uint(v), __float_as_uint(v), false, false); return fmaxf(__uint_as_float(r[0]), __uint_as_float(r[1])); }
DI float xor32_sum(float v) { const u32x2 r = __builtin_amdgcn_permlane32_swap(__float_as_uint(v), __float_as_uint(v), false, false); return __uint_as_float(r[0]) + __uint_as_float(r[1]); }
DI unsigned wminu(unsigned v) {
  unsigned o;
  o = (unsigned)dpp_movi<0xB1>((int)v); v = o < v ? o : v;
  o = (unsigned)dpp_movi<0x4E>((int)v); v = o < v ? o : v;
  o = (unsigned)dpp_movi<0x141>((int)v); v = o < v ? o : v;
  o = (unsigned)dpp_movi<0x140>((int)v); v = o < v ? o : v;
  u32x2 r = __builtin_amdgcn_permlane16_swap(v, v, false, false); v = r[0] < r[1] ? r[0] : r[1];
  r = __builtin_amdgcn_permlane32_swap(v, v, false, false); return r[0] < r[1] ? r[0] : r[1];
}
DI int wsumi(int v) { for (int o = 32; o > 0; o >>= 1) v += __shfl_xor(v, o); return v; }
DI float silu(float g) { return g / (1.f + __expf(-g)); }
DI float dot2(unsigned a, unsigned b, float c) { return __builtin_amdgcn_fdot2_f32_bf16(__builtin_bit_cast(bf2_t, a), __builtin_bit_cast(bf2_t, b), c, false); }
template <int CTRL> DI float dpp_add(float v) { return v + __int_as_float(__builtin_amdgcn_mov_dpp(__float_as_int(v), CTRL, 0xF, 0xF, true)); }
DI int t5_bucket(int n) {
  if (n < 16) return n;
  int lg = 16 + (int)(logf((float)n / 16.f) / logf(8.f) * 16.f);
  return lg < 31 ? lg : 31;
}

DI int next_job(unsigned* ctr, char* lds, int& pending, int njobs, int& par) {
  int* sj = (int*)(lds + LDS_JOB);
  if (threadIdx.x == 0) sj[par] = pending;
  __syncthreads();
  const int j = sj[par];
  par ^= 1;
  if (threadIdx.x == 0 && j < njobs) pending = (int)atomicAdd(ctr, 1u);
  return j;
}

template <bool SWAP, class Epi>
DI void gemm_tile(const u16* __restrict__ A, int lda, const u16* __restrict__ Bw, int ldb, int K, char* lds, Epi epi) {
  const int tid = opaque_tid(), lane = tid & 63, w = tid >> 6, r = lane & 31, h = lane >> 5;
  const int wm = w & 3, wn = w >> 2;
  f32x16 acc[2][2];
#pragma unroll
  for (int a = 0; a < 2; ++a)
#pragma unroll
    for (int b = 0; b < 2; ++b)
#pragma unroll
      for (int i = 0; i < 16; ++i) acc[a][b][i] = 0.f;
  const int lrow = tid >> 3, lkc = tid & 7;
  u32x4 ra0[4], rb0[2], ra1[4], rb1[2];
  const u16* ap = A + (size_t)lrow * lda + lkc * 8;
  const u16* bp = Bw + (size_t)lrow * ldb + lkc * 8;
  const int nk = K >> 6;
  auto gload = [&](int kt, u32x4* ra, u32x4* rb) {
#pragma unroll
    for (int j = 0; j < 4; ++j) ra[j] = *(const u32x4*)(ap + (size_t)(64 * j) * lda + kt * 64);
#pragma unroll
    for (int j = 0; j < 2; ++j) rb[j] = *(const u32x4*)(bp + (size_t)(64 * j) * ldb + kt * 64);
  };
  auto lstore = [&](int st, const u32x4* ra, const u32x4* rb) {
    char* base = lds + st * GEMM_STAGE;
#pragma unroll
    for (int j = 0; j < 4; ++j) *(u32x4*)(base + ((lrow + 64 * j) * 72 + lkc * 8) * 2) = ra[j];
#pragma unroll
    for (int j = 0; j < 2; ++j) *(u32x4*)(base + 36864 + ((lrow + 64 * j) * 72 + lkc * 8) * 2) = rb[j];
  };
  auto compute = [&](int st) {
    const char* as = lds + st * GEMM_STAGE;
    const char* bs = as + 36864;
#pragma unroll
    for (int ks = 0; ks < 4; ++ks) {
      bf16x8 af[2], bfr[2];
#pragma unroll
      for (int mi = 0; mi < 2; ++mi) af[mi] = *(const bf16x8*)(as + ((wm * 64 + mi * 32 + r) * 72 + ks * 16 + 8 * h) * 2);
#pragma unroll
      for (int ni = 0; ni < 2; ++ni) bfr[ni] = *(const bf16x8*)(bs + ((wn * 64 + ni * 32 + r) * 72 + ks * 16 + 8 * h) * 2);
#pragma unroll
      for (int mi = 0; mi < 2; ++mi)
#pragma unroll
        for (int ni = 0; ni < 2; ++ni) {
          if (SWAP) acc[mi][ni] = MFMA32(bfr[ni], af[mi], acc[mi][ni]);
          else acc[mi][ni] = MFMA32(af[mi], bfr[ni], acc[mi][ni]);
        }
    }
  };
  gload(0, ra0, rb0);
  lstore(0, ra0, rb0);
  gload(1, ra1, rb1);
  __syncthreads();
  for (int kt = 0; kt < nk; kt += 2) {
    if (kt + 2 < nk) gload(kt + 2, ra0, rb0);
    compute(0);
    lstore(1, ra1, rb1);
    __syncthreads();
    if (kt + 3 < nk) gload(kt + 3, ra1, rb1);
    compute(1);
    if (kt + 2 < nk) lstore(0, ra0, rb0);
    __syncthreads();
  }
#pragma unroll
  for (int mi = 0; mi < 2; ++mi)
#pragma unroll
    for (int ni = 0; ni < 2; ++ni) epi(mi, ni, acc[mi][ni]);
}

DI void store_rowmajor(u16* dst, const f32x16& a, int h, float sc) {
#pragma unroll
  for (int kp = 0; kp < 2; ++kp) {
    const int g = 2 * kp;
    unsigned ax = pk2(a[4 * g] * sc, a[4 * g + 1] * sc), ay = pk2(a[4 * g + 2] * sc, a[4 * g + 3] * sc);
    unsigned bx = pk2(a[4 * g + 4] * sc, a[4 * g + 5] * sc), by = pk2(a[4 * g + 6] * sc, a[4 * g + 7] * sc);
    const u32x2 rx = __builtin_amdgcn_permlane32_swap(ax, bx, false, false);
    const u32x2 ry = __builtin_amdgcn_permlane32_swap(ay, by, false, false);
    const u32x4 v = {rx[0], ry[0], rx[1], ry[1]};
    *(u32x4*)(dst + 8 * (g + h)) = v;
  }
}
DI void store_rope(u16* dst, const f32x16& a, int h, float sc, const float* rp) {
#pragma unroll
  for (int g = 0; g < 2; ++g) {
    f32x4 cs = *(const f32x4*)(rp + 8 * g + 4 * h);
    f32x4 sn = *(const f32x4*)(rp + 16 + 8 * g + 4 * h);
    float o1[4], o2[4];
#pragma unroll
    for (int e = 0; e < 4; ++e) {
      float x1 = a[4 * g + e] * sc, x2 = a[8 + 4 * g + e] * sc;
      o1[e] = x1 * cs[e] - x2 * sn[e];
      o2[e] = x1 * sn[e] + x2 * cs[e];
    }
    u32x2 v1 = {pk2(o1[0], o1[1]), pk2(o1[2], o1[3])};
    u32x2 v2 = {pk2(o2[0], o2[1]), pk2(o2[2], o2[3])};
    *(u32x2*)(dst + 8 * g + 4 * h) = v1;
    *(u32x2*)(dst + 16 + 8 * g + 4 * h) = v2;
  }
}
DI void store_transposed(u16* dst, const f32x16& a, int h, const float* rs  ) {
#pragma unroll
  for (int g = 0; g < 4; ++g) {
    float s0 = 1.f, s1 = 1.f, s2 = 1.f, s3 = 1.f;
    if (rs) { f32x4 sv = *(const f32x4*)(rs + 8 * g + 4 * h); s0 = sv[0]; s1 = sv[1]; s2 = sv[2]; s3 = sv[3]; }
    u32x2 v = {pk2(a[4 * g] * s0, a[4 * g + 1] * s1), pk2(a[4 * g + 2] * s2, a[4 * g + 3] * s3)};
    *(u32x2*)(dst + 8 * g + 4 * h) = v;
  }
}

DI void inproj_tile(const Params& p, int l, int mt, int nt, char* lds) {
  const int tid = opaque_tid(), lane = tid & 63, w = tid >> 6, r = lane & 31, h = lane >> 5;
  const int wm = w & 3, wn = w >> 2;
  const int m0 = mt * 256;
  const u16* A = p.Xb + (size_t)m0 * DM;
  const u16* Bw = p.Wt_in + (size_t)nt * 128 * DM;
  if (nt < 42) {
    float ssq = 0.f;
    gemm_tile<true>(A, DM, Bw, DM, DM, lds, [&](int mi, int ni, const f32x16& a) {
      const int tok = m0 + wm * 64 + mi * 32 + r;
      store_rowmajor(p.H + (size_t)tok * LDH + nt * 128 + wn * 64 + ni * 32, a, h, 1.f);
      if (nt >= 4 && nt < 8) {
        if (ni == 0) ssq = 0.f;
#pragma unroll
        for (int i = 0; i < 16; ++i) ssq += a[i] * a[i];
        if (ni == 1) {
          float tot = ssq + __shfl_xor(ssq, 32);
          tot = wmax(tot);
          if (lane == 0) atomicMax(p.ctr + 64 + l * 16 + (m0 / PP) * 8 + (nt - 4) * 2 + wn, __float_as_uint(sqrtf(tot) * 1.01f));
        }
      }
    });
  } else if (nt == 42) {
    gemm_tile<true>(A, DM, Bw, DM, DM, lds, [&](int mi, int ni, const f32x16& a) {
      const int tok = m0 + wm * 64 + mi * 32 + r;
      const int b = tok / PP, t = tok - b * PP;
      const int sub = wn * 2 + ni;
      if (sub == 0) {
        store_rope(p.Kpe + (size_t)tok * 32, a, h, 1.f, p.ROPE + (size_t)t * 32);
      } else if (sub == 1) {
        store_rowmajor(p.IK + (size_t)tok * 64, a, h, 1.f);
      } else if (sub == 2) {
        store_rowmajor(p.IK + (size_t)tok * 64 + 32, a, h, 1.f);
      } else {
#pragma unroll
        for (int e = 0; e < 4; ++e) {
          const int hd = e + 4 * h;
          float xv = a[e] + p.b_f[l * 8 + hd];
          float lf = fminf(xv, 0.f) - log1pf(expf(-fabsf(xv)));
          p.LOGF[(size_t)(b * 8 + hd) * PP + t] = lf;
          p.IW[(size_t)tok * 8 + hd] = a[4 + e];
        }
      }
    });
  } else {
    u16* vt; int nv, c0;
    if (nt < 47) { vt = p.VtA; nv = 512; c0 = (nt - 43) * 128; } else { vt = p.VtD; nv = 128; c0 = 0; }
    gemm_tile<false>(A, DM, Bw, DM, DM, lds, [&](int mi, int ni, const f32x16& a) {
      const int b = m0 / PP, t0 = m0 - b * PP + wm * 64 + mi * 32;
      const int col = c0 + wn * 64 + ni * 32 + r;
      store_transposed(vt + ((size_t)b * nv + col) * PP + t0, a, h, nullptr);
    });
  }
}

DI void upproj_tile(const Params& p, int mt, int nt14, char* lds) {
  const int tid = opaque_tid(), lane = tid & 63, w = tid >> 6, r = lane & 31, h = lane >> 5;
  const int wm = w & 3, wn = w >> 2;
  const int m0 = mt * 256;
  float* rs = (float*)(lds + 2 * GEMM_STAGE);
  const bool isq = nt14 < 6;
  {
    const int row = tid >> 1, half = tid & 1;
    const int kw = isq ? 128 : 64;
    const u16* src = p.H + (size_t)(m0 + row) * LDH + (isq ? HCQ_B : HCKV_B) + half * kw;
    float ss = 0.f;
    u32x4 rv[16];
#pragma unroll
    for (int c = 0; c < 8; ++c) rv[c] = *(const u32x4*)(src + c * 8);
    if (isq) {
#pragma unroll
      for (int c = 8; c < 16; ++c) rv[c] = *(const u32x4*)(src + c * 8);
    } else {
#pragma unroll
      for (int c = 8; c < 16; ++c) { rv[c][0] = 0u; rv[c][1] = 0u; rv[c][2] = 0u; rv[c][3] = 0u; }
    }
#pragma unroll
    for (int c = 0; c < 16; ++c)
#pragma unroll
      for (int e = 0; e < 4; ++e) { float a = bf_lo(rv[c][e]), b2 = bf_hi(rv[c][e]); ss += a * a + b2 * b2; }
    ss += __shfl_xor(ss, 1);
    if (half == 0) rs[row] = rsqrtf(ss / (isq ? 256.f : 128.f) + 1e-6f);
  }
  __syncthreads();
  if (isq) {
    const int nt = nt14;
    gemm_tile<true>(p.H + (size_t)m0 * LDH + HCQ_B, LDH, p.Wt_uq + (size_t)nt * 128 * 256, 256, 256, lds, [&](int mi, int ni, const f32x16& a) {
      const int lr = wm * 64 + mi * 32 + r;
      const int tok = m0 + lr;
      const int t = tok % PP;
      const int j32 = nt * 4 + wn * 2 + ni;
      const float sc = rs[lr];
      u16* dst = p.Qm + (size_t)tok * 768 + j32 * 32;
      if (j32 % 3 == 2) store_rope(dst, a, h, sc, p.ROPE + (size_t)t * 32);
      else store_rowmajor(dst, a, h, sc);
    });
  } else {
    const int nt = nt14 - 6;
    const u16* A = p.H + (size_t)m0 * LDH + HCKV_B;
    const u16* Bw = p.Wt_ukv + (size_t)nt * 128 * 128;
    if (nt < 4) {
      gemm_tile<true>(A, LDH, Bw, 128, 128, lds, [&](int mi, int ni, const f32x16& a) {
        const int lr = wm * 64 + mi * 32 + r;
        store_rowmajor(p.Km + (size_t)(m0 + lr) * 512 + nt * 128 + wn * 64 + ni * 32, a, h, rs[lr]);
      });
    } else {
      gemm_tile<false>(A, LDH, Bw, 128, 128, lds, [&](int mi, int ni, const f32x16& a) {
        const int b = m0 / PP, t0 = m0 - b * PP + wm * 64 + mi * 32;
        const int col = (nt - 4) * 128 + wn * 64 + ni * 32 + r;
        store_transposed(p.VtB + ((size_t)b * 512 + col) * PP + t0, a, h, rs + wm * 64 + mi * 32);
      });
    }
  }
}

DI void cumsum_job(const Params& p, int j, char* lds) {
  const int tid = opaque_tid(), lane = tid & 63, w = tid >> 6;
  const float* src = p.LOGF + (size_t)j * PP;
  float* dst = p.CUM + (size_t)j * PP;
  float* wt = (float*)lds;
  float v[17];
#pragma unroll
  for (int rr = 0; rr < 17; ++rr) {
    const int o = rr * 64 + lane, i = w * 1056 + o;
    v[rr] = (o < 1056 && i >= LEAD) ? src[i] : 0.f;
  }
  float carry = 0.f;
#pragma unroll
  for (int rr = 0; rr < 17; ++rr) {
    float inc = v[rr];
    for (int o = 1; o < 64; o <<= 1) { float x = __shfl_up(inc, o); if (lane >= o) inc += x; }
    v[rr] = inc + carry;
    carry += __shfl(inc, 63);
  }
  if (lane == 0) wt[w] = carry;
  __syncthreads();
  float base = 0.f;
  for (int k = 0; k < w; ++k) base += wt[k];
#pragma unroll
  for (int rr = 0; rr < 17; ++rr) {
    const int o = rr * 64 + lane;
    if (o < 1056) dst[w * 1056 + o] = v[rr] + base;
  }
}

DI void topk_job(const Params& p, int b, int t0, char* lds) {
  const int tid = opaque_tid(), lane = tid & 63, w = tid >> 6, r = lane & 31, h = lane >> 5;
  const int cmax = (t0 + 3) >> 6;
  unsigned sc[17][4];
  {
    const u16* iqp = p.H + (size_t)(b * PP + t0 + (r >> 3)) * LDH + HIQ_C + (r & 7) * 64 + 8 * h;
    bf16x8 af[4];
#pragma unroll
    for (int ks = 0; ks < 4; ++ks) af[ks] = *(const bf16x8*)(iqp + ks * 16);
    f32x4 iw[4];
#pragma unroll
    for (int qi = 0; qi < 4; ++qi) iw[qi] = *(const f32x4*)(p.IW + (size_t)(b * PP + t0 + qi) * 8 + 4 * h);
    char* wb = lds + 16384 + w * 9216;
    const int lrow = lane >> 3, lpc = lane & 7;
    const u16* ikb = p.IK + ((size_t)(b * PP) + lrow) * 64 + lpc * 8;
    u32x4 st[8];
    if (1 + w <= cmax) {
      const u16* kp = ikb + (size_t)(1 + w) * 64 * 64;
#pragma unroll
      for (int j = 0; j < 8; ++j) st[j] = *(const u32x4*)(kp + (size_t)j * 8 * 64);
#pragma unroll
      for (int j = 0; j < 8; ++j) *(u32x4*)(wb + (lrow + 8 * j) * 144 + lpc * 16) = st[j];
    }
#pragma unroll
    for (int i = 0; i < 17; ++i) {
      const int c = 1 + w + 8 * i;
      if (c <= cmax) {
        const bool more = c + 8 <= cmax;
        if (more) {
          const u16* kp = ikb + (size_t)(c + 8) * 64 * 64;
#pragma unroll
          for (int j = 0; j < 8; ++j) st[j] = *(const u32x4*)(kp + (size_t)j * 8 * 64);
        }
        bf16x8 b0[4], b1[4];
#pragma unroll
        for (int ks = 0; ks < 4; ++ks) {
          b0[ks] = *(const bf16x8*)(wb + r * 144 + ks * 32 + h * 16);
          b1[ks] = *(const bf16x8*)(wb + (32 + r) * 144 + ks * 32 + h * 16);
        }
        __builtin_amdgcn_sched_barrier(0);
        f32x16 a0, a1;
#pragma unroll
        for (int e = 0; e < 16; ++e) { a0[e] = 0.f; a1[e] = 0.f; }
#pragma unroll
        for (int ks = 0; ks < 4; ++ks) { a0 = MFMA32(af[ks], b0[ks], a0); a1 = MFMA32(af[ks], b1[ks], a1); }
        const int key = c * 64 + lane;
#pragma unroll
        for (int qi = 0; qi < 4; ++qi) {
          f32x2 pp2 = {0.f, 0.f};
#pragma unroll
          for (int e = 0; e < 4; ++e) {
            const f32x2 rl = {fmaxf(a0[4 * qi + e], 0.f), fmaxf(a1[4 * qi + e], 0.f)};
            const f32x2 wv = {iw[qi][e], iw[qi][e]};
            pp2 += rl * wv;
          }
          const float p0 = pp2[0], p1 = pp2[1];
          const u32x2 sw = __builtin_amdgcn_permlane32_swap(__float_as_uint(p0), __float_as_uint(p1), false, false);
          float mine = __uint_as_float(sw[0]) + __uint_as_float(sw[1]);
          mine += 0.0f;
          unsigned u = __float_as_uint(mine);
          u = (u & 0x80000000u) ? ~u : (u | 0x80000000u);
          if (key > t0 + qi || key < LEAD) u = 0u;
          sc[i][qi] = u;
        }
        if (more) {
#pragma unroll
          for (int j = 0; j < 8; ++j) *(u32x4*)(wb + (lrow + 8 * j) * 144 + lpc * 16) = st[j];
        }
      } else {
#pragma unroll
        for (int qi = 0; qi < 4; ++qi) sc[i][qi] = 0u;
      }
    }
  }
  int* ng = (int*)(lds + 256);
  unsigned long long* mg = (unsigned long long*)(lds + 1024);
  unsigned long long* me = mg + 4 * 132;
  int* bg = (int*)(me + 4 * 132);
  int* be = bg + 4 * 132;
  unsigned T[4];
  {
    unsigned* hist = (unsigned*)(lds + 16384);
    int* sel = (int*)(lds + 512);
    unsigned pref[4] = {0u, 0u, 0u, 0u};
    int chi[4] = {0, 0, 0, 0};
    bool few[4] = {false, false, false, false};
    __syncthreads();
    bool small = false;
    int nb[4] = {0, 0, 0, 0};
#pragma unroll
    for (int pass = 0; pass < 3; ++pass) {
      if (pass == 2) {
        small = true;
#pragma unroll
        for (int q = 0; q < 4; ++q) small = small && (few[q] || nb[q] <= 64);
        if (small) break;
      }
      {
        const u32x4 z = {0u, 0u, 0u, 0u};
#pragma unroll
        for (int j = 0; j < 8; ++j) ((u32x4*)hist)[tid + 512 * j] = z;
      }
      __syncthreads();
#pragma unroll
      for (int i = 0; i < 17; ++i) {
#pragma unroll
        for (int q = 0; q < 4; ++q) {
          const unsigned u = sc[i][q];
          bool part; unsigned bin;
          if (pass == 0) { part = (u != 0u); bin = (u >> 22) + (lane & 3) * 1024; }
          else if (pass == 1) { part = (u != 0u) && ((u >> 22) == pref[q]) && !few[q]; bin = ((u >> 12) & 1023u) + (lane & 3) * 1024; }
          else { part = (u != 0u) && ((u >> 12) == pref[q]) && !few[q]; bin = u & 4095u; }
          if (part) atomicAdd(hist + q * 4096 + bin, 1u);
        }
      }
      __syncthreads();
      if (w < 4) {
        const int q = w;
        const unsigned* hq = hist + q * 4096;
        const int need = 256 - chi[q];
        int G = 0;
        if (pass < 2) {
#pragma unroll
          for (int rep = 0; rep < 4; ++rep)
#pragma unroll
            for (int j = 0; j < 16; ++j) G += (int)hq[rep * 1024 + 16 * lane + ((j + lane) & 15)];
        } else {
#pragma unroll 8
          for (int j = 0; j < 64; ++j) G += (int)hq[64 * lane + ((j + lane) & 63)];
        }
        int S = G;
        { int tt; S = wscan<false>(S, lane, tt); }
        const unsigned long long mk = __ballot(S >= need);
        int B = 0, cg2 = 0, fw = 0, nbin = 0;
        if (mk == 0ull) {
          fw = 1;
        } else {
          const int ks = 63 - __clzll(mk);
          const int above = (ks < 63) ? __builtin_amdgcn_readlane(S, ks + 1) : 0;
          int hh;
          if (pass < 2) {
            hh = 0;
            if (lane < 16) hh = (int)(hq[16 * ks + lane] + hq[1024 + 16 * ks + lane] + hq[2048 + 16 * ks + lane] + hq[3072 + 16 * ks + lane]);
          } else {
            hh = (int)hq[64 * ks + lane];
          }
          int s2 = hh;
          { int tt; s2 = wscan<false>(s2, lane, tt); }
          const unsigned long long m2 = __ballot(above + s2 >= need);
          const int Ls = 63 - __clzll(m2);
          B = (pass < 2 ? 16 : 64) * ks + Ls;
          nbin = __builtin_amdgcn_readlane(hh, Ls);
          cg2 = above + __builtin_amdgcn_readlane(s2, Ls) - nbin;
        }
        if (lane == 0) { sel[q * 4 + 0] = B; sel[q * 4 + 1] = chi[q] + cg2; sel[q * 4 + 2] = fw; sel[q * 4 + 3] = nbin; }
      }
      __syncthreads();
#pragma unroll
      for (int q = 0; q < 4; ++q) {
        if (!few[q]) {
          pref[q] = (pref[q] << (pass < 2 ? 10 : 12)) | (unsigned)sel[q * 4 + 0];
          chi[q] = sel[q * 4 + 1];
          nb[q] = sel[q * 4 + 3];
          if (pass == 0) few[q] = sel[q * 4 + 2] != 0;
        }
      }
    }
    if (small) {
      unsigned* lst = hist;
      int* lcnt = sel + 16;
      if (tid < 4) lcnt[tid] = 0;
      __syncthreads();
#pragma unroll
      for (int i = 0; i < 17; ++i)
#pragma unroll
        for (int q = 0; q < 4; ++q) {
          const unsigned u = sc[i][q];
          if (!few[q] && u != 0u && (u >> 12) == pref[q]) { const int pos = atomicAdd(lcnt + q, 1); lst[q * 64 + pos] = u; }
        }
      __syncthreads();
      if (w < 4) {
        const int q = w, n = lcnt[q], need = 256 - chi[q];
        const unsigned e = lane < n ? lst[q * 64 + lane] : 0u;
        int rank = 0;
        for (int k = 0; k < n; ++k) rank += (lst[q * 64 + k] > e) ? 1 : 0;
        unsigned cand = (lane < n && rank <= need - 1) ? e : 0xFFFFFFFFu;
        cand = wminu(cand);
        if (lane == 0) sel[q * 4 + 0] = (int)cand;
      }
      __syncthreads();
#pragma unroll
      for (int q = 0; q < 4; ++q) T[q] = few[q] ? 0u : (unsigned)sel[q * 4 + 0];
    } else {
#pragma unroll
      for (int q = 0; q < 4; ++q) T[q] = few[q] ? 0u : pref[q];
    }
  }
  unsigned* cntb = (unsigned*)mg;
  unsigned* baseb = (unsigned*)bg;
#pragma unroll
  for (int i = 0; i < 17; ++i) {
    const int c = 1 + w + 8 * i;
    if (c <= cmax) {
      unsigned mine = 0u;
#pragma unroll
      for (int q = 0; q < 4; ++q) {
        const unsigned pk = (unsigned)__popcll(__ballot(sc[i][q] > T[q])) | ((unsigned)__popcll(__ballot(sc[i][q] == T[q])) << 16);
        mine = (lane == q) ? pk : mine;
      }
      if (lane < 4) cntb[lane * 132 + c] = mine;
    }
  }
  __syncthreads();
  if (w < 4) {
    const int q = w;
    int cg_ = 0, ce_ = 0;
    for (int base = 0; base <= cmax; base += 64) {
      const int c = base + lane;
      const bool in = (c >= 1) && (c <= cmax);
      const unsigned cv = in ? cntb[q * 132 + c] : 0u;
      const int v1 = (int)(cv & 0xffffu), v2 = (int)(cv >> 16);
      int t1, t2;
      const int i1 = wscan<true>(v1, lane, t1), i2 = wscan<true>(v2, lane, t2);
      if (in) baseb[q * 132 + c] = (unsigned)(cg_ + i1 - v1) | ((unsigned)(ce_ + i2 - v2) << 16);
      cg_ += t1;
      ce_ += t2;
    }
    if (lane == 0) ng[q] = cg_;
  }
  __syncthreads();
  const unsigned long long lt = (1ull << lane) - 1ull;
#pragma unroll
  for (int i = 0; i < 17; ++i) {
    const int c = 1 + w + 8 * i;
    if (c <= cmax) {
      const int key = c * 64 + lane;
#pragma unroll
      for (int q = 0; q < 4; ++q) {
        u16* out = p.IDX + (size_t)(b * PP + t0 + q) * 256;
        const bool gt = sc[i][q] > T[q];
        const bool eq = (sc[i][q] == T[q]) && (T[q] != 0u);
        const unsigned long long m1 = __ballot(gt), m2 = __ballot(eq);
        if ((m1 | m2) != 0ull) {
          const unsigned bb = baseb[q * 132 + c];
          if (gt) out[(int)(bb & 0xffffu) + __popcll(m1 & lt)] = (u16)key;
          if (eq) { const int pos = ng[q] + (int)(bb >> 16) + __popcll(m2 & lt); if (pos < 256) out[pos] = (u16)key; }
        }
      }
    }
  }
#pragma unroll
  for (int q = 0; q < 4; ++q) {
    if (T[q] == 0u) {
      u16* out = p.IDX + (size_t)(b * PP + t0 + q) * 256;
      if (tid < 256 && tid >= ng[q]) out[tid] = (u16)0xFFFF;
    }
  }
}

constexpr int AT_STAGE = 23040;
template <int DK, int MODE>
DI void attn_unit(const Params& p, int l, int b, int head, int qu, char* lds) {
  const int tid = opaque_tid(), lane = tid & 63, w = tid >> 6, r = lane & 31, h = lane >> 5;
  constexpr int KS = DK / 16, KST = DK + 8;
  const int q0 = qu * 256, qw0 = q0 + w * 32, qw = qw0 + r;
  const size_t tokq = (size_t)b * PP + qw;
  const u16 *qptr, *kptr, *vtptr, *gptr;
  int ldk;
  if (MODE == 0) {
    qptr = p.H + tokq * LDH + HQ_A + head * 64; kptr = p.H + (size_t)b * PP * LDH + HK_A + head * 64; ldk = LDH;
    vtptr = p.VtA + ((size_t)b * 512 + head * 64) * PP; gptr = p.H + tokq * LDH + HG_A + head * 64;
  } else if (MODE == 1) {
    qptr = p.Qm + tokq * 768 + head * 96; kptr = p.Km + (size_t)b * PP * 512 + head * 64; ldk = 512;
    vtptr = p.VtB + ((size_t)b * 512 + head * 64) * PP; gptr = p.H + tokq * LDH + HG_B + head * 64;
  } else {
    qptr = p.H + tokq * LDH + HQ_D + head * 64; kptr = p.H + (size_t)b * PP * LDH + HK_D + (head >> 2) * 64; ldk = LDH;
    vtptr = p.VtD + ((size_t)b * 128 + (head >> 2) * 64) * PP; gptr = p.H + tokq * LDH + HG_D + head * 64;
  }
  const float* cum = p.CUM + (size_t)(b * 8 + head) * PP;
  float* btab = (float*)(lds + 2 * AT_STAGE);
  u32x2 gpre[2][4];
#pragma unroll
  for (int d = 0; d < 2; ++d)
#pragma unroll
    for (int g = 0; g < 4; ++g) gpre[d][g] = *(const u32x2*)(gptr + d * 32 + 8 * g + 4 * h);
  bf16x8 qf[KS];
#pragma unroll
  for (int ks = 0; ks < KS; ++ks) qf[ks] = *(const bf16x8*)(qptr + ks * 16 + 8 * h);
  float cref = 0.f;
  if (MODE == 0) cref = cum[q0];
  if (MODE == 2) { if (tid < 128) btab[tid] = p.rel_bias[t5_bucket(tid) * 16 + 8 + head] * LOG2E; }
  const float sc2 = (MODE == 1 ? 0.10206207261596577f : 0.125f) * LOG2E;
  const int kt_hi = qu * 4 + 3;
  int kt_lo = 1;
  if (MODE == 2) { kt_lo = qu * 4 - 2; if (kt_lo < 1) kt_lo = 1; }
  u32x4 rk, rk2, rv;
  float re = 0.f;
  const int srow = tid >> 3, sc8 = tid & 7;
  auto gload = [&](int kt) {
    const int k0 = kt * 64;
    rk = *(const u32x4*)(kptr + (size_t)(k0 + srow) * ldk + sc8 * 8);
    if (MODE == 1) { if (tid < 256) rk2 = *(const u32x4*)(p.Kpe + ((size_t)b * PP + k0 + (tid >> 2)) * 32 + (tid & 3) * 8); }
    rv = *(const u32x4*)(vtptr + (size_t)srow * PP + k0 + sc8 * 8);
    if (MODE == 0) { if (tid < 64) re = (cum[k0 + tid] - cref) * LOG2E; }
  };
  auto lstore = [&](int st) {
    char* base = lds + st * AT_STAGE;
    *(u32x4*)(base + (srow * KST + sc8 * 8) * 2) = rk;
    if (MODE == 1) { if (tid < 256) *(u32x4*)(base + ((tid >> 2) * KST + 64 + (tid & 3) * 8) * 2) = rk2; }
    char* vb = base + 64 * KST * 2;
    u32x2 lo = {rv[0], rv[1]}, hi = {rv[2], rv[3]};
    *(u32x2*)(vb + (srow * 68 + sc8 * 8) * 2) = lo;
    *(u32x2*)(vb + (srow * 68 + sc8 * 8 + 4) * 2) = hi;
    if (MODE == 0) { if (tid < 64) *(float*)(vb + 64 * 68 * 2 + tid * 4) = re; }
  };
  f32x16 o[2];
#pragma unroll
  for (int d = 0; d < 2; ++d)
#pragma unroll
    for (int i = 0; i < 16; ++i) o[d][i] = 0.f;
  float m = NEGL, lsum = 0.f;
  float qn = 0.f, kmx = 0.f;
  int* stopf = (int*)(lds + 2 * AT_STAGE + 1024);
  if (MODE == 0) {
#pragma unroll
    for (int ks = 0; ks < KS; ++ks) {
      const u32x4 qq = __builtin_bit_cast(u32x4, qf[ks]);
#pragma unroll
      for (int e = 0; e < 4; ++e) { const float a = bf_lo(qq[e]), b2 = bf_hi(qq[e]); qn += a * a + b2 * b2; }
    }
    qn = xor32_sum(qn);
    qn = sqrtf(qn) * 1.01f;
    kmx = __uint_as_float(p.ctr[64 + l * 16 + b * 8 + head]);
  }
  gload(kt_hi); lstore(0);
  __syncthreads();
  for (int kt = kt_hi; kt >= kt_lo; --kt) {
    const bool more = kt > kt_lo;
    if (more) gload(kt - 1);
    float cnext = 0.f;
    if (MODE == 0) { if (more) cnext = cum[(kt - 1) * 64 + 63]; }
    const int st = (kt_hi - kt) & 1;
    const int k0 = kt * 64;
    bool active = k0 <= qw0 + 31;
    if (MODE == 2) active = active && (k0 + 63 >= qw0 - 127);
    if (active) {
      const char* kb = lds + st * AT_STAGE;
      const char* vb = kb + 64 * KST * 2;
      f32x16 s[2];
      bf16x8 kf[2][KS];
#pragma unroll
      for (int kr = 0; kr < 2; ++kr)
#pragma unroll
        for (int ks = 0; ks < KS; ++ks) kf[kr][ks] = *(const bf16x8*)(kb + ((kr * 32 + r) * KST + ks * 16 + 8 * h) * 2);
      __builtin_amdgcn_sched_barrier(0);
#pragma unroll
      for (int kr = 0; kr < 2; ++kr) {
#pragma unroll
        for (int i = 0; i < 16; ++i) s[kr][i] = 0.f;
#pragma unroll
        for (int ks = 0; ks < KS; ++ks) s[kr] = MFMA32(kf[kr][ks], qf[ks], s[kr]);
      }
      u32x4 vfr[2][2][2];
#pragma unroll
      for (int kr = 0; kr < 2; ++kr)
#pragma unroll
        for (int s2 = 0; s2 < 2; ++s2)
#pragma unroll
          for (int d = 0; d < 2; ++d) {
            const char* va = vb + ((d * 32 + r) * 68 + kr * 32 + s2 * 16 + 4 * h) * 2;
            const u32x2 lo = *(const u32x2*)va;
            const u32x2 hi = *(const u32x2*)(va + 16);
            vfr[kr][s2][d] = (u32x4){lo[0], lo[1], hi[0], hi[1]};
          }
      __builtin_amdgcn_sched_barrier(0);
      const bool need_mask = (MODE == 2) || (k0 + 63 > qw0) || (k0 < LEAD);
      const bool rawpath = (MODE == 1) && !need_mask;
      float tmax = NEGL;
      const f32x2 sc2v = {sc2, sc2};
      if (rawpath) {
#pragma unroll
        for (int kr = 0; kr < 2; ++kr)
#pragma unroll
          for (int i = 0; i < 16; ++i) tmax = fmaxf(tmax, s[kr][i]);
        tmax *= sc2;
      } else {
#pragma unroll
        for (int kr = 0; kr < 2; ++kr) {
#pragma unroll
          for (int g = 0; g < 4; ++g) {
            f32x4 ev = {0.f, 0.f, 0.f, 0.f};
            if (MODE == 0) ev = *(const f32x4*)(vb + 64 * 68 * 2 + (kr * 32 + 8 * g + 4 * h) * 4);
#pragma unroll
            for (int e2 = 0; e2 < 2; ++e2) {
              const int i = 4 * g + 2 * e2;
              f32x2 v2 = {s[kr][i], s[kr][i + 1]};
              if (MODE == 0) { const f32x2 e2v = {ev[2 * e2], ev[2 * e2 + 1]}; v2 = v2 * sc2v - e2v; }
              else v2 = v2 * sc2v;
#pragma unroll
              for (int e1 = 0; e1 < 2; ++e1) {
                const int key = k0 + kr * 32 + 8 * g + 4 * h + 2 * e2 + e1;
                float v = v2[e1];
                if (MODE == 2) v += btab[(qw - key) & 127];
                if (need_mask) {
                  bool ok = (key <= qw) && (key >= LEAD);
                  if (MODE == 2) ok = ok && (qw - key < 128);
                  v = ok ? v : NEGL;
                }
                s[kr][i + e1] = v;
                tmax = fmaxf(tmax, v);
              }
            }
          }
        }
      }
      tmax = xor32_max(tmax);
      const float mn = fmaxf(m, tmax);
      const float alpha = __builtin_amdgcn_exp2f(m - mn);
      const bool resc = __any(m != mn);
      m = mn;
      f32x2 ps2 = {0.f, 0.f};
      const f32x2 mnv = {mn, mn};
      const f32x2 scx = rawpath ? sc2v : (f32x2){1.f, 1.f};
#pragma unroll
      for (int kr = 0; kr < 2; ++kr)
#pragma unroll
        for (int i = 0; i < 16; i += 2) {
          f32x2 v2 = {s[kr][i], s[kr][i + 1]};
          v2 = v2 * scx - mnv;
          f32x2 p2 = {__builtin_amdgcn_exp2f(v2[0]), __builtin_amdgcn_exp2f(v2[1])};
          s[kr][i] = p2[0]; s[kr][i + 1] = p2[1];
          ps2 += p2;
        }
      const float ps = ps2[0] + ps2[1];
      lsum = lsum * alpha + ps;
      if (resc)
#pragma unroll
      for (int d = 0; d < 2; ++d)
#pragma unroll
        for (int i = 0; i < 16; ++i) o[d][i] *= alpha;
#pragma unroll
      for (int kr = 0; kr < 2; ++kr) {
#pragma unroll
        for (int s2 = 0; s2 < 2; ++s2) {
          u32x4 pp = {pk2(s[kr][8 * s2], s[kr][8 * s2 + 1]), pk2(s[kr][8 * s2 + 2], s[kr][8 * s2 + 3]),
                      pk2(s[kr][8 * s2 + 4], s[kr][8 * s2 + 5]), pk2(s[kr][8 * s2 + 6], s[kr][8 * s2 + 7])};
          bf16x8 pf = __builtin_bit_cast(bf16x8, pp);
#pragma unroll
          for (int d = 0; d < 2; ++d) o[d] = MFMA32(__builtin_bit_cast(bf16x8, vfr[kr][s2][d]), pf, o[d]);
        }
      }
    }
    if (more) lstore(st ^ 1);
    if (MODE == 0) {
      if (more) {
        const float enext = (cnext - cref) * LOG2E;
        const bool okl = (qn * kmx * sc2 - enext) <= (m - 40.f);
        const bool okw = __all(okl);
        if (lane == 0) stopf[(kt & 1) * 8 + w] = okw ? 1 : 0;
      }
    }
    __syncthreads();
    if (MODE == 0) {
      if (more) {
        const int* sf = stopf + (kt & 1) * 8;
        if (sf[0] & sf[1] & sf[2] & sf[3] & sf[4] & sf[5] & sf[6] & sf[7]) break;
      }
    }
  }
  lsum = xor32_sum(lsum);
  float f;
  if (MODE == 2) {
    const float s2 = p.sinks[l * 8 + head] * LOG2E;
    const float mf = fmaxf(m, s2);
    const float em = __builtin_amdgcn_exp2f(m - mf);
    f = em / (lsum * em + __builtin_amdgcn_exp2f(s2 - mf));
  } else {
    f = lsum > 0.f ? 1.f / lsum : 0.f;
  }
  f *= (MODE == 0 ? SC_FOX : (MODE == 1 ? SC_MLA : SC_SWA));
  u16* mp = p.Mix + tokq * 2048 + (MODE == 0 ? 0 : (MODE == 1 ? 512 : 1536)) + head * 64;
#pragma unroll
  for (int d = 0; d < 2; ++d)
#pragma unroll
    for (int g = 0; g < 4; ++g) {
      const int dd = d * 32 + 8 * g + 4 * h;
      const u32x2 gv = gpre[d][g];
      float g0 = silu(bf_lo(gv[0])), g1 = silu(bf_hi(gv[0])), g2 = silu(bf_lo(gv[1])), g3 = silu(bf_hi(gv[1]));
      u32x2 ov = {pk2(o[d][4 * g] * f * g0, o[d][4 * g + 1] * f * g1), pk2(o[d][4 * g + 2] * f * g2, o[d][4 * g + 3] * f * g3)};
      *(u32x2*)(mp + dd) = ov;
    }
}

DI void dsa_job(const Params& p, int b, int tq0, char* lds) {
  const int tid = opaque_tid(), lane = tid & 63, w = tid >> 6;
  float* biasC = (float*)(lds + 143360);
  int* btab = (int*)(lds + 143360 + 1024);
  char* wl = lds + w * 17920;
  float* Pl = (float*)wl;
  int* kid = (int*)(wl + 8192);
  const int tq = tq0 + w;
  const size_t tok = (size_t)b * PP + tq;
  const u16* Hb = p.H + (size_t)b * PP * LDH;
  int kk[4], ku[4];
  {
    u32x2 iv = *(const u32x2*)(p.IDX + tok * 256 + 4 * lane);
    kk[0] = iv[0] & 0xffff; kk[1] = iv[0] >> 16; kk[2] = iv[1] & 0xffff; kk[3] = iv[1] >> 16;
#pragma unroll
    for (int j = 0; j < 4; ++j) ku[j] = (kk[j] == 0xFFFF) ? LEAD : kk[j];
    u32x4 kv4 = {(unsigned)ku[0], (unsigned)ku[1], (unsigned)ku[2], (unsigned)ku[3]};
    ((u32x4*)kid)[lane] = kv4;
  }
  u32x4 gvp[4];
#pragma unroll
  for (int hh = 0; hh < 4; ++hh) gvp[hh] = *(const u32x4*)(p.H + tok * LDH + HG_C + (((lane >> 3) & 1) * 4 + hh) * 64 + (lane & 7) * 8);
  __builtin_amdgcn_wave_barrier();
  const int ksub = lane >> 4, g = (lane >> 3) & 1, dc = lane & 7;
  {
    const int r = lane & 31, h = lane >> 5, pc = lane & 15;
    char* kst = wl + 9216;
    bf16x8 qb[8];
#pragma unroll
    for (int ks = 0; ks < 8; ++ks) {
      u32x4 v = {0u, 0u, 0u, 0u};
      if (r < 8 && (ks >> 2) == (r >> 2)) v = *(const u32x4*)(p.H + tok * LDH + HQ_C + r * 64 + (ks & 3) * 16 + 8 * h);
      qb[ks] = __builtin_bit_cast(bf16x8, v);
    }
    const u16* kbase = Hb + HK_C + pc * 8;
    u32x4 st0[8], st1[8];
#pragma unroll
    for (int s2 = 0; s2 < 8; ++s2) st0[s2] = *(const u32x4*)(kbase + (size_t)kid[4 * s2 + ksub] * LDH);
#pragma unroll
    for (int s2 = 0; s2 < 8; ++s2) st1[s2] = *(const u32x4*)(kbase + (size_t)kid[32 + 4 * s2 + ksub] * LDH);
    auto chunk = [&](int c, u32x4* stc) {
#pragma unroll
      for (int s2 = 0; s2 < 8; ++s2) *(u32x4*)(kst + (4 * s2 + ksub) * 272 + pc * 16) = stc[s2];
      if (c + 2 < 8) {
#pragma unroll
        for (int s2 = 0; s2 < 8; ++s2) stc[s2] = *(const u32x4*)(kbase + (size_t)kid[32 * (c + 2) + 4 * s2 + ksub] * LDH);
      }
      bf16x8 af[8];
#pragma unroll
      for (int ks = 0; ks < 8; ++ks) af[ks] = *(const bf16x8*)(kst + r * 272 + ks * 32 + 16 * h);
      __builtin_amdgcn_sched_barrier(0);
      f32x16 acc0, acc1;
#pragma unroll
      for (int i = 0; i < 16; ++i) { acc0[i] = 0.f; acc1[i] = 0.f; }
#pragma unroll
      for (int ks = 0; ks < 8; ks += 2) { acc0 = MFMA32(af[ks], qb[ks], acc0); acc1 = MFMA32(af[ks + 1], qb[ks + 1], acc1); }
      if (r < 8) {
#pragma unroll
        for (int i = 0; i < 16; ++i) Pl[(32 * c + crow(i, h)) * 8 + r] = acc0[i] + acc1[i];
      }
    };
#pragma unroll 1
    for (int c = 0; c < 8; c += 2) { chunk(c, st0); chunk(c + 1, st1); }
  }
  __builtin_amdgcn_wave_barrier();
  float lg[4][8];
#pragma unroll
  for (int j = 0; j < 4; ++j) {
    const f32x4 v0 = *(const f32x4*)(Pl + (4 * lane + j) * 8), v1 = *(const f32x4*)(Pl + (4 * lane + j) * 8 + 4);
#pragma unroll
    for (int e = 0; e < 4; ++e) { lg[j][e] = v0[e]; lg[j][4 + e] = v1[e]; }
  }
  int bk[4];
#pragma unroll
  for (int j = 0; j < 4; ++j) { int dist = tq - ku[j]; bk[j] = (dist < 128) ? btab[dist & 127] : 31; }
#pragma unroll
  for (int hd = 0; hd < 8; ++hd) {
    float mx = NEGL;
#pragma unroll
    for (int j = 0; j < 4; ++j) {
      float v = lg[j][hd] * 0.125f + biasC[bk[j] * 8 + hd];
      v = (kk[j] == 0xFFFF) ? NEGL : v;
      lg[j][hd] = v;
      mx = fmaxf(mx, v);
    }
    mx = wmax(mx);
    float sm = 0.f;
#pragma unroll
    for (int j = 0; j < 4; ++j) { float e = __expf(lg[j][hd] - mx); lg[j][hd] = e; sm += e; }
    sm = wsum(sm);
    const float inv = 1.f / sm;
#pragma unroll
    for (int j = 0; j < 4; ++j) lg[j][hd] *= inv;
  }
#pragma unroll
  for (int j = 0; j < 4; ++j) {
    f32x4 v0 = {lg[j][0], lg[j][1], lg[j][2], lg[j][3]}, v1 = {lg[j][4], lg[j][5], lg[j][6], lg[j][7]};
    *(f32x4*)(Pl + (4 * lane + j) * 8) = v0;
    *(f32x4*)(Pl + (4 * lane + j) * 8 + 4) = v1;
  }
  __builtin_amdgcn_wave_barrier();
  const u16* vb = Hb + HV_C + g * 64 + dc * 8;
  f32x2 acc2[4][4];
#pragma unroll
  for (int hh = 0; hh < 4; ++hh)
#pragma unroll
    for (int e = 0; e < 4; ++e) { acc2[hh][e][0] = 0.f; acc2[hh][e][1] = 0.f; }
  u32x4 vA[16], vB[16];
  auto pv_load = [&](int grp, u32x4* dst) {
#pragma unroll
    for (int s = 0; s < 16; ++s) dst[s] = *(const u32x4*)(vb + (size_t)kid[4 * (grp * 16 + s) + ksub] * LDH);
  };
  auto pv_fma = [&](int grp, const u32x4* src) {
#pragma unroll
    for (int s = 0; s < 16; ++s) {
      const int slot = 4 * (grp * 16 + s) + ksub;
      const f32x4 pp = *(const f32x4*)(Pl + slot * 8 + g * 4);
      const u32x4 vv = src[s];
#pragma unroll
      for (int hh = 0; hh < 4; ++hh) {
        const f32x2 ph = {pp[hh], pp[hh]};
#pragma unroll
        for (int e = 0; e < 4; ++e) {
          const f32x2 vf2 = {bf_lo(vv[e]), bf_hi(vv[e])};
          acc2[hh][e] += ph * vf2;
        }
      }
    }
  };
  pv_load(0, vA);
  pv_load(1, vB);
  pv_fma(0, vA);
  pv_load(2, vA);
  pv_fma(1, vB);
  pv_load(3, vB);
  pv_fma(2, vA);
  pv_fma(3, vB);
  float acc[4][8];
#pragma unroll
  for (int hh = 0; hh < 4; ++hh)
#pragma unroll
    for (int e = 0; e < 8; ++e) { float v = acc2[hh][e >> 1][e & 1]; v += __shfl_xor(v, 16); v += __shfl_xor(v, 32); acc[hh][e] = v; }
  if (ksub == 0) {
#pragma unroll
    for (int hh = 0; hh < 4; ++hh) {
      const int hd = g * 4 + hh;
      const u32x4 gv = gvp[hh];
      u32x4 ov;
#pragma unroll
      for (int e = 0; e < 4; ++e) ov[e] = pk2(acc[hh][2 * e] * SC_DSA * silu(bf_lo(gv[e])), acc[hh][2 * e + 1] * SC_DSA * silu(bf_hi(gv[e])));
      *(u32x4*)(p.Mix + tok * 2048 + 1024 + hd * 64 + dc * 8) = ov;
    }
  }
}

DI void outproj_tile(const Params& p, int mt, int nt, char* lds, int khalf) {
  const int tid = opaque_tid(), lane = tid & 63, w = tid >> 6, r = lane & 31, h = lane >> 5;
  const int wm = w & 3, wn = w >> 2;
  const int m0 = mt * 256;
  const int koff = khalf > 0 ? 1024 : 0, klen = khalf < 0 ? 2048 : 1024;
  const u16* A = p.Mix + (size_t)m0 * 2048 + koff;
  const u16* Bw = p.Wt_out + (size_t)nt * 128 * 2048 + koff;
  if (khalf <= 0) {
    gemm_tile<true>(A, 2048, Bw, 2048, klen, lds, [&](int mi, int ni, const f32x16& a) {
      const int tok = m0 + wm * 64 + mi * 32 + r;
      float* rp = p.R + (size_t)tok * DM + nt * 128 + wn * 64 + ni * 32;
#pragma unroll
      for (int g = 0; g < 4; ++g) {
        f32x4 v = *(const f32x4*)(rp + 8 * g + 4 * h);
#pragma unroll
        for (int e = 0; e < 4; ++e) v[e] = ALPHA * v[e] + a[4 * g + e];
        *(f32x4*)(rp + 8 * g + 4 * h) = v;
      }
    });
  } else {
    gemm_tile<true>(A, 2048, Bw, 2048, klen, lds, [&](int mi, int ni, const f32x16& a) {
      const int tok = m0 + wm * 64 + mi * 32 + r;
      float* rp = p.Y1 + (size_t)(tok - 16384) * DM + nt * 128 + wn * 64 + ni * 32;
#pragma unroll
      for (int g = 0; g < 4; ++g) {
        const f32x4 v = {a[4 * g], a[4 * g + 1], a[4 * g + 2], a[4 * g + 3]};
        *(f32x4*)(rp + 8 * g + 4 * h) = v;
      }
    });
  }
}

DI void ln_rows(const Params& p, int l) {
  const int tid = opaque_tid(), lane = tid & 63, w = tid >> 6;
  const float* gg = l < 0 ? p.ln0_g : p.ln_g + l * DM;
  const float* bb = l < 0 ? p.ln0_b : p.ln_b + l * DM;
  const int stride = gridDim.x * 8;
  auto loadrow = [&](int row, f32x4* dst) {
    if (l < 0) {
      const int b = row / PP, t = row - b * PP;
      const float* src = nullptr;
      if (t >= 128 && t < PV) src = p.x + ((size_t)b * SEQ + (t - 128)) * DM;
      else if (t >= LEAD && t < 128) src = p.meta + (size_t)(t - LEAD) * DM;
#pragma unroll
      for (int j = 0; j < 4; ++j) {
        if (src) dst[j] = *(const f32x4*)(src + lane * 4 + 256 * j);
        else { dst[j][0] = 0.f; dst[j][1] = 0.f; dst[j][2] = 0.f; dst[j][3] = 0.f; }
      }
    } else {
#pragma unroll
      for (int j = 0; j < 4; ++j) {
        dst[j] = *(const f32x4*)(p.R + (size_t)row * DM + lane * 4 + 256 * j);
        if (row >= 16384) dst[j] += *(const f32x4*)(p.Y1 + (size_t)(row - 16384) * DM + lane * 4 + 256 * j);
      }
    }
  };
  f32x4 v[4], vn[4];
  int row = blockIdx.x * 8 + w;
  if (row < MT) loadrow(row, v);
  for (; row < MT; row += stride) {
    const int b = row / PP, t = row - b * PP;
    if (row + stride < MT) loadrow(row + stride, vn);
    float s = 0.f;
#pragma unroll
    for (int j = 0; j < 4; ++j) s += v[j][0] + v[j][1] + v[j][2] + v[j][3];
    const float mu = wsum(s) * (1.f / DM);
    float q = 0.f;
#pragma unroll
    for (int j = 0; j < 4; ++j)
#pragma unroll
      for (int e = 0; e < 4; ++e) { float d = v[j][e] - mu; q += d * d; }
    const float rstd = rsqrtf(wsum(q) * (1.f / DM) + 1e-5f);
#pragma unroll
    for (int j = 0; j < 4; ++j) {
      const int c = lane * 4 + 256 * j;
      f32x4 g4 = *(const f32x4*)(gg + c), b4 = *(const f32x4*)(bb + c);
      f32x4 y;
#pragma unroll
      for (int e = 0; e < 4; ++e) y[e] = (v[j][e] - mu) * rstd * g4[e] + b4[e];
      if (l == 3) {
        if (t >= 128 && t < PV) *(f32x4*)(p.out + ((size_t)b * SEQ + (t - 128)) * DM + c) = y;
      } else {
        *(f32x4*)(p.R + (size_t)row * DM + c) = y;
        u32x2 yb = {pk2(y[0], y[1]), pk2(y[2], y[3])};
        *(u32x2*)(p.Xb + (size_t)row * DM + c) = yb;
      }
    }
#pragma unroll
    for (int j = 0; j < 4; ++j) v[j] = vn[j];
  }
}

DI int map_in(int n) {
  if (n < 512) return n;
  if (n < 1024) return n;
  if (n < 1536) return 1544 + (n - 1024);
  if (n < 1792) return 2056 + (n - 1536);
  if (n < 1920) return 2312 + (n - 1792);
  if (n < 2432) return 2472 + (n - 1920);
  if (n < 2944) return 2984 + (n - 2432);
  if (n < 3072) return 3496 + (n - 2944);
  if (n < 3200) return 3624 + (n - 3072);
  if (n < 3712) return 3752 + (n - 3200);
  if (n < 4224) return 4336 + (n - 3712);
  if (n < 4736) return 4848 + (n - 4224);
  if (n < 4864) return 5360 + (n - 4736);
  if (n < 5376) return 5616 + (n - 4864);
  if (n < 5408) return 2440 + (n - 5376);
  if (n < 5472) return 4264 + (n - 5408);
  if (n < 5480) return 1536 + (n - 5472);
  if (n < 5488) return 4328 + (n - 5480);
  if (n < 5504) return -1;
  if (n < 6016) return 1024 + (n - 5504);
  return 5488 + (n - 6016);
}
DI void conv_weights(const Params& p, int l, char* lds) {
  const int tid = opaque_tid();
  float* tile = (float*)lds;
  struct TD { u16* dst; int K, k0, n0; };
  const int nn_l = tid & 63;
  auto loadtile = [&](int tI, float* rv, TD& d) {
    const float* src; const float* ksc = nullptr; int ldsrc, kind, kt, ntile;
    if (tI < 1536) { kind = 0; kt = tI / 96; ntile = tI % 96; src = p.w_in + (size_t)l * DM * D_IN; ldsrc = D_IN; d.K = DM; d.dst = p.Wt_in; }
    else if (tI < 2048) { int u = tI - 1536; kind = 1; kt = u / 16; ntile = u % 16; src = p.w_out + (size_t)l * 2048 * DM; ldsrc = DM; d.K = 2048; d.dst = p.Wt_out; }
    else if (tI < 2096) { int u = tI - 2048; kind = 2; kt = u / 12; ntile = u % 12; src = p.w_uq + (size_t)l * 256 * 768; ldsrc = 768; d.K = 256; d.dst = p.Wt_uq; ksc = p.gq + l * 256; }
    else { int u = tI - 2096; kind = 3; kt = u / 16; ntile = u % 16; src = p.w_ukv + (size_t)l * 128 * 1024; ldsrc = 1024; d.K = 128; d.dst = p.Wt_ukv; ksc = p.gkv + l * 128; }
    d.k0 = kt * 64; d.n0 = ntile * 64;
    const int n = d.n0 + nn_l;
    int sc;
    if (kind == 0) sc = map_in(n);
    else if (kind == 3) sc = (n < 512) ? ((n >> 6) * 128 + (n & 63)) : (((n - 512) >> 6) * 128 + 64 + (n & 63));
    else sc = n;
#pragma unroll
    for (int j = 0; j < 8; ++j) {
      const int kk = (tid >> 6) + 8 * j;
      float v = 0.f;
      if (sc >= 0) v = src[(size_t)(d.k0 + kk) * ldsrc + sc];
      if (ksc) v *= ksc[d.k0 + kk];
      rv[j] = v;
    }
  };
  float rv[8], rn[8];
  TD dc, dn;
  int tI = blockIdx.x;
  if (tI < 2128) loadtile(tI, rv, dc);
  for (; tI < 2128; tI += gridDim.x) {
    const int tN = tI + gridDim.x;
    if (tN < 2128) loadtile(tN, rn, dn);
#pragma unroll
    for (int j = 0; j < 8; ++j) tile[nn_l * 65 + (tid >> 6) + 8 * j] = rv[j];
    __syncthreads();
    {
      const int nn = tid >> 3, kc = (tid & 7) * 8;
      const float* tp = tile + nn * 65 + kc;
      u32x4 ov = {pk2(tp[0], tp[1]), pk2(tp[2], tp[3]), pk2(tp[4], tp[5]), pk2(tp[6], tp[7])};
      *(u32x4*)(dc.dst + (size_t)(dc.n0 + nn) * dc.K + dc.k0 + kc) = ov;
    }
    __syncthreads();
#pragma unroll
    for (int j = 0; j < 8; ++j) rv[j] = rn[j];
    dc = dn;
  }
}
DI void rope_table(const Params& p) {
  const int gt = blockIdx.x * NTHREADS + threadIdx.x;
  for (int i = gt; i < PP * 16; i += gridDim.x * NTHREADS) {
    const int t = i >> 4, c = i & 15;
    const float freq = powf(10000.f, -(float)c / 16.f);
    const float ang = (float)(t - LEAD) * freq;
    float sn, cs;
    sincosf(ang, &sn, &cs);
    p.ROPE[(size_t)t * 32 + c] = cs;
    p.ROPE[(size_t)t * 32 + 16 + c] = sn;
  }
}


#define XB_TMO      128
#define XB_XCNT(j)  (256  + 64 * (j))
#define XB_XSUB(j)  (1280 + 64 * (j))
#define XB_XGEN(j)  (2304 + 64 * (j))
#define XB_TOP      3328
#define XB_TOPGEN   3392
#define XCD_BAR_WORDS 3456
#define XB_SPIN_CAP (1u << 18)
DI unsigned xb_ld(unsigned* p) { return __hip_atomic_load(p, __ATOMIC_RELAXED, __HIP_MEMORY_SCOPE_AGENT); }
DI unsigned xb_add(unsigned* p, unsigned v) { return __hip_atomic_fetch_add(p, v, __ATOMIC_RELAXED, __HIP_MEMORY_SCOPE_AGENT); }
DI unsigned xb_xcc_id() { return (unsigned)__builtin_amdgcn_s_getreg((3 << 11) | 20) & 0xFu; }
#define XB_SPIN(cond, bar) do { unsigned _sp = 0; while (cond) { __builtin_amdgcn_s_sleep(1); \
    if ((++_sp & 255u) == 0u) { if (xb_ld(&(bar)[XB_TMO])) break; if (_sp > XB_SPIN_CAP) { atomicAdd(&(bar)[XB_TMO], 1u); break; } } } } while (0)
struct XcdBarrier { unsigned* bar; unsigned x; volatile unsigned* st; };
DI XcdBarrier xcd_barrier_post(unsigned* bar, volatile unsigned* st) {
  XcdBarrier b; b.bar = bar; b.x = xb_xcc_id(); b.st = st;
  if (threadIdx.x == 0) (void)xb_add(&bar[XB_XCNT(b.x)], 1u);
  return b;
}
DI void xcd_barrier_complete(unsigned* bar, unsigned x, unsigned& nloc, unsigned& nx) {
  const unsigned G = gridDim.x * gridDim.y * gridDim.z;
  unsigned sum, cnt, mine, sp = 0u;
  for (;;) {
    sum = 0u; cnt = 0u; mine = 0u;
#pragma unroll
    for (unsigned j = 0; j < 16; ++j) { const unsigned c = xb_ld(&bar[XB_XCNT(j)]); sum += c; cnt += (c > 0u) ? 1u : 0u; mine = (j == x) ? c : mine; }
    if (sum == G) break;
    __builtin_amdgcn_s_sleep(1);
    if ((++sp & 255u) == 0u) { if (xb_ld(&bar[XB_TMO])) break; if (sp > XB_SPIN_CAP) { atomicAdd(&bar[XB_TMO], 1u); break; } }
  }
  nloc = mine > 0u ? mine : 1u; nx = cnt > 0u ? cnt : 1u;
}
DI void xcd_barrier(const XcdBarrier& b) {
  asm volatile("s_waitcnt vmcnt(0)" ::: "memory");
  __syncthreads();
  if (threadIdx.x == 0) {
    unsigned* bar = b.bar;
    __builtin_amdgcn_s_waitcnt(0);
    unsigned nloc = b.st[0], nx = b.st[1];
    if (nloc == 0u) { xcd_barrier_complete(bar, b.x, nloc, nx); b.st[0] = nloc; b.st[1] = nx; }
    const unsigned old = xb_add(&bar[XB_XSUB(b.x)], 1u);
    const unsigned gen = old / nloc;
    if (old + 1u == (gen + 1u) * nloc) {
      __builtin_amdgcn_fence(__ATOMIC_RELEASE, "agent");
      asm volatile("s_waitcnt vmcnt(0)" ::: "memory");
      const unsigned og = xb_add(&bar[XB_TOP], 1u);
      const unsigned tg = og / nx;
      if (og + 1u == (tg + 1u) * nx) xb_add(&bar[XB_TOPGEN], 1u);
      else XB_SPIN(xb_ld(&bar[XB_TOPGEN]) == tg, bar);
      __builtin_amdgcn_fence(__ATOMIC_ACQUIRE, "agent");
      xb_add(&bar[XB_XGEN(b.x)], 1u);
      asm volatile("s_waitcnt vmcnt(0)" ::: "memory");
    } else {
      XB_SPIN(xb_ld(&bar[XB_XGEN(b.x)]) == gen, bar);
      __builtin_amdgcn_fence(__ATOMIC_ACQUIRE, "agent");
      asm volatile("s_waitcnt vmcnt(0)" ::: "memory");
    }
  }
  __syncthreads();
}

__global__ void __launch_bounds__(NTHREADS) mega(Params p) {
  extern __shared__ __attribute__((aligned(16))) char lds[];
  cg::grid_group grid = cg::this_grid();
  ln_rows(p, -1);
  conv_weights(p, 0, lds);
  rope_table(p);
  if (blockIdx.x == 0) {
    if (threadIdx.x < 256) p.ctr[threadIdx.x] = 0u;
    for (int i = threadIdx.x; i < XCD_BAR_WORDS; i += NTHREADS) p.bar[i] = 0u;
  }
  volatile unsigned* xst = (volatile unsigned*)(lds + LDS_JOB + 16);
  if (threadIdx.x == 0) { xst[0] = 0u; xst[1] = 0u; }
  grid.sync();
  const XcdBarrier xb = xcd_barrier_post(p.bar, xst);
  for (int l = 0; l < 4; ++l) {
    for (int rep = 0; rep < REP_P1; ++rep) {
      for (int j = blockIdx.x; j < 66 * 48; j += gridDim.x) inproj_tile(p, l, j / 48, j % 48, lds);
      xcd_barrier(xb);
    }
    for (int rep = 0; rep < REP_P2; ++rep) {
      constexpr int NTK = 2 * 2052, NUP = 66 * 14, NJ = NTK + NUP + 16;
      int pending = 0, par = 0;
      if (threadIdx.x == 0) pending = (int)atomicAdd(p.ctr + l * 2 + 8 * rep, 1u);
      for (;;) {
        const int j = next_job(p.ctr + l * 2 + 8 * rep, lds, pending, NJ, par);
        if (j >= NJ) break;
        if (j < 16) {
          cumsum_job(p, j, lds);
        } else if (j < 16 + NTK) {
          const int jj = j - 16;
          const int b = jj & 1, q = 2051 - (jj >> 1);
          topk_job(p, b, LEAD + 4 * q, lds);
        } else {
          const int u = j - 16 - NTK;
          upproj_tile(p, u / 14, u % 14, lds);
        }
      }
      xcd_barrier(xb);
    }
    for (int rep = 0; rep < REP_P3; ++rep) {
      constexpr int ND = 1056, NS = 528, NC = 2 * 1026, NJ = ND + NS + NC;
      {
        float* biasC = (float*)(lds + 143360);
        int* btab = (int*)(lds + 143360 + 1024);
        if (threadIdx.x < 256) biasC[threadIdx.x] = p.rel_bias[(threadIdx.x >> 3) * 16 + (threadIdx.x & 7)];
        if (threadIdx.x < 128) btab[threadIdx.x] = t5_bucket(threadIdx.x);
      }
      int pending = 0, par = 0;
      if (threadIdx.x == 0) pending = (int)atomicAdd(p.ctr + l * 2 + 1 + 8 * rep, 1u);
      for (;;) {
        const int j = next_job(p.ctr + l * 2 + 1 + 8 * rep, lds, pending, NJ, par);
        if (j >= NJ) break;
        if (j < ND) {
          const int qu = 32 - (j >> 5), rem = j & 31, kind = rem >> 4, b = (rem >> 3) & 1, head = rem & 7;
          if (kind == 0) attn_unit<64, 0>(p, l, b, head, qu, lds);
          else attn_unit<96, 1>(p, l, b, head, qu, lds);
        } else if (j < ND + NS) {
          const int u = j - ND;
          attn_unit<64, 2>(p, l, (u >> 3) & 1, u & 7, u >> 4, lds);
        } else {
          const int u = j - ND - NS;
          dsa_job(p, u & 1, LEAD + 8 * (u >> 1), lds);
        }
      }
      xcd_barrier(xb);
    }
    for (int j = blockIdx.x; j < 512; j += gridDim.x) {
      const int x = j & 7, a = j >> 3;
      outproj_tile(p, 2 * (a >> 1) + (x >> 2), 2 * (x & 3) + (a & 1), lds, -1);
    }
    if (blockIdx.x < 32) {
      const int j = 512 + (blockIdx.x >> 1), x = j & 7, a = j >> 3;
      outproj_tile(p, 2 * (a >> 1) + (x >> 2), 2 * (x & 3) + (a & 1), lds, blockIdx.x & 1);
    }
    xcd_barrier(xb);
    ln_rows(p, l);
    if (l < 3) { conv_weights(p, l + 1, lds); xcd_barrier(xb); }
  }
}

extern "C" void kernel_launch(void* const* d_in, const int* in_sizes, int n_in, void* d_out, int out_size, void* d_ws, size_t ws_size,
                              hipStream_t stream) {
  static int grid = 0;
  if (grid == 0) {
    int dev = 0, cus = 0, per_cu = 0;
    hipGetDevice(&dev);
    hipDeviceGetAttribute(&cus, hipDeviceAttributeMultiprocessorCount, dev);
    if (hipFuncSetAttribute((const void*)mega, hipFuncAttributeMaxDynamicSharedMemorySize, LDS_BYTES) != hipSuccess) { fprintf(stderr, "hipFuncSetAttribute failed\n"); grid = -1; return; }
    hipOccupancyMaxActiveBlocksPerMultiprocessor(&per_cu, (const void*)mega, NTHREADS, LDS_BYTES);
    if (per_cu < 1) { fprintf(stderr, "occupancy query: %d\n", per_cu); grid = -1; return; }
    grid = cus * per_cu;
  }
  if (grid < 0) return;
  size_t off = 0;
  auto take = [&](size_t bytes) { size_t o = off; off += (bytes + 255) & ~(size_t)255; return (char*)d_ws + o; };
  Params p{};
  p.x = (const float*)d_in[0]; p.meta = (const float*)d_in[1]; p.ln0_g = (const float*)d_in[2]; p.ln0_b = (const float*)d_in[3];
  p.rel_bias = (const float*)d_in[4]; p.w_in = (const float*)d_in[5]; p.b_f = (const float*)d_in[6]; p.gq = (const float*)d_in[7];
  p.gkv = (const float*)d_in[8]; p.w_uq = (const float*)d_in[9]; p.w_ukv = (const float*)d_in[10]; p.sinks = (const float*)d_in[11];
  p.w_out = (const float*)d_in[12]; p.ln_g = (const float*)d_in[13]; p.ln_b = (const float*)d_in[14];
  p.out = (float*)d_out;
  p.ctr = (unsigned*)take(1024);
  p.bar = (unsigned*)take(XCD_BAR_WORDS * 4);
  p.Wt_in = (u16*)take((size_t)NIN * DM * 2);
  p.Wt_out = (u16*)take((size_t)DM * 2048 * 2);
  p.Wt_uq = (u16*)take((size_t)768 * 256 * 2);
  p.Wt_ukv = (u16*)take((size_t)1024 * 128 * 2);
  p.H = (u16*)take((size_t)MT * LDH * 2);
  p.Mix = (u16*)take((size_t)MT * 2048 * 2);
  p.Xb = p.Mix;
  p.VtA = (u16*)take((size_t)NB * 512 * PP * 2);
  p.VtD = (u16*)take((size_t)NB * 128 * PP * 2);
  p.R = (float*)take((size_t)MT * DM * 4);
  p.Y1 = (float*)take((size_t)512 * DM * 4);
  p.IDX = (u16*)take((size_t)MT * 256 * 2);
  p.IK = (u16*)take((size_t)MT * 64 * 2);
  p.Kpe = (u16*)take((size_t)MT * 32 * 2);
  p.IW = (float*)take((size_t)MT * 8 * 4);
  p.LOGF = (float*)take((size_t)NB * 8 * PP * 4);
  p.CUM = (float*)take((size_t)NB * 8 * PP * 4);
  p.ROPE = (float*)take((size_t)PP * 32 * 4);
  if (off > ws_size) { fprintf(stderr, "workspace too small: need %zu have %zu\n", off, ws_size); return; }
  {
    char* ob = (char*)d_out;
    p.Qm = (u16*)ob; ob += (size_t)MT * 768 * 2;
    p.Km = (u16*)ob; ob += (size_t)MT * 512 * 2;
    p.VtB = (u16*)ob; ob += (size_t)NB * 512 * PP * 2;
    if ((size_t)(ob - (char*)d_out) > (size_t)out_size * 4) { fprintf(stderr, "d_out too small for scratch\n"); return; }
  }
  hipMemsetAsync(p.ctr, 0, 1024 + XCD_BAR_WORDS * 4, stream);
  void* args[] = {&p};
  hipError_t e = hipLaunchCooperativeKernel((const void*)mega, dim3(grid), dim3(NTHREADS), args, LDS_BYTES, stream);
  if (e != hipSuccess) fprintf(stderr, "cooperative launch failed: %s (grid %d)\n", hipGetErrorString(e), grid);
}
```

```cpp
#include <hip/hip_runtime.h>
#include <hip/hip_cooperative_groups.h>
#include <cstdio>
namespace cg = cooperative_groups;

#define DI __device__ __forceinline__
typedef __attribute__((ext_vector_type(8))) short bf16x8;
typedef __attribute__((ext_vector_type(16))) float f32x16;
typedef __attribute__((ext_vector_type(4))) float f32x4;
typedef __attribute__((ext_vector_type(2))) float f32x2;
typedef __attribute__((ext_vector_type(2))) __bf16 bf2_t;
typedef __attribute__((ext_vector_type(4))) unsigned u32x4;
typedef __attribute__((ext_vector_type(2))) unsigned u32x2;
typedef unsigned short u16;
#define MFMA32(a, b, c) __builtin_amdgcn_mfma_f32_32x32x16_bf16((a), (b), (c), 0, 0, 0)

constexpr int NB = 2, PP = 8448, PV = 8320, LEAD = 112, DM = 1024, MT = NB * PP, SEQ = 8192;
constexpr int LDH = 5376, NIN = 6144;
constexpr int HQ_A = 0, HK_A = 512, HG_A = 1024, HCQ_B = 1536, HCKV_B = 1792, HG_B = 1920, HQ_C = 2432, HK_C = 2944, HV_C = 3072,
              HIQ_C = 3200, HG_C = 3712, HQ_D = 4224, HK_D = 4736, HG_D = 4864;
constexpr int D_IN = 6128;
constexpr float LOG2E = 1.4426950408889634f;
constexpr float NEGL = -1e30f;
constexpr float ALPHA = 1.681792830507429f;
constexpr int LDS_JOB = 147456;
constexpr int LDS_BYTES = LDS_JOB + 64;
constexpr int GEMM_STAGE = 55296;
constexpr int NTHREADS = 512;
#define REP_P1 1
#define REP_P2 1
#define REP_P3 1
#define SC_FOX 1.0f
#define SC_MLA 1.0f
#define SC_SWA 1.0f
#define SC_DSA 1.0f

struct Params {
  const float *x, *meta, *ln0_g, *ln0_b, *rel_bias, *w_in, *b_f, *gq, *gkv, *w_uq, *w_ukv, *sinks, *w_out, *ln_g, *ln_b;
  float* out;
  u16 *Wt_in, *Wt_out, *Wt_uq, *Wt_ukv;
  u16 *H, *Xb, *Mix, *VtA, *VtD, *VtB, *Qm, *Km, *Kpe, *IK, *IDX;
  float *R, *LOGF, *CUM, *IW, *ROPE, *Y1;
  unsigned* ctr;
  unsigned* bar;
};

DI unsigned pk2(float a, float b) { f32x2 v = {a, b}; return __builtin_bit_cast(unsigned, __builtin_convertvector(v, bf2_t)); }
DI float bf_lo(unsigned u) { return __uint_as_float(u << 16); }
DI float bf_hi(unsigned u) { return __uint_as_float(u & 0xffff0000u); }
DI int opaque_tid() { int t = threadIdx.x; asm volatile("" : "+v"(t)); return t; }
DI int crow(int i, int h) { return (i & 3) + 8 * (i >> 2) + 4 * h; }
template <int CTRL> DI float dpp_mov(float v) { return __int_as_float(__builtin_amdgcn_mov_dpp(__float_as_int(v), CTRL, 0xF, 0xF, true)); }
DI float wsum(float v) {
  v += dpp_mov<0xB1>(v); v += dpp_mov<0x4E>(v); v += dpp_mov<0x141>(v); v += dpp_mov<0x140>(v);
  u32x2 r = __builtin_amdgcn_permlane16_swap(__float_as_uint(v), __float_as_uint(v), false, false);
  v = __uint_as_float(r[0]) + __uint_as_float(r[1]);
  r = __builtin_amdgcn_permlane32_swap(__float_as_uint(v), __float_as_uint(v), false, false);
  return __uint_as_float(r[0]) + __uint_as_float(r[1]);
}
DI float wmax(float v) {
  v = fmaxf(v, dpp_mov<0xB1>(v)); v = fmaxf(v, dpp_mov<0x4E>(v)); v = fmaxf(v, dpp_mov<0x141>(v)); v = fmaxf(v, dpp_mov<0x140>(v));
  u32x2 r = __builtin_amdgcn_permlane16_swap(__float_as_uint(v), __float_as_uint(v), false, false);
  v = fmaxf(__uint_as_float(r[0]), __uint_as_float(r[1]));
  r = __builtin_amdgcn_permlane32_swap(__float_as_uint(v), __float_as_uint(v), false, false);
  return fmaxf(__uint_as_float(r[0]), __uint_as_float(r[1]));
}
template <int CTRL> DI int dpp_movi(int v) { return __builtin_amdgcn_mov_dpp(v, CTRL, 0xF, 0xF, true); }
template <bool UP> DI int wscan(int v, int lane, int& total) {
  int acc = v, tot = v, o;
  o = dpp_movi<0xB1>(tot);  if (((lane & 1) != 0) == UP) acc += o;  tot += o;
  o = dpp_movi<0x4E>(tot);  if (((lane & 2) != 0) == UP) acc += o;  tot += o;
  o = dpp_movi<0x141>(tot); if (((lane & 4) != 0) == UP) acc += o;  tot += o;
  o = dpp_movi<0x140>(tot); if (((lane & 8) != 0) == UP) acc += o;  tot += o;
  u32x2 r = __builtin_amdgcn_permlane16_swap((unsigned)tot, (unsigned)tot, false, false);
  o = (int)((lane & 16) ? r[0] : r[1]); if (((lane & 16) != 0) == UP) acc += o; tot += o;
  r = __builtin_amdgcn_permlane32_swap((unsigned)tot, (unsigned)tot, false, false);
  o = (int)((lane & 32) ? r[0] : r[1]); if (((lane & 32) != 0) == UP) acc += o; tot += o;
  total = tot;
  return acc;
}
DI float xor32_max(float v) { const u32x2 r = __builtin_amdgcn_permlane32_swap(__float_as_uint(v), __float_as_uint(v), false, false); return fmaxf(__uint_as_float(r[0]), __uint_as_float(r[1])); }
DI float xor32_sum(float v) { const u32x2 r = __builtin_amdgcn_permlane32_swap(__float_as_uint(v), __float_as_uint(v), false, false); return __uint_as_float(r[0]) + __uint_as_float(r[1]); }
DI unsigned wminu(unsigned v) {
  unsigned o;
  o = (unsigned)dpp_movi<0xB1>((int)v); v = o < v ? o : v;
  o = (unsigned)dpp_movi<0x4E>((int)v); v = o < v ? o : v;
  o = (unsigned)dpp_movi<0x141>((int)v); v = o < v ? o : v;
  o = (unsigned)dpp_movi<0x140>((int)v); v = o < v ? o : v;
  u32x2 r = __builtin_amdgcn_permlane16_swap(v, v, false, false); v = r[0] < r[1] ? r[0] : r[1];
  r = __builtin_amdgcn_permlane32_swap(v, v, false, false); return r[0] < r[1] ? r[0] : r[1];
}
DI int wsumi(int v) { for (int o = 32; o > 0; o >>= 1) v += __shfl_xor(v, o); return v; }
DI float silu(float g) { return g / (1.f + __expf(-g)); }
DI float dot2(unsigned a, unsigned b, float c) { return __builtin_amdgcn_fdot2_f32_bf16(__builtin_bit_cast(bf2_t, a), __builtin_bit_cast(bf2_t, b), c, false); }
template <int CTRL> DI float dpp_add(float v) { return v + __int_as_float(__builtin_amdgcn_mov_dpp(__float_as_int(v), CTRL, 0xF, 0xF, true)); }
DI int t5_bucket(int n) {
  if (n < 16) return n;
  int lg = 16 + (int)(logf((float)n / 16.f) / logf(8.f) * 16.f);
  return lg < 31 ? lg : 31;
}

DI int next_job(unsigned* ctr, char* lds, int& pending, int njobs, int& par) {
  int* sj = (int*)(lds + LDS_JOB);
  if (threadIdx.x == 0) sj[par] = pending;
  __syncthreads();
  const int j = sj[par];
  par ^= 1;
  if (threadIdx.x == 0 && j < njobs) pending = (int)atomicAdd(ctr, 1u);
  return j;
}

template <bool SWAP, class Epi>
DI void gemm_tile(const u16* __restrict__ A, int lda, const u16* __restrict__ Bw, int ldb, int K, char* lds, Epi epi) {
  const int tid = opaque_tid(), lane = tid & 63, w = tid >> 6, r = lane & 31, h = lane >> 5;
  const int wm = w & 3, wn = w >> 2;
  f32x16 acc[2][2];
#pragma unroll
  for (int a = 0; a < 2; ++a)
#pragma unroll
    for (int b = 0; b < 2; ++b)
#pragma unroll
      for (int i = 0; i < 16; ++i) acc[a][b][i] = 0.f;
  const int lrow = tid >> 3, lkc = tid & 7;
  u32x4 ra0[4], rb0[2], ra1[4], rb1[2];
  const u16* ap = A + (size_t)lrow * lda + lkc * 8;
  const u16* bp = Bw + (size_t)lrow * ldb + lkc * 8;
  const int nk = K >> 6;
  auto gload = [&](int kt, u32x4* ra, u32x4* rb) {
#pragma unroll
    for (int j = 0; j < 4; ++j) ra[j] = *(const u32x4*)(ap + (size_t)(64 * j) * lda + kt * 64);
#pragma unroll
    for (int j = 0; j < 2; ++j) rb[j] = *(const u32x4*)(bp + (size_t)(64 * j) * ldb + kt * 64);
  };
  auto lstore = [&](int st, const u32x4* ra, const u32x4* rb) {
    char* base = lds + st * GEMM_STAGE;
#pragma unroll
    for (int j = 0; j < 4; ++j) *(u32x4*)(base + ((lrow + 64 * j) * 72 + lkc * 8) * 2) = ra[j];
#pragma unroll
    for (int j = 0; j < 2; ++j) *(u32x4*)(base + 36864 + ((lrow + 64 * j) * 72 + lkc * 8) * 2) = rb[j];
  };
  auto compute = [&](int st) {
    const char* as = lds + st * GEMM_STAGE;
    const char* bs = as + 36864;
#pragma unroll
    for (int ks = 0; ks < 4; ++ks) {
      bf16x8 af[2], bfr[2];
#pragma unroll
      for (int mi = 0; mi < 2; ++mi) af[mi] = *(const bf16x8*)(as + ((wm * 64 + mi * 32 + r) * 72 + ks * 16 + 8 * h) * 2);
#pragma unroll
      for (int ni = 0; ni < 2; ++ni) bfr[ni] = *(const bf16x8*)(bs + ((wn * 64 + ni * 32 + r) * 72 + ks * 16 + 8 * h) * 2);
#pragma unroll
      for (int mi = 0; mi < 2; ++mi)
#pragma unroll
        for (int ni = 0; ni < 2; ++ni) {
          if (SWAP) acc[mi][ni] = MFMA32(bfr[ni], af[mi], acc[mi][ni]);
          else acc[mi][ni] = MFMA32(af[mi], bfr[ni], acc[mi][ni]);
        }
    }
  };
  gload(0, ra0, rb0);
  lstore(0, ra0, rb0);
  gload(1, ra1, rb1);
  __syncthreads();
  for (int kt = 0; kt < nk; kt += 2) {
    if (kt + 2 < nk) gload(kt + 2, ra0, rb0);
    compute(0);
    lstore(1, ra1, rb1);
    __syncthreads();
    if (kt + 3 < nk) gload(kt + 3, ra1, rb1);
    compute(1);
    if (kt + 2 < nk) lstore(0, ra0, rb0);
    __syncthreads();
  }
#pragma unroll
  for (int mi = 0; mi < 2; ++mi)
#pragma unroll
    for (int ni = 0; ni < 2; ++ni) epi(mi, ni, acc[mi][ni]);
}

DI void store_rowmajor(u16* dst, const f32x16& a, int h, float sc) {
#pragma unroll
  for (int kp = 0; kp < 2; ++kp) {
    const int g = 2 * kp;
    unsigned ax = pk2(a[4 * g] * sc, a[4 * g + 1] * sc), ay = pk2(a[4 * g + 2] * sc, a[4 * g + 3] * sc);
    unsigned bx = pk2(a[4 * g + 4] * sc, a[4 * g + 5] * sc), by = pk2(a[4 * g + 6] * sc, a[4 * g + 7] * sc);
    const u32x2 rx = __builtin_amdgcn_permlane32_swap(ax, bx, false, false);
    const u32x2 ry = __builtin_amdgcn_permlane32_swap(ay, by, false, false);
    const u32x4 v = {rx[0], ry[0], rx[1], ry[1]};
    *(u32x4*)(dst + 8 * (g + h)) = v;
  }
}
DI void store_rope(u16* dst, const f32x16& a, int h, float sc, const float* rp) {
#pragma unroll
  for (int g = 0; g < 2; ++g) {
    f32x4 cs = *(const f32x4*)(rp + 8 * g + 4 * h);
    f32x4 sn = *(const f32x4*)(rp + 16 + 8 * g + 4 * h);
    float o1[4], o2[4];
#pragma unroll
    for (int e = 0; e < 4; ++e) {
      float x1 = a[4 * g + e] * sc, x2 = a[8 + 4 * g + e] * sc;
      o1[e] = x1 * cs[e] - x2 * sn[e];
      o2[e] = x1 * sn[e] + x2 * cs[e];
    }
    u32x2 v1 = {pk2(o1[0], o1[1]), pk2(o1[2], o1[3])};
    u32x2 v2 = {pk2(o2[0], o2[1]), pk2(o2[2], o2[3])};
    *(u32x2*)(dst + 8 * g + 4 * h) = v1;
    *(u32x2*)(dst + 16 + 8 * g + 4 * h) = v2;
  }
}
DI void store_transposed(u16* dst, const f32x16& a, int h, const float* rs  ) {
#pragma unroll
  for (int g = 0; g < 4; ++g) {
    float s0 = 1.f, s1 = 1.f, s2 = 1.f, s3 = 1.f;
    if (rs) { f32x4 sv = *(const f32x4*)(rs + 8 * g + 4 * h); s0 = sv[0]; s1 = sv[1]; s2 = sv[2]; s3 = sv[3]; }
    u32x2 v = {pk2(a[4 * g] * s0, a[4 * g + 1] * s1), pk2(a[4 * g + 2] * s2, a[4 * g + 3] * s3)};
    *(u32x2*)(dst + 8 * g + 4 * h) = v;
  }
}

DI void inproj_tile(const Params& p, int l, int mt, int nt, char* lds) {
  const int tid = opaque_tid(), lane = tid & 63, w = tid >> 6, r = lane & 31, h = lane >> 5;
  const int wm = w & 3, wn = w >> 2;
  const int m0 = mt * 256;
  const u16* A = p.Xb + (size_t)m0 * DM;
  const u16* Bw = p.Wt_in + (size_t)nt * 128 * DM;
  if (nt < 42) {
    float ssq = 0.f;
    gemm_tile<true>(A, DM, Bw, DM, DM, lds, [&](int mi, int ni, const f32x16& a) {
      const int tok = m0 + wm * 64 + mi * 32 + r;
      store_rowmajor(p.H + (size_t)tok * LDH + nt * 128 + wn * 64 + ni * 32, a, h, 1.f);
      if (nt >= 4 && nt < 8) {
        if (ni == 0) ssq = 0.f;
#pragma unroll
        for (int i = 0; i < 16; ++i) ssq += a[i] * a[i];
        if (ni == 1) {
          float tot = ssq + __shfl_xor(ssq, 32);
          tot = wmax(tot);
          if (lane == 0) atomicMax(p.ctr + 64 + l * 16 + (m0 / PP) * 8 + (nt - 4) * 2 + wn, __float_as_uint(sqrtf(tot) * 1.01f));
        }
      }
    });
  } else if (nt == 42) {
    gemm_tile<true>(A, DM, Bw, DM, DM, lds, [&](int mi, int ni, const f32x16& a) {
      const int tok = m0 + wm * 64 + mi * 32 + r;
      const int b = tok / PP, t = tok - b * PP;
      const int sub = wn * 2 + ni;
      if (sub == 0) {
        store_rope(p.Kpe + (size_t)tok * 32, a, h, 1.f, p.ROPE + (size_t)t * 32);
      } else if (sub == 1) {
        store_rowmajor(p.IK + (size_t)tok * 64, a, h, 1.f);
      } else if (sub == 2) {
        store_rowmajor(p.IK + (size_t)tok * 64 + 32, a, h, 1.f);
      } else {
#pragma unroll
        for (int e = 0; e < 4; ++e) {
          const int hd = e + 4 * h;
          float xv = a[e] + p.b_f[l * 8 + hd];
          float lf = fminf(xv, 0.f) - log1pf(expf(-fabsf(xv)));
          p.LOGF[(size_t)(b * 8 + hd) * PP + t] = lf;
          p.IW[(size_t)tok * 8 + hd] = a[4 + e];
        }
      }
    });
  } else {
    u16* vt; int nv, c0;
    if (nt < 47) { vt = p.VtA; nv = 512; c0 = (nt - 43) * 128; } else { vt = p.VtD; nv = 128; c0 = 0; }
    gemm_tile<false>(A, DM, Bw, DM, DM, lds, [&](int mi, int ni, const f32x16& a) {
      const int b = m0 / PP, t0 = m0 - b * PP + wm * 64 + mi * 32;
      const int col = c0 + wn * 64 + ni * 32 + r;
      store_transposed(vt + ((size_t)b * nv + col) * PP + t0, a, h, nullptr);
    });
  }
}

DI void upproj_tile(const Params& p, int mt, int nt14, char* lds) {
  const int tid = opaque_tid(), lane = tid & 63, w = tid >> 6, r = lane & 31, h = lane >> 5;
  const int wm = w & 3, wn = w >> 2;
  const int m0 = mt * 256;
  float* rs = (float*)(lds + 2 * GEMM_STAGE);
  const bool isq = nt14 < 6;
  {
    const int row = tid >> 1, half = tid & 1;
    const int kw = isq ? 128 : 64;
    const u16* src = p.H + (size_t)(m0 + row) * LDH + (isq ? HCQ_B : HCKV_B) + half * kw;
    float ss = 0.f;
    u32x4 rv[16];
#pragma unroll
    for (int c = 0; c < 8; ++c) rv[c] = *(const u32x4*)(src + c * 8);
    if (isq) {
#pragma unroll
      for (int c = 8; c < 16; ++c) rv[c] = *(const u32x4*)(src + c * 8);
    } else {
#pragma unroll
      for (int c = 8; c < 16; ++c) { rv[c][0] = 0u; rv[c][1] = 0u; rv[c][2] = 0u; rv[c][3] = 0u; }
    }
#pragma unroll
    for (int c = 0; c < 16; ++c)
#pragma unroll
      for (int e = 0; e < 4; ++e) { float a = bf_lo(rv[c][e]), b2 = bf_hi(rv[c][e]); ss += a * a + b2 * b2; }
    ss += __shfl_xor(ss, 1);
    if (half == 0) rs[row] = rsqrtf(ss / (isq ? 256.f : 128.f) + 1e-6f);
  }
  __syncthreads();
  if (isq) {
    const int nt = nt14;
    gemm_tile<true>(p.H + (size_t)m0 * LDH + HCQ_B, LDH, p.Wt_uq + (size_t)nt * 128 * 256, 256, 256, lds, [&](int mi, int ni, const f32x16& a) {
      const int lr = wm * 64 + mi * 32 + r;
      const int tok = m0 + lr;
      const int t = tok % PP;
      const int j32 = nt * 4 + wn * 2 + ni;
      const float sc = rs[lr];
      u16* dst = p.Qm + (size_t)tok * 768 + j32 * 32;
      if (j32 % 3 == 2) store_rope(dst, a, h, sc, p.ROPE + (size_t)t * 32);
      else store_rowmajor(dst, a, h, sc);
    });
  } else {
    const int nt = nt14 - 6;
    const u16* A = p.H + (size_t)m0 * LDH + HCKV_B;
    const u16* Bw = p.Wt_ukv + (size_t)nt * 128 * 128;
    if (nt < 4) {
      gemm_tile<true>(A, LDH, Bw, 128, 128, lds, [&](int mi, int ni, const f32x16& a) {
        const int lr = wm * 64 + mi * 32 + r;
        store_rowmajor(p.Km + (size_t)(m0 + lr) * 512 + nt * 128 + wn * 64 + ni * 32, a, h, rs[lr]);
      });
    } else {
      gemm_tile<false>(A, LDH, Bw, 128, 128, lds, [&](int mi, int ni, const f32x16& a) {
        const int b = m0 / PP, t0 = m0 - b * PP + wm * 64 + mi * 32;
        const int col = (nt - 4) * 128 + wn * 64 + ni * 32 + r;
        store_transposed(p.VtB + ((size_t)b * 512 + col) * PP + t0, a, h, rs + wm * 64 + mi * 32);
      });
    }
  }
}

DI void cumsum_job(const Params& p, int j, char* lds) {
  const int tid = opaque_tid(), lane = tid & 63, w = tid >> 6;
  const float* src = p.LOGF + (size_t)j * PP;
  float* dst = p.CUM + (size_t)j * PP;
  float* wt = (float*)lds;
  float v[17];
#pragma unroll
  for (int rr = 0; rr < 17; ++rr) {
    const int o = rr * 64 + lane, i = w * 1056 + o;
    v[rr] = (o < 1056 && i >= LEAD) ? src[i] : 0.f;
  }
  float carry = 0.f;
#pragma unroll
  for (int rr = 0; rr < 17; ++rr) {
    float inc = v[rr];
    for (int o = 1; o < 64; o <<= 1) { float x = __shfl_up(inc, o); if (lane >= o) inc += x; }
    v[rr] = inc + carry;
    carry += __shfl(inc, 63);
  }
  if (lane == 0) wt[w] = carry;
  __syncthreads();
  float base = 0.f;
  for (int k = 0; k < w; ++k) base += wt[k];
#pragma unroll
  for (int rr = 0; rr < 17; ++rr) {
    const int o = rr * 64 + lane;
    if (o < 1056) dst[w * 1056 + o] = v[rr] + base;
  }
}

DI void topk_job(const Params& p, int b, int t0, char* lds) {
  const int tid = opaque_tid(), lane = tid & 63, w = tid >> 6, r = lane & 31, h = lane >> 5;
  const int cmax = (t0 + 3) >> 6;
  unsigned sc[17][4];
  {
    const u16* iqp = p.H + (size_t)(b * PP + t0 + (r >> 3)) * LDH + HIQ_C + (r & 7) * 64 + 8 * h;
    bf16x8 af[4];
#pragma unroll
    for (int ks = 0; ks < 4; ++ks) af[ks] = *(const bf16x8*)(iqp + ks * 16);
    f32x4 iw[4];
#pragma unroll
    for (int qi = 0; qi < 4; ++qi) iw[qi] = *(const f32x4*)(p.IW + (size_t)(b * PP + t0 + qi) * 8 + 4 * h);
    char* wb = lds + 16384 + w * 9216;
    const int lrow = lane >> 3, lpc = lane & 7;
    const u16* ikb = p.IK + ((size_t)(b * PP) + lrow) * 64 + lpc * 8;
    u32x4 st[8];
    if (1 + w <= cmax) {
      const u16* kp = ikb + (size_t)(1 + w) * 64 * 64;
#pragma unroll
      for (int j = 0; j < 8; ++j) st[j] = *(const u32x4*)(kp + (size_t)j * 8 * 64);
#pragma unroll
      for (int j = 0; j < 8; ++j) *(u32x4*)(wb + (lrow + 8 * j) * 144 + lpc * 16) = st[j];
    }
#pragma unroll
    for (int i = 0; i < 17; ++i) {
      const int c = 1 + w + 8 * i;
      if (c <= cmax) {
        const bool more = c + 8 <= cmax;
        if (more) {
          const u16* kp = ikb + (size_t)(c + 8) * 64 * 64;
#pragma unroll
          for (int j = 0; j < 8; ++j) st[j] = *(const u32x4*)(kp + (size_t)j * 8 * 64);
        }
        bf16x8 b0[4], b1[4];
#pragma unroll
        for (int ks = 0; ks < 4; ++ks) {
          b0[ks] = *(const bf16x8*)(wb + r * 144 + ks * 32 + h * 16);
          b1[ks] = *(const bf16x8*)(wb + (32 + r) * 144 + ks * 32 + h * 16);
        }
        __builtin_amdgcn_sched_barrier(0);
        f32x16 a0, a1;
#pragma unroll
        for (int e = 0; e < 16; ++e) { a0[e] = 0.f; a1[e] = 0.f; }
#pragma unroll
        for (int ks = 0; ks < 4; ++ks) { a0 = MFMA32(af[ks], b0[ks], a0); a1 = MFMA32(af[ks], b1[ks], a1); }
        const int key = c * 64 + lane;
#pragma unroll
        for (int qi = 0; qi < 4; ++qi) {
          f32x2 pp2 = {0.f, 0.f};
#pragma unroll
          for (int e = 0; e < 4; ++e) {
            const f32x2 rl = {fmaxf(a0[4 * qi + e], 0.f), fmaxf(a1[4 * qi + e], 0.f)};
            const f32x2 wv = {iw[qi][e], iw[qi][e]};
            pp2 += rl * wv;
          }
          const float p0 = pp2[0], p1 = pp2[1];
          const u32x2 sw = __builtin_amdgcn_permlane32_swap(__float_as_uint(p0), __float_as_uint(p1), false, false);
          float mine = __uint_as_float(sw[0]) + __uint_as_float(sw[1]);
          mine += 0.0f;
          unsigned u = __float_as_uint(mine);
          u = (u & 0x80000000u) ? ~u : (u | 0x80000000u);
          if (key > t0 + qi || key < LEAD) u = 0u;
          sc[i][qi] = u;
        }
        if (more) {
#pragma unroll
          for (int j = 0; j < 8; ++j) *(u32x4*)(wb + (lrow + 8 * j) * 144 + lpc * 16) = st[j];
        }
      } else {
#pragma unroll
        for (int qi = 0; qi < 4; ++qi) sc[i][qi] = 0u;
      }
    }
  }
  int* ng = (int*)(lds + 256);
  unsigned long long* mg = (unsigned long long*)(lds + 1024);
  unsigned long long* me = mg + 4 * 132;
  int* bg = (int*)(me + 4 * 132);
  int* be = bg + 4 * 132;
  unsigned T[4];
  {
    unsigned* hist = (unsigned*)(lds + 16384);
    int* sel = (int*)(lds + 512);
    unsigned pref[4] = {0u, 0u, 0u, 0u};
    int chi[4] = {0, 0, 0, 0};
    bool few[4] = {false, false, false, false};
    __syncthreads();
    bool small = false;
    int nb[4] = {0, 0, 0, 0};
#pragma unroll
    for (int pass = 0; pass < 3; ++pass) {
      if (pass == 2) {
        small = true;
#pragma unroll
        for (int q = 0; q < 4; ++q) small = small && (few[q] || nb[q] <= 64);
        if (small) break;
      }
      {
        const u32x4 z = {0u, 0u, 0u, 0u};
#pragma unroll
        for (int j = 0; j < 8; ++j) ((u32x4*)hist)[tid + 512 * j] = z;
      }
      __syncthreads();
#pragma unroll
      for (int i = 0; i < 17; ++i) {
#pragma unroll
        for (int q = 0; q < 4; ++q) {
          const unsigned u = sc[i][q];
          bool part; unsigned bin;
          if (pass == 0) { part = (u != 0u); bin = (u >> 22) + (lane & 3) * 1024; }
          else if (pass == 1) { part = (u != 0u) && ((u >> 22) == pref[q]) && !few[q]; bin = ((u >> 12) & 1023u) + (lane & 3) * 1024; }
          else { part = (u != 0u) && ((u >> 12) == pref[q]) && !few[q]; bin = u & 4095u; }
          if (part) atomicAdd(hist + q * 4096 + bin, 1u);
        }
      }
      __syncthreads();
      if (w < 4) {
        const int q = w;
        const unsigned* hq = hist + q * 4096;
        const int need = 256 - chi[q];
        int G = 0;
        if (pass < 2) {
#pragma unroll
          for (int rep = 0; rep < 4; ++rep)
#pragma unroll
            for (int j = 0; j < 16; ++j) G += (int)hq[rep * 1024 + 16 * lane + ((j + lane) & 15)];
        } else {
#pragma unroll 8
          for (int j = 0; j < 64; ++j) G += (int)hq[64 * lane + ((j + lane) & 63)];
        }
        int S = G;
        { int tt; S = wscan<false>(S, lane, tt); }
        const unsigned long long mk = __ballot(S >= need);
        int B = 0, cg2 = 0, fw = 0, nbin = 0;
        if (mk == 0ull) {
          fw = 1;
        } else {
          const int ks = 63 - __clzll(mk);
          const int above = (ks < 63) ? __builtin_amdgcn_readlane(S, ks + 1) : 0;
          int hh;
          if (pass < 2) {
            hh = 0;
            if (lane < 16) hh = (int)(hq[16 * ks + lane] + hq[1024 + 16 * ks + lane] + hq[2048 + 16 * ks + lane] + hq[3072 + 16 * ks + lane]);
          } else {
            hh = (int)hq[64 * ks + lane];
          }
          int s2 = hh;
          { int tt; s2 = wscan<false>(s2, lane, tt); }
          const unsigned long long m2 = __ballot(above + s2 >= need);
          const int Ls = 63 - __clzll(m2);
          B = (pass < 2 ? 16 : 64) * ks + Ls;
          nbin = __builtin_amdgcn_readlane(hh, Ls);
          cg2 = above + __builtin_amdgcn_readlane(s2, Ls) - nbin;
        }
        if (lane == 0) { sel[q * 4 + 0] = B; sel[q * 4 + 1] = chi[q] + cg2; sel[q * 4 + 2] = fw; sel[q * 4 + 3] = nbin; }
      }
      __syncthreads();
#pragma unroll
      for (int q = 0; q < 4; ++q) {
        if (!few[q]) {
          pref[q] = (pref[q] << (pass < 2 ? 10 : 12)) | (unsigned)sel[q * 4 + 0];
          chi[q] = sel[q * 4 + 1];
          nb[q] = sel[q * 4 + 3];
          if (pass == 0) few[q] = sel[q * 4 + 2] != 0;
        }
      }
    }
    if (small) {
      unsigned* lst = hist;
      int* lcnt = sel + 16;
      if (tid < 4) lcnt[tid] = 0;
      __syncthreads();
#pragma unroll
      for (int i = 0; i < 17; ++i)
#pragma unroll
        for (int q = 0; q < 4; ++q) {
          const unsigned u = sc[i][q];
          if (!few[q] && u != 0u && (u >> 12) == pref[q]) { const int pos = atomicAdd(lcnt + q, 1); lst[q * 64 + pos] = u; }
        }
      __syncthreads();
      if (w < 4) {
        const int q = w, n = lcnt[q], need = 256 - chi[q];
        const unsigned e = lane < n ? lst[q * 64 + lane] : 0u;
        int rank = 0;
        for (int k = 0; k < n; ++k) rank += (lst[q * 64 + k] > e) ? 1 : 0;
        unsigned cand = (lane < n && rank <= need - 1) ? e : 0xFFFFFFFFu;
        cand = wminu(cand);
        if (lane == 0) sel[q * 4 + 0] = (int)cand;
      }
      __syncthreads();
#pragma unroll
      for (int q = 0; q < 4; ++q) T[q] = few[q] ? 0u : (unsigned)sel[q * 4 + 0];
    } else {
#pragma unroll
      for (int q = 0; q < 4; ++q) T[q] = few[q] ? 0u : pref[q];
    }
  }
  unsigned* cntb = (unsigned*)mg;
  unsigned* baseb = (unsigned*)bg;
#pragma unroll
  for (int i = 0; i < 17; ++i) {
    const int c = 1 + w + 8 * i;
    if (c <= cmax) {
      unsigned mine = 0u;
#pragma unroll
      for (int q = 0; q < 4; ++q) {
        const unsigned pk = (unsigned)__popcll(__ballot(sc[i][q] > T[q])) | ((unsigned)__popcll(__ballot(sc[i][q] == T[q])) << 16);
        mine = (lane == q) ? pk : mine;
      }
      if (lane < 4) cntb[lane * 132 + c] = mine;
    }
  }
  __syncthreads();
  if (w < 4) {
    const int q = w;
    int cg_ = 0, ce_ = 0;
    for (int base = 0; base <= cmax; base += 64) {
      const int c = base + lane;
      const bool in = (c >= 1) && (c <= cmax);
      const unsigned cv = in ? cntb[q * 132 + c] : 0u;
      const int v1 = (int)(cv & 0xffffu), v2 = (int)(cv >> 16);
      int t1, t2;
      const int i1 = wscan<true>(v1, lane, t1), i2 = wscan<true>(v2, lane, t2);
      if (in) baseb[q * 132 + c] = (unsigned)(cg_ + i1 - v1) | ((unsigned)(ce_ + i2 - v2) << 16);
      cg_ += t1;
      ce_ += t2;
    }
    if (lane == 0) ng[q] = cg_;
  }
  __syncthreads();
  const unsigned long long lt = (1ull << lane) - 1ull;
#pragma unroll
  for (int i = 0; i < 17; ++i) {
    const int c = 1 + w + 8 * i;
    if (c <= cmax) {
      const int key = c * 64 + lane;
#pragma unroll
      for (int q = 0; q < 4; ++q) {
        u16* out = p.IDX + (size_t)(b * PP + t0 + q) * 256;
        const bool gt = sc[i][q] > T[q];
        const bool eq = (sc[i][q] == T[q]) && (T[q] != 0u);
        const unsigned long long m1 = __ballot(gt), m2 = __ballot(eq);
        if ((m1 | m2) != 0ull) {
          const unsigned bb = baseb[q * 132 + c];
          if (gt) out[(int)(bb & 0xffffu) + __popcll(m1 & lt)] = (u16)key;
          if (eq) { const int pos = ng[q] + (int)(bb >> 16) + __popcll(m2 & lt); if (pos < 256) out[pos] = (u16)key; }
        }
      }
    }
  }
#pragma unroll
  for (int q = 0; q < 4; ++q) {
    if (T[q] == 0u) {
      u16* out = p.IDX + (size_t)(b * PP + t0 + q) * 256;
      if (tid < 256 && tid >= ng[q]) out[tid] = (u16)0xFFFF;
    }
  }
}

constexpr int AT_STAGE = 23040;
template <int DK, int MODE>
DI void attn_unit(const Params& p, int l, int b, int head, int qu, char* lds) {
  const int tid = opaque_tid(), lane = tid & 63, w = tid >> 6, r = lane & 31, h = lane >> 5;
  constexpr int KS = DK / 16, KST = DK + 8;
  const int q0 = qu * 256, qw0 = q0 + w * 32, qw = qw0 + r;
  const size_t tokq = (size_t)b * PP + qw;
  const u16 *qptr, *kptr, *vtptr, *gptr;
  int ldk;
  if (MODE == 0) {
    qptr = p.H + tokq * LDH + HQ_A + head * 64; kptr = p.H + (size_t)b * PP * LDH + HK_A + head * 64; ldk = LDH;
    vtptr = p.VtA + ((size_t)b * 512 + head * 64) * PP; gptr = p.H + tokq * LDH + HG_A + head * 64;
  } else if (MODE == 1) {
    qptr = p.Qm + tokq * 768 + head * 96; kptr = p.Km + (size_t)b * PP * 512 + head * 64; ldk = 512;
    vtptr = p.VtB + ((size_t)b * 512 + head * 64) * PP; gptr = p.H + tokq * LDH + HG_B + head * 64;
  } else {
    qptr = p.H + tokq * LDH + HQ_D + head * 64; kptr = p.H + (size_t)b * PP * LDH + HK_D + (head >> 2) * 64; ldk = LDH;
    vtptr = p.VtD + ((size_t)b * 128 + (head >> 2) * 64) * PP; gptr = p.H + tokq * LDH + HG_D + head * 64;
  }
  const float* cum = p.CUM + (size_t)(b * 8 + head) * PP;
  float* btab = (float*)(lds + 2 * AT_STAGE);
  u32x2 gpre[2][4];
#pragma unroll
  for (int d = 0; d < 2; ++d)
#pragma unroll
    for (int g = 0; g < 4; ++g) gpre[d][g] = *(const u32x2*)(gptr + d * 32 + 8 * g + 4 * h);
  bf16x8 qf[KS];
#pragma unroll
  for (int ks = 0; ks < KS; ++ks) qf[ks] = *(const bf16x8*)(qptr + ks * 16 + 8 * h);
  float cref = 0.f;
  if (MODE == 0) cref = cum[q0];
  if (MODE == 2) { if (tid < 128) btab[tid] = p.rel_bias[t5_bucket(tid) * 16 + 8 + head] * LOG2E; }
  const float sc2 = (MODE == 1 ? 0.10206207261596577f : 0.125f) * LOG2E;
  const int kt_hi = qu * 4 + 3;
  int kt_lo = 1;
  if (MODE == 2) { kt_lo = qu * 4 - 2; if (kt_lo < 1) kt_lo = 1; }
  u32x4 rk, rk2, rv;
  float re = 0.f;
  const int srow = tid >> 3, sc8 = tid & 7;
  auto gload = [&](int kt) {
    const int k0 = kt * 64;
    rk = *(const u32x4*)(kptr + (size_t)(k0 + srow) * ldk + sc8 * 8);
    if (MODE == 1) { if (tid < 256) rk2 = *(const u32x4*)(p.Kpe + ((size_t)b * PP + k0 + (tid >> 2)) * 32 + (tid & 3) * 8); }
    rv = *(const u32x4*)(vtptr + (size_t)srow * PP + k0 + sc8 * 8);
    if (MODE == 0) { if (tid < 64) re = (cum[k0 + tid] - cref) * LOG2E; }
  };
  auto lstore = [&](int st) {
    char* base = lds + st * AT_STAGE;
    *(u32x4*)(base + (srow * KST + sc8 * 8) * 2) = rk;
    if (MODE == 1) { if (tid < 256) *(u32x4*)(base + ((tid >> 2) * KST + 64 + (tid & 3) * 8) * 2) = rk2; }
    char* vb = base + 64 * KST * 2;
    u32x2 lo = {rv[0], rv[1]}, hi = {rv[2], rv[3]};
    *(u32x2*)(vb + (srow * 68 + sc8 * 8) * 2) = lo;
    *(u32x2*)(vb + (srow * 68 + sc8 * 8 + 4) * 2) = hi;
    if (MODE == 0) { if (tid < 64) *(float*)(vb + 64 * 68 * 2 + tid * 4) = re; }
  };
  f32x16 o[2];
#pragma unroll
  for (int d = 0; d < 2; ++d)
#pragma unroll
    for (int i = 0; i < 16; ++i) o[d][i] = 0.f;
  float m = NEGL, lsum = 0.f;
  float qn = 0.f, kmx = 0.f;
  int* stopf = (int*)(lds + 2 * AT_STAGE + 1024);
  if (MODE == 0) {
#pragma unroll
    for (int ks = 0; ks < KS; ++ks) {
      const u32x4 qq = __builtin_bit_cast(u32x4, qf[ks]);
#pragma unroll
      for (int e = 0; e < 4; ++e) { const float a = bf_lo(qq[e]), b2 = bf_hi(qq[e]); qn += a * a + b2 * b2; }
    }
    qn = xor32_sum(qn);
    qn = sqrtf(qn) * 1.01f;
    kmx = __uint_as_float(p.ctr[64 + l * 16 + b * 8 + head]);
  }
  gload(kt_hi); lstore(0);
  __syncthreads();
  for (int kt = kt_hi; kt >= kt_lo; --kt) {
    const bool more = kt > kt_lo;
    if (more) gload(kt - 1);
    float cnext = 0.f;
    if (MODE == 0) { if (more) cnext = cum[(kt - 1) * 64 + 63]; }
    const int st = (kt_hi - kt) & 1;
    const int k0 = kt * 64;
    bool active = k0 <= qw0 + 31;
    if (MODE == 2) active = active && (k0 + 63 >= qw0 - 127);
    if (active) {
      const char* kb = lds + st * AT_STAGE;
      const char* vb = kb + 64 * KST * 2;
      f32x16 s[2];
      bf16x8 kf[2][KS];
#pragma unroll
      for (int kr = 0; kr < 2; ++kr)
#pragma unroll
        for (int ks = 0; ks < KS; ++ks) kf[kr][ks] = *(const bf16x8*)(kb + ((kr * 32 + r) * KST + ks * 16 + 8 * h) * 2);
      __builtin_amdgcn_sched_barrier(0);
#pragma unroll
      for (int kr = 0; kr < 2; ++kr) {
#pragma unroll
        for (int i = 0; i < 16; ++i) s[kr][i] = 0.f;
#pragma unroll
        for (int ks = 0; ks < KS; ++ks) s[kr] = MFMA32(kf[kr][ks], qf[ks], s[kr]);
      }
      u32x4 vfr[2][2][2];
#pragma unroll
      for (int kr = 0; kr < 2; ++kr)
#pragma unroll
        for (int s2 = 0; s2 < 2; ++s2)
#pragma unroll
          for (int d = 0; d < 2; ++d) {
            const char* va = vb + ((d * 32 + r) * 68 + kr * 32 + s2 * 16 + 4 * h) * 2;
            const u32x2 lo = *(const u32x2*)va;
            const u32x2 hi = *(const u32x2*)(va + 16);
            vfr[kr][s2][d] = (u32x4){lo[0], lo[1], hi[0], hi[1]};
          }
      __builtin_amdgcn_sched_barrier(0);
      const bool need_mask = (MODE == 2) || (k0 + 63 > qw0) || (k0 < LEAD);
      const bool rawpath = (MODE == 1) && !need_mask;
      float tmax = NEGL;
      const f32x2 sc2v = {sc2, sc2};
      if (rawpath) {
#pragma unroll
        for (int kr = 0; kr < 2; ++kr)
#pragma unroll
          for (int i = 0; i < 16; ++i) tmax = fmaxf(tmax, s[kr][i]);
        tmax *= sc2;
      } else {
#pragma unroll
        for (int kr = 0; kr < 2; ++kr) {
#pragma unroll
          for (int g = 0; g < 4; ++g) {
            f32x4 ev = {0.f, 0.f, 0.f, 0.f};
            if (MODE == 0) ev = *(const f32x4*)(vb + 64 * 68 * 2 + (kr * 32 + 8 * g + 4 * h) * 4);
#pragma unroll
            for (int e2 = 0; e2 < 2; ++e2) {
              const int i = 4 * g + 2 * e2;
              f32x2 v2 = {s[kr][i], s[kr][i + 1]};
              if (MODE == 0) { const f32x2 e2v = {ev[2 * e2], ev[2 * e2 + 1]}; v2 = v2 * sc2v - e2v; }
              else v2 = v2 * sc2v;
#pragma unroll
              for (int e1 = 0; e1 < 2; ++e1) {
                const int key = k0 + kr * 32 + 8 * g + 4 * h + 2 * e2 + e1;
                float v = v2[e1];
                if (MODE == 2) v += btab[(qw - key) & 127];
                if (need_mask) {
                  bool ok = (key <= qw) && (key >= LEAD);
                  if (MODE == 2) ok = ok && (qw - key < 128);
                  v = ok ? v : NEGL;
                }
                s[kr][i + e1] = v;
                tmax = fmaxf(tmax, v);
              }
            }
          }
        }
      }
      tmax = xor32_max(tmax);
      const float mn = fmaxf(m, tmax);
      const float alpha = __builtin_amdgcn_exp2f(m - mn);
      const bool resc = __any(m != mn);
      m = mn;
      f32x2 ps2 = {0.f, 0.f};
      const f32x2 mnv = {mn, mn};
      const f32x2 scx = rawpath ? sc2v : (f32x2){1.f, 1.f};
#pragma unroll
      for (int kr = 0; kr < 2; ++kr)
#pragma unroll
        for (int i = 0; i < 16; i += 2) {
          f32x2 v2 = {s[kr][i], s[kr][i + 1]};
          v2 = v2 * scx - mnv;
          f32x2 p2 = {__builtin_amdgcn_exp2f(v2[0]), __builtin_amdgcn_exp2f(v2[1])};
          s[kr][i] = p2[0]; s[kr][i + 1] = p2[1];
          ps2 += p2;
        }
      const float ps = ps2[0] + ps2[1];
      lsum = lsum * alpha + ps;
      if (resc)
#pragma unroll
      for (int d = 0; d < 2; ++d)
#pragma unroll
        for (int i = 0; i < 16; ++i) o[d][i] *= alpha;
#pragma unroll
      for (int kr = 0; kr < 2; ++kr) {
#pragma unroll
        for (int s2 = 0; s2 < 2; ++s2) {
          u32x4 pp = {pk2(s[kr][8 * s2], s[kr][8 * s2 + 1]), pk2(s[kr][8 * s2 + 2], s[kr][8 * s2 + 3]),
                      pk2(s[kr][8 * s2 + 4], s[kr][8 * s2 + 5]), pk2(s[kr][8 * s2 + 6], s[kr][8 * s2 + 7])};
          bf16x8 pf = __builtin_bit_cast(bf16x8, pp);
#pragma unroll
          for (int d = 0; d < 2; ++d) o[d] = MFMA32(__builtin_bit_cast(bf16x8, vfr[kr][s2][d]), pf, o[d]);
        }
      }
    }
    if (more) lstore(st ^ 1);
    if (MODE == 0) {
      if (more) {
        const float enext = (cnext - cref) * LOG2E;
        const bool okl = (qn * kmx * sc2 - enext) <= (m - 40.f);
        const bool okw = __all(okl);
        if (lane == 0) stopf[(kt & 1) * 8 + w] = okw ? 1 : 0;
      }
    }
    __syncthreads();
    if (MODE == 0) {
      if (more) {
        const int* sf = stopf + (kt & 1) * 8;
        if (sf[0] & sf[1] & sf[2] & sf[3] & sf[4] & sf[5] & sf[6] & sf[7]) break;
      }
    }
  }
  lsum = xor32_sum(lsum);
  float f;
  if (MODE == 2) {
    const float s2 = p.sinks[l * 8 + head] * LOG2E;
    const float mf = fmaxf(m, s2);
    const float em = __builtin_amdgcn_exp2f(m - mf);
    f = em / (lsum * em + __builtin_amdgcn_exp2f(s2 - mf));
  } else {
    f = lsum > 0.f ? 1.f / lsum : 0.f;
  }
  f *= (MODE == 0 ? SC_FOX : (MODE == 1 ? SC_MLA : SC_SWA));
  u16* mp = p.Mix + tokq * 2048 + (MODE == 0 ? 0 : (MODE == 1 ? 512 : 1536)) + head * 64;
#pragma unroll
  for (int d = 0; d < 2; ++d)
#pragma unroll
    for (int g = 0; g < 4; ++g) {
      const int dd = d * 32 + 8 * g + 4 * h;
      const u32x2 gv = gpre[d][g];
      float g0 = silu(bf_lo(gv[0])), g1 = silu(bf_hi(gv[0])), g2 = silu(bf_lo(gv[1])), g3 = silu(bf_hi(gv[1]));
      u32x2 ov = {pk2(o[d][4 * g] * f * g0, o[d][4 * g + 1] * f * g1), pk2(o[d][4 * g + 2] * f * g2, o[d][4 * g + 3] * f * g3)};
      *(u32x2*)(mp + dd) = ov;
    }
}

DI void dsa_job(const Params& p, int b, int tq0, char* lds) {
  const int tid = opaque_tid(), lane = tid & 63, w = tid >> 6;
  float* biasC = (float*)(lds + 143360);
  int* btab = (int*)(lds + 143360 + 1024);
  char* wl = lds + w * 17920;
  float* Pl = (float*)wl;
  int* kid = (int*)(wl + 8192);
  const int tq = tq0 + w;
  const size_t tok = (size_t)b * PP + tq;
  const u16* Hb = p.H + (size_t)b * PP * LDH;
  int kk[4], ku[4];
  {
    u32x2 iv = *(const u32x2*)(p.IDX + tok * 256 + 4 * lane);
    kk[0] = iv[0] & 0xffff; kk[1] = iv[0] >> 16; kk[2] = iv[1] & 0xffff; kk[3] = iv[1] >> 16;
#pragma unroll
    for (int j = 0; j < 4; ++j) ku[j] = (kk[j] == 0xFFFF) ? LEAD : kk[j];
    u32x4 kv4 = {(unsigned)ku[0], (unsigned)ku[1], (unsigned)ku[2], (unsigned)ku[3]};
    ((u32x4*)kid)[lane] = kv4;
  }
  u32x4 gvp[4];
#pragma unroll
  for (int hh = 0; hh < 4; ++hh) gvp[hh] = *(const u32x4*)(p.H + tok * LDH + HG_C + (((lane >> 3) & 1) * 4 + hh) * 64 + (lane & 7) * 8);
  __builtin_amdgcn_wave_barrier();
  const int ksub = lane >> 4, g = (lane >> 3) & 1, dc = lane & 7;
  {
    const int r = lane & 31, h = lane >> 5, pc = lane & 15;
    char* kst = wl + 9216;
    bf16x8 qb[8];
#pragma unroll
    for (int ks = 0; ks < 8; ++ks) {
      u32x4 v = {0u, 0u, 0u, 0u};
      if (r < 8 && (ks >> 2) == (r >> 2)) v = *(const u32x4*)(p.H + tok * LDH + HQ_C + r * 64 + (ks & 3) * 16 + 8 * h);
      qb[ks] = __builtin_bit_cast(bf16x8, v);
    }
    const u16* kbase = Hb + HK_C + pc * 8;
    u32x4 st0[8], st1[8];
#pragma unroll
    for (int s2 = 0; s2 < 8; ++s2) st0[s2] = *(const u32x4*)(kbase + (size_t)kid[4 * s2 + ksub] * LDH);
#pragma unroll
    for (int s2 = 0; s2 < 8; ++s2) st1[s2] = *(const u32x4*)(kbase + (size_t)kid[32 + 4 * s2 + ksub] * LDH);
    auto chunk = [&](int c, u32x4* stc) {
#pragma unroll
      for (int s2 = 0; s2 < 8; ++s2) *(u32x4*)(kst + (4 * s2 + ksub) * 272 + pc * 16) = stc[s2];
      if (c + 2 < 8) {
#pragma unroll
        for (int s2 = 0; s2 < 8; ++s2) stc[s2] = *(const u32x4*)(kbase + (size_t)kid[32 * (c + 2) + 4 * s2 + ksub] * LDH);
      }
      bf16x8 af[8];
#pragma unroll
      for (int ks = 0; ks < 8; ++ks) af[ks] = *(const bf16x8*)(kst + r * 272 + ks * 32 + 16 * h);
      __builtin_amdgcn_sched_barrier(0);
      f32x16 acc0, acc1;
#pragma unroll
      for (int i = 0; i < 16; ++i) { acc0[i] = 0.f; acc1[i] = 0.f; }
#pragma unroll
      for (int ks = 0; ks < 8; ks += 2) { acc0 = MFMA32(af[ks], qb[ks], acc0); acc1 = MFMA32(af[ks + 1], qb[ks + 1], acc1); }
      if (r < 8) {
#pragma unroll
        for (int i = 0; i < 16; ++i) Pl[(32 * c + crow(i, h)) * 8 + r] = acc0[i] + acc1[i];
      }
    };
#pragma unroll 1
    for (int c = 0; c < 8; c += 2) { chunk(c, st0); chunk(c + 1, st1); }
  }
  __builtin_amdgcn_wave_barrier();
  float lg[4][8];
#pragma unroll
  for (int j = 0; j < 4; ++j) {
    const f32x4 v0 = *(const f32x4*)(Pl + (4 * lane + j) * 8), v1 = *(const f32x4*)(Pl + (4 * lane + j) * 8 + 4);
#pragma unroll
    for (int e = 0; e < 4; ++e) { lg[j][e] = v0[e]; lg[j][4 + e] = v1[e]; }
  }
  int bk[4];
#pragma unroll
  for (int j = 0; j < 4; ++j) { int dist = tq - ku[j]; bk[j] = (dist < 128) ? btab[dist & 127] : 31; }
#pragma unroll
  for (int hd = 0; hd < 8; ++hd) {
    float mx = NEGL;
#pragma unroll
    for (int j = 0; j < 4; ++j) {
      float v = lg[j][hd] * 0.125f + biasC[bk[j] * 8 + hd];
      v = (kk[j] == 0xFFFF) ? NEGL : v;
      lg[j][hd] = v;
      mx = fmaxf(mx, v);
    }
    mx = wmax(mx);
    float sm = 0.f;
#pragma unroll
    for (int j = 0; j < 4; ++j) { float e = __expf(lg[j][hd] - mx); lg[j][hd] = e; sm += e; }
    sm = wsum(sm);
    const float inv = 1.f / sm;
#pragma unroll
    for (int j = 0; j < 4; ++j) lg[j][hd] *= inv;
  }
#pragma unroll
  for (int j = 0; j < 4; ++j) {
    f32x4 v0 = {lg[j][0], lg[j][1], lg[j][2], lg[j][3]}, v1 = {lg[j][4], lg[j][5], lg[j][6], lg[j][7]};
    *(f32x4*)(Pl + (4 * lane + j) * 8) = v0;
    *(f32x4*)(Pl + (4 * lane + j) * 8 + 4) = v1;
  }
  __builtin_amdgcn_wave_barrier();
  const u16* vb = Hb + HV_C + g * 64 + dc * 8;
  f32x2 acc2[4][4];
#pragma unroll
  for (int hh = 0; hh < 4; ++hh)
#pragma unroll
    for (int e = 0; e < 4; ++e) { acc2[hh][e][0] = 0.f; acc2[hh][e][1] = 0.f; }
  u32x4 vA[16], vB[16];
  auto pv_load = [&](int grp, u32x4* dst) {
#pragma unroll
    for (int s = 0; s < 16; ++s) dst[s] = *(const u32x4*)(vb + (size_t)kid[4 * (grp * 16 + s) + ksub] * LDH);
  };
  auto pv_fma = [&](int grp, const u32x4* src) {
#pragma unroll
    for (int s = 0; s < 16; ++s) {
      const int slot = 4 * (grp * 16 + s) + ksub;
      const f32x4 pp = *(const f32x4*)(Pl + slot * 8 + g * 4);
      const u32x4 vv = src[s];
#pragma unroll
      for (int hh = 0; hh < 4; ++hh) {
        const f32x2 ph = {pp[hh], pp[hh]};
#pragma unroll
        for (int e = 0; e < 4; ++e) {
          const f32x2 vf2 = {bf_lo(vv[e]), bf_hi(vv[e])};
          acc2[hh][e] += ph * vf2;
        }
      }
    }
  };
  pv_load(0, vA);
  pv_load(1, vB);
  pv_fma(0, vA);
  pv_load(2, vA);
  pv_fma(1, vB);
  pv_load(3, vB);
  pv_fma(2, vA);
  pv_fma(3, vB);
  float acc[4][8];
#pragma unroll
  for (int hh = 0; hh < 4; ++hh)
#pragma unroll
    for (int e = 0; e < 8; ++e) { float v = acc2[hh][e >> 1][e & 1]; v += __shfl_xor(v, 16); v += __shfl_xor(v, 32); acc[hh][e] = v; }
  if (ksub == 0) {
#pragma unroll
    for (int hh = 0; hh < 4; ++hh) {
      const int hd = g * 4 + hh;
      const u32x4 gv = gvp[hh];
      u32x4 ov;
#pragma unroll
      for (int e = 0; e < 4; ++e) ov[e] = pk2(acc[hh][2 * e] * SC_DSA * silu(bf_lo(gv[e])), acc[hh][2 * e + 1] * SC_DSA * silu(bf_hi(gv[e])));
      *(u32x4*)(p.Mix + tok * 2048 + 1024 + hd * 64 + dc * 8) = ov;
    }
  }
}

DI void outproj_tile(const Params& p, int mt, int nt, char* lds, int khalf) {
  const int tid = opaque_tid(), lane = tid & 63, w = tid >> 6, r = lane & 31, h = lane >> 5;
  const int wm = w & 3, wn = w >> 2;
  const int m0 = mt * 256;
  const int koff = khalf > 0 ? 512 * khalf : 0, klen = khalf < 0 ? 2048 : 512;
  const u16* A = p.Mix + (size_t)m0 * 2048 + koff;
  const u16* Bw = p.Wt_out + (size_t)nt * 128 * 2048 + koff;
  if (khalf <= 0) {
    gemm_tile<true>(A, 2048, Bw, 2048, klen, lds, [&](int mi, int ni, const f32x16& a) {
      const int tok = m0 + wm * 64 + mi * 32 + r;
      float* rp = p.R + (size_t)tok * DM + nt * 128 + wn * 64 + ni * 32;
#pragma unroll
      for (int g = 0; g < 4; ++g) {
        f32x4 v = *(const f32x4*)(rp + 8 * g + 4 * h);
#pragma unroll
        for (int e = 0; e < 4; ++e) v[e] = ALPHA * v[e] + a[4 * g + e];
        *(f32x4*)(rp + 8 * g + 4 * h) = v;
      }
    });
  } else {
    gemm_tile<true>(A, 2048, Bw, 2048, klen, lds, [&](int mi, int ni, const f32x16& a) {
      const int tok = m0 + wm * 64 + mi * 32 + r;
      float* rp = p.Y1 + ((size_t)(khalf - 1) * 512 + (tok - 16384)) * DM + nt * 128 + wn * 64 + ni * 32;
#pragma unroll
      for (int g = 0; g < 4; ++g) {
        const f32x4 v = {a[4 * g], a[4 * g + 1], a[4 * g + 2], a[4 * g + 3]};
        *(f32x4*)(rp + 8 * g + 4 * h) = v;
      }
    });
  }
}

DI void ln_rows(const Params& p, int l) {
  const int tid = opaque_tid(), lane = tid & 63, w = tid >> 6;
  const float* gg = l < 0 ? p.ln0_g : p.ln_g + l * DM;
  const float* bb = l < 0 ? p.ln0_b : p.ln_b + l * DM;
  const int stride = gridDim.x * 8;
  auto loadrow = [&](int row, f32x4* dst) {
    if (l < 0) {
      const int b = row / PP, t = row - b * PP;
      const float* src = nullptr;
      if (t >= 128 && t < PV) src = p.x + ((size_t)b * SEQ + (t - 128)) * DM;
      else if (t >= LEAD && t < 128) src = p.meta + (size_t)(t - LEAD) * DM;
#pragma unroll
      for (int j = 0; j < 4; ++j) {
        if (src) dst[j] = *(const f32x4*)(src + lane * 4 + 256 * j);
        else { dst[j][0] = 0.f; dst[j][1] = 0.f; dst[j][2] = 0.f; dst[j][3] = 0.f; }
      }
    } else {
#pragma unroll
      for (int j = 0; j < 4; ++j) {
        dst[j] = *(const f32x4*)(p.R + (size_t)row * DM + lane * 4 + 256 * j);
        if (row >= 16384) {
#pragma unroll
          for (int q = 0; q < 3; ++q) dst[j] += *(const f32x4*)(p.Y1 + ((size_t)q * 512 + (row - 16384)) * DM + lane * 4 + 256 * j);
        }
      }
    }
  };
  f32x4 v[4], vn[4];
  int row = blockIdx.x * 8 + w;
  if (row < MT) loadrow(row, v);
  for (; row < MT; row += stride) {
    const int b = row / PP, t = row - b * PP;
    if (row + stride < MT) loadrow(row + stride, vn);
    float s = 0.f;
#pragma unroll
    for (int j = 0; j < 4; ++j) s += v[j][0] + v[j][1] + v[j][2] + v[j][3];
    const float mu = wsum(s) * (1.f / DM);
    float q = 0.f;
#pragma unroll
    for (int j = 0; j < 4; ++j)
#pragma unroll
      for (int e = 0; e < 4; ++e) { float d = v[j][e] - mu; q += d * d; }
    const float rstd = rsqrtf(wsum(q) * (1.f / DM) + 1e-5f);
#pragma unroll
    for (int j = 0; j < 4; ++j) {
      const int c = lane * 4 + 256 * j;
      f32x4 g4 = *(const f32x4*)(gg + c), b4 = *(const f32x4*)(bb + c);
      f32x4 y;
#pragma unroll
      for (int e = 0; e < 4; ++e) y[e] = (v[j][e] - mu) * rstd * g4[e] + b4[e];
      if (l == 3) {
        if (t >= 128 && t < PV) *(f32x4*)(p.out + ((size_t)b * SEQ + (t - 128)) * DM + c) = y;
      } else {
        *(f32x4*)(p.R + (size_t)row * DM + c) = y;
        u32x2 yb = {pk2(y[0], y[1]), pk2(y[2], y[3])};
        *(u32x2*)(p.Xb + (size_t)row * DM + c) = yb;
      }
    }
#pragma unroll
    for (int j = 0; j < 4; ++j) v[j] = vn[j];
  }
}

DI int map_in(int n) {
  if (n < 512) return n;
  if (n < 1024) return n;
  if (n < 1536) return 1544 + (n - 1024);
  if (n < 1792) return 2056 + (n - 1536);
  if (n < 1920) return 2312 + (n - 1792);
  if (n < 2432) return 2472 + (n - 1920);
  if (n < 2944) return 2984 + (n - 2432);
  if (n < 3072) return 3496 + (n - 2944);
  if (n < 3200) return 3624 + (n - 3072);
  if (n < 3712) return 3752 + (n - 3200);
  if (n < 4224) return 4336 + (n - 3712);
  if (n < 4736) return 4848 + (n - 4224);
  if (n < 4864) return 5360 + (n - 4736);
  if (n < 5376) return 5616 + (n - 4864);
  if (n < 5408) return 2440 + (n - 5376);
  if (n < 5472) return 4264 + (n - 5408);
  if (n < 5480) return 1536 + (n - 5472);
  if (n < 5488) return 4328 + (n - 5480);
  if (n < 5504) return -1;
  if (n < 6016) return 1024 + (n - 5504);
  return 5488 + (n - 6016);
}
DI void conv_weights(const Params& p, int l, char* lds) {
  const int tid = opaque_tid();
  float* tile = (float*)lds;
  struct TD { u16* dst; int K, k0, n0; };
  const int nn_l = tid & 63;
  auto loadtile = [&](int tI, float* rv, TD& d) {
    const float* src; const float* ksc = nullptr; int ldsrc, kind, kt, ntile;
    if (tI < 1536) { kind = 0; kt = tI / 96; ntile = tI % 96; src = p.w_in + (size_t)l * DM * D_IN; ldsrc = D_IN; d.K = DM; d.dst = p.Wt_in; }
    else if (tI < 2048) { int u = tI - 1536; kind = 1; kt = u / 16; ntile = u % 16; src = p.w_out + (size_t)l * 2048 * DM; ldsrc = DM; d.K = 2048; d.dst = p.Wt_out; }
    else if (tI < 2096) { int u = tI - 2048; kind = 2; kt = u / 12; ntile = u % 12; src = p.w_uq + (size_t)l * 256 * 768; ldsrc = 768; d.K = 256; d.dst = p.Wt_uq; ksc = p.gq + l * 256; }
    else { int u = tI - 2096; kind = 3; kt = u / 16; ntile = u % 16; src = p.w_ukv + (size_t)l * 128 * 1024; ldsrc = 1024; d.K = 128; d.dst = p.Wt_ukv; ksc = p.gkv + l * 128; }
    d.k0 = kt * 64; d.n0 = ntile * 64;
    const int n = d.n0 + nn_l;
    int sc;
    if (kind == 0) sc = map_in(n);
    else if (kind == 3) sc = (n < 512) ? ((n >> 6) * 128 + (n & 63)) : (((n - 512) >> 6) * 128 + 64 + (n & 63));
    else sc = n;
#pragma unroll
    for (int j = 0; j < 8; ++j) {
      const int kk = (tid >> 6) + 8 * j;
      float v = 0.f;
      if (sc >= 0) v = src[(size_t)(d.k0 + kk) * ldsrc + sc];
      if (ksc) v *= ksc[d.k0 + kk];
      rv[j] = v;
    }
  };
  float rv[8], rn[8];
  TD dc, dn;
  int tI = blockIdx.x;
  if (tI < 2128) loadtile(tI, rv, dc);
  for (; tI < 2128; tI += gridDim.x) {
    const int tN = tI + gridDim.x;
    if (tN < 2128) loadtile(tN, rn, dn);
#pragma unroll
    for (int j = 0; j < 8; ++j) tile[nn_l * 65 + (tid >> 6) + 8 * j] = rv[j];
    __syncthreads();
    {
      const int nn = tid >> 3, kc = (tid & 7) * 8;
      const float* tp = tile + nn * 65 + kc;
      u32x4 ov = {pk2(tp[0], tp[1]), pk2(tp[2], tp[3]), pk2(tp[4], tp[5]), pk2(tp[6], tp[7])};
      *(u32x4*)(dc.dst + (size_t)(dc.n0 + nn) * dc.K + dc.k0 + kc) = ov;
    }
    __syncthreads();
#pragma unroll
    for (int j = 0; j < 8; ++j) rv[j] = rn[j];
    dc = dn;
  }
}
DI void rope_table(const Params& p) {
  const int gt = blockIdx.x * NTHREADS + threadIdx.x;
  for (int i = gt; i < PP * 16; i += gridDim.x * NTHREADS) {
    const int t = i >> 4, c = i & 15;
    const float freq = powf(10000.f, -(float)c / 16.f);
    const float ang = (float)(t - LEAD) * freq;
    float sn, cs;
    sincosf(ang, &sn, &cs);
    p.ROPE[(size_t)t * 32 + c] = cs;
    p.ROPE[(size_t)t * 32 + 16 + c] = sn;
  }
}


#define XB_TMO      128
#define XB_XCNT(j)  (256  + 64 * (j))
#define XB_XSUB(j)  (1280 + 64 * (j))
#define XB_XGEN(j)  (2304 + 64 * (j))
#define XB_TOP      3328
#define XB_TOPGEN   3392
#define XCD_BAR_WORDS 3456
#define XB_SPIN_CAP (1u << 18)
DI unsigned xb_ld(unsigned* p) { return __hip_atomic_load(p, __ATOMIC_RELAXED, __HIP_MEMORY_SCOPE_AGENT); }
DI unsigned xb_add(unsigned* p, unsigned v) { return __hip_atomic_fetch_add(p, v, __ATOMIC_RELAXED, __HIP_MEMORY_SCOPE_AGENT); }
DI unsigned xb_xcc_id() { return (unsigned)__builtin_amdgcn_s_getreg((3 << 11) | 20) & 0xFu; }
#define XB_SPIN(cond, bar) do { unsigned _sp = 0; while (cond) { __builtin_amdgcn_s_sleep(1); \
    if ((++_sp & 255u) == 0u) { if (xb_ld(&(bar)[XB_TMO])) break; if (_sp > XB_SPIN_CAP) { atomicAdd(&(bar)[XB_TMO], 1u); break; } } } } while (0)
struct XcdBarrier { unsigned* bar; unsigned x; volatile unsigned* st; };
DI XcdBarrier xcd_barrier_post(unsigned* bar, volatile unsigned* st) {
  XcdBarrier b; b.bar = bar; b.x = xb_xcc_id(); b.st = st;
  if (threadIdx.x == 0) (void)xb_add(&bar[XB_XCNT(b.x)], 1u);
  return b;
}
DI void xcd_barrier_complete(unsigned* bar, unsigned x, unsigned& nloc, unsigned& nx) {
  const unsigned G = gridDim.x * gridDim.y * gridDim.z;
  unsigned sum, cnt, mine, sp = 0u;
  for (;;) {
    sum = 0u; cnt = 0u; mine = 0u;
#pragma unroll
    for (unsigned j = 0; j < 16; ++j) { const unsigned c = xb_ld(&bar[XB_XCNT(j)]); sum += c; cnt += (c > 0u) ? 1u : 0u; mine = (j == x) ? c : mine; }
    if (sum == G) break;
    __builtin_amdgcn_s_sleep(1);
    if ((++sp & 255u) == 0u) { if (xb_ld(&bar[XB_TMO])) break; if (sp > XB_SPIN_CAP) { atomicAdd(&bar[XB_TMO], 1u); break; } }
  }
  nloc = mine > 0u ? mine : 1u; nx = cnt > 0u ? cnt : 1u;
}
DI void xcd_barrier(const XcdBarrier& b) {
  asm volatile("s_waitcnt vmcnt(0)" ::: "memory");
  __syncthreads();
  if (threadIdx.x == 0) {
    unsigned* bar = b.bar;
    __builtin_amdgcn_s_waitcnt(0);
    unsigned nloc = b.st[0], nx = b.st[1];
    if (nloc == 0u) { xcd_barrier_complete(bar, b.x, nloc, nx); b.st[0] = nloc; b.st[1] = nx; }
    const unsigned old = xb_add(&bar[XB_XSUB(b.x)], 1u);
    const unsigned gen = old / nloc;
    if (old + 1u == (gen + 1u) * nloc) {
      __builtin_amdgcn_fence(__ATOMIC_RELEASE, "agent");
      asm volatile("s_waitcnt vmcnt(0)" ::: "memory");
      const unsigned og = xb_add(&bar[XB_TOP], 1u);
      const unsigned tg = og / nx;
      if (og + 1u == (tg + 1u) * nx) xb_add(&bar[XB_TOPGEN], 1u);
      else XB_SPIN(xb_ld(&bar[XB_TOPGEN]) == tg, bar);
      __builtin_amdgcn_fence(__ATOMIC_ACQUIRE, "agent");
      xb_add(&bar[XB_XGEN(b.x)], 1u);
      asm volatile("s_waitcnt vmcnt(0)" ::: "memory");
    } else {
      XB_SPIN(xb_ld(&bar[XB_XGEN(b.x)]) == gen, bar);
      __builtin_amdgcn_fence(__ATOMIC_ACQUIRE, "agent");
      asm volatile("s_waitcnt vmcnt(0)" ::: "memory");
    }
  }
  __syncthreads();
}

__global__ void __launch_bounds__(NTHREADS) mega(Params p) {
  extern __shared__ __attribute__((aligned(16))) char lds[];
  cg::grid_group grid = cg::this_grid();
  ln_rows(p, -1);
  conv_weights(p, 0, lds);
  rope_table(p);
  if (blockIdx.x == 0) {
    if (threadIdx.x < 256) p.ctr[threadIdx.x] = 0u;
    for (int i = threadIdx.x; i < XCD_BAR_WORDS; i += NTHREADS) p.bar[i] = 0u;
  }
  volatile unsigned* xst = (volatile unsigned*)(lds + LDS_JOB + 16);
  if (threadIdx.x == 0) { xst[0] = 0u; xst[1] = 0u; }
  grid.sync();
  const XcdBarrier xb = xcd_barrier_post(p.bar, xst);
  for (int l = 0; l < 4; ++l) {
    for (int rep = 0; rep < REP_P1; ++rep) {
      for (int j = blockIdx.x; j < 66 * 48; j += gridDim.x) inproj_tile(p, l, j / 48, j % 48, lds);
      xcd_barrier(xb);
    }
    for (int rep = 0; rep < REP_P2; ++rep) {
      constexpr int NTK = 2 * 2052, NUP = 66 * 14, NJ = NTK + NUP + 16;
      int pending = 0, par = 0;
      if (threadIdx.x == 0) pending = (int)atomicAdd(p.ctr + l * 2 + 8 * rep, 1u);
      for (;;) {
        const int j = next_job(p.ctr + l * 2 + 8 * rep, lds, pending, NJ, par);
        if (j >= NJ) break;
        if (j < 16) {
          cumsum_job(p, j, lds);
        } else if (j < 16 + NTK) {
          const int jj = j - 16;
          const int b = jj & 1, q = 2051 - (jj >> 1);
          topk_job(p, b, LEAD + 4 * q, lds);
        } else {
          const int u = j - 16 - NTK;
          upproj_tile(p, u / 14, u % 14, lds);
        }
      }
      xcd_barrier(xb);
    }
    for (int rep = 0; rep < REP_P3; ++rep) {
      constexpr int ND = 1056, NS = 528, NC = 2 * 1026, NJ = ND + NS + NC;
      {
        float* biasC = (float*)(lds + 143360);
        int* btab = (int*)(lds + 143360 + 1024);
        if (threadIdx.x < 256) biasC[threadIdx.x] = p.rel_bias[(threadIdx.x >> 3) * 16 + (threadIdx.x & 7)];
        if (threadIdx.x < 128) btab[threadIdx.x] = t5_bucket(threadIdx.x);
      }
      int pending = 0, par = 0;
      if (threadIdx.x == 0) pending = (int)atomicAdd(p.ctr + l * 2 + 1 + 8 * rep, 1u);
      for (;;) {
        const int j = next_job(p.ctr + l * 2 + 1 + 8 * rep, lds, pending, NJ, par);
        if (j >= NJ) break;
        if (j < ND) {
          const int qu = 32 - (j >> 5), rem = j & 31, kind = rem >> 4, b = (rem >> 3) & 1, head = rem & 7;
          if (kind == 0) attn_unit<64, 0>(p, l, b, head, qu, lds);
          else attn_unit<96, 1>(p, l, b, head, qu, lds);
        } else if (j < ND + NS) {
          const int u = j - ND;
          attn_unit<64, 2>(p, l, (u >> 3) & 1, u & 7, u >> 4, lds);
        } else {
          const int u = j - ND - NS;
          dsa_job(p, u & 1, LEAD + 8 * (u >> 1), lds);
        }
      }
      xcd_barrier(xb);
    }
    for (int j = blockIdx.x; j < 512; j += gridDim.x) {
      const int x = j & 7, a = j >> 3;
      outproj_tile(p, 2 * (a >> 1) + (x >> 2), 2 * (x & 3) + (a & 1), lds, -1);
    }
    if (blockIdx.x < 64) {
      const int j = 512 + (blockIdx.x >> 2), x = j & 7, a = j >> 3;
      outproj_tile(p, 2 * (a >> 1) + (x >> 2), 2 * (x & 3) + (a & 1), lds, blockIdx.x & 3);
    }
    xcd_barrier(xb);
    ln_rows(p, l);
    if (l < 3) { conv_weights(p, l + 1, lds); xcd_barrier(xb); }
  }
}

extern "C" void kernel_launch(void* const* d_in, const int* in_sizes, int n_in, void* d_out, int out_size, void* d_ws, size_t ws_size,
                              hipStream_t stream) {
  static int grid = 0;
  if (grid == 0) {
    int dev = 0, cus = 0, per_cu = 0;
    hipGetDevice(&dev);
    hipDeviceGetAttribute(&cus, hipDeviceAttributeMultiprocessorCount, dev);
    if (hipFuncSetAttribute((const void*)mega, hipFuncAttributeMaxDynamicSharedMemorySize, LDS_BYTES) != hipSuccess) { fprintf(stderr, "hipFuncSetAttribute failed\n"); grid = -1; return; }
    hipOccupancyMaxActiveBlocksPerMultiprocessor(&per_cu, (const void*)mega, NTHREADS, LDS_BYTES);
    if (per_cu < 1) { fprintf(stderr, "occupancy query: %d\n", per_cu); grid = -1; return; }
    grid = cus * per_cu;
  }
  if (grid < 0) return;
  size_t off = 0;
  auto take = [&](size_t bytes) { size_t o = off; off += (bytes + 255) & ~(size_t)255; return (char*)d_ws + o; };
  Params p{};
  p.x = (const float*)d_in[0]; p.meta = (const float*)d_in[1]; p.ln0_g = (const float*)d_in[2]; p.ln0_b = (const float*)d_in[3];
  p.rel_bias = (const float*)d_in[4]; p.w_in = (const float*)d_in[5]; p.b_f = (const float*)d_in[6]; p.gq = (const float*)d_in[7];
  p.gkv = (const float*)d_in[8]; p.w_uq = (const float*)d_in[9]; p.w_ukv = (const float*)d_in[10]; p.sinks = (const float*)d_in[11];
  p.w_out = (const float*)d_in[12]; p.ln_g = (const float*)d_in[13]; p.ln_b = (const float*)d_in[14];
  p.out = (float*)d_out;
  p.ctr = (unsigned*)take(1024);
  p.bar = (unsigned*)take(XCD_BAR_WORDS * 4);
  p.Wt_in = (u16*)take((size_t)NIN * DM * 2);
  p.Wt_out = (u16*)take((size_t)DM * 2048 * 2);
  p.Wt_uq = (u16*)take((size_t)768 * 256 * 2);
  p.Wt_ukv = (u16*)take((size_t)1024 * 128 * 2);
  p.H = (u16*)take((size_t)MT * LDH * 2);
  p.Mix = (u16*)take((size_t)MT * 2048 * 2);
  p.Xb = p.Mix;
  p.VtA = (u16*)take((size_t)NB * 512 * PP * 2);
  p.VtD = (u16*)take((size_t)NB * 128 * PP * 2);
  p.R = (float*)take((size_t)MT * DM * 4);
  p.Y1 = (float*)take((size_t)3 * 512 * DM * 4);
  p.IDX = (u16*)take((size_t)MT * 256 * 2);
  p.IK = (u16*)take((size_t)MT * 64 * 2);
  p.Kpe = (u16*)take((size_t)MT * 32 * 2);
  p.IW = (float*)take((size_t)MT * 8 * 4);
  p.LOGF = (float*)take((size_t)NB * 8 * PP * 4);
  p.CUM = (float*)take((size_t)NB * 8 * PP * 4);
  p.ROPE = (float*)take((size_t)PP * 32 * 4);
  if (off > ws_size) { fprintf(stderr, "workspace too small: need %zu have %zu\n", off, ws_size); return; }
  {
    char* ob = (char*)d_out;
    p.Qm = (u16*)ob; ob += (size_t)MT * 768 * 2;
    p.Km = (u16*)ob; ob += (size_t)MT * 512 * 2;
    p.VtB = (u16*)ob; ob += (size_t)NB * 512 * PP * 2;
    if ((size_t)(ob - (char*)d_out) > (size_t)out_size * 4) { fprintf(stderr, "d_out too small for scratch\n"); return; }
  }
  hipMemsetAsync(p.ctr, 0, 1024 + XCD_BAR_WORDS * 4, stream);
  void* args[] = {&p};
  hipError_t e = hipLaunchCooperativeKernel((const void*)mega, dim3(grid), dim3(NTHREADS), args, LDS_BYTES, stream);
  if (e != hipSuccess) fprintf(stderr, "cooperative launch failed: %s (grid %d)\n", hipGetErrorString(e), grid);
}
```

```cpp
#include <hip/hip_runtime.h>
#include <hip/hip_cooperative_groups.h>
#include <cstdio>
namespace cg = cooperative_groups;

#define DI __device__ __forceinline__
typedef __attribute__((ext_vector_type(8))) short bf16x8;
typedef __attribute__((ext_vector_type(16))) float f32x16;
typedef __attribute__((ext_vector_type(4))) float f32x4;
typedef __attribute__((ext_vector_type(2))) float f32x2;
typedef __attribute__((ext_vector_type(2))) __bf16 bf2_t;
typedef __attribute__((ext_vector_type(4))) unsigned u32x4;
typedef __attribute__((ext_vector_type(2))) unsigned u32x2;
typedef unsigned short u16;
#define MFMA32(a, b, c) __builtin_amdgcn_mfma_f32_32x32x16_bf16((a), (b), (c), 0, 0, 0)

constexpr int NB = 2, PP = 8448, PV = 8320, LEAD = 112, DM = 1024, MT = NB * PP, SEQ = 8192;
constexpr int LDH = 5376, NIN = 6144;
constexpr int HQ_A = 0, HK_A = 512, HG_A = 1024, HCQ_B = 1536, HCKV_B = 1792, HG_B = 1920, HQ_C = 2432, HK_C = 2944, HV_C = 3072,
              HIQ_C = 3200, HG_C = 3712, HQ_D = 4224, HK_D = 4736, HG_D = 4864;
constexpr int D_IN = 6128;
constexpr float LOG2E = 1.4426950408889634f;
constexpr float NEGL = -1e30f;
constexpr float ALPHA = 1.681792830507429f;
constexpr int LDS_JOB = 147456;
constexpr int LDS_BYTES = LDS_JOB + 64;
constexpr int GEMM_STAGE = 55296;
constexpr int NTHREADS = 512;
#define REP_P1 1
#define REP_P2 1
#define REP_P3 1
#define SC_FOX 1.0f
#define SC_MLA 1.0f
#define SC_SWA 1.0f
#define SC_DSA 1.0f

struct Params {
  const float *x, *meta, *ln0_g, *ln0_b, *rel_bias, *w_in, *b_f, *gq, *gkv, *w_uq, *w_ukv, *sinks, *w_out, *ln_g, *ln_b;
  float* out;
  u16 *Wt_in, *Wt_out, *Wt_uq, *Wt_ukv;
  u16 *H, *Xb, *Mix, *VtA, *VtD, *VtB, *Qm, *Km, *Kpe, *IK, *IDX;
  float *R, *LOGF, *CUM, *IW, *ROPE, *Y1;
  unsigned* ctr;
  unsigned* bar;
};

DI unsigned pk2(float a, float b) { f32x2 v = {a, b}; return __builtin_bit_cast(unsigned, __builtin_convertvector(v, bf2_t)); }
DI float bf_lo(unsigned u) { return __uint_as_float(u << 16); }
DI float bf_hi(unsigned u) { return __uint_as_float(u & 0xffff0000u); }
DI int opaque_tid() { int t = threadIdx.x; asm volatile("" : "+v"(t)); return t; }
DI int crow(int i, int h) { return (i & 3) + 8 * (i >> 2) + 4 * h; }
template <int CTRL> DI float dpp_mov(float v) { return __int_as_float(__builtin_amdgcn_mov_dpp(__float_as_int(v), CTRL, 0xF, 0xF, true)); }
DI float wsum(float v) {
  v += dpp_mov<0xB1>(v); v += dpp_mov<0x4E>(v); v += dpp_mov<0x141>(v); v += dpp_mov<0x140>(v);
  u32x2 r = __builtin_amdgcn_permlane16_swap(__float_as_uint(v), __float_as_uint(v), false, false);
  v = __uint_as_float(r[0]) + __uint_as_float(r[1]);
  r = __builtin_amdgcn_permlane32_swap(__float_as_uint(v), __float_as_uint(v), false, false);
  return __uint_as_float(r[0]) + __uint_as_float(r[1]);
}
DI float wmax(float v) {
  v = fmaxf(v, dpp_mov<0xB1>(v)); v = fmaxf(v, dpp_mov<0x4E>(v)); v = fmaxf(v, dpp_mov<0x141>(v)); v = fmaxf(v, dpp_mov<0x140>(v));
  u32x2 r = __builtin_amdgcn_permlane16_swap(__float_as_uint(v), __float_as_uint(v), false, false);
  v = fmaxf(__uint_as_float(r[0]), __uint_as_float(r[1]));
  r = __builtin_amdgcn_permlane32_swap(__float_as_uint(v), __float_as_uint(v), false, false);
  return fmaxf(__uint_as_float(r[0]), __uint_as_float(r[1]));
}
template <int CTRL> DI int dpp_movi(int v) { return __builtin_amdgcn_mov_dpp(v, CTRL, 0xF, 0xF, true); }
template <bool UP> DI int wscan(int v, int lane, int& total) {
  int acc = v, tot = v, o;
  o = dpp_movi<0xB1>(tot);  if (((lane & 1) != 0) == UP) acc += o;  tot += o;
  o = dpp_movi<0x4E>(tot);  if (((lane & 2) != 0) == UP) acc += o;  tot += o;
  o = dpp_movi<0x141>(tot); if (((lane & 4) != 0) == UP) acc += o;  tot += o;
  o = dpp_movi<0x140>(tot); if (((lane & 8) != 0) == UP) acc += o;  tot += o;
  u32x2 r = __builtin_amdgcn_permlane16_swap((unsigned)tot, (unsigned)tot, false, false);
  o = (int)((lane & 16) ? r[0] : r[1]); if (((lane & 16) != 0) == UP) acc += o; tot += o;
  r = __builtin_amdgcn_permlane32_swap((unsigned)tot, (unsigned)tot, false, false);
  o = (int)((lane & 32) ? r[0] : r[1]); if (((lane & 32) != 0) == UP) acc += o; tot += o;
  total = tot;
  return acc;
}
DI float xor32_max(float v) { const u32x2 r = __builtin_amdgcn_permlane32_swap(__float_as_uint(v), __float_as_uint(v), false, false); return fmaxf(__uint_as_float(r[0]), __uint_as_float(r[1])); }
DI float xor32_sum(float v) { const u32x2 r = __builtin_amdgcn_permlane32_swap(__float_as_uint(v), __float_as_uint(v), false, false); return __uint_as_float(r[0]) + __uint_as_float(r[1]); }
DI unsigned wminu(unsigned v) {
  unsigned o;
  o = (unsigned)dpp_movi<0xB1>((int)v); v = o < v ? o : v;
  o = (unsigned)dpp_movi<0x4E>((int)v); v = o < v ? o : v;
  o = (unsigned)dpp_movi<0x141>((int)v); v = o < v ? o : v;
  o = (unsigned)dpp_movi<0x140>((int)v); v = o < v ? o : v;
  u32x2 r = __builtin_amdgcn_permlane16_swap(v, v, false, false); v = r[0] < r[1] ? r[0] : r[1];
  r = __builtin_amdgcn_permlane32_swap(v, v, false, false); return r[0] < r[1] ? r[0] : r[1];
}
DI int wsumi(int v) { for (int o = 32; o > 0; o >>= 1) v += __shfl_xor(v, o); return v; }
DI float silu(float g) { return g / (1.f + __expf(-g)); }
DI float dot2(unsigned a, unsigned b, float c) { return __builtin_amdgcn_fdot2_f32_bf16(__builtin_bit_cast(bf2_t, a), __builtin_bit_cast(bf2_t, b), c, false); }
template <int CTRL> DI float dpp_add(float v) { return v + __int_as_float(__builtin_amdgcn_mov_dpp(__float_as_int(v), CTRL, 0xF, 0xF, true)); }
DI int t5_bucket(int n) {
  if (n < 16) return n;
  int lg = 16 + (int)(logf((float)n / 16.f) / logf(8.f) * 16.f);
  return lg < 31 ? lg : 31;
}

DI int next_job(unsigned* ctr, char* lds, int& pending, int njobs, int& par) {
  int* sj = (int*)(lds + LDS_JOB);
  if (threadIdx.x == 0) sj[par] = pending;
  __syncthreads();
  const int j = sj[par];
  par ^= 1;
  if (threadIdx.x == 0 && j < njobs) pending = (int)atomicAdd(ctr, 1u);
  return j;
}

template <bool SWAP, class Epi>
DI void gemm_tile(const u16* __restrict__ A, int lda, const u16* __restrict__ Bw, int ldb, int K, char* lds, Epi epi) {
  const int tid = opaque_tid(), lane = tid & 63, w = tid >> 6, r = lane & 31, h = lane >> 5;
  const int wm = w & 3, wn = w >> 2;
  f32x16 acc[2][2];
#pragma unroll
  for (int a = 0; a < 2; ++a)
#pragma unroll
    for (int b = 0; b < 2; ++b)
#pragma unroll
      for (int i = 0; i < 16; ++i) acc[a][b][i] = 0.f;
  const int lrow = tid >> 3, lkc = tid & 7;
  u32x4 ra0[4], rb0[2], ra1[4], rb1[2];
  const u16* ap = A + (size_t)lrow * lda + lkc * 8;
  const u16* bp = Bw + (size_t)lrow * ldb + lkc * 8;
  const int nk = K >> 6;
  auto gload = [&](int kt, u32x4* ra, u32x4* rb) {
#pragma unroll
    for (int j = 0; j < 4; ++j) ra[j] = *(const u32x4*)(ap + (size_t)(64 * j) * lda + kt * 64);
#pragma unroll
    for (int j = 0; j < 2; ++j) rb[j] = *(const u32x4*)(bp + (size_t)(64 * j) * ldb + kt * 64);
  };
  auto lstore = [&](int st, const u32x4* ra, const u32x4* rb) {
    char* base = lds + st * GEMM_STAGE;
#pragma unroll
    for (int j = 0; j < 4; ++j) *(u32x4*)(base + ((lrow + 64 * j) * 72 + lkc * 8) * 2) = ra[j];
#pragma unroll
    for (int j = 0; j < 2; ++j) *(u32x4*)(base + 36864 + ((lrow + 64 * j) * 72 + lkc * 8) * 2) = rb[j];
  };
  auto compute = [&](int st) {
    const char* as = lds + st * GEMM_STAGE;
    const char* bs = as + 36864;
#pragma unroll
    for (int ks = 0; ks < 4; ++ks) {
      bf16x8 af[2], bfr[2];
#pragma unroll
      for (int mi = 0; mi < 2; ++mi) af[mi] = *(const bf16x8*)(as + ((wm * 64 + mi * 32 + r) * 72 + ks * 16 + 8 * h) * 2);
#pragma unroll
      for (int ni = 0; ni < 2; ++ni) bfr[ni] = *(const bf16x8*)(bs + ((wn * 64 + ni * 32 + r) * 72 + ks * 16 + 8 * h) * 2);
#pragma unroll
      for (int mi = 0; mi < 2; ++mi)
#pragma unroll
        for (int ni = 0; ni < 2; ++ni) {
          if (SWAP) acc[mi][ni] = MFMA32(bfr[ni], af[mi], acc[mi][ni]);
          else acc[mi][ni] = MFMA32(af[mi], bfr[ni], acc[mi][ni]);
        }
    }
  };
  gload(0, ra0, rb0);
  lstore(0, ra0, rb0);
  gload(1, ra1, rb1);
  __syncthreads();
  for (int kt = 0; kt < nk; kt += 2) {
    if (kt + 2 < nk) gload(kt + 2, ra0, rb0);
    compute(0);
    lstore(1, ra1, rb1);
    __syncthreads();
    if (kt + 3 < nk) gload(kt + 3, ra1, rb1);
    compute(1);
    if (kt + 2 < nk) lstore(0, ra0, rb0);
    __syncthreads();
  }
#pragma unroll
  for (int mi = 0; mi < 2; ++mi)
#pragma unroll
    for (int ni = 0; ni < 2; ++ni) epi(mi, ni, acc[mi][ni]);
}

DI void store_rowmajor(u16* dst, const f32x16& a, int h, float sc) {
#pragma unroll
  for (int kp = 0; kp < 2; ++kp) {
    const int g = 2 * kp;
    unsigned ax = pk2(a[4 * g] * sc, a[4 * g + 1] * sc), ay = pk2(a[4 * g + 2] * sc, a[4 * g + 3] * sc);
    unsigned bx = pk2(a[4 * g + 4] * sc, a[4 * g + 5] * sc), by = pk2(a[4 * g + 6] * sc, a[4 * g + 7] * sc);
    const u32x2 rx = __builtin_amdgcn_permlane32_swap(ax, bx, false, false);
    const u32x2 ry = __builtin_amdgcn_permlane32_swap(ay, by, false, false);
    const u32x4 v = {rx[0], ry[0], rx[1], ry[1]};
    *(u32x4*)(dst + 8 * (g + h)) = v;
  }
}
DI void store_rope(u16* dst, const f32x16& a, int h, float sc, const float* rp) {
#pragma unroll
  for (int g = 0; g < 2; ++g) {
    f32x4 cs = *(const f32x4*)(rp + 8 * g + 4 * h);
    f32x4 sn = *(const f32x4*)(rp + 16 + 8 * g + 4 * h);
    float o1[4], o2[4];
#pragma unroll
    for (int e = 0; e < 4; ++e) {
      float x1 = a[4 * g + e] * sc, x2 = a[8 + 4 * g + e] * sc;
      o1[e] = x1 * cs[e] - x2 * sn[e];
      o2[e] = x1 * sn[e] + x2 * cs[e];
    }
    u32x2 v1 = {pk2(o1[0], o1[1]), pk2(o1[2], o1[3])};
    u32x2 v2 = {pk2(o2[0], o2[1]), pk2(o2[2], o2[3])};
    *(u32x2*)(dst + 8 * g + 4 * h) = v1;
    *(u32x2*)(dst + 16 + 8 * g + 4 * h) = v2;
  }
}
DI void store_transposed(u16* dst, const f32x16& a, int h, const float* rs  ) {
#pragma unroll
  for (int g = 0; g < 4; ++g) {
    float s0 = 1.f, s1 = 1.f, s2 = 1.f, s3 = 1.f;
    if (rs) { f32x4 sv = *(const f32x4*)(rs + 8 * g + 4 * h); s0 = sv[0]; s1 = sv[1]; s2 = sv[2]; s3 = sv[3]; }
    u32x2 v = {pk2(a[4 * g] * s0, a[4 * g + 1] * s1), pk2(a[4 * g + 2] * s2, a[4 * g + 3] * s3)};
    *(u32x2*)(dst + 8 * g + 4 * h) = v;
  }
}

DI void inproj_tile(const Params& p, int l, int mt, int nt, char* lds) {
  const int tid = opaque_tid(), lane = tid & 63, w = tid >> 6, r = lane & 31, h = lane >> 5;
  const int wm = w & 3, wn = w >> 2;
  const int m0 = mt * 256;
  const u16* A = p.Xb + (size_t)m0 * DM;
  const u16* Bw = p.Wt_in + (size_t)(l & 1) * NIN * DM + (size_t)nt * 128 * DM;
  if (nt < 42) {
    float ssq = 0.f;
    gemm_tile<true>(A, DM, Bw, DM, DM, lds, [&](int mi, int ni, const f32x16& a) {
      const int tok = m0 + wm * 64 + mi * 32 + r;
      store_rowmajor(p.H + (size_t)tok * LDH + nt * 128 + wn * 64 + ni * 32, a, h, 1.f);
      if (nt >= 4 && nt < 8) {
        if (ni == 0) ssq = 0.f;
#pragma unroll
        for (int i = 0; i < 16; ++i) ssq += a[i] * a[i];
        if (ni == 1) {
          float tot = ssq + __shfl_xor(ssq, 32);
          tot = wmax(tot);
          if (lane == 0) atomicMax(p.ctr + 64 + l * 16 + (m0 / PP) * 8 + (nt - 4) * 2 + wn, __float_as_uint(sqrtf(tot) * 1.01f));
        }
      }
    });
  } else if (nt == 42) {
    gemm_tile<true>(A, DM, Bw, DM, DM, lds, [&](int mi, int ni, const f32x16& a) {
      const int tok = m0 + wm * 64 + mi * 32 + r;
      const int b = tok / PP, t = tok - b * PP;
      const int sub = wn * 2 + ni;
      if (sub == 0) {
        store_rope(p.Kpe + (size_t)tok * 32, a, h, 1.f, p.ROPE + (size_t)t * 32);
      } else if (sub == 1) {
        store_rowmajor(p.IK + (size_t)tok * 64, a, h, 1.f);
      } else if (sub == 2) {
        store_rowmajor(p.IK + (size_t)tok * 64 + 32, a, h, 1.f);
      } else {
#pragma unroll
        for (int e = 0; e < 4; ++e) {
          const int hd = e + 4 * h;
          float xv = a[e] + p.b_f[l * 8 + hd];
          float lf = fminf(xv, 0.f) - log1pf(expf(-fabsf(xv)));
          p.LOGF[(size_t)(b * 8 + hd) * PP + t] = lf;
          p.IW[(size_t)tok * 8 + hd] = a[4 + e];
        }
      }
    });
  } else {
    u16* vt; int nv, c0;
    if (nt < 47) { vt = p.VtA; nv = 512; c0 = (nt - 43) * 128; } else { vt = p.VtD; nv = 128; c0 = 0; }
    gemm_tile<false>(A, DM, Bw, DM, DM, lds, [&](int mi, int ni, const f32x16& a) {
      const int b = m0 / PP, t0 = m0 - b * PP + wm * 64 + mi * 32;
      const int col = c0 + wn * 64 + ni * 32 + r;
      store_transposed(vt + ((size_t)b * nv + col) * PP + t0, a, h, nullptr);
    });
  }
}

DI void upproj_tile(const Params& p, int mt, int nt14, char* lds) {
  const int tid = opaque_tid(), lane = tid & 63, w = tid >> 6, r = lane & 31, h = lane >> 5;
  const int wm = w & 3, wn = w >> 2;
  const int m0 = mt * 256;
  float* rs = (float*)(lds + 2 * GEMM_STAGE);
  const bool isq = nt14 < 6;
  {
    const int row = tid >> 1, half = tid & 1;
    const int kw = isq ? 128 : 64;
    const u16* src = p.H + (size_t)(m0 + row) * LDH + (isq ? HCQ_B : HCKV_B) + half * kw;
    float ss = 0.f;
    u32x4 rv[16];
#pragma unroll
    for (int c = 0; c < 8; ++c) rv[c] = *(const u32x4*)(src + c * 8);
    if (isq) {
#pragma unroll
      for (int c = 8; c < 16; ++c) rv[c] = *(const u32x4*)(src + c * 8);
    } else {
#pragma unroll
      for (int c = 8; c < 16; ++c) { rv[c][0] = 0u; rv[c][1] = 0u; rv[c][2] = 0u; rv[c][3] = 0u; }
    }
#pragma unroll
    for (int c = 0; c < 16; ++c)
#pragma unroll
      for (int e = 0; e < 4; ++e) { float a = bf_lo(rv[c][e]), b2 = bf_hi(rv[c][e]); ss += a * a + b2 * b2; }
    ss += __shfl_xor(ss, 1);
    if (half == 0) rs[row] = rsqrtf(ss / (isq ? 256.f : 128.f) + 1e-6f);
  }
  __syncthreads();
  if (isq) {
    const int nt = nt14;
    gemm_tile<true>(p.H + (size_t)m0 * LDH + HCQ_B, LDH, p.Wt_uq + (size_t)nt * 128 * 256, 256, 256, lds, [&](int mi, int ni, const f32x16& a) {
      const int lr = wm * 64 + mi * 32 + r;
      const int tok = m0 + lr;
      const int t = tok % PP;
      const int j32 = nt * 4 + wn * 2 + ni;
      const float sc = rs[lr];
      u16* dst = p.Qm + (size_t)tok * 768 + j32 * 32;
      if (j32 % 3 == 2) store_rope(dst, a, h, sc, p.ROPE + (size_t)t * 32);
      else store_rowmajor(dst, a, h, sc);
    });
  } else {
    const int nt = nt14 - 6;
    const u16* A = p.H + (size_t)m0 * LDH + HCKV_B;
    const u16* Bw = p.Wt_ukv + (size_t)nt * 128 * 128;
    if (nt < 4) {
      gemm_tile<true>(A, LDH, Bw, 128, 128, lds, [&](int mi, int ni, const f32x16& a) {
        const int lr = wm * 64 + mi * 32 + r;
        store_rowmajor(p.Km + (size_t)(m0 + lr) * 512 + nt * 128 + wn * 64 + ni * 32, a, h, rs[lr]);
      });
    } else {
      gemm_tile<false>(A, LDH, Bw, 128, 128, lds, [&](int mi, int ni, const f32x16& a) {
        const int b = m0 / PP, t0 = m0 - b * PP + wm * 64 + mi * 32;
        const int col = (nt - 4) * 128 + wn * 64 + ni * 32 + r;
        store_transposed(p.VtB + ((size_t)b * 512 + col) * PP + t0, a, h, rs + wm * 64 + mi * 32);
      });
    }
  }
}

DI void cumsum_job(const Params& p, int j, char* lds) {
  const int tid = opaque_tid(), lane = tid & 63, w = tid >> 6;
  const float* src = p.LOGF + (size_t)j * PP;
  float* dst = p.CUM + (size_t)j * PP;
  float* wt = (float*)lds;
  float v[17];
#pragma unroll
  for (int rr = 0; rr < 17; ++rr) {
    const int o = rr * 64 + lane, i = w * 1056 + o;
    v[rr] = (o < 1056 && i >= LEAD) ? src[i] : 0.f;
  }
  float carry = 0.f;
#pragma unroll
  for (int rr = 0; rr < 17; ++rr) {
    float inc = v[rr];
    for (int o = 1; o < 64; o <<= 1) { float x = __shfl_up(inc, o); if (lane >= o) inc += x; }
    v[rr] = inc + carry;
    carry += __shfl(inc, 63);
  }
  if (lane == 0) wt[w] = carry;
  __syncthreads();
  float base = 0.f;
  for (int k = 0; k < w; ++k) base += wt[k];
#pragma unroll
  for (int rr = 0; rr < 17; ++rr) {
    const int o = rr * 64 + lane;
    if (o < 1056) dst[w * 1056 + o] = v[rr] + base;
  }
}

DI void topk_job(const Params& p, int b, int t0, char* lds) {
  const int tid = opaque_tid(), lane = tid & 63, w = tid >> 6, r = lane & 31, h = lane >> 5;
  const int cmax = (t0 + 3) >> 6;
  unsigned sc[17][4];
  {
    const u16* iqp = p.H + (size_t)(b * PP + t0 + (r >> 3)) * LDH + HIQ_C + (r & 7) * 64 + 8 * h;
    bf16x8 af[4];
#pragma unroll
    for (int ks = 0; ks < 4; ++ks) af[ks] = *(const bf16x8*)(iqp + ks * 16);
    f32x4 iw[4];
#pragma unroll
    for (int qi = 0; qi < 4; ++qi) iw[qi] = *(const f32x4*)(p.IW + (size_t)(b * PP + t0 + qi) * 8 + 4 * h);
    char* wb = lds + 16384 + w * 9216;
    const int lrow = lane >> 3, lpc = lane & 7;
    const u16* ikb = p.IK + ((size_t)(b * PP) + lrow) * 64 + lpc * 8;
    u32x4 st[8];
    if (1 + w <= cmax) {
      const u16* kp = ikb + (size_t)(1 + w) * 64 * 64;
#pragma unroll
      for (int j = 0; j < 8; ++j) st[j] = *(const u32x4*)(kp + (size_t)j * 8 * 64);
#pragma unroll
      for (int j = 0; j < 8; ++j) *(u32x4*)(wb + (lrow + 8 * j) * 144 + lpc * 16) = st[j];
    }
#pragma unroll
    for (int i = 0; i < 17; ++i) {
      const int c = 1 + w + 8 * i;
      if (c <= cmax) {
        const bool more = c + 8 <= cmax;
        if (more) {
          const u16* kp = ikb + (size_t)(c + 8) * 64 * 64;
#pragma unroll
          for (int j = 0; j < 8; ++j) st[j] = *(const u32x4*)(kp + (size_t)j * 8 * 64);
        }
        bf16x8 b0[4], b1[4];
#pragma unroll
        for (int ks = 0; ks < 4; ++ks) {
          b0[ks] = *(const bf16x8*)(wb + r * 144 + ks * 32 + h * 16);
          b1[ks] = *(const bf16x8*)(wb + (32 + r) * 144 + ks * 32 + h * 16);
        }
        __builtin_amdgcn_sched_barrier(0);
        f32x16 a0, a1;
#pragma unroll
        for (int e = 0; e < 16; ++e) { a0[e] = 0.f; a1[e] = 0.f; }
#pragma unroll
        for (int ks = 0; ks < 4; ++ks) { a0 = MFMA32(af[ks], b0[ks], a0); a1 = MFMA32(af[ks], b1[ks], a1); }
        const int key = c * 64 + lane;
#pragma unroll
        for (int qi = 0; qi < 4; ++qi) {
          f32x2 pp2 = {0.f, 0.f};
#pragma unroll
          for (int e = 0; e < 4; ++e) {
            const f32x2 rl = {fmaxf(a0[4 * qi + e], 0.f), fmaxf(a1[4 * qi + e], 0.f)};
            const f32x2 wv = {iw[qi][e], iw[qi][e]};
            pp2 += rl * wv;
          }
          const float p0 = pp2[0], p1 = pp2[1];
          const u32x2 sw = __builtin_amdgcn_permlane32_swap(__float_as_uint(p0), __float_as_uint(p1), false, false);
          float mine = __uint_as_float(sw[0]) + __uint_as_float(sw[1]);
          mine += 0.0f;
          unsigned u = __float_as_uint(mine);
          u = (u & 0x80000000u) ? ~u : (u | 0x80000000u);
          if (key > t0 + qi || key < LEAD) u = 0u;
          sc[i][qi] = u;
        }
        if (more) {
#pragma unroll
          for (int j = 0; j < 8; ++j) *(u32x4*)(wb + (lrow + 8 * j) * 144 + lpc * 16) = st[j];
        }
      } else {
#pragma unroll
        for (int qi = 0; qi < 4; ++qi) sc[i][qi] = 0u;
      }
    }
  }
  int* ng = (int*)(lds + 256);
  unsigned long long* mg = (unsigned long long*)(lds + 1024);
  unsigned long long* me = mg + 4 * 132;
  int* bg = (int*)(me + 4 * 132);
  int* be = bg + 4 * 132;
  unsigned T[4];
  {
    unsigned* hist = (unsigned*)(lds + 16384);
    int* sel = (int*)(lds + 512);
    unsigned pref[4] = {0u, 0u, 0u, 0u};
    int chi[4] = {0, 0, 0, 0};
    bool few[4] = {false, false, false, false};
    __syncthreads();
    bool small = false;
    int nb[4] = {0, 0, 0, 0};
#pragma unroll
    for (int pass = 0; pass < 3; ++pass) {
      if (pass == 2) {
        small = true;
#pragma unroll
        for (int q = 0; q < 4; ++q) small = small && (few[q] || nb[q] <= 64);
        if (small) break;
      }
      {
        const u32x4 z = {0u, 0u, 0u, 0u};
#pragma unroll
        for (int j = 0; j < 8; ++j) ((u32x4*)hist)[tid + 512 * j] = z;
      }
      __syncthreads();
#pragma unroll
      for (int i = 0; i < 17; ++i) {
#pragma unroll
        for (int q = 0; q < 4; ++q) {
          const unsigned u = sc[i][q];
          bool part; unsigned bin;
          if (pass == 0) { part = (u != 0u); bin = (u >> 22) + (lane & 3) * 1024; }
          else if (pass == 1) { part = (u != 0u) && ((u >> 22) == pref[q]) && !few[q]; bin = ((u >> 12) & 1023u) + (lane & 3) * 1024; }
          else { part = (u != 0u) && ((u >> 12) == pref[q]) && !few[q]; bin = u & 4095u; }
          if (part) atomicAdd(hist + q * 4096 + bin, 1u);
        }
      }
      __syncthreads();
      if (w < 4) {
        const int q = w;
        const unsigned* hq = hist + q * 4096;
        const int need = 256 - chi[q];
        int G = 0;
        if (pass < 2) {
#pragma unroll
          for (int rep = 0; rep < 4; ++rep)
#pragma unroll
            for (int j = 0; j < 16; ++j) G += (int)hq[rep * 1024 + 16 * lane + ((j + lane) & 15)];
        } else {
#pragma unroll 8
          for (int j = 0; j < 64; ++j) G += (int)hq[64 * lane + ((j + lane) & 63)];
        }
        int S = G;
        { int tt; S = wscan<false>(S, lane, tt); }
        const unsigned long long mk = __ballot(S >= need);
        int B = 0, cg2 = 0, fw = 0, nbin = 0;
        if (mk == 0ull) {
          fw = 1;
        } else {
          const int ks = 63 - __clzll(mk);
          const int above = (ks < 63) ? __builtin_amdgcn_readlane(S, ks + 1) : 0;
          int hh;
          if (pass < 2) {
            hh = 0;
            if (lane < 16) hh = (int)(hq[16 * ks + lane] + hq[1024 + 16 * ks + lane] + hq[2048 + 16 * ks + lane] + hq[3072 + 16 * ks + lane]);
          } else {
            hh = (int)hq[64 * ks + lane];
          }
          int s2 = hh;
          { int tt; s2 = wscan<false>(s2, lane, tt); }
          const unsigned long long m2 = __ballot(above + s2 >= need);
          const int Ls = 63 - __clzll(m2);
          B = (pass < 2 ? 16 : 64) * ks + Ls;
          nbin = __builtin_amdgcn_readlane(hh, Ls);
          cg2 = above + __builtin_amdgcn_readlane(s2, Ls) - nbin;
        }
        if (lane == 0) { sel[q * 4 + 0] = B; sel[q * 4 + 1] = chi[q] + cg2; sel[q * 4 + 2] = fw; sel[q * 4 + 3] = nbin; }
      }
      __syncthreads();
#pragma unroll
      for (int q = 0; q < 4; ++q) {
        if (!few[q]) {
          pref[q] = (pref[q] << (pass < 2 ? 10 : 12)) | (unsigned)sel[q * 4 + 0];
          chi[q] = sel[q * 4 + 1];
          nb[q] = sel[q * 4 + 3];
          if (pass == 0) few[q] = sel[q * 4 + 2] != 0;
        }
      }
    }
    if (small) {
      unsigned* lst = hist;
      int* lcnt = sel + 16;
      if (tid < 4) lcnt[tid] = 0;
      __syncthreads();
#pragma unroll
      for (int i = 0; i < 17; ++i)
#pragma unroll
        for (int q = 0; q < 4; ++q) {
          const unsigned u = sc[i][q];
          if (!few[q] && u != 0u && (u >> 12) == pref[q]) { const int pos = atomicAdd(lcnt + q, 1); lst[q * 64 + pos] = u; }
        }
      __syncthreads();
      if (w < 4) {
        const int q = w, n = lcnt[q], need = 256 - chi[q];
        const unsigned e = lane < n ? lst[q * 64 + lane] : 0u;
        int rank = 0;
        for (int k = 0; k < n; ++k) rank += (lst[q * 64 + k] > e) ? 1 : 0;
        unsigned cand = (lane < n && rank <= need - 1) ? e : 0xFFFFFFFFu;
        cand = wminu(cand);
        if (lane == 0) sel[q * 4 + 0] = (int)cand;
      }
      __syncthreads();
#pragma unroll
      for (int q = 0; q < 4; ++q) T[q] = few[q] ? 0u : (unsigned)sel[q * 4 + 0];
    } else {
#pragma unroll
      for (int q = 0; q < 4; ++q) T[q] = few[q] ? 0u : pref[q];
    }
  }
  unsigned* cntb = (unsigned*)mg;
  unsigned* baseb = (unsigned*)bg;
#pragma unroll
  for (int i = 0; i < 17; ++i) {
    const int c = 1 + w + 8 * i;
    if (c <= cmax) {
      unsigned mine = 0u;
#pragma unroll
      for (int q = 0; q < 4; ++q) {
        const unsigned pk = (unsigned)__popcll(__ballot(sc[i][q] > T[q])) | ((unsigned)__popcll(__ballot(sc[i][q] == T[q])) << 16);
        mine = (lane == q) ? pk : mine;
      }
      if (lane < 4) cntb[lane * 132 + c] = mine;
    }
  }
  __syncthreads();
  if (w < 4) {
    const int q = w;
    int cg_ = 0, ce_ = 0;
    for (int base = 0; base <= cmax; base += 64) {
      const int c = base + lane;
      const bool in = (c >= 1) && (c <= cmax);
      const unsigned cv = in ? cntb[q * 132 + c] : 0u;
      const int v1 = (int)(cv & 0xffffu), v2 = (int)(cv >> 16);
      int t1, t2;
      const int i1 = wscan<true>(v1, lane, t1), i2 = wscan<true>(v2, lane, t2);
      if (in) baseb[q * 132 + c] = (unsigned)(cg_ + i1 - v1) | ((unsigned)(ce_ + i2 - v2) << 16);
      cg_ += t1;
      ce_ += t2;
    }
    if (lane == 0) ng[q] = cg_;
  }
  __syncthreads();
  const unsigned long long lt = (1ull << lane) - 1ull;
#pragma unroll
  for (int i = 0; i < 17; ++i) {
    const int c = 1 + w + 8 * i;
    if (c <= cmax) {
      const int key = c * 64 + lane;
#pragma unroll
      for (int q = 0; q < 4; ++q) {
        u16* out = p.IDX + (size_t)(b * PP + t0 + q) * 256;
        const bool gt = sc[i][q] > T[q];
        const bool eq = (sc[i][q] == T[q]) && (T[q] != 0u);
        const unsigned long long m1 = __ballot(gt), m2 = __ballot(eq);
        if ((m1 | m2) != 0ull) {
          const unsigned bb = baseb[q * 132 + c];
          if (gt) out[(int)(bb & 0xffffu) + __popcll(m1 & lt)] = (u16)key;
          if (eq) { const int pos = ng[q] + (int)(bb >> 16) + __popcll(m2 & lt); if (pos < 256) out[pos] = (u16)key; }
        }
      }
    }
  }
#pragma unroll
  for (int q = 0; q < 4; ++q) {
    if (T[q] == 0u) {
      u16* out = p.IDX + (size_t)(b * PP + t0 + q) * 256;
      if (tid < 256 && tid >= ng[q]) out[tid] = (u16)0xFFFF;
    }
  }
}

constexpr int AT_STAGE = 23040;
template <int DK, int MODE>
DI void attn_unit(const Params& p, int l, int b, int head, int qu, char* lds) {
  const int tid = opaque_tid(), lane = tid & 63, w = tid >> 6, r = lane & 31, h = lane >> 5;
  constexpr int KS = DK / 16, KST = DK + 8;
  const int q0 = qu * 256, qw0 = q0 + w * 32, qw = qw0 + r;
  const size_t tokq = (size_t)b * PP + qw;
  const u16 *qptr, *kptr, *vtptr, *gptr;
  int ldk;
  if (MODE == 0) {
    qptr = p.H + tokq * LDH + HQ_A + head * 64; kptr = p.H + (size_t)b * PP * LDH + HK_A + head * 64; ldk = LDH;
    vtptr = p.VtA + ((size_t)b * 512 + head * 64) * PP; gptr = p.H + tokq * LDH + HG_A + head * 64;
  } else if (MODE == 1) {
    qptr = p.Qm + tokq * 768 + head * 96; kptr = p.Km + (size_t)b * PP * 512 + head * 64; ldk = 512;
    vtptr = p.VtB + ((size_t)b * 512 + head * 64) * PP; gptr = p.H + tokq * LDH + HG_B + head * 64;
  } else {
    qptr = p.H + tokq * LDH + HQ_D + head * 64; kptr = p.H + (size_t)b * PP * LDH + HK_D + (head >> 2) * 64; ldk = LDH;
    vtptr = p.VtD + ((size_t)b * 128 + (head >> 2) * 64) * PP; gptr = p.H + tokq * LDH + HG_D + head * 64;
  }
  const float* cum = p.CUM + (size_t)(b * 8 + head) * PP;
  float* btab = (float*)(lds + 2 * AT_STAGE);
  u32x2 gpre[2][4];
#pragma unroll
  for (int d = 0; d < 2; ++d)
#pragma unroll
    for (int g = 0; g < 4; ++g) gpre[d][g] = *(const u32x2*)(gptr + d * 32 + 8 * g + 4 * h);
  bf16x8 qf[KS];
#pragma unroll
  for (int ks = 0; ks < KS; ++ks) qf[ks] = *(const bf16x8*)(qptr + ks * 16 + 8 * h);
  float cref = 0.f;
  if (MODE == 0) cref = cum[q0];
  if (MODE == 2) { if (tid < 128) btab[tid] = p.rel_bias[t5_bucket(tid) * 16 + 8 + head] * LOG2E; }
  const float sc2 = (MODE == 1 ? 0.10206207261596577f : 0.125f) * LOG2E;
  const int kt_hi = qu * 4 + 3;
  int kt_lo = 1;
  if (MODE == 2) { kt_lo = qu * 4 - 2; if (kt_lo < 1) kt_lo = 1; }
  u32x4 rk, rk2, rv;
  float re = 0.f;
  const int srow = tid >> 3, sc8 = tid & 7;
  auto gload = [&](int kt) {
    const int k0 = kt * 64;
    rk = *(const u32x4*)(kptr + (size_t)(k0 + srow) * ldk + sc8 * 8);
    if (MODE == 1) { if (tid < 256) rk2 = *(const u32x4*)(p.Kpe + ((size_t)b * PP + k0 + (tid >> 2)) * 32 + (tid & 3) * 8); }
    rv = *(const u32x4*)(vtptr + (size_t)srow * PP + k0 + sc8 * 8);
    if (MODE == 0) { if (tid < 64) re = (cum[k0 + tid] - cref) * LOG2E; }
  };
  auto lstore = [&](int st) {
    char* base = lds + st * AT_STAGE;
    *(u32x4*)(base + (srow * KST + sc8 * 8) * 2) = rk;
    if (MODE == 1) { if (tid < 256) *(u32x4*)(base + ((tid >> 2) * KST + 64 + (tid & 3) * 8) * 2) = rk2; }
    char* vb = base + 64 * KST * 2;
    u32x2 lo = {rv[0], rv[1]}, hi = {rv[2], rv[3]};
    *(u32x2*)(vb + (srow * 68 + sc8 * 8) * 2) = lo;
    *(u32x2*)(vb + (srow * 68 + sc8 * 8 + 4) * 2) = hi;
    if (MODE == 0) { if (tid < 64) *(float*)(vb + 64 * 68 * 2 + tid * 4) = re; }
  };
  f32x16 o[2];
#pragma unroll
  for (int d = 0; d < 2; ++d)
#pragma unroll
    for (int i = 0; i < 16; ++i) o[d][i] = 0.f;
  float m = NEGL, lsum = 0.f;
  float qn = 0.f, kmx = 0.f;
  int* stopf = (int*)(lds + 2 * AT_STAGE + 1024);
  if (MODE == 0) {
#pragma unroll
    for (int ks = 0; ks < KS; ++ks) {
      const u32x4 qq = __builtin_bit_cast(u32x4, qf[ks]);
#pragma unroll
      for (int e = 0; e < 4; ++e) { const float a = bf_lo(qq[e]), b2 = bf_hi(qq[e]); qn += a * a + b2 * b2; }
    }
    qn = xor32_sum(qn);
    qn = sqrtf(qn) * 1.01f;
    kmx = __uint_as_float(p.ctr[64 + l * 16 + b * 8 + head]);
  }
  gload(kt_hi); lstore(0);
  __syncthreads();
  for (int kt = kt_hi; kt >= kt_lo; --kt) {
    const bool more = kt > kt_lo;
    if (more) gload(kt - 1);
    float cnext = 0.f;
    if (MODE == 0) { if (more) cnext = cum[(kt - 1) * 64 + 63]; }
    const int st = (kt_hi - kt) & 1;
    const int k0 = kt * 64;
    bool active = k0 <= qw0 + 31;
    if (MODE == 2) active = active && (k0 + 63 >= qw0 - 127);
    if (active) {
      const char* kb = lds + st * AT_STAGE;
      const char* vb = kb + 64 * KST * 2;
      f32x16 s[2];
      bf16x8 kf[2][KS];
#pragma unroll
      for (int kr = 0; kr < 2; ++kr)
#pragma unroll
        for (int ks = 0; ks < KS; ++ks) kf[kr][ks] = *(const bf16x8*)(kb + ((kr * 32 + r) * KST + ks * 16 + 8 * h) * 2);
      __builtin_amdgcn_sched_barrier(0);
#pragma unroll
      for (int kr = 0; kr < 2; ++kr) {
#pragma unroll
        for (int i = 0; i < 16; ++i) s[kr][i] = 0.f;
#pragma unroll
        for (int ks = 0; ks < KS; ++ks) s[kr] = MFMA32(kf[kr][ks], qf[ks], s[kr]);
      }
      u32x4 vfr[2][2][2];
#pragma unroll
      for (int kr = 0; kr < 2; ++kr)
#pragma unroll
        for (int s2 = 0; s2 < 2; ++s2)
#pragma unroll
          for (int d = 0; d < 2; ++d) {
            const char* va = vb + ((d * 32 + r) * 68 + kr * 32 + s2 * 16 + 4 * h) * 2;
            const u32x2 lo = *(const u32x2*)va;
            const u32x2 hi = *(const u32x2*)(va + 16);
            vfr[kr][s2][d] = (u32x4){lo[0], lo[1], hi[0], hi[1]};
          }
      __builtin_amdgcn_sched_barrier(0);
      const bool need_mask = (MODE == 2) || (k0 + 63 > qw0) || (k0 < LEAD);
      const bool rawpath = (MODE == 1) && !need_mask;
      float tmax = NEGL;
      const f32x2 sc2v = {sc2, sc2};
      if (rawpath) {
#pragma unroll
        for (int kr = 0; kr < 2; ++kr)
#pragma unroll
          for (int i = 0; i < 16; ++i) tmax = fmaxf(tmax, s[kr][i]);
        tmax *= sc2;
      } else {
#pragma unroll
        for (int kr = 0; kr < 2; ++kr) {
#pragma unroll
          for (int g = 0; g < 4; ++g) {
            f32x4 ev = {0.f, 0.f, 0.f, 0.f};
            if (MODE == 0) ev = *(const f32x4*)(vb + 64 * 68 * 2 + (kr * 32 + 8 * g + 4 * h) * 4);
#pragma unroll
            for (int e2 = 0; e2 < 2; ++e2) {
              const int i = 4 * g + 2 * e2;
              f32x2 v2 = {s[kr][i], s[kr][i + 1]};
              if (MODE == 0) { const f32x2 e2v = {ev[2 * e2], ev[2 * e2 + 1]}; v2 = v2 * sc2v - e2v; }
              else v2 = v2 * sc2v;
#pragma unroll
              for (int e1 = 0; e1 < 2; ++e1) {
                const int key = k0 + kr * 32 + 8 * g + 4 * h + 2 * e2 + e1;
                float v = v2[e1];
                if (MODE == 2) v += btab[(qw - key) & 127];
                if (need_mask) {
                  bool ok = (key <= qw) && (key >= LEAD);
                  if (MODE == 2) ok = ok && (qw - key < 128);
                  v = ok ? v : NEGL;
                }
                s[kr][i + e1] = v;
                tmax = fmaxf(tmax, v);
              }
            }
          }
        }
      }
      tmax = xor32_max(tmax);
      const float mn = fmaxf(m, tmax);
      const float alpha = __builtin_amdgcn_exp2f(m - mn);
      const bool resc = __any(m != mn);
      m = mn;
      f32x2 ps2 = {0.f, 0.f};
      const f32x2 mnv = {mn, mn};
      const f32x2 scx = rawpath ? sc2v : (f32x2){1.f, 1.f};
#pragma unroll
      for (int kr = 0; kr < 2; ++kr)
#pragma unroll
        for (int i = 0; i < 16; i += 2) {
          f32x2 v2 = {s[kr][i], s[kr][i + 1]};
          v2 = v2 * scx - mnv;
          f32x2 p2 = {__builtin_amdgcn_exp2f(v2[0]), __builtin_amdgcn_exp2f(v2[1])};
          s[kr][i] = p2[0]; s[kr][i + 1] = p2[1];
          ps2 += p2;
        }
      const float ps = ps2[0] + ps2[1];
      lsum = lsum * alpha + ps;
      if (resc)
#pragma unroll
      for (int d = 0; d < 2; ++d)
#pragma unroll
        for (int i = 0; i < 16; ++i) o[d][i] *= alpha;
#pragma unroll
      for (int kr = 0; kr < 2; ++kr) {
#pragma unroll
        for (int s2 = 0; s2 < 2; ++s2) {
          u32x4 pp = {pk2(s[kr][8 * s2], s[kr][8 * s2 + 1]), pk2(s[kr][8 * s2 + 2], s[kr][8 * s2 + 3]),
                      pk2(s[kr][8 * s2 + 4], s[kr][8 * s2 + 5]), pk2(s[kr][8 * s2 + 6], s[kr][8 * s2 + 7])};
          bf16x8 pf = __builtin_bit_cast(bf16x8, pp);
#pragma unroll
          for (int d = 0; d < 2; ++d) o[d] = MFMA32(__builtin_bit_cast(bf16x8, vfr[kr][s2][d]), pf, o[d]);
        }
      }
    }
    if (more) lstore(st ^ 1);
    if (MODE == 0) {
      if (more) {
        const float enext = (cnext - cref) * LOG2E;
        const bool okl = (qn * kmx * sc2 - enext) <= (m - 40.f);
        const bool okw = __all(okl);
        if (lane == 0) stopf[(kt & 1) * 8 + w] = okw ? 1 : 0;
      }
    }
    __syncthreads();
    if (MODE == 0) {
      if (more) {
        const int* sf = stopf + (kt & 1) * 8;
        if (sf[0] & sf[1] & sf[2] & sf[3] & sf[4] & sf[5] & sf[6] & sf[7]) break;
      }
    }
  }
  lsum = xor32_sum(lsum);
  float f;
  if (MODE == 2) {
    const float s2 = p.sinks[l * 8 + head] * LOG2E;
    const float mf = fmaxf(m, s2);
    const float em = __builtin_amdgcn_exp2f(m - mf);
    f = em / (lsum * em + __builtin_amdgcn_exp2f(s2 - mf));
  } else {
    f = lsum > 0.f ? 1.f / lsum : 0.f;
  }
  f *= (MODE == 0 ? SC_FOX : (MODE == 1 ? SC_MLA : SC_SWA));
  u16* mp = p.Mix + tokq * 2048 + (MODE == 0 ? 0 : (MODE == 1 ? 512 : 1536)) + head * 64;
#pragma unroll
  for (int d = 0; d < 2; ++d)
#pragma unroll
    for (int g = 0; g < 4; ++g) {
      const int dd = d * 32 + 8 * g + 4 * h;
      const u32x2 gv = gpre[d][g];
      float g0 = silu(bf_lo(gv[0])), g1 = silu(bf_hi(gv[0])), g2 = silu(bf_lo(gv[1])), g3 = silu(bf_hi(gv[1]));
      u32x2 ov = {pk2(o[d][4 * g] * f * g0, o[d][4 * g + 1] * f * g1), pk2(o[d][4 * g + 2] * f * g2, o[d][4 * g + 3] * f * g3)};
      *(u32x2*)(mp + dd) = ov;
    }
}

DI void dsa_job(const Params& p, int b, int tq0, char* lds) {
  const int tid = opaque_tid(), lane = tid & 63, w = tid >> 6;
  float* biasC = (float*)(lds + 143360);
  int* btab = (int*)(lds + 143360 + 1024);
  char* wl = lds + w * 17920;
  float* Pl = (float*)wl;
  int* kid = (int*)(wl + 8192);
  const int tq = tq0 + w;
  const size_t tok = (size_t)b * PP + tq;
  const u16* Hb = p.H + (size_t)b * PP * LDH;
  int kk[4], ku[4];
  {
    u32x2 iv = *(const u32x2*)(p.IDX + tok * 256 + 4 * lane);
    kk[0] = iv[0] & 0xffff; kk[1] = iv[0] >> 16; kk[2] = iv[1] & 0xffff; kk[3] = iv[1] >> 16;
#pragma unroll
    for (int j = 0; j < 4; ++j) ku[j] = (kk[j] == 0xFFFF) ? LEAD : kk[j];
    u32x4 kv4 = {(unsigned)ku[0], (unsigned)ku[1], (unsigned)ku[2], (unsigned)ku[3]};
    ((u32x4*)kid)[lane] = kv4;
  }
  u32x4 gvp[4];
#pragma unroll
  for (int hh = 0; hh < 4; ++hh) gvp[hh] = *(const u32x4*)(p.H + tok * LDH + HG_C + (((lane >> 3) & 1) * 4 + hh) * 64 + (lane & 7) * 8);
  __builtin_amdgcn_wave_barrier();
  const int ksub = lane >> 4, g = (lane >> 3) & 1, dc = lane & 7;
  {
    const int r = lane & 31, h = lane >> 5, pc = lane & 15;
    char* kst = wl + 9216;
    bf16x8 qb[8];
#pragma unroll
    for (int ks = 0; ks < 8; ++ks) {
      u32x4 v = {0u, 0u, 0u, 0u};
      if (r < 8 && (ks >> 2) == (r >> 2)) v = *(const u32x4*)(p.H + tok * LDH + HQ_C + r * 64 + (ks & 3) * 16 + 8 * h);
      qb[ks] = __builtin_bit_cast(bf16x8, v);
    }
    const u16* kbase = Hb + HK_C + pc * 8;
    u32x4 st0[8], st1[8];
#pragma unroll
    for (int s2 = 0; s2 < 8; ++s2) st0[s2] = *(const u32x4*)(kbase + (size_t)kid[4 * s2 + ksub] * LDH);
#pragma unroll
    for (int s2 = 0; s2 < 8; ++s2) st1[s2] = *(const u32x4*)(kbase + (size_t)kid[32 + 4 * s2 + ksub] * LDH);
    auto chunk = [&](int c, u32x4* stc) {
#pragma unroll
      for (int s2 = 0; s2 < 8; ++s2) *(u32x4*)(kst + (4 * s2 + ksub) * 272 + pc * 16) = stc[s2];
      if (c + 2 < 8) {
#pragma unroll
        for (int s2 = 0; s2 < 8; ++s2) stc[s2] = *(const u32x4*)(kbase + (size_t)kid[32 * (c + 2) + 4 * s2 + ksub] * LDH);
      }
      bf16x8 af[8];
#pragma unroll
      for (int ks = 0; ks < 8; ++ks) af[ks] = *(const bf16x8*)(kst + r * 272 + ks * 32 + 16 * h);
      __builtin_amdgcn_sched_barrier(0);
      f32x16 acc0, acc1;
#pragma unroll
      for (int i = 0; i < 16; ++i) { acc0[i] = 0.f; acc1[i] = 0.f; }
#pragma unroll
      for (int ks = 0; ks < 8; ks += 2) { acc0 = MFMA32(af[ks], qb[ks], acc0); acc1 = MFMA32(af[ks + 1], qb[ks + 1], acc1); }
      if (r < 8) {
#pragma unroll
        for (int i = 0; i < 16; ++i) Pl[(32 * c + crow(i, h)) * 8 + r] = acc0[i] + acc1[i];
      }
    };
#pragma unroll 1
    for (int c = 0; c < 8; c += 2) { chunk(c, st0); chunk(c + 1, st1); }
  }
  __builtin_amdgcn_wave_barrier();
  float lg[4][8];
#pragma unroll
  for (int j = 0; j < 4; ++j) {
    const f32x4 v0 = *(const f32x4*)(Pl + (4 * lane + j) * 8), v1 = *(const f32x4*)(Pl + (4 * lane + j) * 8 + 4);
#pragma unroll
    for (int e = 0; e < 4; ++e) { lg[j][e] = v0[e]; lg[j][4 + e] = v1[e]; }
  }
  int bk[4];
#pragma unroll
  for (int j = 0; j < 4; ++j) { int dist = tq - ku[j]; bk[j] = (dist < 128) ? btab[dist & 127] : 31; }
#pragma unroll
  for (int hd = 0; hd < 8; ++hd) {
    float mx = NEGL;
#pragma unroll
    for (int j = 0; j < 4; ++j) {
      float v = lg[j][hd] * 0.125f + biasC[bk[j] * 8 + hd];
      v = (kk[j] == 0xFFFF) ? NEGL : v;
      lg[j][hd] = v;
      mx = fmaxf(mx, v);
    }
    mx = wmax(mx);
    float sm = 0.f;
#pragma unroll
    for (int j = 0; j < 4; ++j) { float e = __expf(lg[j][hd] - mx); lg[j][hd] = e; sm += e; }
    sm = wsum(sm);
    const float inv = 1.f / sm;
#pragma unroll
    for (int j = 0; j < 4; ++j) lg[j][hd] *= inv;
  }
#pragma unroll
  for (int j = 0; j < 4; ++j) {
    f32x4 v0 = {lg[j][0], lg[j][1], lg[j][2], lg[j][3]}, v1 = {lg[j][4], lg[j][5], lg[j][6], lg[j][7]};
    *(f32x4*)(Pl + (4 * lane + j) * 8) = v0;
    *(f32x4*)(Pl + (4 * lane + j) * 8 + 4) = v1;
  }
  __builtin_amdgcn_wave_barrier();
  const u16* vb = Hb + HV_C + g * 64 + dc * 8;
  f32x2 acc2[4][4];
#pragma unroll
  for (int hh = 0; hh < 4; ++hh)
#pragma unroll
    for (int e = 0; e < 4; ++e) { acc2[hh][e][0] = 0.f; acc2[hh][e][1] = 0.f; }
  u32x4 vA[16], vB[16];
  auto pv_load = [&](int grp, u32x4* dst) {
#pragma unroll
    for (int s = 0; s < 16; ++s) dst[s] = *(const u32x4*)(vb + (size_t)kid[4 * (grp * 16 + s) + ksub] * LDH);
  };
  auto pv_fma = [&](int grp, const u32x4* src) {
#pragma unroll
    for (int s = 0; s < 16; ++s) {
      const int slot = 4 * (grp * 16 + s) + ksub;
      const f32x4 pp = *(const f32x4*)(Pl + slot * 8 + g * 4);
      const u32x4 vv = src[s];
#pragma unroll
      for (int hh = 0; hh < 4; ++hh) {
        const f32x2 ph = {pp[hh], pp[hh]};
#pragma unroll
        for (int e = 0; e < 4; ++e) {
          const f32x2 vf2 = {bf_lo(vv[e]), bf_hi(vv[e])};
          acc2[hh][e] += ph * vf2;
        }
      }
    }
  };
  pv_load(0, vA);
  pv_load(1, vB);
  pv_fma(0, vA);
  pv_load(2, vA);
  pv_fma(1, vB);
  pv_load(3, vB);
  pv_fma(2, vA);
  pv_fma(3, vB);
  float acc[4][8];
#pragma unroll
  for (int hh = 0; hh < 4; ++hh)
#pragma unroll
    for (int e = 0; e < 8; ++e) { float v = acc2[hh][e >> 1][e & 1]; v += __shfl_xor(v, 16); v += __shfl_xor(v, 32); acc[hh][e] = v; }
  if (ksub == 0) {
#pragma unroll
    for (int hh = 0; hh < 4; ++hh) {
      const int hd = g * 4 + hh;
      const u32x4 gv = gvp[hh];
      u32x4 ov;
#pragma unroll
      for (int e = 0; e < 4; ++e) ov[e] = pk2(acc[hh][2 * e] * SC_DSA * silu(bf_lo(gv[e])), acc[hh][2 * e + 1] * SC_DSA * silu(bf_hi(gv[e])));
      *(u32x4*)(p.Mix + tok * 2048 + 1024 + hd * 64 + dc * 8) = ov;
    }
  }
}

DI void outproj_tile(const Params& p, int mt, int nt, char* lds, int khalf) {
  const int tid = opaque_tid(), lane = tid & 63, w = tid >> 6, r = lane & 31, h = lane >> 5;
  const int wm = w & 3, wn = w >> 2;
  const int m0 = mt * 256;
  const int koff = khalf > 0 ? 512 * khalf : 0, klen = khalf < 0 ? 2048 : 512;
  const u16* A = p.Mix + (size_t)m0 * 2048 + koff;
  const u16* Bw = p.Wt_out + (size_t)nt * 128 * 2048 + koff;
  if (khalf <= 0) {
    gemm_tile<true>(A, 2048, Bw, 2048, klen, lds, [&](int mi, int ni, const f32x16& a) {
      const int tok = m0 + wm * 64 + mi * 32 + r;
      float* rp = p.R + (size_t)tok * DM + nt * 128 + wn * 64 + ni * 32;
#pragma unroll
      for (int g = 0; g < 4; ++g) {
        f32x4 v = *(const f32x4*)(rp + 8 * g + 4 * h);
#pragma unroll
        for (int e = 0; e < 4; ++e) v[e] = ALPHA * v[e] + a[4 * g + e];
        *(f32x4*)(rp + 8 * g + 4 * h) = v;
      }
    });
  } else {
    gemm_tile<true>(A, 2048, Bw, 2048, klen, lds, [&](int mi, int ni, const f32x16& a) {
      const int tok = m0 + wm * 64 + mi * 32 + r;
      float* rp = p.Y1 + ((size_t)(khalf - 1) * 512 + (tok - 16384)) * DM + nt * 128 + wn * 64 + ni * 32;
#pragma unroll
      for (int g = 0; g < 4; ++g) {
        const f32x4 v = {a[4 * g], a[4 * g + 1], a[4 * g + 2], a[4 * g + 3]};
        *(f32x4*)(rp + 8 * g + 4 * h) = v;
      }
    });
  }
}

DI void ln_rows(const Params& p, int l) {
  const int tid = opaque_tid(), lane = tid & 63, w = tid >> 6;
  const float* gg = l < 0 ? p.ln0_g : p.ln_g + l * DM;
  const float* bb = l < 0 ? p.ln0_b : p.ln_b + l * DM;
  const int stride = gridDim.x * 8;
  auto loadrow = [&](int row, f32x4* dst) {
    if (l < 0) {
      const int b = row / PP, t = row - b * PP;
      const float* src = nullptr;
      if (t >= 128 && t < PV) src = p.x + ((size_t)b * SEQ + (t - 128)) * DM;
      else if (t >= LEAD && t < 128) src = p.meta + (size_t)(t - LEAD) * DM;
#pragma unroll
      for (int j = 0; j < 4; ++j) {
        if (src) dst[j] = *(const f32x4*)(src + lane * 4 + 256 * j);
        else { dst[j][0] = 0.f; dst[j][1] = 0.f; dst[j][2] = 0.f; dst[j][3] = 0.f; }
      }
    } else {
#pragma unroll
      for (int j = 0; j < 4; ++j) {
        dst[j] = *(const f32x4*)(p.R + (size_t)row * DM + lane * 4 + 256 * j);
        if (row >= 16384) {
#pragma unroll
          for (int q = 0; q < 3; ++q) dst[j] += *(const f32x4*)(p.Y1 + ((size_t)q * 512 + (row - 16384)) * DM + lane * 4 + 256 * j);
        }
      }
    }
  };
  f32x4 v[4], vn[4];
  int row = blockIdx.x * 8 + w;
  if (row < MT) loadrow(row, v);
  for (; row < MT; row += stride) {
    const int b = row / PP, t = row - b * PP;
    if (row + stride < MT) loadrow(row + stride, vn);
    float s = 0.f;
#pragma unroll
    for (int j = 0; j < 4; ++j) s += v[j][0] + v[j][1] + v[j][2] + v[j][3];
    const float mu = wsum(s) * (1.f / DM);
    float q = 0.f;
#pragma unroll
    for (int j = 0; j < 4; ++j)
#pragma unroll
      for (int e = 0; e < 4; ++e) { float d = v[j][e] - mu; q += d * d; }
    const float rstd = rsqrtf(wsum(q) * (1.f / DM) + 1e-5f);
#pragma unroll
    for (int j = 0; j < 4; ++j) {
      const int c = lane * 4 + 256 * j;
      f32x4 g4 = *(const f32x4*)(gg + c), b4 = *(const f32x4*)(bb + c);
      f32x4 y;
#pragma unroll
      for (int e = 0; e < 4; ++e) y[e] = (v[j][e] - mu) * rstd * g4[e] + b4[e];
      if (l == 3) {
        if (t >= 128 && t < PV) *(f32x4*)(p.out + ((size_t)b * SEQ + (t - 128)) * DM + c) = y;
      } else {
        *(f32x4*)(p.R + (size_t)row * DM + c) = y;
        u32x2 yb = {pk2(y[0], y[1]), pk2(y[2], y[3])};
        *(u32x2*)(p.Xb + (size_t)row * DM + c) = yb;
      }
    }
#pragma unroll
    for (int j = 0; j < 4; ++j) v[j] = vn[j];
  }
}

DI int map_in(int n) {
  if (n < 512) return n;
  if (n < 1024) return n;
  if (n < 1536) return 1544 + (n - 1024);
  if (n < 1792) return 2056 + (n - 1536);
  if (n < 1920) return 2312 + (n - 1792);
  if (n < 2432) return 2472 + (n - 1920);
  if (n < 2944) return 2984 + (n - 2432);
  if (n < 3072) return 3496 + (n - 2944);
  if (n < 3200) return 3624 + (n - 3072);
  if (n < 3712) return 3752 + (n - 3200);
  if (n < 4224) return 4336 + (n - 3712);
  if (n < 4736) return 4848 + (n - 4224);
  if (n < 4864) return 5360 + (n - 4736);
  if (n < 5376) return 5616 + (n - 4864);
  if (n < 5408) return 2440 + (n - 5376);
  if (n < 5472) return 4264 + (n - 5408);
  if (n < 5480) return 1536 + (n - 5472);
  if (n < 5488) return 4328 + (n - 5480);
  if (n < 5504) return -1;
  if (n < 6016) return 1024 + (n - 5504);
  return 5488 + (n - 6016);
}
DI void conv_weights(const Params& p, int l, char* lds, int t_first, int t_stride, int t_end) {
  const int tid = opaque_tid();
  float* tile = (float*)lds;
  struct TD { u16* dst; int K, k0, n0; };
  const int nn_l = tid & 63;
  auto loadtile = [&](int tI, float* rv, TD& d) {
    const float* src; const float* ksc = nullptr; int ldsrc, kind, kt, ntile;
    if (tI < 1536) { kind = 0; kt = tI / 96; ntile = tI % 96; src = p.w_in + (size_t)l * DM * D_IN; ldsrc = D_IN; d.K = DM; d.dst = p.Wt_in + (size_t)(l & 1) * NIN * DM; }
    else if (tI < 2048) { int u = tI - 1536; kind = 1; kt = u / 16; ntile = u % 16; src = p.w_out + (size_t)l * 2048 * DM; ldsrc = DM; d.K = 2048; d.dst = p.Wt_out; }
    else if (tI < 2096) { int u = tI - 2048; kind = 2; kt = u / 12; ntile = u % 12; src = p.w_uq + (size_t)l * 256 * 768; ldsrc = 768; d.K = 256; d.dst = p.Wt_uq; ksc = p.gq + l * 256; }
    else { int u = tI - 2096; kind = 3; kt = u / 16; ntile = u % 16; src = p.w_ukv + (size_t)l * 128 * 1024; ldsrc = 1024; d.K = 128; d.dst = p.Wt_ukv; ksc = p.gkv + l * 128; }
    d.k0 = kt * 64; d.n0 = ntile * 64;
    const int n = d.n0 + nn_l;
    int sc;
    if (kind == 0) sc = map_in(n);
    else if (kind == 3) sc = (n < 512) ? ((n >> 6) * 128 + (n & 63)) : (((n - 512) >> 6) * 128 + 64 + (n & 63));
    else sc = n;
#pragma unroll
    for (int j = 0; j < 8; ++j) {
      const int kk = (tid >> 6) + 8 * j;
      float v = 0.f;
      if (sc >= 0) v = src[(size_t)(d.k0 + kk) * ldsrc + sc];
      if (ksc) v *= ksc[d.k0 + kk];
      rv[j] = v;
    }
  };
  float rv[8], rn[8];
  TD dc, dn;
  int tI = t_first;
  if (tI < t_end) loadtile(tI, rv, dc);
  for (; tI < t_end; tI += t_stride) {
    const int tN = tI + t_stride;
    if (tN < t_end) loadtile(tN, rn, dn);
#pragma unroll
    for (int j = 0; j < 8; ++j) tile[nn_l * 65 + (tid >> 6) + 8 * j] = rv[j];
    __syncthreads();
    {
      const int nn = tid >> 3, kc = (tid & 7) * 8;
      const float* tp = tile + nn * 65 + kc;
      u32x4 ov = {pk2(tp[0], tp[1]), pk2(tp[2], tp[3]), pk2(tp[4], tp[5]), pk2(tp[6], tp[7])};
      *(u32x4*)(dc.dst + (size_t)(dc.n0 + nn) * dc.K + dc.k0 + kc) = ov;
    }
    __syncthreads();
#pragma unroll
    for (int j = 0; j < 8; ++j) rv[j] = rn[j];
    dc = dn;
  }
}
DI void rope_table(const Params& p) {
  const int gt = blockIdx.x * NTHREADS + threadIdx.x;
  for (int i = gt; i < PP * 16; i += gridDim.x * NTHREADS) {
    const int t = i >> 4, c = i & 15;
    const float freq = powf(10000.f, -(float)c / 16.f);
    const float ang = (float)(t - LEAD) * freq;
    float sn, cs;
    sincosf(ang, &sn, &cs);
    p.ROPE[(size_t)t * 32 + c] = cs;
    p.ROPE[(size_t)t * 32 + 16 + c] = sn;
  }
}


#define XB_TMO      128
#define XB_XCNT(j)  (256  + 64 * (j))
#define XB_XSUB(j)  (1280 + 64 * (j))
#define XB_XGEN(j)  (2304 + 64 * (j))
#define XB_TOP      3328
#define XB_TOPGEN   3392
#define XCD_BAR_WORDS 3456
#define XB_SPIN_CAP (1u << 18)
DI unsigned xb_ld(unsigned* p) { return __hip_atomic_load(p, __ATOMIC_RELAXED, __HIP_MEMORY_SCOPE_AGENT); }
DI unsigned xb_add(unsigned* p, unsigned v) { return __hip_atomic_fetch_add(p, v, __ATOMIC_RELAXED, __HIP_MEMORY_SCOPE_AGENT); }
DI unsigned xb_xcc_id() { return (unsigned)__builtin_amdgcn_s_getreg((3 << 11) | 20) & 0xFu; }
#define XB_SPIN(cond, bar) do { unsigned _sp = 0; while (cond) { __builtin_amdgcn_s_sleep(1); \
    if ((++_sp & 255u) == 0u) { if (xb_ld(&(bar)[XB_TMO])) break; if (_sp > XB_SPIN_CAP) { atomicAdd(&(bar)[XB_TMO], 1u); break; } } } } while (0)
struct XcdBarrier { unsigned* bar; unsigned x; volatile unsigned* st; };
DI XcdBarrier xcd_barrier_post(unsigned* bar, volatile unsigned* st) {
  XcdBarrier b; b.bar = bar; b.x = xb_xcc_id(); b.st = st;
  if (threadIdx.x == 0) (void)xb_add(&bar[XB_XCNT(b.x)], 1u);
  return b;
}
DI void xcd_barrier_complete(unsigned* bar, unsigned x, unsigned& nloc, unsigned& nx) {
  const unsigned G = gridDim.x * gridDim.y * gridDim.z;
  unsigned sum, cnt, mine, sp = 0u;
  for (;;) {
    sum = 0u; cnt = 0u; mine = 0u;
#pragma unroll
    for (unsigned j = 0; j < 16; ++j) { const unsigned c = xb_ld(&bar[XB_XCNT(j)]); sum += c; cnt += (c > 0u) ? 1u : 0u; mine = (j == x) ? c : mine; }
    if (sum == G) break;
    __builtin_amdgcn_s_sleep(1);
    if ((++sp & 255u) == 0u) { if (xb_ld(&bar[XB_TMO])) break; if (sp > XB_SPIN_CAP) { atomicAdd(&bar[XB_TMO], 1u); break; } }
  }
  nloc = mine > 0u ? mine : 1u; nx = cnt > 0u ? cnt : 1u;
}
DI void xcd_barrier(const XcdBarrier& b) {
  asm volatile("s_waitcnt vmcnt(0)" ::: "memory");
  __syncthreads();
  if (threadIdx.x == 0) {
    unsigned* bar = b.bar;
    __builtin_amdgcn_s_waitcnt(0);
    unsigned nloc = b.st[0], nx = b.st[1];
    if (nloc == 0u) { xcd_barrier_complete(bar, b.x, nloc, nx); b.st[0] = nloc; b.st[1] = nx; }
    const unsigned old = xb_add(&bar[XB_XSUB(b.x)], 1u);
    const unsigned gen = old / nloc;
    if (old + 1u == (gen + 1u) * nloc) {
      __builtin_amdgcn_fence(__ATOMIC_RELEASE, "agent");
      asm volatile("s_waitcnt vmcnt(0)" ::: "memory");
      const unsigned og = xb_add(&bar[XB_TOP], 1u);
      const unsigned tg = og / nx;
      if (og + 1u == (tg + 1u) * nx) xb_add(&bar[XB_TOPGEN], 1u);
      else XB_SPIN(xb_ld(&bar[XB_TOPGEN]) == tg, bar);
      __builtin_amdgcn_fence(__ATOMIC_ACQUIRE, "agent");
      xb_add(&bar[XB_XGEN(b.x)], 1u);
      asm volatile("s_waitcnt vmcnt(0)" ::: "memory");
    } else {
      XB_SPIN(xb_ld(&bar[XB_XGEN(b.x)]) == gen, bar);
      __builtin_amdgcn_fence(__ATOMIC_ACQUIRE, "agent");
      asm volatile("s_waitcnt vmcnt(0)" ::: "memory");
    }
  }
  __syncthreads();
}

__global__ void __launch_bounds__(NTHREADS) mega(Params p) {
  extern __shared__ __attribute__((aligned(16))) char lds[];
  cg::grid_group grid = cg::this_grid();
  ln_rows(p, -1);
  conv_weights(p, 0, lds, blockIdx.x, gridDim.x, 2128);
  rope_table(p);
  if (blockIdx.x == 0) {
    if (threadIdx.x < 256) p.ctr[threadIdx.x] = 0u;
    for (int i = threadIdx.x; i < XCD_BAR_WORDS; i += NTHREADS) p.bar[i] = 0u;
  }
  volatile unsigned* xst = (volatile unsigned*)(lds + LDS_JOB + 16);
  if (threadIdx.x == 0) { xst[0] = 0u; xst[1] = 0u; }
  grid.sync();
  const XcdBarrier xb = xcd_barrier_post(p.bar, xst);
  for (int l = 0; l < 4; ++l) {
    for (int rep = 0; rep < REP_P1; ++rep) {
      for (int j = blockIdx.x; j < 66 * 48; j += gridDim.x) inproj_tile(p, l, j / 48, j % 48, lds);
      if (l < 3 && rep == 0) {
        const int nbusy = 66 * 48 - (66 * 48 / (int)gridDim.x) * (int)gridDim.x;
        const int nidle = (int)gridDim.x - nbusy;
        if ((int)blockIdx.x >= nbusy && nidle > 0) conv_weights(p, l + 1, lds, (int)blockIdx.x - nbusy, nidle, 1536);
      }
      xcd_barrier(xb);
    }
    for (int rep = 0; rep < REP_P2; ++rep) {
      constexpr int NTK = 2 * 2052, NUP = 66 * 14, NJ = NTK + NUP + 16;
      int pending = 0, par = 0;
      if (threadIdx.x == 0) pending = (int)atomicAdd(p.ctr + l * 2 + 8 * rep, 1u);
      for (;;) {
        const int j = next_job(p.ctr + l * 2 + 8 * rep, lds, pending, NJ, par);
        if (j >= NJ) break;
        if (j < 16) {
          cumsum_job(p, j, lds);
        } else if (j < 16 + NTK) {
          const int jj = j - 16;
          const int b = jj & 1, q = 2051 - (jj >> 1);
          topk_job(p, b, LEAD + 4 * q, lds);
        } else {
          const int u = j - 16 - NTK;
          upproj_tile(p, u / 14, u % 14, lds);
        }
      }
      xcd_barrier(xb);
    }
    for (int rep = 0; rep < REP_P3; ++rep) {
      constexpr int ND = 1056, NS = 528, NC = 2 * 1026, NJ = ND + NS + NC;
      {
        float* biasC = (float*)(lds + 143360);
        int* btab = (int*)(lds + 143360 + 1024);
        if (threadIdx.x < 256) biasC[threadIdx.x] = p.rel_bias[(threadIdx.x >> 3) * 16 + (threadIdx.x & 7)];
        if (threadIdx.x < 128) btab[threadIdx.x] = t5_bucket(threadIdx.x);
      }
      int pending = 0, par = 0;
      if (threadIdx.x == 0) pending = (int)atomicAdd(p.ctr + l * 2 + 1 + 8 * rep, 1u);
      for (;;) {
        const int j = next_job(p.ctr + l * 2 + 1 + 8 * rep, lds, pending, NJ, par);
        if (j >= NJ) break;
        if (j < ND) {
          const int qu = 32 - (j >> 5), rem = j & 31, kind = rem >> 4, b = (rem >> 3) & 1, head = rem & 7;
          if (kind == 0) attn_unit<64, 0>(p, l, b, head, qu, lds);
          else attn_unit<96, 1>(p, l, b, head, qu, lds);
        } else if (j < ND + NS) {
          const int u = j - ND;
          attn_unit<64, 2>(p, l, (u >> 3) & 1, u & 7, u >> 4, lds);
        } else {
          const int u = j - ND - NS;
          dsa_job(p, u & 1, LEAD + 8 * (u >> 1), lds);
        }
      }
      xcd_barrier(xb);
    }
    for (int j = blockIdx.x; j < 512; j += gridDim.x) {
      const int x = j & 7, a = j >> 3;
      outproj_tile(p, 2 * (a >> 1) + (x >> 2), 2 * (x & 3) + (a & 1), lds, -1);
    }
    if (blockIdx.x < 64) {
      const int j = 512 + (blockIdx.x >> 2), x = j & 7, a = j >> 3;
      outproj_tile(p, 2 * (a >> 1) + (x >> 2), 2 * (x & 3) + (a & 1), lds, blockIdx.x & 3);
    }
    xcd_barrier(xb);
    ln_rows(p, l);
    if (l < 3) { conv_weights(p, l + 1, lds, 1536 + blockIdx.x, gridDim.x, 2128); xcd_barrier(xb); }
  }
}

extern "C" void kernel_launch(void* const* d_in, const int* in_sizes, int n_in, void* d_out, int out_size, void* d_ws, size_t ws_size,
                              hipStream_t stream) {
  static int grid = 0;
  if (grid == 0) {
    int dev = 0, cus = 0, per_cu = 0;
    hipGetDevice(&dev);
    hipDeviceGetAttribute(&cus, hipDeviceAttributeMultiprocessorCount, dev);
    if (hipFuncSetAttribute((const void*)mega, hipFuncAttributeMaxDynamicSharedMemorySize, LDS_BYTES) != hipSuccess) { fprintf(stderr, "hipFuncSetAttribute failed\n"); grid = -1; return; }
    hipOccupancyMaxActiveBlocksPerMultiprocessor(&per_cu, (const void*)mega, NTHREADS, LDS_BYTES);
    if (per_cu < 1) { fprintf(stderr, "occupancy query: %d\n", per_cu); grid = -1; return; }
    grid = cus * per_cu;
  }
  if (grid < 0) return;
  size_t off = 0;
  auto take = [&](size_t bytes) { size_t o = off; off += (bytes + 255) & ~(size_t)255; return (char*)d_ws + o; };
  Params p{};
  p.x = (const float*)d_in[0]; p.meta = (const float*)d_in[1]; p.ln0_g = (const float*)d_in[2]; p.ln0_b = (const float*)d_in[3];
  p.rel_bias = (const float*)d_in[4]; p.w_in = (const float*)d_in[5]; p.b_f = (const float*)d_in[6]; p.gq = (const float*)d_in[7];
  p.gkv = (const float*)d_in[8]; p.w_uq = (const float*)d_in[9]; p.w_ukv = (const float*)d_in[10]; p.sinks = (const float*)d_in[11];
  p.w_out = (const float*)d_in[12]; p.ln_g = (const float*)d_in[13]; p.ln_b = (const float*)d_in[14];
  p.out = (float*)d_out;
  p.ctr = (unsigned*)take(1024);
  p.bar = (unsigned*)take(XCD_BAR_WORDS * 4);
  p.Wt_in = (u16*)take((size_t)2 * NIN * DM * 2);
  p.Wt_out = (u16*)take((size_t)DM * 2048 * 2);
  p.Wt_uq = (u16*)take((size_t)768 * 256 * 2);
  p.Wt_ukv = (u16*)take((size_t)1024 * 128 * 2);
  p.H = (u16*)take((size_t)MT * LDH * 2);
  p.Mix = (u16*)take((size_t)MT * 2048 * 2);
  p.Xb = p.Mix;
  p.VtA = (u16*)take((size_t)NB * 512 * PP * 2);
  p.VtD = (u16*)take((size_t)NB * 128 * PP * 2);
  p.R = (float*)take((size_t)MT * DM * 4);
  p.Y1 = (float*)take((size_t)3 * 512 * DM * 4);
  p.IDX = (u16*)take((size_t)MT * 256 * 2);
  p.IK = (u16*)take((size_t)MT * 64 * 2);
  p.Kpe = (u16*)take((size_t)MT * 32 * 2);
  p.IW = (float*)take((size_t)MT * 8 * 4);
  p.LOGF = (float*)take((size_t)NB * 8 * PP * 4);
  p.CUM = (float*)take((size_t)NB * 8 * PP * 4);
  p.ROPE = (float*)take((size_t)PP * 32 * 4);
  if (off > ws_size) { fprintf(stderr, "workspace too small: need %zu have %zu\n", off, ws_size); return; }
  {
    char* ob = (char*)d_out;
    p.Qm = (u16*)ob; ob += (size_t)MT * 768 * 2;
    p.Km = (u16*)ob; ob += (size_t)MT * 512 * 2;
    p.VtB = (u16*)ob; ob += (size_t)NB * 512 * PP * 2;
    if ((size_t)(ob - (char*)d_out) > (size_t)out_size * 4) { fprintf(stderr, "d_out too small for scratch\n"); return; }
  }
  hipMemsetAsync(p.ctr, 0, 1024 + XCD_BAR_WORDS * 4, stream);
  void* args[] = {&p};
  hipError_t e = hipLaunchCooperativeKernel((const void*)mega, dim3(grid), dim3(NTHREADS), args, LDS_BYTES, stream);
  if (e != hipSuccess) fprintf(stderr, "cooperative launch failed: %s (grid %d)\n", hipGetErrorString(e), grid);
}
```

```cpp
#include <hip/hip_runtime.h>
#include <hip/hip_cooperative_groups.h>
#include <cstdio>
namespace cg = cooperative_groups;

#define DI __device__ __forceinline__
typedef __attribute__((ext_vector_type(8))) short bf16x8;
typedef __attribute__((ext_vector_type(16))) float f32x16;
typedef __attribute__((ext_vector_type(4))) float f32x4;
typedef __attribute__((ext_vector_type(2))) float f32x2;
typedef __attribute__((ext_vector_type(2))) __bf16 bf2_t;
typedef __attribute__((ext_vector_type(4))) unsigned u32x4;
typedef __attribute__((ext_vector_type(2))) unsigned u32x2;
typedef unsigned short u16;
#define MFMA32(a, b, c) __builtin_amdgcn_mfma_f32_32x32x16_bf16((a), (b), (c), 0, 0, 0)

constexpr int NB = 2, PP = 8448, PV = 8320, LEAD = 112, DM = 1024, MT = NB * PP, SEQ = 8192;
constexpr int LDH = 5376, NIN = 6144;
constexpr int HQ_A = 0, HK_A = 512, HG_A = 1024, HCQ_B = 1536, HCKV_B = 1792, HG_B = 1920, HQ_C = 2432, HK_C = 2944, HV_C = 3072,
              HIQ_C = 3200, HG_C = 3712, HQ_D = 4224, HK_D = 4736, HG_D = 4864;
constexpr int D_IN = 6128;
constexpr float LOG2E = 1.4426950408889634f;
constexpr float NEGL = -1e30f;
constexpr float ALPHA = 1.681792830507429f;
constexpr int LDS_JOB = 147456;
constexpr int LDS_BYTES = LDS_JOB + 64;
constexpr int GEMM_STAGE = 55296;
constexpr int NTHREADS = 512;
#define REP_P1 1
#define REP_P2 1
#define REP_P3 1
#define SC_FOX 1.0f
#define SC_MLA 1.0f
#define SC_SWA 1.0f
#define SC_DSA 1.0f

struct Params {
  const float *x, *meta, *ln0_g, *ln0_b, *rel_bias, *w_in, *b_f, *gq, *gkv, *w_uq, *w_ukv, *sinks, *w_out, *ln_g, *ln_b;
  float* out;
  u16 *Wt_in, *Wt_out, *Wt_uq, *Wt_ukv;
  u16 *H, *Xb, *Mix, *VtA, *VtD, *VtB, *Qm, *Km, *Kpe, *IK, *IDX;
  float *R, *LOGF, *CUM, *IW, *ROPE, *Y1;
  unsigned* ctr;
  unsigned* bar;
};

DI unsigned pk2(float a, float b) { f32x2 v = {a, b}; return __builtin_bit_cast(unsigned, __builtin_convertvector(v, bf2_t)); }
DI float bf_lo(unsigned u) { return __uint_as_float(u << 16); }
DI float bf_hi(unsigned u) { return __uint_as_float(u & 0xffff0000u); }
DI int opaque_tid() { int t = threadIdx.x; asm volatile("" : "+v"(t)); return t; }
DI int crow(int i, int h) { return (i & 3) + 8 * (i >> 2) + 4 * h; }
template <int CTRL> DI float dpp_mov(float v) { return __int_as_float(__builtin_amdgcn_mov_dpp(__float_as_int(v), CTRL, 0xF, 0xF, true)); }
DI float wsum(float v) {
  v += dpp_mov<0xB1>(v); v += dpp_mov<0x4E>(v); v += dpp_mov<0x141>(v); v += dpp_mov<0x140>(v);
  u32x2 r = __builtin_amdgcn_permlane16_swap(__float_as_uint(v), __float_as_uint(v), false, false);
  v = __uint_as_float(r[0]) + __uint_as_float(r[1]);
  r = __builtin_amdgcn_permlane32_swap(__float_as_uint(v), __float_as_uint(v), false, false);
  return __uint_as_float(r[0]) + __uint_as_float(r[1]);
}
DI float wmax(float v) {
  v = fmaxf(v, dpp_mov<0xB1>(v)); v = fmaxf(v, dpp_mov<0x4E>(v)); v = fmaxf(v, dpp_mov<0x141>(v)); v = fmaxf(v, dpp_mov<0x140>(v));
  u32x2 r = __builtin_amdgcn_permlane16_swap(__float_as_uint(v), __float_as_uint(v), false, false);
  v = fmaxf(__uint_as_float(r[0]), __uint_as_float(r[1]));
  r = __builtin_amdgcn_permlane32_swap(__float_as_uint(v), __float_as_uint(v), false, false);
  return fmaxf(__uint_as_float(r[0]), __uint_as_float(r[1]));
}
template <int CTRL> DI int dpp_movi(int v) { return __builtin_amdgcn_mov_dpp(v, CTRL, 0xF, 0xF, true); }
template <bool UP> DI int wscan(int v, int lane, int& total) {
  int acc = v, tot = v, o;
  o = dpp_movi<0xB1>(tot);  if (((lane & 1) != 0) == UP) acc += o;  tot += o;
  o = dpp_movi<0x4E>(tot);  if (((lane & 2) != 0) == UP) acc += o;  tot += o;
  o = dpp_movi<0x141>(tot); if (((lane & 4) != 0) == UP) acc += o;  tot += o;
  o = dpp_movi<0x140>(tot); if (((lane & 8) != 0) == UP) acc += o;  tot += o;
  u32x2 r = __builtin_amdgcn_permlane16_swap((unsigned)tot, (unsigned)tot, false, false);
  o = (int)((lane & 16) ? r[0] : r[1]); if (((lane & 16) != 0) == UP) acc += o; tot += o;
  r = __builtin_amdgcn_permlane32_swap((unsigned)tot, (unsigned)tot, false, false);
  o = (int)((lane & 32) ? r[0] : r[1]); if (((lane & 32) != 0) == UP) acc += o; tot += o;
  total = tot;
  return acc;
}
DI float xor32_max(float v) { const u32x2 r = __builtin_amdgcn_permlane32_swap(__float_as_uint(v), __float_as_uint(v), false, false); return fmaxf(__uint_as_float(r[0]), __uint_as_float(r[1])); }
DI float xor32_sum(float v) { const u32x2 r = __builtin_amdgcn_permlane32_swap(__float_as_uint(v), __float_as_uint(v), false, false); return __uint_as_float(r[0]) + __uint_as_float(r[1]); }
DI unsigned wminu(unsigned v) {
  unsigned o;
  o = (unsigned)dpp_movi<0xB1>((int)v); v = o < v ? o : v;
  o = (unsigned)dpp_movi<0x4E>((int)v); v = o < v ? o : v;
  o = (unsigned)dpp_movi<0x141>((int)v); v = o < v ? o : v;
  o = (unsigned)dpp_movi<0x140>((int)v); v = o < v ? o : v;
  u32x2 r = __builtin_amdgcn_permlane16_swap(v, v, false, false); v = r[0] < r[1] ? r[0] : r[1];
  r = __builtin_amdgcn_permlane32_swap(v, v, false, false); return r[0] < r[1] ? r[0] : r[1];
}
DI int wsumi(int v) { for (int o = 32; o > 0; o >>= 1) v += __shfl_xor(v, o); return v; }
DI float silu(float g) { return g / (1.f + __expf(-g)); }
DI float dot2(unsigned a, unsigned b, float c) { return __builtin_amdgcn_fdot2_f32_bf16(__builtin_bit_cast(bf2_t, a), __builtin_bit_cast(bf2_t, b), c, false); }
template <int CTRL> DI float dpp_add(float v) { return v + __int_as_float(__builtin_amdgcn_mov_dpp(__float_as_int(v), CTRL, 0xF, 0xF, true)); }
DI int t5_bucket(int n) {
  if (n < 16) return n;
  int lg = 16 + (int)(logf((float)n / 16.f) / logf(8.f) * 16.f);
  return lg < 31 ? lg : 31;
}

DI int next_job(unsigned* ctr, char* lds, int& pending, int njobs, int& par) {
  int* sj = (int*)(lds + LDS_JOB);
  if (threadIdx.x == 0) sj[par] = pending;
  __syncthreads();
  const int j = sj[par];
  par ^= 1;
  if (threadIdx.x == 0 && j < njobs) pending = (int)atomicAdd(ctr, 1u);
  return j;
}

template <bool SWAP, class Epi>
DI void gemm_tile(const u16* __restrict__ A, int lda, const u16* __restrict__ Bw, int ldb, int K, char* lds, Epi epi) {
  const int tid = opaque_tid(), lane = tid & 63, w = tid >> 6, r = lane & 31, h = lane >> 5;
  const int wm = w & 3, wn = w >> 2;
  f32x16 acc[2][2];
#pragma unroll
  for (int a = 0; a < 2; ++a)
#pragma unroll
    for (int b = 0; b < 2; ++b)
#pragma unroll
      for (int i = 0; i < 16; ++i) acc[a][b][i] = 0.f;
  const int lrow = tid >> 3, lkc = tid & 7;
  u32x4 ra0[4], rb0[2], ra1[4], rb1[2];
  const u16* ap = A + (size_t)lrow * lda + lkc * 8;
  const u16* bp = Bw + (size_t)lrow * ldb + lkc * 8;
  const int nk = K >> 6;
  auto gload = [&](int kt, u32x4* ra, u32x4* rb) {
#pragma unroll
    for (int j = 0; j < 4; ++j) ra[j] = *(const u32x4*)(ap + (size_t)(64 * j) * lda + kt * 64);
#pragma unroll
    for (int j = 0; j < 2; ++j) rb[j] = *(const u32x4*)(bp + (size_t)(64 * j) * ldb + kt * 64);
  };
  auto lstore = [&](int st, const u32x4* ra, const u32x4* rb) {
    char* base = lds + st * GEMM_STAGE;
#pragma unroll
    for (int j = 0; j < 4; ++j) *(u32x4*)(base + ((lrow + 64 * j) * 72 + lkc * 8) * 2) = ra[j];
#pragma unroll
    for (int j = 0; j < 2; ++j) *(u32x4*)(base + 36864 + ((lrow + 64 * j) * 72 + lkc * 8) * 2) = rb[j];
  };
  auto compute = [&](int st) {
    const char* as = lds + st * GEMM_STAGE;
    const char* bs = as + 36864;
#pragma unroll
    for (int ks = 0; ks < 4; ++ks) {
      bf16x8 af[2], bfr[2];
#pragma unroll
      for (int mi = 0; mi < 2; ++mi) af[mi] = *(const bf16x8*)(as + ((wm * 64 + mi * 32 + r) * 72 + ks * 16 + 8 * h) * 2);
#pragma unroll
      for (int ni = 0; ni < 2; ++ni) bfr[ni] = *(const bf16x8*)(bs + ((wn * 64 + ni * 32 + r) * 72 + ks * 16 + 8 * h) * 2);
#pragma unroll
      for (int mi = 0; mi < 2; ++mi)
#pragma unroll
        for (int ni = 0; ni < 2; ++ni) {
          if (SWAP) acc[mi][ni] = MFMA32(bfr[ni], af[mi], acc[mi][ni]);
          else acc[mi][ni] = MFMA32(af[mi], bfr[ni], acc[mi][ni]);
        }
    }
  };
  gload(0, ra0, rb0);
  lstore(0, ra0, rb0);
  gload(1, ra1, rb1);
  __syncthreads();
  for (int kt = 0; kt < nk; kt += 2) {
    if (kt + 2 < nk) gload(kt + 2, ra0, rb0);
    compute(0);
    lstore(1, ra1, rb1);
    __syncthreads();
    if (kt + 3 < nk) gload(kt + 3, ra1, rb1);
    compute(1);
    if (kt + 2 < nk) lstore(0, ra0, rb0);
    __syncthreads();
  }
#pragma unroll
  for (int mi = 0; mi < 2; ++mi)
#pragma unroll
    for (int ni = 0; ni < 2; ++ni) epi(mi, ni, acc[mi][ni]);
}

DI void store_rowmajor(u16* dst, const f32x16& a, int h, float sc) {
#pragma unroll
  for (int kp = 0; kp < 2; ++kp) {
    const int g = 2 * kp;
    unsigned ax = pk2(a[4 * g] * sc, a[4 * g + 1] * sc), ay = pk2(a[4 * g + 2] * sc, a[4 * g + 3] * sc);
    unsigned bx = pk2(a[4 * g + 4] * sc, a[4 * g + 5] * sc), by = pk2(a[4 * g + 6] * sc, a[4 * g + 7] * sc);
    const u32x2 rx = __builtin_amdgcn_permlane32_swap(ax, bx, false, false);
    const u32x2 ry = __builtin_amdgcn_permlane32_swap(ay, by, false, false);
    const u32x4 v = {rx[0], ry[0], rx[1], ry[1]};
    *(u32x4*)(dst + 8 * (g + h)) = v;
  }
}
DI void store_rope(u16* dst, const f32x16& a, int h, float sc, const float* rp) {
#pragma unroll
  for (int g = 0; g < 2; ++g) {
    f32x4 cs = *(const f32x4*)(rp + 8 * g + 4 * h);
    f32x4 sn = *(const f32x4*)(rp + 16 + 8 * g + 4 * h);
    float o1[4], o2[4];
#pragma unroll
    for (int e = 0; e < 4; ++e) {
      float x1 = a[4 * g + e] * sc, x2 = a[8 + 4 * g + e] * sc;
      o1[e] = x1 * cs[e] - x2 * sn[e];
      o2[e] = x1 * sn[e] + x2 * cs[e];
    }
    u32x2 v1 = {pk2(o1[0], o1[1]), pk2(o1[2], o1[3])};
    u32x2 v2 = {pk2(o2[0], o2[1]), pk2(o2[2], o2[3])};
    *(u32x2*)(dst + 8 * g + 4 * h) = v1;
    *(u32x2*)(dst + 16 + 8 * g + 4 * h) = v2;
  }
}
DI void store_transposed(u16* dst, const f32x16& a, int h, const float* rs  ) {
#pragma unroll
  for (int g = 0; g < 4; ++g) {
    float s0 = 1.f, s1 = 1.f, s2 = 1.f, s3 = 1.f;
    if (rs) { f32x4 sv = *(const f32x4*)(rs + 8 * g + 4 * h); s0 = sv[0]; s1 = sv[1]; s2 = sv[2]; s3 = sv[3]; }
    u32x2 v = {pk2(a[4 * g] * s0, a[4 * g + 1] * s1), pk2(a[4 * g + 2] * s2, a[4 * g + 3] * s3)};
    *(u32x2*)(dst + 8 * g + 4 * h) = v;
  }
}

DI void inproj_tile(const Params& p, int l, int mt, int nt, char* lds) {
  const int tid = opaque_tid(), lane = tid & 63, w = tid >> 6, r = lane & 31, h = lane >> 5;
  const int wm = w & 3, wn = w >> 2;
  const int m0 = mt * 256;
  const u16* A = p.Xb + (size_t)m0 * DM;
  const u16* Bw = p.Wt_in + (size_t)(l & 1) * NIN * DM + (size_t)nt * 128 * DM;
  if (nt < 42) {
    float ssq = 0.f;
    gemm_tile<true>(A, DM, Bw, DM, DM, lds, [&](int mi, int ni, const f32x16& a) {
      const int tok = m0 + wm * 64 + mi * 32 + r;
      store_rowmajor(p.H + (size_t)tok * LDH + nt * 128 + wn * 64 + ni * 32, a, h, 1.f);
      if (nt >= 4 && nt < 8) {
        if (ni == 0) ssq = 0.f;
#pragma unroll
        for (int i = 0; i < 16; ++i) ssq += a[i] * a[i];
        if (ni == 1) {
          float tot = ssq + __shfl_xor(ssq, 32);
          tot = wmax(tot);
          if (lane == 0) atomicMax(p.ctr + 64 + l * 16 + (m0 / PP) * 8 + (nt - 4) * 2 + wn, __float_as_uint(sqrtf(tot) * 1.01f));
        }
      }
    });
  } else if (nt == 42) {
    gemm_tile<true>(A, DM, Bw, DM, DM, lds, [&](int mi, int ni, const f32x16& a) {
      const int tok = m0 + wm * 64 + mi * 32 + r;
      const int b = tok / PP, t = tok - b * PP;
      const int sub = wn * 2 + ni;
      if (sub == 0) {
        store_rope(p.Kpe + (size_t)tok * 32, a, h, 1.f, p.ROPE + (size_t)t * 32);
      } else if (sub == 1) {
        store_rowmajor(p.IK + (size_t)tok * 64, a, h, 1.f);
      } else if (sub == 2) {
        store_rowmajor(p.IK + (size_t)tok * 64 + 32, a, h, 1.f);
      } else {
#pragma unroll
        for (int e = 0; e < 4; ++e) {
          const int hd = e + 4 * h;
          float xv = a[e] + p.b_f[l * 8 + hd];
          float lf = fminf(xv, 0.f) - log1pf(expf(-fabsf(xv)));
          p.LOGF[(size_t)(b * 8 + hd) * PP + t] = lf;
          p.IW[(size_t)tok * 8 + hd] = a[4 + e];
        }
      }
    });
  } else {
    u16* vt; int nv, c0;
    if (nt < 47) { vt = p.VtA; nv = 512; c0 = (nt - 43) * 128; } else { vt = p.VtD; nv = 128; c0 = 0; }
    gemm_tile<false>(A, DM, Bw, DM, DM, lds, [&](int mi, int ni, const f32x16& a) {
      const int b = m0 / PP, t0 = m0 - b * PP + wm * 64 + mi * 32;
      const int col = c0 + wn * 64 + ni * 32 + r;
      store_transposed(vt + ((size_t)b * nv + col) * PP + t0, a, h, nullptr);
    });
  }
}

DI void upproj_tile(const Params& p, int mt, int nt14, char* lds) {
  const int tid = opaque_tid(), lane = tid & 63, w = tid >> 6, r = lane & 31, h = lane >> 5;
  const int wm = w & 3, wn = w >> 2;
  const int m0 = mt * 256;
  float* rs = (float*)(lds + 2 * GEMM_STAGE);
  const bool isq = nt14 < 6;
  {
    const int row = tid >> 1, half = tid & 1;
    const int kw = isq ? 128 : 64;
    const u16* src = p.H + (size_t)(m0 + row) * LDH + (isq ? HCQ_B : HCKV_B) + half * kw;
    float ss = 0.f;
    u32x4 rv[16];
#pragma unroll
    for (int c = 0; c < 8; ++c) rv[c] = *(const u32x4*)(src + c * 8);
    if (isq) {
#pragma unroll
      for (int c = 8; c < 16; ++c) rv[c] = *(const u32x4*)(src + c * 8);
    } else {
#pragma unroll
      for (int c = 8; c < 16; ++c) { rv[c][0] = 0u; rv[c][1] = 0u; rv[c][2] = 0u; rv[c][3] = 0u; }
    }
#pragma unroll
    for (int c = 0; c < 16; ++c)
#pragma unroll
      for (int e = 0; e < 4; ++e) { float a = bf_lo(rv[c][e]), b2 = bf_hi(rv[c][e]); ss += a * a + b2 * b2; }
    ss += __shfl_xor(ss, 1);
    if (half == 0) rs[row] = rsqrtf(ss / (isq ? 256.f : 128.f) + 1e-6f);
  }
  __syncthreads();
  if (isq) {
    const int nt = nt14;
    gemm_tile<true>(p.H + (size_t)m0 * LDH + HCQ_B, LDH, p.Wt_uq + (size_t)nt * 128 * 256, 256, 256, lds, [&](int mi, int ni, const f32x16& a) {
      const int lr = wm * 64 + mi * 32 + r;
      const int tok = m0 + lr;
      const int t = tok % PP;
      const int j32 = nt * 4 + wn * 2 + ni;
      const float sc = rs[lr];
      u16* dst = p.Qm + (size_t)tok * 768 + j32 * 32;
      if (j32 % 3 == 2) store_rope(dst, a, h, sc, p.ROPE + (size_t)t * 32);
      else store_rowmajor(dst, a, h, sc);
    });
  } else {
    const int nt = nt14 - 6;
    const u16* A = p.H + (size_t)m0 * LDH + HCKV_B;
    const u16* Bw = p.Wt_ukv + (size_t)nt * 128 * 128;
    if (nt < 4) {
      gemm_tile<true>(A, LDH, Bw, 128, 128, lds, [&](int mi, int ni, const f32x16& a) {
        const int lr = wm * 64 + mi * 32 + r;
        store_rowmajor(p.Km + (size_t)(m0 + lr) * 512 + nt * 128 + wn * 64 + ni * 32, a, h, rs[lr]);
      });
    } else {
      gemm_tile<false>(A, LDH, Bw, 128, 128, lds, [&](int mi, int ni, const f32x16& a) {
        const int b = m0 / PP, t0 = m0 - b * PP + wm * 64 + mi * 32;
        const int col = (nt - 4) * 128 + wn * 64 + ni * 32 + r;
        store_transposed(p.VtB + ((size_t)b * 512 + col) * PP + t0, a, h, rs + wm * 64 + mi * 32);
      });
    }
  }
}

DI void cumsum_job(const Params& p, int j, char* lds) {
  const int tid = opaque_tid(), lane = tid & 63, w = tid >> 6;
  const float* src = p.LOGF + (size_t)j * PP;
  float* dst = p.CUM + (size_t)j * PP;
  float* wt = (float*)lds;
  float v[17];
#pragma unroll
  for (int rr = 0; rr < 17; ++rr) {
    const int o = rr * 64 + lane, i = w * 1056 + o;
    v[rr] = (o < 1056 && i >= LEAD) ? src[i] : 0.f;
  }
  float carry = 0.f;
#pragma unroll
  for (int rr = 0; rr < 17; ++rr) {
    float inc = v[rr];
    for (int o = 1; o < 64; o <<= 1) { float x = __shfl_up(inc, o); if (lane >= o) inc += x; }
    v[rr] = inc + carry;
    carry += __shfl(inc, 63);
  }
  if (lane == 0) wt[w] = carry;
  __syncthreads();
  float base = 0.f;
  for (int k = 0; k < w; ++k) base += wt[k];
#pragma unroll
  for (int rr = 0; rr < 17; ++rr) {
    const int o = rr * 64 + lane;
    if (o < 1056) dst[w * 1056 + o] = v[rr] + base;
  }
}

DI void topk_job(const Params& p, int b, int t0, char* lds) {
  const int tid = opaque_tid(), lane = tid & 63, w = tid >> 6, r = lane & 31, h = lane >> 5;
  const int cmax = (t0 + 3) >> 6;
  unsigned sc[17][4];
  {
    const u16* iqp = p.H + (size_t)(b * PP + t0 + (r >> 3)) * LDH + HIQ_C + (r & 7) * 64 + 8 * h;
    bf16x8 af[4];
#pragma unroll
    for (int ks = 0; ks < 4; ++ks) af[ks] = *(const bf16x8*)(iqp + ks * 16);
    f32x4 iw[4];
#pragma unroll
    for (int qi = 0; qi < 4; ++qi) iw[qi] = *(const f32x4*)(p.IW + (size_t)(b * PP + t0 + qi) * 8 + 4 * h);
    char* wb = lds + 16384 + w * 9216;
    const int lrow = lane >> 3, lpc = lane & 7;
    const u16* ikb = p.IK + ((size_t)(b * PP) + lrow) * 64 + lpc * 8;
    u32x4 st[8];
    if (1 + w <= cmax) {
      const u16* kp = ikb + (size_t)(1 + w) * 64 * 64;
#pragma unroll
      for (int j = 0; j < 8; ++j) st[j] = *(const u32x4*)(kp + (size_t)j * 8 * 64);
#pragma unroll
      for (int j = 0; j < 8; ++j) *(u32x4*)(wb + (lrow + 8 * j) * 144 + lpc * 16) = st[j];
    }
#pragma unroll
    for (int i = 0; i < 17; ++i) {
      const int c = 1 + w + 8 * i;
      if (c <= cmax) {
        const bool more = c + 8 <= cmax;
        if (more) {
          const u16* kp = ikb + (size_t)(c + 8) * 64 * 64;
#pragma unroll
          for (int j = 0; j < 8; ++j) st[j] = *(const u32x4*)(kp + (size_t)j * 8 * 64);
        }
        bf16x8 b0[4], b1[4];
#pragma unroll
        for (int ks = 0; ks < 4; ++ks) {
          b0[ks] = *(const bf16x8*)(wb + r * 144 + ks * 32 + h * 16);
          b1[ks] = *(const bf16x8*)(wb + (32 + r) * 144 + ks * 32 + h * 16);
        }
        __builtin_amdgcn_sched_barrier(0);
        f32x16 a0, a1;
#pragma unroll
        for (int e = 0; e < 16; ++e) { a0[e] = 0.f; a1[e] = 0.f; }
#pragma unroll
        for (int ks = 0; ks < 4; ++ks) { a0 = MFMA32(af[ks], b0[ks], a0); a1 = MFMA32(af[ks], b1[ks], a1); }
        const int key = c * 64 + lane;
#pragma unroll
        for (int qi = 0; qi < 4; ++qi) {
          f32x2 pp2 = {0.f, 0.f};
#pragma unroll
          for (int e = 0; e < 4; ++e) {
            const f32x2 rl = {fmaxf(a0[4 * qi + e], 0.f), fmaxf(a1[4 * qi + e], 0.f)};
            const f32x2 wv = {iw[qi][e], iw[qi][e]};
            pp2 += rl * wv;
          }
          const float p0 = pp2[0], p1 = pp2[1];
          const u32x2 sw = __builtin_amdgcn_permlane32_swap(__float_as_uint(p0), __float_as_uint(p1), false, false);
          float mine = __uint_as_float(sw[0]) + __uint_as_float(sw[1]);
          mine += 0.0f;
          unsigned u = __float_as_uint(mine);
          u = (u & 0x80000000u) ? ~u : (u | 0x80000000u);
          if (key > t0 + qi || key < LEAD) u = 0u;
          sc[i][qi] = u;
        }
        if (more) {
#pragma unroll
          for (int j = 0; j < 8; ++j) *(u32x4*)(wb + (lrow + 8 * j) * 144 + lpc * 16) = st[j];
        }
      } else {
#pragma unroll
        for (int qi = 0; qi < 4; ++qi) sc[i][qi] = 0u;
      }
    }
  }
  int* ng = (int*)(lds + 256);
  unsigned long long* mg = (unsigned long long*)(lds + 1024);
  unsigned long long* me = mg + 4 * 132;
  int* bg = (int*)(me + 4 * 132);
  int* be = bg + 4 * 132;
  unsigned T[4];
  {
    unsigned* hist = (unsigned*)(lds + 16384);
    int* sel = (int*)(lds + 512);
    unsigned pref[4] = {0u, 0u, 0u, 0u};
    int chi[4] = {0, 0, 0, 0};
    bool few[4] = {false, false, false, false};
    __syncthreads();
    bool small = false;
    int nb[4] = {0, 0, 0, 0};
#pragma unroll
    for (int pass = 0; pass < 3; ++pass) {
      if (pass == 2) {
        small = true;
#pragma unroll
        for (int q = 0; q < 4; ++q) small = small && (few[q] || nb[q] <= 64);
        if (small) break;
      }
      {
        const u32x4 z = {0u, 0u, 0u, 0u};
#pragma unroll
        for (int j = 0; j < 8; ++j) ((u32x4*)hist)[tid + 512 * j] = z;
      }
      __syncthreads();
#pragma unroll
      for (int i = 0; i < 17; ++i) {
#pragma unroll
        for (int q = 0; q < 4; ++q) {
          const unsigned u = sc[i][q];
          bool part; unsigned bin;
          if (pass == 0) { part = (u != 0u); bin = (u >> 22) + (lane & 3) * 1024; }
          else if (pass == 1) { part = (u != 0u) && ((u >> 22) == pref[q]) && !few[q]; bin = ((u >> 12) & 1023u) + (lane & 3) * 1024; }
          else { part = (u != 0u) && ((u >> 12) == pref[q]) && !few[q]; bin = u & 4095u; }
          if (part) atomicAdd(hist + q * 4096 + bin, 1u);
        }
      }
      __syncthreads();
      if (w < 4) {
        const int q = w;
        const unsigned* hq = hist + q * 4096;
        const int need = 256 - chi[q];
        int G = 0;
        if (pass < 2) {
#pragma unroll
          for (int rep = 0; rep < 4; ++rep)
#pragma unroll
            for (int j = 0; j < 16; ++j) G += (int)hq[rep * 1024 + 16 * lane + ((j + lane) & 15)];
        } else {
#pragma unroll 8
          for (int j = 0; j < 64; ++j) G += (int)hq[64 * lane + ((j + lane) & 63)];
        }
        int S = G;
        { int tt; S = wscan<false>(S, lane, tt); }
        const unsigned long long mk = __ballot(S >= need);
        int B = 0, cg2 = 0, fw = 0, nbin = 0;
        if (mk == 0ull) {
          fw = 1;
        } else {
          const int ks = 63 - __clzll(mk);
          const int above = (ks < 63) ? __builtin_amdgcn_readlane(S, ks + 1) : 0;
          int hh;
          if (pass < 2) {
            hh = 0;
            if (lane < 16) hh = (int)(hq[16 * ks + lane] + hq[1024 + 16 * ks + lane] + hq[2048 + 16 * ks + lane] + hq[3072 + 16 * ks + lane]);
          } else {
            hh = (int)hq[64 * ks + lane];
          }
          int s2 = hh;
          { int tt; s2 = wscan<false>(s2, lane, tt); }
          const unsigned long long m2 = __ballot(above + s2 >= need);
          const int Ls = 63 - __clzll(m2);
          B = (pass < 2 ? 16 : 64) * ks + Ls;
          nbin = __builtin_amdgcn_readlane(hh, Ls);
          cg2 = above + __builtin_amdgcn_readlane(s2, Ls) - nbin;
        }
        if (lane == 0) { sel[q * 4 + 0] = B; sel[q * 4 + 1] = chi[q] + cg2; sel[q * 4 + 2] = fw; sel[q * 4 + 3] = nbin; }
      }
      __syncthreads();
#pragma unroll
      for (int q = 0; q < 4; ++q) {
        if (!few[q]) {
          pref[q] = (pref[q] << (pass < 2 ? 10 : 12)) | (unsigned)sel[q * 4 + 0];
          chi[q] = sel[q * 4 + 1];
          nb[q] = sel[q * 4 + 3];
          if (pass == 0) few[q] = sel[q * 4 + 2] != 0;
        }
      }
    }
    if (small) {
      unsigned* lst = hist;
      int* lcnt = sel + 16;
      if (tid < 4) lcnt[tid] = 0;
      __syncthreads();
#pragma unroll
      for (int i = 0; i < 17; ++i)
#pragma unroll
        for (int q = 0; q < 4; ++q) {
          const unsigned u = sc[i][q];
          if (!few[q] && u != 0u && (u >> 12) == pref[q]) { const int pos = atomicAdd(lcnt + q, 1); lst[q * 64 + pos] = u; }
        }
      __syncthreads();
      if (w < 4) {
        const int q = w, n = lcnt[q], need = 256 - chi[q];
        const unsigned e = lane < n ? lst[q * 64 + lane] : 0u;
        int rank = 0;
        for (int k = 0; k < n; ++k) rank += (lst[q * 64 + k] > e) ? 1 : 0;
        unsigned cand = (lane < n && rank <= need - 1) ? e : 0xFFFFFFFFu;
        cand = wminu(cand);
        if (lane == 0) sel[q * 4 + 0] = (int)cand;
      }
      __syncthreads();
#pragma unroll
      for (int q = 0; q < 4; ++q) T[q] = few[q] ? 0u : (unsigned)sel[q * 4 + 0];
    } else {
#pragma unroll
      for (int q = 0; q < 4; ++q) T[q] = few[q] ? 0u : pref[q];
    }
  }
  unsigned* cntb = (unsigned*)mg;
  unsigned* baseb = (unsigned*)bg;
#pragma unroll
  for (int i = 0; i < 17; ++i) {
    const int c = 1 + w + 8 * i;
    if (c <= cmax) {
      unsigned mine = 0u;
#pragma unroll
      for (int q = 0; q < 4; ++q) {
        const unsigned pk = (unsigned)__popcll(__ballot(sc[i][q] > T[q])) | ((unsigned)__popcll(__ballot(sc[i][q] == T[q])) << 16);
        mine = (lane == q) ? pk : mine;
      }
      if (lane < 4) cntb[lane * 132 + c] = mine;
    }
  }
  __syncthreads();
  if (w < 4) {
    const int q = w;
    int cg_ = 0, ce_ = 0;
    for (int base = 0; base <= cmax; base += 64) {
      const int c = base + lane;
      const bool in = (c >= 1) && (c <= cmax);
      const unsigned cv = in ? cntb[q * 132 + c] : 0u;
      const int v1 = (int)(cv & 0xffffu), v2 = (int)(cv >> 16);
      int t1, t2;
      const int i1 = wscan<true>(v1, lane, t1), i2 = wscan<true>(v2, lane, t2);
      if (in) baseb[q * 132 + c] = (unsigned)(cg_ + i1 - v1) | ((unsigned)(ce_ + i2 - v2) << 16);
      cg_ += t1;
      ce_ += t2;
    }
    if (lane == 0) ng[q] = cg_;
  }
  __syncthreads();
  const unsigned long long lt = (1ull << lane) - 1ull;
#pragma unroll
  for (int i = 0; i < 17; ++i) {
    const int c = 1 + w + 8 * i;
    if (c <= cmax) {
      const int key = c * 64 + lane;
#pragma unroll
      for (int q = 0; q < 4; ++q) {
        u16* out = p.IDX + (size_t)(b * PP + t0 + q) * 256;
        const bool gt = sc[i][q] > T[q];
        const bool eq = (sc[i][q] == T[q]) && (T[q] != 0u);
        const unsigned long long m1 = __ballot(gt), m2 = __ballot(eq);
        if ((m1 | m2) != 0ull) {
          const unsigned bb = baseb[q * 132 + c];
          if (gt) out[(int)(bb & 0xffffu) + __popcll(m1 & lt)] = (u16)key;
          if (eq) { const int pos = ng[q] + (int)(bb >> 16) + __popcll(m2 & lt); if (pos < 256) out[pos] = (u16)key; }
        }
      }
    }
  }
#pragma unroll
  for (int q = 0; q < 4; ++q) {
    if (T[q] == 0u) {
      u16* out = p.IDX + (size_t)(b * PP + t0 + q) * 256;
      if (tid < 256 && tid >= ng[q]) out[tid] = (u16)0xFFFF;
    }
  }
}

constexpr int AT_STAGE = 23040;
template <int DK, int MODE>
DI void attn_unit(const Params& p, int l, int b, int head, int qu, char* lds) {
  const int tid = opaque_tid(), lane = tid & 63, w = tid >> 6, r = lane & 31, h = lane >> 5;
  constexpr int KS = DK / 16, KST = DK + 8;
  const int q0 = qu * 256, qw0 = q0 + w * 32, qw = qw0 + r;
  const size_t tokq = (size_t)b * PP + qw;
  const u16 *qptr, *kptr, *vtptr, *gptr;
  int ldk;
  if (MODE == 0) {
    qptr = p.H + tokq * LDH + HQ_A + head * 64; kptr = p.H + (size_t)b * PP * LDH + HK_A + head * 64; ldk = LDH;
    vtptr = p.VtA + ((size_t)b * 512 + head * 64) * PP; gptr = p.H + tokq * LDH + HG_A + head * 64;
  } else if (MODE == 1) {
    qptr = p.Qm + tokq * 768 + head * 96; kptr = p.Km + (size_t)b * PP * 512 + head * 64; ldk = 512;
    vtptr = p.VtB + ((size_t)b * 512 + head * 64) * PP; gptr = p.H + tokq * LDH + HG_B + head * 64;
  } else {
    qptr = p.H + tokq * LDH + HQ_D + head * 64; kptr = p.H + (size_t)b * PP * LDH + HK_D + (head >> 2) * 64; ldk = LDH;
    vtptr = p.VtD + ((size_t)b * 128 + (head >> 2) * 64) * PP; gptr = p.H + tokq * LDH + HG_D + head * 64;
  }
  const float* cum = p.CUM + (size_t)(b * 8 + head) * PP;
  float* btab = (float*)(lds + 2 * AT_STAGE);
  u32x2 gpre[2][4];
#pragma unroll
  for (int d = 0; d < 2; ++d)
#pragma unroll
    for (int g = 0; g < 4; ++g) gpre[d][g] = *(const u32x2*)(gptr + d * 32 + 8 * g + 4 * h);
  bf16x8 qf[KS];
#pragma unroll
  for (int ks = 0; ks < KS; ++ks) qf[ks] = *(const bf16x8*)(qptr + ks * 16 + 8 * h);
  float cref = 0.f;
  if (MODE == 0) cref = cum[q0];
  if (MODE == 2) { if (tid < 128) btab[tid] = p.rel_bias[t5_bucket(tid) * 16 + 8 + head] * LOG2E; }
  const float sc2 = (MODE == 1 ? 0.10206207261596577f : 0.125f) * LOG2E;
  const int kt_hi = qu * 4 + 3;
  int kt_lo = 1;
  if (MODE == 2) { kt_lo = qu * 4 - 2; if (kt_lo < 1) kt_lo = 1; }
  u32x4 rk, rk2, rv;
  float re = 0.f;
  const int srow = tid >> 3, sc8 = tid & 7;
  auto gload = [&](int kt) {
    const int k0 = kt * 64;
    rk = *(const u32x4*)(kptr + (size_t)(k0 + srow) * ldk + sc8 * 8);
    if (MODE == 1) { if (tid < 256) rk2 = *(const u32x4*)(p.Kpe + ((size_t)b * PP + k0 + (tid >> 2)) * 32 + (tid & 3) * 8); }
    rv = *(const u32x4*)(vtptr + (size_t)srow * PP + k0 + sc8 * 8);
    if (MODE == 0) { if (tid < 64) re = (cum[k0 + tid] - cref) * LOG2E; }
  };
  auto lstore = [&](int st) {
    char* base = lds + st * AT_STAGE;
    *(u32x4*)(base + (srow * KST + sc8 * 8) * 2) = rk;
    if (MODE == 1) { if (tid < 256) *(u32x4*)(base + ((tid >> 2) * KST + 64 + (tid & 3) * 8) * 2) = rk2; }
    char* vb = base + 64 * KST * 2;
    u32x2 lo = {rv[0], rv[1]}, hi = {rv[2], rv[3]};
    *(u32x2*)(vb + (srow * 68 + sc8 * 8) * 2) = lo;
    *(u32x2*)(vb + (srow * 68 + sc8 * 8 + 4) * 2) = hi;
    if (MODE == 0) { if (tid < 64) *(float*)(vb + 64 * 68 * 2 + tid * 4) = re; }
  };
  f32x16 o[2];
#pragma unroll
  for (int d = 0; d < 2; ++d)
#pragma unroll
    for (int i = 0; i < 16; ++i) o[d][i] = 0.f;
  float m = NEGL, lsum = 0.f;
  float qn = 0.f, kmx = 0.f;
  int* stopf = (int*)(lds + 2 * AT_STAGE + 1024);
  if (MODE == 0) {
#pragma unroll
    for (int ks = 0; ks < KS; ++ks) {
      const u32x4 qq = __builtin_bit_cast(u32x4, qf[ks]);
#pragma unroll
      for (int e = 0; e < 4; ++e) { const float a = bf_lo(qq[e]), b2 = bf_hi(qq[e]); qn += a * a + b2 * b2; }
    }
    qn = xor32_sum(qn);
    qn = sqrtf(qn) * 1.01f;
    kmx = __uint_as_float(p.ctr[64 + l * 16 + b * 8 + head]);
  }
  gload(kt_hi); lstore(0);
  __syncthreads();
  for (int kt = kt_hi; kt >= kt_lo; --kt) {
    const bool more = kt > kt_lo;
    if (more) gload(kt - 1);
    float cnext = 0.f;
    if (MODE == 0) { if (more) cnext = cum[(kt - 1) * 64 + 63]; }
    const int st = (kt_hi - kt) & 1;
    const int k0 = kt * 64;
    bool active = k0 <= qw0 + 31;
    if (MODE == 2) active = active && (k0 + 63 >= qw0 - 127);
    if (active) {
      const char* kb = lds + st * AT_STAGE;
      const char* vb = kb + 64 * KST * 2;
      f32x16 s[2];
      bf16x8 kf[2][KS];
#pragma unroll
      for (int kr = 0; kr < 2; ++kr)
#pragma unroll
        for (int ks = 0; ks < KS; ++ks) kf[kr][ks] = *(const bf16x8*)(kb + ((kr * 32 + r) * KST + ks * 16 + 8 * h) * 2);
      __builtin_amdgcn_sched_barrier(0);
#pragma unroll
      for (int kr = 0; kr < 2; ++kr) {
#pragma unroll
        for (int i = 0; i < 16; ++i) s[kr][i] = 0.f;
#pragma unroll
        for (int ks = 0; ks < KS; ++ks) s[kr] = MFMA32(kf[kr][ks], qf[ks], s[kr]);
      }
      u32x4 vfr[2][2][2];
#pragma unroll
      for (int kr = 0; kr < 2; ++kr)
#pragma unroll
        for (int s2 = 0; s2 < 2; ++s2)
#pragma unroll
          for (int d = 0; d < 2; ++d) {
            const char* va = vb + ((d * 32 + r) * 68 + kr * 32 + s2 * 16 + 4 * h) * 2;
            const u32x2 lo = *(const u32x2*)va;
            const u32x2 hi = *(const u32x2*)(va + 16);
            vfr[kr][s2][d] = (u32x4){lo[0], lo[1], hi[0], hi[1]};
          }
      __builtin_amdgcn_sched_barrier(0);
      const bool need_mask = (MODE == 2) || (k0 + 63 > qw0) || (k0 < LEAD);
      const bool rawpath = (MODE == 1) && !need_mask;
      float tmax = NEGL;
      const f32x2 sc2v = {sc2, sc2};
      if (rawpath) {
#pragma unroll
        for (int kr = 0; kr < 2; ++kr)
#pragma unroll
          for (int i = 0; i < 16; ++i) tmax = fmaxf(tmax, s[kr][i]);
        tmax *= sc2;
      } else {
#pragma unroll
        for (int kr = 0; kr < 2; ++kr) {
#pragma unroll
          for (int g = 0; g < 4; ++g) {
            f32x4 ev = {0.f, 0.f, 0.f, 0.f};
            if (MODE == 0) ev = *(const f32x4*)(vb + 64 * 68 * 2 + (kr * 32 + 8 * g + 4 * h) * 4);
#pragma unroll
            for (int e2 = 0; e2 < 2; ++e2) {
              const int i = 4 * g + 2 * e2;
              f32x2 v2 = {s[kr][i], s[kr][i + 1]};
              if (MODE == 0) { const f32x2 e2v = {ev[2 * e2], ev[2 * e2 + 1]}; v2 = v2 * sc2v - e2v; }
              else v2 = v2 * sc2v;
#pragma unroll
              for (int e1 = 0; e1 < 2; ++e1) {
                const int key = k0 + kr * 32 + 8 * g + 4 * h + 2 * e2 + e1;
                float v = v2[e1];
                if (MODE == 2) v += btab[(qw - key) & 127];
                if (need_mask) {
                  bool ok = (key <= qw) && (key >= LEAD);
                  if (MODE == 2) ok = ok && (qw - key < 128);
                  v = ok ? v : NEGL;
                }
                s[kr][i + e1] = v;
                tmax = fmaxf(tmax, v);
              }
            }
          }
        }
      }
      tmax = xor32_max(tmax);
      const float mn = fmaxf(m, tmax);
      const float alpha = __builtin_amdgcn_exp2f(m - mn);
      const bool resc = __any(m != mn);
      m = mn;
      f32x2 ps2 = {0.f, 0.f};
      const f32x2 mnv = {mn, mn};
      const f32x2 scx = rawpath ? sc2v : (f32x2){1.f, 1.f};
#pragma unroll
      for (int kr = 0; kr < 2; ++kr)
#pragma unroll
        for (int i = 0; i < 16; i += 2) {
          f32x2 v2 = {s[kr][i], s[kr][i + 1]};
          v2 = v2 * scx - mnv;
          f32x2 p2 = {__builtin_amdgcn_exp2f(v2[0]), __builtin_amdgcn_exp2f(v2[1])};
          s[kr][i] = p2[0]; s[kr][i + 1] = p2[1];
          ps2 += p2;
        }
      const float ps = ps2[0] + ps2[1];
      lsum = lsum * alpha + ps;
      if (resc)
#pragma unroll
      for (int d = 0; d < 2; ++d)
#pragma unroll
        for (int i = 0; i < 16; ++i) o[d][i] *= alpha;
#pragma unroll
      for (int kr = 0; kr < 2; ++kr) {
#pragma unroll
        for (int s2 = 0; s2 < 2; ++s2) {
          u32x4 pp = {pk2(s[kr][8 * s2], s[kr][8 * s2 + 1]), pk2(s[kr][8 * s2 + 2], s[kr][8 * s2 + 3]),
                      pk2(s[kr][8 * s2 + 4], s[kr][8 * s2 + 5]), pk2(s[kr][8 * s2 + 6], s[kr][8 * s2 + 7])};
          bf16x8 pf = __builtin_bit_cast(bf16x8, pp);
#pragma unroll
          for (int d = 0; d < 2; ++d) o[d] = MFMA32(__builtin_bit_cast(bf16x8, vfr[kr][s2][d]), pf, o[d]);
        }
      }
    }
    if (more) lstore(st ^ 1);
    if (MODE == 0) {
      if (more) {
        const float enext = (cnext - cref) * LOG2E;
        const bool okl = (qn * kmx * sc2 - enext) <= (m - 40.f);
        const bool okw = __all(okl);
        if (lane == 0) stopf[(kt & 1) * 8 + w] = okw ? 1 : 0;
      }
    }
    __syncthreads();
    if (MODE == 0) {
      if (more) {
        const int* sf = stopf + (kt & 1) * 8;
        if (sf[0] & sf[1] & sf[2] & sf[3] & sf[4] & sf[5] & sf[6] & sf[7]) break;
      }
    }
  }
  lsum = xor32_sum(lsum);
  float f;
  if (MODE == 2) {
    const float s2 = p.sinks[l * 8 + head] * LOG2E;
    const float mf = fmaxf(m, s2);
    const float em = __builtin_amdgcn_exp2f(m - mf);
    f = em / (lsum * em + __builtin_amdgcn_exp2f(s2 - mf));
  } else {
    f = lsum > 0.f ? 1.f / lsum : 0.f;
  }
  f *= (MODE == 0 ? SC_FOX : (MODE == 1 ? SC_MLA : SC_SWA));
  u16* mp = p.Mix + tokq * 2048 + (MODE == 0 ? 0 : (MODE == 1 ? 512 : 1536)) + head * 64;
#pragma unroll
  for (int d = 0; d < 2; ++d)
#pragma unroll
    for (int g = 0; g < 4; ++g) {
      const int dd = d * 32 + 8 * g + 4 * h;
      const u32x2 gv = gpre[d][g];
      float g0 = silu(bf_lo(gv[0])), g1 = silu(bf_hi(gv[0])), g2 = silu(bf_lo(gv[1])), g3 = silu(bf_hi(gv[1]));
      u32x2 ov = {pk2(o[d][4 * g] * f * g0, o[d][4 * g + 1] * f * g1), pk2(o[d][4 * g + 2] * f * g2, o[d][4 * g + 3] * f * g3)};
      *(u32x2*)(mp + dd) = ov;
    }
}

DI void dsa_job(const Params& p, int b, int tq0, char* lds) {
  const int tid = opaque_tid(), lane = tid & 63, w = tid >> 6;
  float* biasC = (float*)(lds + 143360);
  int* btab = (int*)(lds + 143360 + 1024);
  char* wl = lds + w * 17920;
  float* Pl = (float*)wl;
  int* kid = (int*)(wl + 8192);
  const int tq = tq0 + w;
  const size_t tok = (size_t)b * PP + tq;
  const u16* Hb = p.H + (size_t)b * PP * LDH;
  int kk[4], ku[4];
  {
    u32x2 iv = *(const u32x2*)(p.IDX + tok * 256 + 4 * lane);
    kk[0] = iv[0] & 0xffff; kk[1] = iv[0] >> 16; kk[2] = iv[1] & 0xffff; kk[3] = iv[1] >> 16;
#pragma unroll
    for (int j = 0; j < 4; ++j) ku[j] = (kk[j] == 0xFFFF) ? LEAD : kk[j];
    u32x4 kv4 = {(unsigned)ku[0], (unsigned)ku[1], (unsigned)ku[2], (unsigned)ku[3]};
    ((u32x4*)kid)[lane] = kv4;
  }
  u32x4 gvp[4];
#pragma unroll
  for (int hh = 0; hh < 4; ++hh) gvp[hh] = *(const u32x4*)(p.H + tok * LDH + HG_C + (((lane >> 3) & 1) * 4 + hh) * 64 + (lane & 7) * 8);
  __builtin_amdgcn_wave_barrier();
  const int ksub = lane >> 4, g = (lane >> 3) & 1, dc = lane & 7;
  {
    const int r = lane & 31, h = lane >> 5, pc = lane & 15;
    char* kst = wl + 9216;
    bf16x8 qb[8];
#pragma unroll
    for (int ks = 0; ks < 8; ++ks) {
      u32x4 v = {0u, 0u, 0u, 0u};
      if (r < 8 && (ks >> 2) == (r >> 2)) v = *(const u32x4*)(p.H + tok * LDH + HQ_C + r * 64 + (ks & 3) * 16 + 8 * h);
      qb[ks] = __builtin_bit_cast(bf16x8, v);
    }
    const u16* kbase = Hb + HK_C + pc * 8;
    u32x4 st0[8], st1[8];
#pragma unroll
    for (int s2 = 0; s2 < 8; ++s2) st0[s2] = *(const u32x4*)(kbase + (size_t)kid[4 * s2 + ksub] * LDH);
#pragma unroll
    for (int s2 = 0; s2 < 8; ++s2) st1[s2] = *(const u32x4*)(kbase + (size_t)kid[32 + 4 * s2 + ksub] * LDH);
    auto chunk = [&](int c, u32x4* stc) {
#pragma unroll
      for (int s2 = 0; s2 < 8; ++s2) *(u32x4*)(kst + (4 * s2 + ksub) * 272 + pc * 16) = stc[s2];
      if (c + 2 < 8) {
#pragma unroll
        for (int s2 = 0; s2 < 8; ++s2) stc[s2] = *(const u32x4*)(kbase + (size_t)kid[32 * (c + 2) + 4 * s2 + ksub] * LDH);
      }
      bf16x8 af[8];
#pragma unroll
      for (int ks = 0; ks < 8; ++ks) af[ks] = *(const bf16x8*)(kst + r * 272 + ks * 32 + 16 * h);
      __builtin_amdgcn_sched_barrier(0);
      f32x16 acc0, acc1;
#pragma unroll
      for (int i = 0; i < 16; ++i) { acc0[i] = 0.f; acc1[i] = 0.f; }
#pragma unroll
      for (int ks = 0; ks < 8; ks += 2) { acc0 = MFMA32(af[ks], qb[ks], acc0); acc1 = MFMA32(af[ks + 1], qb[ks + 1], acc1); }
      if (r < 8) {
#pragma unroll
        for (int i = 0; i < 16; ++i) Pl[(32 * c + crow(i, h)) * 8 + r] = acc0[i] + acc1[i];
      }
    };
#pragma unroll 1
    for (int c = 0; c < 8; c += 2) { chunk(c, st0); chunk(c + 1, st1); }
  }
  __builtin_amdgcn_wave_barrier();
  float lg[4][8];
#pragma unroll
  for (int j = 0; j < 4; ++j) {
    const f32x4 v0 = *(const f32x4*)(Pl + (4 * lane + j) * 8), v1 = *(const f32x4*)(Pl + (4 * lane + j) * 8 + 4);
#pragma unroll
    for (int e = 0; e < 4; ++e) { lg[j][e] = v0[e]; lg[j][4 + e] = v1[e]; }
  }
  int bk[4];
#pragma unroll
  for (int j = 0; j < 4; ++j) { int dist = tq - ku[j]; bk[j] = (dist < 128) ? btab[dist & 127] : 31; }
#pragma unroll
  for (int hd = 0; hd < 8; ++hd) {
    float mx = NEGL;
#pragma unroll
    for (int j = 0; j < 4; ++j) {
      float v = lg[j][hd] * 0.125f + biasC[bk[j] * 8 + hd];
      v = (kk[j] == 0xFFFF) ? NEGL : v;
      lg[j][hd] = v;
      mx = fmaxf(mx, v);
    }
    mx = wmax(mx);
    float sm = 0.f;
#pragma unroll
    for (int j = 0; j < 4; ++j) { float e = __expf(lg[j][hd] - mx); lg[j][hd] = e; sm += e; }
    sm = wsum(sm);
    const float inv = 1.f / sm;
#pragma unroll
    for (int j = 0; j < 4; ++j) lg[j][hd] *= inv;
  }
#pragma unroll
  for (int j = 0; j < 4; ++j) {
    f32x4 v0 = {lg[j][0], lg[j][1], lg[j][2], lg[j][3]}, v1 = {lg[j][4], lg[j][5], lg[j][6], lg[j][7]};
    *(f32x4*)(Pl + (4 * lane + j) * 8) = v0;
    *(f32x4*)(Pl + (4 * lane + j) * 8 + 4) = v1;
  }
  __builtin_amdgcn_wave_barrier();
  const u16* vb = Hb + HV_C + g * 64 + dc * 8;
  f32x2 acc2[4][4];
#pragma unroll
  for (int hh = 0; hh < 4; ++hh)
#pragma unroll
    for (int e = 0; e < 4; ++e) { acc2[hh][e][0] = 0.f; acc2[hh][e][1] = 0.f; }
  u32x4 vA[16], vB[16];
  auto pv_load = [&](int grp, u32x4* dst) {
#pragma unroll
    for (int s = 0; s < 16; ++s) dst[s] = *(const u32x4*)(vb + (size_t)kid[4 * (grp * 16 + s) + ksub] * LDH);
  };
  auto pv_fma = [&](int grp, const u32x4* src) {
#pragma unroll
    for (int s = 0; s < 16; ++s) {
      const int slot = 4 * (grp * 16 + s) + ksub;
      const f32x4 pp = *(const f32x4*)(Pl + slot * 8 + g * 4);
      const u32x4 vv = src[s];
#pragma unroll
      for (int hh = 0; hh < 4; ++hh) {
        const f32x2 ph = {pp[hh], pp[hh]};
#pragma unroll
        for (int e = 0; e < 4; ++e) {
          const f32x2 vf2 = {bf_lo(vv[e]), bf_hi(vv[e])};
          acc2[hh][e] += ph * vf2;
        }
      }
    }
  };
  pv_load(0, vA);
  pv_load(1, vB);
  pv_fma(0, vA);
  pv_load(2, vA);
  pv_fma(1, vB);
  pv_load(3, vB);
  pv_fma(2, vA);
  pv_fma(3, vB);
  float acc[4][8];
#pragma unroll
  for (int hh = 0; hh < 4; ++hh)
#pragma unroll
    for (int e = 0; e < 8; ++e) { float v = acc2[hh][e >> 1][e & 1]; v += __shfl_xor(v, 16); v += __shfl_xor(v, 32); acc[hh][e] = v; }
  if (ksub == 0) {
#pragma unroll
    for (int hh = 0; hh < 4; ++hh) {
      const int hd = g * 4 + hh;
      const u32x4 gv = gvp[hh];
      u32x4 ov;
#pragma unroll
      for (int e = 0; e < 4; ++e) ov[e] = pk2(acc[hh][2 * e] * SC_DSA * silu(bf_lo(gv[e])), acc[hh][2 * e + 1] * SC_DSA * silu(bf_hi(gv[e])));
      *(u32x4*)(p.Mix + tok * 2048 + 1024 + hd * 64 + dc * 8) = ov;
    }
  }
}

DI void outproj_tile(const Params& p, int l, int mt, int nt, char* lds, int khalf) {
  const int tid = opaque_tid(), lane = tid & 63, w = tid >> 6, r = lane & 31, h = lane >> 5;
  const int wm = w & 3, wn = w >> 2;
  const int m0 = mt * 256;
  const int koff = khalf > 0 ? 512 * khalf : 0, klen = khalf < 0 ? 2048 : 512;
  const u16* A = p.Mix + (size_t)m0 * 2048 + koff;
  const u16* Bw = p.Wt_out + (size_t)(l & 1) * DM * 2048 + (size_t)nt * 128 * 2048 + koff;
  if (khalf <= 0) {
    gemm_tile<true>(A, 2048, Bw, 2048, klen, lds, [&](int mi, int ni, const f32x16& a) {
      const int tok = m0 + wm * 64 + mi * 32 + r;
      float* rp = p.R + (size_t)tok * DM + nt * 128 + wn * 64 + ni * 32;
#pragma unroll
      for (int g = 0; g < 4; ++g) {
        f32x4 v = *(const f32x4*)(rp + 8 * g + 4 * h);
#pragma unroll
        for (int e = 0; e < 4; ++e) v[e] = ALPHA * v[e] + a[4 * g + e];
        *(f32x4*)(rp + 8 * g + 4 * h) = v;
      }
    });
  } else {
    gemm_tile<true>(A, 2048, Bw, 2048, klen, lds, [&](int mi, int ni, const f32x16& a) {
      const int tok = m0 + wm * 64 + mi * 32 + r;
      float* rp = p.Y1 + ((size_t)(khalf - 1) * 512 + (tok - 16384)) * DM + nt * 128 + wn * 64 + ni * 32;
#pragma unroll
      for (int g = 0; g < 4; ++g) {
        const f32x4 v = {a[4 * g], a[4 * g + 1], a[4 * g + 2], a[4 * g + 3]};
        *(f32x4*)(rp + 8 * g + 4 * h) = v;
      }
    });
  }
}

DI void ln_rows(const Params& p, int l) {
  const int tid = opaque_tid(), lane = tid & 63, w = tid >> 6;
  const float* gg = l < 0 ? p.ln0_g : p.ln_g + l * DM;
  const float* bb = l < 0 ? p.ln0_b : p.ln_b + l * DM;
  const int stride = gridDim.x * 8;
  auto loadrow = [&](int row, f32x4* dst) {
    if (l < 0) {
      const int b = row / PP, t = row - b * PP;
      const float* src = nullptr;
      if (t >= 128 && t < PV) src = p.x + ((size_t)b * SEQ + (t - 128)) * DM;
      else if (t >= LEAD && t < 128) src = p.meta + (size_t)(t - LEAD) * DM;
#pragma unroll
      for (int j = 0; j < 4; ++j) {
        if (src) dst[j] = *(const f32x4*)(src + lane * 4 + 256 * j);
        else { dst[j][0] = 0.f; dst[j][1] = 0.f; dst[j][2] = 0.f; dst[j][3] = 0.f; }
      }
    } else {
#pragma unroll
      for (int j = 0; j < 4; ++j) {
        dst[j] = *(const f32x4*)(p.R + (size_t)row * DM + lane * 4 + 256 * j);
        if (row >= 16384) {
#pragma unroll
          for (int q = 0; q < 3; ++q) dst[j] += *(const f32x4*)(p.Y1 + ((size_t)q * 512 + (row - 16384)) * DM + lane * 4 + 256 * j);
        }
      }
    }
  };
  f32x4 v[4], vn[4];
  int row = blockIdx.x * 8 + w;
  if (row < MT) loadrow(row, v);
  for (; row < MT; row += stride) {
    const int b = row / PP, t = row - b * PP;
    if (row + stride < MT) loadrow(row + stride, vn);
    float s = 0.f;
#pragma unroll
    for (int j = 0; j < 4; ++j) s += v[j][0] + v[j][1] + v[j][2] + v[j][3];
    const float mu = wsum(s) * (1.f / DM);
    float q = 0.f;
#pragma unroll
    for (int j = 0; j < 4; ++j)
#pragma unroll
      for (int e = 0; e < 4; ++e) { float d = v[j][e] - mu; q += d * d; }
    const float rstd = rsqrtf(wsum(q) * (1.f / DM) + 1e-5f);
#pragma unroll
    for (int j = 0; j < 4; ++j) {
      const int c = lane * 4 + 256 * j;
      f32x4 g4 = *(const f32x4*)(gg + c), b4 = *(const f32x4*)(bb + c);
      f32x4 y;
#pragma unroll
      for (int e = 0; e < 4; ++e) y[e] = (v[j][e] - mu) * rstd * g4[e] + b4[e];
      if (l == 3) {
        if (t >= 128 && t < PV) *(f32x4*)(p.out + ((size_t)b * SEQ + (t - 128)) * DM + c) = y;
      } else {
        *(f32x4*)(p.R + (size_t)row * DM + c) = y;
        u32x2 yb = {pk2(y[0], y[1]), pk2(y[2], y[3])};
        *(u32x2*)(p.Xb + (size_t)row * DM + c) = yb;
      }
    }
#pragma unroll
    for (int j = 0; j < 4; ++j) v[j] = vn[j];
  }
}

DI int map_in(int n) {
  if (n < 512) return n;
  if (n < 1024) return n;
  if (n < 1536) return 1544 + (n - 1024);
  if (n < 1792) return 2056 + (n - 1536);
  if (n < 1920) return 2312 + (n - 1792);
  if (n < 2432) return 2472 + (n - 1920);
  if (n < 2944) return 2984 + (n - 2432);
  if (n < 3072) return 3496 + (n - 2944);
  if (n < 3200) return 3624 + (n - 3072);
  if (n < 3712) return 3752 + (n - 3200);
  if (n < 4224) return 4336 + (n - 3712);
  if (n < 4736) return 4848 + (n - 4224);
  if (n < 4864) return 5360 + (n - 4736);
  if (n < 5376) return 5616 + (n - 4864);
  if (n < 5408) return 2440 + (n - 5376);
  if (n < 5472) return 4264 + (n - 5408);
  if (n < 5480) return 1536 + (n - 5472);
  if (n < 5488) return 4328 + (n - 5480);
  if (n < 5504) return -1;
  if (n < 6016) return 1024 + (n - 5504);
  return 5488 + (n - 6016);
}
DI void conv_weights(const Params& p, int l, char* lds, int t_first, int t_stride, int t_end) {
  const int tid = opaque_tid();
  float* tile = (float*)lds;
  struct TD { u16* dst; int K, k0, n0; };
  const int nn_l = tid & 63;
  auto loadtile = [&](int tI, float* rv, TD& d) {
    const float* src; const float* ksc = nullptr; int ldsrc, kind, kt, ntile;
    if (tI < 1536) { kind = 0; kt = tI / 96; ntile = tI % 96; src = p.w_in + (size_t)l * DM * D_IN; ldsrc = D_IN; d.K = DM; d.dst = p.Wt_in + (size_t)(l & 1) * NIN * DM; }
    else if (tI < 2048) { int u = tI - 1536; kind = 1; kt = u / 16; ntile = u % 16; src = p.w_out + (size_t)l * 2048 * DM; ldsrc = DM; d.K = 2048; d.dst = p.Wt_out + (size_t)(l & 1) * DM * 2048; }
    else if (tI < 2096) { int u = tI - 2048; kind = 2; kt = u / 12; ntile = u % 12; src = p.w_uq + (size_t)l * 256 * 768; ldsrc = 768; d.K = 256; d.dst = p.Wt_uq; ksc = p.gq + l * 256; }
    else { int u = tI - 2096; kind = 3; kt = u / 16; ntile = u % 16; src = p.w_ukv + (size_t)l * 128 * 1024; ldsrc = 1024; d.K = 128; d.dst = p.Wt_ukv; ksc = p.gkv + l * 128; }
    d.k0 = kt * 64; d.n0 = ntile * 64;
    const int n = d.n0 + nn_l;
    int sc;
    if (kind == 0) sc = map_in(n);
    else if (kind == 3) sc = (n < 512) ? ((n >> 6) * 128 + (n & 63)) : (((n - 512) >> 6) * 128 + 64 + (n & 63));
    else sc = n;
#pragma unroll
    for (int j = 0; j < 8; ++j) {
      const int kk = (tid >> 6) + 8 * j;
      float v = 0.f;
      if (sc >= 0) v = src[(size_t)(d.k0 + kk) * ldsrc + sc];
      if (ksc) v *= ksc[d.k0 + kk];
      rv[j] = v;
    }
  };
  float rv[8], rn[8];
  TD dc, dn;
  int tI = t_first;
  if (tI < t_end) loadtile(tI, rv, dc);
  for (; tI < t_end; tI += t_stride) {
    const int tN = tI + t_stride;
    if (tN < t_end) loadtile(tN, rn, dn);
#pragma unroll
    for (int j = 0; j < 8; ++j) tile[nn_l * 65 + (tid >> 6) + 8 * j] = rv[j];
    __syncthreads();
    {
      const int nn = tid >> 3, kc = (tid & 7) * 8;
      const float* tp = tile + nn * 65 + kc;
      u32x4 ov = {pk2(tp[0], tp[1]), pk2(tp[2], tp[3]), pk2(tp[4], tp[5]), pk2(tp[6], tp[7])};
      *(u32x4*)(dc.dst + (size_t)(dc.n0 + nn) * dc.K + dc.k0 + kc) = ov;
    }
    __syncthreads();
#pragma unroll
    for (int j = 0; j < 8; ++j) rv[j] = rn[j];
    dc = dn;
  }
}
DI void rope_table(const Params& p) {
  const int gt = blockIdx.x * NTHREADS + threadIdx.x;
  for (int i = gt; i < PP * 16; i += gridDim.x * NTHREADS) {
    const int t = i >> 4, c = i & 15;
    const float freq = powf(10000.f, -(float)c / 16.f);
    const float ang = (float)(t - LEAD) * freq;
    float sn, cs;
    sincosf(ang, &sn, &cs);
    p.ROPE[(size_t)t * 32 + c] = cs;
    p.ROPE[(size_t)t * 32 + 16 + c] = sn;
  }
}


#define XB_TMO      128
#define XB_XCNT(j)  (256  + 64 * (j))
#define XB_XSUB(j)  (1280 + 64 * (j))
#define XB_XGEN(j)  (2304 + 64 * (j))
#define XB_TOP      3328
#define XB_TOPGEN   3392
#define XCD_BAR_WORDS 3456
#define XB_SPIN_CAP (1u << 18)
DI unsigned xb_ld(unsigned* p) { return __hip_atomic_load(p, __ATOMIC_RELAXED, __HIP_MEMORY_SCOPE_AGENT); }
DI unsigned xb_add(unsigned* p, unsigned v) { return __hip_atomic_fetch_add(p, v, __ATOMIC_RELAXED, __HIP_MEMORY_SCOPE_AGENT); }
DI unsigned xb_xcc_id() { return (unsigned)__builtin_amdgcn_s_getreg((3 << 11) | 20) & 0xFu; }
#define XB_SPIN(cond, bar) do { unsigned _sp = 0; while (cond) { __builtin_amdgcn_s_sleep(1); \
    if ((++_sp & 255u) == 0u) { if (xb_ld(&(bar)[XB_TMO])) break; if (_sp > XB_SPIN_CAP) { atomicAdd(&(bar)[XB_TMO], 1u); break; } } } } while (0)
struct XcdBarrier { unsigned* bar; unsigned x; volatile unsigned* st; };
DI XcdBarrier xcd_barrier_post(unsigned* bar, volatile unsigned* st) {
  XcdBarrier b; b.bar = bar; b.x = xb_xcc_id(); b.st = st;
  if (threadIdx.x == 0) (void)xb_add(&bar[XB_XCNT(b.x)], 1u);
  return b;
}
DI void xcd_barrier_complete(unsigned* bar, unsigned x, unsigned& nloc, unsigned& nx) {
  const unsigned G = gridDim.x * gridDim.y * gridDim.z;
  unsigned sum, cnt, mine, sp = 0u;
  for (;;) {
    sum = 0u; cnt = 0u; mine = 0u;
#pragma unroll
    for (unsigned j = 0; j < 16; ++j) { const unsigned c = xb_ld(&bar[XB_XCNT(j)]); sum += c; cnt += (c > 0u) ? 1u : 0u; mine = (j == x) ? c : mine; }
    if (sum == G) break;
    __builtin_amdgcn_s_sleep(1);
    if ((++sp & 255u) == 0u) { if (xb_ld(&bar[XB_TMO])) break; if (sp > XB_SPIN_CAP) { atomicAdd(&bar[XB_TMO], 1u); break; } }
  }
  nloc = mine > 0u ? mine : 1u; nx = cnt > 0u ? cnt : 1u;
}
DI void xcd_barrier(const XcdBarrier& b) {
  asm volatile("s_waitcnt vmcnt(0)" ::: "memory");
  __syncthreads();
  if (threadIdx.x == 0) {
    unsigned* bar = b.bar;
    __builtin_amdgcn_s_waitcnt(0);
    unsigned nloc = b.st[0], nx = b.st[1];
    if (nloc == 0u) { xcd_barrier_complete(bar, b.x, nloc, nx); b.st[0] = nloc; b.st[1] = nx; }
    const unsigned old = xb_add(&bar[XB_XSUB(b.x)], 1u);
    const unsigned gen = old / nloc;
    if (old + 1u == (gen + 1u) * nloc) {
      __builtin_amdgcn_fence(__ATOMIC_RELEASE, "agent");
      asm volatile("s_waitcnt vmcnt(0)" ::: "memory");
      const unsigned og = xb_add(&bar[XB_TOP], 1u);
      const unsigned tg = og / nx;
      if (og + 1u == (tg + 1u) * nx) xb_add(&bar[XB_TOPGEN], 1u);
      else XB_SPIN(xb_ld(&bar[XB_TOPGEN]) == tg, bar);
      __builtin_amdgcn_fence(__ATOMIC_ACQUIRE, "agent");
      xb_add(&bar[XB_XGEN(b.x)], 1u);
      asm volatile("s_waitcnt vmcnt(0)" ::: "memory");
    } else {
      XB_SPIN(xb_ld(&bar[XB_XGEN(b.x)]) == gen, bar);
      __builtin_amdgcn_fence(__ATOMIC_ACQUIRE, "agent");
      asm volatile("s_waitcnt vmcnt(0)" ::: "memory");
    }
  }
  __syncthreads();
}

__global__ void __launch_bounds__(NTHREADS) mega(Params p) {
  extern __shared__ __attribute__((aligned(16))) char lds[];
  cg::grid_group grid = cg::this_grid();
  ln_rows(p, -1);
  conv_weights(p, 0, lds, blockIdx.x, gridDim.x, 2128);
  rope_table(p);
  if (blockIdx.x == 0) {
    if (threadIdx.x < 256) p.ctr[threadIdx.x] = 0u;
    for (int i = threadIdx.x; i < XCD_BAR_WORDS; i += NTHREADS) p.bar[i] = 0u;
  }
  volatile unsigned* xst = (volatile unsigned*)(lds + LDS_JOB + 16);
  if (threadIdx.x == 0) { xst[0] = 0u; xst[1] = 0u; }
  grid.sync();
  const XcdBarrier xb = xcd_barrier_post(p.bar, xst);
  for (int l = 0; l < 4; ++l) {
    for (int rep = 0; rep < REP_P1; ++rep) {
      for (int j = blockIdx.x; j < 66 * 48; j += gridDim.x) inproj_tile(p, l, j / 48, j % 48, lds);
      if (l < 3 && rep == 0) {
        const int nbusy = 66 * 48 - (66 * 48 / (int)gridDim.x) * (int)gridDim.x;
        const int nidle = (int)gridDim.x - nbusy;
        if ((int)blockIdx.x >= nbusy && nidle > 0) conv_weights(p, l + 1, lds, (int)blockIdx.x - nbusy, nidle, 1536);
      }
      xcd_barrier(xb);
    }
    for (int rep = 0; rep < REP_P2; ++rep) {
      constexpr int NTK = 2 * 2052, NUP = 66 * 14, NJ = NTK + NUP + 16;
      int pending = 0, par = 0;
      if (threadIdx.x == 0) pending = (int)atomicAdd(p.ctr + l * 2 + 8 * rep, 1u);
      for (;;) {
        const int j = next_job(p.ctr + l * 2 + 8 * rep, lds, pending, NJ, par);
        if (j >= NJ) break;
        if (j < 16) {
          cumsum_job(p, j, lds);
        } else if (j < 16 + NTK) {
          const int jj = j - 16;
          const int b = jj & 1, q = 2051 - (jj >> 1);
          topk_job(p, b, LEAD + 4 * q, lds);
        } else {
          const int u = j - 16 - NTK;
          upproj_tile(p, u / 14, u % 14, lds);
        }
      }
      xcd_barrier(xb);
    }
    for (int rep = 0; rep < REP_P3; ++rep) {
      constexpr int ND = 1056, NS = 528, NC = 2 * 1026, NJ = ND + NS + NC;
      {
        float* biasC = (float*)(lds + 143360);
        int* btab = (int*)(lds + 143360 + 1024);
        if (threadIdx.x < 256) biasC[threadIdx.x] = p.rel_bias[(threadIdx.x >> 3) * 16 + (threadIdx.x & 7)];
        if (threadIdx.x < 128) btab[threadIdx.x] = t5_bucket(threadIdx.x);
      }
      int pending = 0, par = 0;
      if (threadIdx.x == 0) pending = (int)atomicAdd(p.ctr + l * 2 + 1 + 8 * rep, 1u);
      for (;;) {
        const int j = next_job(p.ctr + l * 2 + 1 + 8 * rep, lds, pending, NJ, par);
        if (j >= NJ) break;
        if (j < ND) {
          const int qu = 32 - (j >> 5), rem = j & 31, kind = rem >> 4, b = (rem >> 3) & 1, head = rem & 7;
          if (kind == 0) attn_unit<64, 0>(p, l, b, head, qu, lds);
          else attn_unit<96, 1>(p, l, b, head, qu, lds);
        } else if (j < ND + NS) {
          const int u = j - ND;
          attn_unit<64, 2>(p, l, (u >> 3) & 1, u & 7, u >> 4, lds);
        } else {
          const int u = j - ND - NS;
          dsa_job(p, u & 1, LEAD + 8 * (u >> 1), lds);
        }
      }
      xcd_barrier(xb);
    }
    for (int j = blockIdx.x; j < 512; j += gridDim.x) {
      const int x = j & 7, a = j >> 3;
      outproj_tile(p, l, 2 * (a >> 1) + (x >> 2), 2 * (x & 3) + (a & 1), lds, -1);
    }
    if (blockIdx.x < 64) {
      const int j = 512 + (blockIdx.x >> 2), x = j & 7, a = j >> 3;
      outproj_tile(p, l, 2 * (a >> 1) + (x >> 2), 2 * (x & 3) + (a & 1), lds, blockIdx.x & 3);
    } else if (l < 3) {
      conv_weights(p, l + 1, lds, 1536 + ((int)blockIdx.x - 64), (int)gridDim.x - 64, 2128);
    }
    xcd_barrier(xb);
    ln_rows(p, l);
    if (l < 3) xcd_barrier(xb);
  }
}

extern "C" void kernel_launch(void* const* d_in, const int* in_sizes, int n_in, void* d_out, int out_size, void* d_ws, size_t ws_size,
                              hipStream_t stream) {
  static int grid = 0;
  if (grid == 0) {
    int dev = 0, cus = 0, per_cu = 0;
    hipGetDevice(&dev);
    hipDeviceGetAttribute(&cus, hipDeviceAttributeMultiprocessorCount, dev);
    if (hipFuncSetAttribute((const void*)mega, hipFuncAttributeMaxDynamicSharedMemorySize, LDS_BYTES) != hipSuccess) { fprintf(stderr, "hipFuncSetAttribute failed\n"); grid = -1; return; }
    hipOccupancyMaxActiveBlocksPerMultiprocessor(&per_cu, (const void*)mega, NTHREADS, LDS_BYTES);
    if (per_cu < 1) { fprintf(stderr, "occupancy query: %d\n", per_cu); grid = -1; return; }
    grid = cus * per_cu;
  }
  if (grid < 0) return;
  size_t off = 0;
  auto take = [&](size_t bytes) { size_t o = off; off += (bytes + 255) & ~(size_t)255; return (char*)d_ws + o; };
  Params p{};
  p.x = (const float*)d_in[0]; p.meta = (const float*)d_in[1]; p.ln0_g = (const float*)d_in[2]; p.ln0_b = (const float*)d_in[3];
  p.rel_bias = (const float*)d_in[4]; p.w_in = (const float*)d_in[5]; p.b_f = (const float*)d_in[6]; p.gq = (const float*)d_in[7];
  p.gkv = (const float*)d_in[8]; p.w_uq = (const float*)d_in[9]; p.w_ukv = (const float*)d_in[10]; p.sinks = (const float*)d_in[11];
  p.w_out = (const float*)d_in[12]; p.ln_g = (const float*)d_in[13]; p.ln_b = (const float*)d_in[14];
  p.out = (float*)d_out;
  p.ctr = (unsigned*)take(1024);
  p.bar = (unsigned*)take(XCD_BAR_WORDS * 4);
  p.Wt_in = (u16*)take((size_t)2 * NIN * DM * 2);
  p.Wt_out = (u16*)take((size_t)2 * DM * 2048 * 2);
  p.Wt_uq = (u16*)take((size_t)768 * 256 * 2);
  p.Wt_ukv = (u16*)take((size_t)1024 * 128 * 2);
  p.H = (u16*)take((size_t)MT * LDH * 2);
  p.Mix = (u16*)take((size_t)MT * 2048 * 2);
  p.Xb = p.Mix;
  p.VtA = (u16*)take((size_t)NB * 512 * PP * 2);
  p.VtD = (u16*)take((size_t)NB * 128 * PP * 2);
  p.R = (float*)take((size_t)MT * DM * 4);
  p.Y1 = (float*)take((size_t)3 * 512 * DM * 4);
  p.IDX = (u16*)take((size_t)MT * 256 * 2);
  p.IK = (u16*)take((size_t)MT * 64 * 2);
  p.Kpe = (u16*)take((size_t)MT * 32 * 2);
  p.IW = (float*)take((size_t)MT * 8 * 4);
  p.LOGF = (float*)take((size_t)NB * 8 * PP * 4);
  p.CUM = (float*)take((size_t)NB * 8 * PP * 4);
  p.ROPE = (float*)take((size_t)PP * 32 * 4);
  if (off > ws_size) { fprintf(stderr, "workspace too small: need %zu have %zu\n", off, ws_size); return; }
  {
    char* ob = (char*)d_out;
    p.Qm = (u16*)ob; ob += (size_t)MT * 768 * 2;
    p.Km = (u16*)ob; ob += (size_t)MT * 512 * 2;
    p.VtB = (u16*)ob; ob += (size_t)NB * 512 * PP * 2;
    if ((size_t)(ob - (char*)d_out) > (size_t)out_size * 4) { fprintf(stderr, "d_out too small for scratch\n"); return; }
  }
  hipMemsetAsync(p.ctr, 0, 1024 + XCD_BAR_WORDS * 4, stream);
  void* args[] = {&p};
  hipError_t e = hipLaunchCooperativeKernel((const void*)mega, dim3(grid), dim3(NTHREADS), args, LDS_BYTES, stream);
  if (e != hipSuccess) fprintf(stderr, "cooperative launch failed: %s (grid %d)\n", hipGetErrorString(e), grid);
}
```
